# Optimizing an MI355X kernel written in HIP

```python
import jax, jax.numpy as jnp
from jax import lax
import numpy as np

D_MODEL = 1024
BATCH = 4
SEQ = 4096
DEPTH = 2

GRID_W = 64
CTX_LEN = 256
D_MIX = D_MODEL
RMS_EPS = 1e-6
A_WIDTH = D_MIX // 4
A_HEADS = 4
A_HD = A_WIDTH // A_HEADS
A_CONV = 4
LRU_C = 8.0
A_COLS = 2 * A_WIDTH
B_WIDTH = D_MIX // 4
B_HD = 64
B_HEADS = B_WIDTH // B_HD
DECAY_RANK = 64
ICLR_RANK = 64
GATE_RANK = 64
GN_EPS = 64e-5
B_COLS = 3 * B_WIDTH + DECAY_RANK + ICLR_RANK + GATE_RANK
B_SPLITS = (B_WIDTH, 2 * B_WIDTH, 3 * B_WIDTH, 3 * B_WIDTH + DECAY_RANK,
            3 * B_WIDTH + DECAY_RANK + ICLR_RANK)
C_WIDTH = D_MIX // 2
C_HD = 64
C_HEADS = C_WIDTH // C_HD
WIN_H = 8
WIN_W = 16
C_COLS = 3 * C_WIDTH
IN_COLS = A_COLS + B_COLS + C_COLS
N_EXPERTS = 32
TOP_K = 4
D_FF = D_MODEL
SWIGLU_ALPHA = 1.702
SWIGLU_LIMIT = 7.0
MOE_BLOCK = 128

kernel_name = 'hybrid_lru_rwkv7_natten_moe_dit'


def _rmsnorm(x, g):
    xf = x.astype(jnp.float32)
    y = xf * lax.rsqrt(jnp.mean(xf * xf, axis=-1, keepdims=True) + RMS_EPS)
    return (y * g.astype(jnp.float32)).astype(x.dtype)


def _modulate(h, shift, scale):
    return h * (1 + scale) + shift


def _dir_conv(x, w, b, reverse):
    t = x.shape[1]
    kw = w.shape[0]
    if reverse:
        xp = jnp.pad(x, ((0, 0), (0, kw - 1), (0, 0)))
        taps = [xp[:, j:j + t] for j in range(kw)]
    else:
        xp = jnp.pad(x, ((0, 0), (kw - 1, 0), (0, 0)))
        taps = [xp[:, kw - 1 - j:kw - 1 - j + t] for j in range(kw)]
    return sum(w[j] * taps[j] for j in range(kw)) + b


def _lin_scan(a, b, h0, reverse):
    def combine(e1, e2):
        a1, b1 = e1
        a2, b2 = e2
        return a1 * a2, a2 * b1 + b2
    a_cum, h = lax.associative_scan(combine, (a, b), reverse=reverse, axis=1)
    return h + a_cum * h0[:, None, :]


def _rglru(xc, wr, br, wi, bi, lam, h0, reverse):
    bsz, t, _ = xc.shape
    xf = xc.astype(jnp.float32)
    xh = xf.reshape(bsz, t, A_HEADS, A_HD)
    gate_r = jax.nn.sigmoid(jnp.einsum('bthi,hij->bthj', xh, wr.astype(jnp.float32)).reshape(bsz, t, A_WIDTH) + br)
    gate_i = jax.nn.sigmoid(jnp.einsum('bthi,hij->bthj', xh, wi.astype(jnp.float32)).reshape(bsz, t, A_WIDTH) + bi)
    log_a = -LRU_C * gate_r * jax.nn.softplus(-lam.astype(jnp.float32))
    a = jnp.exp(log_a)
    b = jnp.sqrt(-jnp.expm1(2.0 * log_a)) * (gate_i * xf)
    return _lin_scan(a, b, h0, reverse)


def _lru_mixer(pc, pl, conv_w, conv_b, wr, br, wi, bi, lam, need_ctx_out):
    xc, gc = pc[..., :A_WIDTH], pc[..., A_WIDTH:]
    xl, gl = pl[..., :A_WIDTH], pl[..., A_WIDTH:]
    h0 = jnp.zeros((pc.shape[0], A_WIDTH), jnp.float32)
    hc_dirs, hl_dirs = [], []
    for d, rev in enumerate((False, True)):
        hc = _rglru(_dir_conv(xc, conv_w[d], conv_b[d], rev), wr[d], br[d], wi[d], bi[d], lam[d], h0, rev)
        h_end = hc[:, 0] if rev else hc[:, -1]
        hl = _rglru(_dir_conv(xl, conv_w[d], conv_b[d], rev), wr[d], br[d], wi[d], bi[d], lam[d], h_end, rev)
        hc_dirs.append(hc)
        hl_dirs.append(hl)
    out_l = (jax.nn.gelu(gl.astype(jnp.float32)) * (hl_dirs[0] + hl_dirs[1])).astype(pl.dtype)
    out_c = None
    if need_ctx_out:
        out_c = (jax.nn.gelu(gc.astype(jnp.float32)) * (hc_dirs[0] + hc_dirs[1])).astype(pc.dtype)
    return out_c, out_l


def _token_shift(p, mu):
    prev = jnp.pad(p[:, :-1], ((0, 0), (1, 0), (0, 0)))
    nxt = jnp.pad(p[:, 1:], ((0, 0), (0, 1), (0, 0)))
    return p + mu[0] * (prev - p) + mu[1] * (nxt - p)


def _heads(z):
    return z.reshape(z.shape[0], z.shape[1], B_HEADS, B_HD)


def _wkv7_scan(r, w, k, v, a_vec, b_vec, s0, reverse):
    def step(s, inp):
        r_t, w_t, k_t, v_t, a_t, b_t = inp
        sa = jnp.einsum('bhij,bhj->bhi', s, a_t)
        s = s * w_t[:, :, None, :] + sa[..., None] * b_t[:, :, None, :] + v_t[..., None] * k_t[:, :, None, :]
        return s, jnp.einsum('bhij,bhj->bhi', s, r_t)
    xs = tuple(jnp.moveaxis(z, 1, 0) for z in (r, w, k, v, a_vec, b_vec))
    s_end, ys = lax.scan(step, s0, xs, reverse=reverse)
    return jnp.moveaxis(ys, 0, 1), s_end


def _rwkv_dir(r, k, v, wlo, alo, w0, w2, a0, a2, k_k, k_a, s0, reverse):
    w = -jax.nn.softplus(-(w0 + jnp.tanh(wlo) @ w2)) - 0.5
    decay = jnp.exp(-jnp.exp(w))
    a = jax.nn.sigmoid(a0 + alo @ a2)
    kk = _heads(k * k_k)
    kk = kk / jnp.maximum(jnp.linalg.norm(kk, axis=-1, keepdims=True), 1e-12)
    k_eff = _heads(k * (1 + (a - 1) * k_a))
    y, s_end = _wkv7_scan(_heads(r), _heads(decay), k_eff, _heads(v), -kk, kk * _heads(a), s0, reverse)
    return y, s_end, k_eff


def _rwkv_finish(parts, outs, g2, r_k, lnx_g, lnx_b):
    r, v, glo = _heads(parts[0]), _heads(parts[2]), parts[5]
    y = outs[0][0] + outs[1][0]
    mean = jnp.mean(y, axis=-1, keepdims=True)
    var = jnp.mean(jnp.square(y - mean), axis=-1, keepdims=True)
    yn = (y - mean) * lax.rsqrt(var + GN_EPS)
    bonus = sum(jnp.sum(r * o[1] * r_k, axis=-1, keepdims=True) for o in outs)
    bsz, t = y.shape[:2]
    yn = yn.reshape(bsz, t, B_WIDTH) * lnx_g + lnx_b + (bonus * v).reshape(bsz, t, B_WIDTH)
    g = jax.nn.sigmoid(glo) @ g2
    return yn * g


def _rwkv_mixer(pc, pl, mu, w0, w2, a0, a2, g2, k_k, k_a, r_k, lnx_g, lnx_b, need_ctx_out):
    parts_c = jnp.split(_token_shift(pc, mu).astype(jnp.float32), B_SPLITS, axis=-1)
    parts_l = jnp.split(_token_shift(pl, mu).astype(jnp.float32), B_SPLITS, axis=-1)
    s0 = jnp.zeros((pc.shape[0], B_HEADS, B_HD, B_HD), jnp.float32)
    outs_c, outs_l = [], []
    for d, rev in enumerate((False, True)):
        yc, sc_end, kc_eff = _rwkv_dir(*parts_c[:5], w0[d], w2[d], a0[d], a2[d], k_k, k_a, s0, rev)
        yl, _, kl_eff = _rwkv_dir(*parts_l[:5], w0[d], w2[d], a0[d], a2[d], k_k, k_a, sc_end, rev)
        outs_c.append((yc, kc_eff))
        outs_l.append((yl, kl_eff))
    out_l = _rwkv_finish(parts_l, outs_l, g2, r_k, lnx_g, lnx_b).astype(pl.dtype)
    out_c = None
    if need_ctx_out:
        out_c = _rwkv_finish(parts_c, outs_c, g2, r_k, lnx_g, lnx_b).astype(pc.dtype)
    return out_c, out_l


def _na_mixer(pc, pl, rpb, need_ctx_out):
    bsz, ctx_len, _ = pc.shape
    seq = pl.shape[1]
    scale = C_HD ** -0.5
    qc, kc, vc = (z.reshape(bsz, ctx_len, C_HEADS, C_HD) for z in jnp.split(pc, 3, axis=-1))
    out_c = None
    if need_ctx_out:
        s = jnp.einsum('bqhd,bkhd->bhqk', qc * scale, kc).astype(jnp.float32)
        p = jax.nn.softmax(s, axis=-1).astype(vc.dtype)
        out_c = jnp.einsum('bhqk,bkhd->bqhd', p, vc).reshape(bsz, ctx_len, C_WIDTH)
    rows = seq // GRID_W
    kh = min(WIN_H, rows)
    n_win = kh * WIN_W
    qg, kg, vg = (z.reshape(bsz, rows, GRID_W, C_HEADS, C_HD) for z in jnp.split(pl, 3, axis=-1))
    col = jnp.arange(GRID_W)
    col_start = jnp.clip(col - WIN_W // 2, 0, GRID_W - WIN_W)
    cols = col_start[:, None] + jnp.arange(WIN_W)[None, :]
    col_bidx = cols - col[:, None] + (WIN_W - 1)

    def row_block(args):
        r, q_row = args
        rs = jnp.clip(r - kh // 2, 0, rows - kh)
        k_band = lax.dynamic_slice_in_dim(kg, rs, kh, axis=1)
        v_band = lax.dynamic_slice_in_dim(vg, rs, kh, axis=1)
        k_win = k_band[:, :, cols]
        v_win = v_band[:, :, cols]
        row_bidx = rs + jnp.arange(kh) - r + (WIN_H - 1)
        bias = rpb[:, row_bidx[:, None, None], col_bidx[None, :, :]]
        s_win = jnp.einsum('bqhd,biqjhd->bhqij', q_row * scale, k_win).astype(jnp.float32)
        s_win = s_win + jnp.transpose(bias, (0, 2, 1, 3))[None].astype(jnp.float32)
        s_ctx = jnp.einsum('bqhd,bkhd->bhqk', q_row * scale, kc).astype(jnp.float32)
        s = jnp.concatenate([s_win.reshape(bsz, C_HEADS, GRID_W, n_win), s_ctx], axis=-1)
        p = jax.nn.softmax(s, axis=-1).astype(vc.dtype)
        p_win = p[..., :n_win].reshape(bsz, C_HEADS, GRID_W, kh, WIN_W)
        p_ctx = p[..., n_win:]
        return (jnp.einsum('bhqij,biqjhd->bqhd', p_win, v_win)
                + jnp.einsum('bhqk,bkhd->bqhd', p_ctx, vc))

    out = lax.map(row_block, (jnp.arange(rows), jnp.moveaxis(qg, 1, 0)))
    out_l = jnp.moveaxis(out, 0, 1).reshape(bsz, seq, C_WIDTH)
    return out_c, out_l


def _moe(h, router_w, router_b, w_gu, b_gu, w_dn, b_dn):
    n, d = h.shape
    logits = (h @ router_w + router_b).astype(jnp.float32)
    top_val, top_idx = lax.top_k(logits, TOP_K)
    gate = jax.nn.softmax(top_val, axis=-1)
    n_assign = n * TOP_K
    flat_e = top_idx.reshape(-1).astype(jnp.int32)
    flat_tok = jnp.arange(n_assign, dtype=jnp.int32) // TOP_K
    flat_gate = gate.reshape(-1)
    order = jnp.argsort(flat_e)
    e_sorted = flat_e[order]
    counts = jnp.bincount(flat_e, length=N_EXPERTS)
    padded = (counts + MOE_BLOCK - 1) // MOE_BLOCK * MOE_BLOCK
    pad_end = jnp.cumsum(padded)
    pad_start = pad_end - padded
    start = jnp.cumsum(counts) - counts
    dest = pad_start[e_sorted] + jnp.arange(n_assign, dtype=jnp.int32) - start[e_sorted]
    n_blocks = (n_assign + N_EXPERTS * (MOE_BLOCK - 1) + MOE_BLOCK - 1) // MOE_BLOCK
    cap = n_blocks * MOE_BLOCK
    slot_tok = jnp.full((cap,), n, dtype=jnp.int32).at[dest].set(flat_tok[order])
    slot_gate = jnp.zeros((cap,), jnp.float32).at[dest].set(flat_gate[order])
    block_e = jnp.minimum(jnp.searchsorted(pad_end, jnp.arange(n_blocks, dtype=jnp.int32) * MOE_BLOCK, side='right'),
                          N_EXPERTS - 1)
    h_pad = jnp.concatenate([h, jnp.zeros((1, d), h.dtype)], axis=0)
    xb = h_pad[slot_tok].reshape(n_blocks, MOE_BLOCK, d)

    def expert_block(args):
        xblk, e = args
        gu = xblk @ w_gu[e] + b_gu[e]
        g_, u_ = gu[:, :D_FF], gu[:, D_FF:]
        g_ = jnp.minimum(g_, SWIGLU_LIMIT)
        u_ = jnp.clip(u_, -SWIGLU_LIMIT, SWIGLU_LIMIT)
        act = (u_ + 1) * (g_ * jax.nn.sigmoid(SWIGLU_ALPHA * g_))
        return act @ w_dn[e] + b_dn[e]

    yb = lax.map(expert_block, (xb, block_e)).reshape(cap, d)
    out = jnp.zeros((n + 1, d), yb.dtype).at[slot_tok].add(yb * slot_gate[:, None].astype(yb.dtype))
    return out[:n]


def setup_inputs(seed: int = 0) -> dict:
    key = jax.random.key(seed)
    keys = iter(jax.random.split(key, 40))

    def nrm(shape, scale):
        return jax.random.normal(next(keys), shape, jnp.float32) * scale

    def unif(shape, lo, hi):
        return jax.random.uniform(next(keys), shape, jnp.float32, lo, hi)

    L = DEPTH
    a_init = unif((L, 2, A_WIDTH), 0.9, 0.999)
    return {
        'x': nrm((BATCH, SEQ, D_MODEL), 1.0),
        'c': nrm((BATCH, D_MODEL), 1.0),
        'ctx': nrm((BATCH, CTX_LEN, D_MODEL), 1.0),
        'c_ctx': nrm((D_MODEL,), 1.0),
        'ada_w': nrm((L, D_MODEL, 6 * D_MODEL), 0.5 * D_MODEL ** -0.5),
        'ada_b': nrm((L, 6 * D_MODEL), 0.02),
        'norm_mix_g': 1.0 + nrm((L, D_MODEL), 0.1),
        'norm_ffn_g': 1.0 + nrm((L, D_MODEL), 0.1),
        'w_in': nrm((L, D_MODEL, IN_COLS), D_MODEL ** -0.5),
        'w_out': nrm((L, D_MIX, D_MODEL), D_MIX ** -0.5),
        'lru_conv_w': nrm((L, 2, A_CONV, A_WIDTH), A_CONV ** -0.5),
        'lru_conv_b': nrm((L, 2, A_WIDTH), 0.02),
        'lru_wr': nrm((L, 2, A_HEADS, A_HD, A_HD), A_HD ** -0.5),
        'lru_br': nrm((L, 2, A_WIDTH), 0.1),
        'lru_wi': nrm((L, 2, A_HEADS, A_HD, A_HD), A_HD ** -0.5),
        'lru_bi': nrm((L, 2, A_WIDTH), 0.1),
        'lru_lambda': jnp.log(a_init) - jnp.log1p(-a_init),
        'rwkv_mu': unif((L, 2, B_COLS), 0.0, 0.5),
        'rwkv_w0': unif((L, 2, B_WIDTH), -6.0, -1.0),
        'rwkv_w2': nrm((L, 2, DECAY_RANK, B_WIDTH), 0.5 * DECAY_RANK ** -0.5),
        'rwkv_a0': nrm((L, 2, B_WIDTH), 0.3),
        'rwkv_a2': nrm((L, 2, ICLR_RANK, B_WIDTH), 0.5 * ICLR_RANK ** -0.5),
        'rwkv_g2': nrm((L, GATE_RANK, B_WIDTH), GATE_RANK ** -0.5),
        'rwkv_kk': 0.85 + nrm((L, B_WIDTH), 0.05),
        'rwkv_ka': 1.0 + nrm((L, B_WIDTH), 0.05),
        'rwkv_rk': nrm((L, B_HEADS, B_HD), 0.1),
        'rwkv_lnx_g': 1.0 + nrm((L, B_WIDTH), 0.1),
        'rwkv_lnx_b': nrm((L, B_WIDTH), 0.02),
        'na_rpb': nrm((L, C_HEADS, 2 * WIN_H - 1, 2 * WIN_W - 1), 0.2),
        'router_w': nrm((L, D_MODEL, N_EXPERTS), D_MODEL ** -0.5),
        'router_b': nrm((L, N_EXPERTS), 0.01),
        'moe_w_gu': nrm((L, N_EXPERTS, D_MODEL, 2 * D_FF), D_MODEL ** -0.5),
        'moe_b_gu': nrm((L, N_EXPERTS, 2 * D_FF), 0.02),
        'moe_w_dn': nrm((L, N_EXPERTS, D_FF, D_MODEL), D_FF ** -0.5),
        'moe_b_dn': nrm((L, N_EXPERTS, D_MODEL), 0.02),
        'final_g': 1.0 + nrm((D_MODEL,), 0.1),
    }


def reference(x, c, ctx, c_ctx, ada_w, ada_b, norm_mix_g, norm_ffn_g, w_in, w_out,
              lru_conv_w, lru_conv_b, lru_wr, lru_br, lru_wi, lru_bi, lru_lambda,
              rwkv_mu, rwkv_w0, rwkv_w2, rwkv_a0, rwkv_a2, rwkv_g2, rwkv_kk, rwkv_ka, rwkv_rk,
              rwkv_lnx_g, rwkv_lnx_b, na_rpb, router_w, router_b, moe_w_gu, moe_b_gu,
              moe_w_dn, moe_b_dn, final_g):
    bsz, seq, d = x.shape
    ctx_len = ctx.shape[1]
    cond_lat = jax.nn.silu(c)[:, None, :]
    cond_ctx = jax.nn.silu(c_ctx)[None, None, :]
    xl, xc = x, ctx
    for l in range(DEPTH):
        last = l == DEPTH - 1
        mod_l = jnp.split(cond_lat @ ada_w[l] + ada_b[l], 6, axis=-1)
        mod_c = jnp.split(cond_ctx @ ada_w[l] + ada_b[l], 6, axis=-1)
        hl = _modulate(_rmsnorm(xl, norm_mix_g[l]), mod_l[0], mod_l[1])
        hc = _modulate(_rmsnorm(xc, norm_mix_g[l]), mod_c[0], mod_c[1])
        pl = hl @ w_in[l]
        pc = hc @ w_in[l]
        pl_a, pl_b, pl_c = jnp.split(pl, [A_COLS, A_COLS + B_COLS], axis=-1)
        pc_a, pc_b, pc_c = jnp.split(pc, [A_COLS, A_COLS + B_COLS], axis=-1)
        need_ctx = not last
        ya_c, ya_l = _lru_mixer(pc_a, pl_a, lru_conv_w[l], lru_conv_b[l], lru_wr[l], lru_br[l],
                                lru_wi[l], lru_bi[l], lru_lambda[l], need_ctx)
        yb_c, yb_l = _rwkv_mixer(pc_b, pl_b, rwkv_mu[l], rwkv_w0[l], rwkv_w2[l], rwkv_a0[l], rwkv_a2[l],
                                 rwkv_g2[l], rwkv_kk[l], rwkv_ka[l], rwkv_rk[l], rwkv_lnx_g[l],
                                 rwkv_lnx_b[l], need_ctx)
        yc_c, yc_l = _na_mixer(pc_c, pl_c, na_rpb[l], need_ctx)
        xl = xl + mod_l[2] * (jnp.concatenate([ya_l, yb_l, yc_l], axis=-1) @ w_out[l])
        hl = _modulate(_rmsnorm(xl, norm_ffn_g[l]), mod_l[3], mod_l[4])
        if last:
            yl = _moe(hl.reshape(-1, d), router_w[l], router_b[l], moe_w_gu[l], moe_b_gu[l],
                      moe_w_dn[l], moe_b_dn[l])
        else:
            xc = xc + mod_c[2] * (jnp.concatenate([ya_c, yb_c, yc_c], axis=-1) @ w_out[l])
            hc = _modulate(_rmsnorm(xc, norm_ffn_g[l]), mod_c[3], mod_c[4])
            tok = jnp.concatenate([hc.reshape(-1, d), hl.reshape(-1, d)], axis=0)
            y = _moe(tok, router_w[l], router_b[l], moe_w_gu[l], moe_b_gu[l], moe_w_dn[l], moe_b_dn[l])
            xc = xc + mod_c[5] * y[:bsz * ctx_len].reshape(bsz, ctx_len, d)
            yl = y[bsz * ctx_len:]
        xl = xl + mod_l[5] * yl.reshape(bsz, seq, d)
    return _rmsnorm(xl, final_g)
```

```cpp
#include <hip/hip_runtime.h>
#include <stdint.h>

#define DM 1024
#define NBATCH 4
#define SEQ 4096
#define CTXL 256
#define TPB 4352
#define NROW 17408
#define INC 3008
#define NEXP 32
#define MOE_TM 64
#define CAP (NROW * 4 + NEXP * MOE_TM)
#define MAXTILES (CAP / MOE_TM)

enum { I_X = 0, I_C, I_CTX, I_CCTX, I_ADAW, I_ADAB, I_NMG, I_NFG, I_WIN, I_WOUT, I_CONVW, I_CONVB, I_WR, I_BR, I_WI, I_BI,
       I_LAM, I_MU, I_W0, I_W2, I_A0, I_A2, I_G2, I_KK, I_KA, I_RK, I_LNG, I_LNB, I_RPB, I_RTW, I_RTB, I_WGU, I_BGU, I_WDN,
       I_BDN, I_FING, N_IN };

struct Params {
    const float* in[N_IN];
    float* out;
    float* X;
    float* H;
    float* P;
    float* MIX;
    float* SC;
    float* MOD;
    float* LA;
    float* LB;
    float* LH;
    float* RS;
    float* DEC;
    float* AIC;
    float* KKN;
    float* GG;
    float* YB;
    float* TOPG;
    int* TOPI;
    int* TOKPOS;
    int* CNT;
    int* OFF;
    int* TILE_E;
    int* NTILE;
    int* SLOT_TOK;
    float* GU;
    float* ACT;
    float* Y;
};

__device__ __forceinline__ float sigmoidf_(float x) { return 1.f / (1.f + __expf(-x)); }
__device__ __forceinline__ float softplusf_(float x) { return x > 20.f ? x : log1pf(__expf(x)); }
__device__ __forceinline__ float wave_sum(float v) {
#pragma unroll
    for (int o = 32; o > 0; o >>= 1) v += __shfl_xor(v, o);
    return v;
}
__device__ __forceinline__ float wave_max(float v) {
#pragma unroll
    for (int o = 32; o > 0; o >>= 1) v = fmaxf(v, __shfl_xor(v, o));
    return v;
}

__global__ void k_prologue(Params p) {
    const int gtid = blockIdx.x * blockDim.x + threadIdx.x, gsz = gridDim.x * blockDim.x;
    const float4* x4 = (const float4*)p.in[I_X];
    const float4* c4 = (const float4*)p.in[I_CTX];
    float4* X4 = (float4*)p.X;
    for (int i = gtid; i < NROW * 256; i += gsz) {
        int R = i >> 8, q = i & 255, b = R / TPB, pos = R % TPB;
        X4[i] = pos < CTXL ? c4[(b * CTXL + pos) * 256 + q] : x4[((size_t)b * SEQ + (pos - CTXL)) * 256 + q];
    }
    for (int i = gtid; i < 5 * DM; i += gsz) {
        int r = i / DM, d = i % DM;
        float v = r < 4 ? p.in[I_C][r * DM + d] : p.in[I_CCTX][d];
        p.SC[i] = v * sigmoidf_(v);
    }
    if (gtid < 64) p.CNT[gtid] = 0;
}

__global__ void k_ada(Params p) {
    const int gtid = blockIdx.x * blockDim.x + threadIdx.x;
    if (gtid >= 2 * 6144) return;
    const int l = gtid / 6144, n = gtid % 6144;
    const float* W = p.in[I_ADAW] + (size_t)l * DM * 6144 + n;
    float acc[5] = {0, 0, 0, 0, 0};
    for (int k = 0; k < DM; ++k) {
        float w = W[(size_t)k * 6144];
#pragma unroll
        for (int r = 0; r < 5; ++r) acc[r] += p.SC[r * DM + k] * w;
    }
    float bb = p.in[I_ADAB][l * 6144 + n];
#pragma unroll
    for (int r = 0; r < 5; ++r) p.MOD[(l * 5 + r) * 6144 + n] = acc[r] + bb;
}

__global__ void k_norm_mod(Params p, int l, int which) {
    const int wid = (blockIdx.x * blockDim.x + threadIdx.x) >> 6, lane = threadIdx.x & 63, nw = (gridDim.x * blockDim.x) >> 6;
    const float* g = (which == 0 ? p.in[I_NMG] : p.in[I_NFG]) + l * DM;
    for (int R = wid; R < NROW; R += nw) {
        const int b = R / TPB, pos = R % TPB, mr = pos < CTXL ? 4 : b;
        const float* mod = p.MOD + (l * 5 + mr) * 6144 + (which == 0 ? 0 : 3 * DM);
        const float4* xr = (const float4*)(p.X + (size_t)R * DM);
        float4 v[4]; float ss = 0.f;
#pragma unroll
        for (int i = 0; i < 4; ++i) { v[i] = xr[lane + 64 * i]; ss += v[i].x * v[i].x + v[i].y * v[i].y + v[i].z * v[i].z + v[i].w * v[i].w; }
        ss = wave_sum(ss);
        const float rinv = rsqrtf(ss * (1.f / DM) + 1e-6f);
        float4* hr = (float4*)(p.H + (size_t)R * DM);
#pragma unroll
        for (int i = 0; i < 4; ++i) {
            const int c = (lane + 64 * i) * 4;
            const float4 gg = *(const float4*)(g + c), sh = *(const float4*)(mod + c), sc = *(const float4*)(mod + DM + c);
            float4 o;
            o.x = v[i].x * rinv * gg.x * (1.f + sc.x) + sh.x; o.y = v[i].y * rinv * gg.y * (1.f + sc.y) + sh.y;
            o.z = v[i].z * rinv * gg.z * (1.f + sc.z) + sh.z; o.w = v[i].w * rinv * gg.w * (1.f + sc.w) + sh.w;
            hr[lane + 64 * i] = o;
        }
    }
}

template <class TileFn, class Epi>
__device__ __forceinline__ void gemm_tiles_f32(int ntiles, int K, TileFn tf, Epi epi) {
    __shared__ float As[16][68];
    __shared__ float Bs[16][68];
    const int tid = threadIdx.x, tx = tid & 15, ty = tid >> 4;
    for (int t = blockIdx.x; t < ntiles; t += gridDim.x) {
        const float* A; const float* B; int lda, ldb, crow0, ccol0; const int* arow;
        tf(t, A, lda, arow, B, ldb, crow0, ccol0);
        float acc[4][4];
#pragma unroll
        for (int i = 0; i < 4; ++i)
#pragma unroll
            for (int j = 0; j < 4; ++j) acc[i][j] = 0.f;
        const int am = tid >> 2, ak = (tid & 3) * 4;
        const float* arp = A + (size_t)(arow ? arow[am] : am) * lda + ak;
        const int bk = tid >> 4, bn = (tid & 15) * 4;
        const float* brp = B + (size_t)bk * ldb + bn;
        for (int k0 = 0; k0 < K; k0 += 16) {
            const float4 av = *(const float4*)(arp + k0);
            const float4 bv = *(const float4*)(brp + (size_t)k0 * ldb);
            __syncthreads();
            As[ak + 0][am] = av.x; As[ak + 1][am] = av.y; As[ak + 2][am] = av.z; As[ak + 3][am] = av.w;
            *(float4*)&Bs[bk][bn] = bv;
            __syncthreads();
#pragma unroll
            for (int k = 0; k < 16; ++k) {
                const float4 a = *(const float4*)&As[k][ty * 4];
                const float4 b = *(const float4*)&Bs[k][tx * 4];
                const float aa[4] = {a.x, a.y, a.z, a.w}, bb[4] = {b.x, b.y, b.z, b.w};
#pragma unroll
                for (int i = 0; i < 4; ++i)
#pragma unroll
                    for (int j = 0; j < 4; ++j) acc[i][j] += aa[i] * bb[j];
            }
        }
#pragma unroll
        for (int i = 0; i < 4; ++i)
#pragma unroll
            for (int j = 0; j < 4; ++j) epi(crow0 + ty * 4 + i, ccol0 + tx * 4 + j, acc[i][j]);
    }
}

__global__ void __launch_bounds__(256) k_gemm_in(Params p, int l) {
    const float* W = p.in[I_WIN] + (size_t)l * DM * INC;
    const int tn = INC / 64;
    gemm_tiles_f32((NROW / 64) * tn, DM,
        [&](int t, const float*& A, int& lda, const int*& arow, const float*& B, int& ldb, int& r0, int& c0) {
            r0 = (t / tn) * 64; c0 = (t % tn) * 64; A = p.H + (size_t)r0 * DM; lda = DM; arow = nullptr; B = W + c0; ldb = INC; },
        [&](int r, int c, float v) { p.P[(size_t)r * INC + c] = v; });
}
__global__ void __launch_bounds__(256) k_gemm_out(Params p, int l, int skip_ctx) {
    const float* W = p.in[I_WOUT] + (size_t)l * DM * DM;
    const int tn = DM / 64;
    gemm_tiles_f32((NROW / 64) * tn, DM,
        [&](int t, const float*& A, int& lda, const int*& arow, const float*& B, int& ldb, int& r0, int& c0) {
            r0 = (t / tn) * 64; c0 = (t % tn) * 64; A = p.MIX + (size_t)r0 * DM; lda = DM; arow = nullptr; B = W + c0; ldb = DM; },
        [&](int r, int c, float v) {
            const int b = r / TPB, pos = r % TPB, mr = pos < CTXL ? 4 : b;
            if (skip_ctx && pos < CTXL) return;
            p.X[(size_t)r * DM + c] += p.MOD[(l * 5 + mr) * 6144 + 2 * DM + c] * v; });
}

__global__ void __launch_bounds__(256) k_lru_pre(Params p, int l) {
    __shared__ float xc[256];
    const int c = threadIdx.x;
    for (int it = blockIdx.x; it < 2 * NROW; it += gridDim.x) {
        const int d = it / NROW, R = it % NROW, pos = R % TPB;
        const int seg0 = pos < CTXL ? 0 : CTXL, seg1 = pos < CTXL ? CTXL : TPB;
        const float* cw = p.in[I_CONVW] + ((l * 2 + d) * 4) * 256;
        float acc = p.in[I_CONVB][(l * 2 + d) * 256 + c];
#pragma unroll
        for (int j = 0; j < 4; ++j) {
            const int q = d == 0 ? pos - j : pos + j;
            if (q >= seg0 && q < seg1) acc += cw[j * 256 + c] * p.P[(size_t)(R + (q - pos)) * INC + c];
        }
        __syncthreads();
        xc[c] = acc;
        __syncthreads();
        const int h = c >> 6, j = c & 63;
        const float* wr = p.in[I_WR] + (size_t)((l * 2 + d) * 4 + h) * 4096 + j;
        const float* wi = p.in[I_WI] + (size_t)((l * 2 + d) * 4 + h) * 4096 + j;
        float gr = p.in[I_BR][(l * 2 + d) * 256 + c], gi = p.in[I_BI][(l * 2 + d) * 256 + c];
#pragma unroll 8
        for (int i = 0; i < 64; ++i) { const float xv = xc[h * 64 + i]; gr += xv * wr[i * 64]; gi += xv * wi[i * 64]; }
        gr = sigmoidf_(gr); gi = sigmoidf_(gi);
        const float lam = p.in[I_LAM][(l * 2 + d) * 256 + c];
        const float log_a = -8.0f * gr * softplusf_(-lam);
        const float a = __expf(log_a);
        const float bb = sqrtf(fmaxf(-expm1f(2.f * log_a), 0.f)) * (gi * acc);
        p.LA[((size_t)d * NROW + R) * 256 + c] = a;
        p.LB[((size_t)d * NROW + R) * 256 + c] = bb;
    }
}
__global__ void __launch_bounds__(256) k_lru_scan(Params p) {
    const int gt = blockIdx.x * blockDim.x + threadIdx.x;
    if (gt >= NBATCH * 2 * 256) return;
    const int c = gt & 255, d = (gt >> 8) & 1, b = gt >> 9;
    const float* la = p.LA + ((size_t)d * NROW + (size_t)b * TPB) * 256 + c;
    const float* lb = p.LB + ((size_t)d * NROW + (size_t)b * TPB) * 256 + c;
    float* lh = p.LH + ((size_t)d * NROW + (size_t)b * TPB) * 256 + c;
    float h = 0.f;
    for (int s0 = 0; s0 < TPB; s0 += 16) {
        float av[16], bv[16]; int ps[16];
#pragma unroll
        for (int u = 0; u < 16; ++u) {
            const int s = s0 + u;
            ps[u] = d == 0 ? s : (s < CTXL ? CTXL - 1 - s : TPB - 1 - (s - CTXL));
            av[u] = la[(size_t)ps[u] * 256]; bv[u] = lb[(size_t)ps[u] * 256];
        }
#pragma unroll
        for (int u = 0; u < 16; ++u) { h = av[u] * h + bv[u]; lh[(size_t)ps[u] * 256] = h; }
    }
}
__device__ __forceinline__ float gelu_tanh(float x) {
    const float u = 0.7978845608028654f * (x + 0.044715f * x * x * x);
    return 0.5f * x * (1.f + tanhf(u));
}
__global__ void k_lru_finish(Params p) {
    const int gtid = blockIdx.x * blockDim.x + threadIdx.x, gsz = gridDim.x * blockDim.x;
    for (int i = gtid; i < NROW * 256; i += gsz) {
        const int R = i >> 8, c = i & 255;
        const float g = p.P[(size_t)R * INC + 256 + c];
        p.MIX[(size_t)R * DM + c] = gelu_tanh(g) * (p.LH[(size_t)R * 256 + c] + p.LH[((size_t)NROW + R) * 256 + c]);
    }
}

__global__ void k_rwkv_shift(Params p, int l) {
    const int gtid = blockIdx.x * blockDim.x + threadIdx.x, gsz = gridDim.x * blockDim.x;
    const float* mu = p.in[I_MU] + l * 2 * 960;
    for (int i = gtid; i < NROW * 960; i += gsz) {
        const int R = i / 960, col = i % 960, pos = R % TPB;
        const int seg0 = pos < CTXL ? 0 : CTXL, seg1 = pos < CTXL ? CTXL : TPB;
        const float v = p.P[(size_t)R * INC + 512 + col];
        const float pv = pos > seg0 ? p.P[(size_t)(R - 1) * INC + 512 + col] : 0.f;
        const float nv = pos + 1 < seg1 ? p.P[(size_t)(R + 1) * INC + 512 + col] : 0.f;
        p.RS[i] = v + mu[col] * (pv - v) + mu[960 + col] * (nv - v);
    }
}
__global__ void __launch_bounds__(256) k_rwkv_pre(Params p, int l) {
    __shared__ float tw[64], al[64], sg[64];
    const int c = threadIdx.x;
    for (int R = blockIdx.x; R < NROW; R += gridDim.x) {
        const float* rs = p.RS + (size_t)R * 960;
        __syncthreads();
        if (c < 64) tw[c] = tanhf(rs[768 + c]);
        else if (c < 128) al[c - 64] = rs[832 + c - 64];
        else if (c < 192) sg[c - 128] = sigmoidf_(rs[896 + c - 128]);
        __syncthreads();
#pragma unroll 1
        for (int d = 0; d < 2; ++d) {
            const float* w2 = p.in[I_W2] + (size_t)(l * 2 + d) * 64 * 256 + c;
            const float* a2 = p.in[I_A2] + (size_t)(l * 2 + d) * 64 * 256 + c;
            float wl = p.in[I_W0][(l * 2 + d) * 256 + c], aa = p.in[I_A0][(l * 2 + d) * 256 + c];
#pragma unroll 8
            for (int i = 0; i < 64; ++i) { wl += tw[i] * w2[i * 256]; aa += al[i] * a2[i * 256]; }
            const float w = -softplusf_(-wl) - 0.5f;
            p.DEC[((size_t)d * NROW + R) * 256 + c] = __expf(-__expf(w));
            p.AIC[((size_t)d * NROW + R) * 256 + c] = sigmoidf_(aa);
        }
        const float* g2 = p.in[I_G2] + (size_t)l * 64 * 256 + c;
        float g = 0.f;
#pragma unroll 8
        for (int i = 0; i < 64; ++i) g += sg[i] * g2[i * 256];
        p.GG[(size_t)R * 256 + c] = g;
        const float kk = rs[256 + c] * p.in[I_KK][l * 256 + c];
        const float n2 = wave_sum(kk * kk);
        p.KKN[(size_t)R * 256 + c] = kk / fmaxf(sqrtf(n2), 1e-12f);
    }
}
__global__ void __launch_bounds__(64) k_rwkv_scan(Params p, int l) {
    const int bid = blockIdx.x;
    const int d = bid & 1, h = (bid >> 1) & 3, b = bid >> 3;
    const int lane = threadIdx.x;
    const int c = h * 64 + lane;
    const float ka = p.in[I_KA][l * 256 + c];
    float S[64];
#pragma unroll
    for (int j = 0; j < 64; ++j) S[j] = 0.f;
    for (int s = 0; s < TPB; ++s) {
        const int pos = d == 0 ? s : (s < CTXL ? CTXL - 1 - s : TPB - 1 - (s - CTXL));
        const size_t R = (size_t)b * TPB + pos;
        const float* rs = p.RS + R * 960;
        const float r = rs[c], k = rs[256 + c], v = rs[512 + c];
        const float w = p.DEC[((size_t)d * NROW + R) * 256 + c];
        const float a = p.AIC[((size_t)d * NROW + R) * 256 + c];
        const float kkn = p.KKN[R * 256 + c];
        const float av = -kkn, bv = kkn * a, ke = k * (1.f + (a - 1.f) * ka);
        float sa = 0.f;
#pragma unroll
        for (int j = 0; j < 64; ++j) sa += S[j] * __shfl(av, j);
        float y = 0.f;
#pragma unroll
        for (int j = 0; j < 64; ++j) {
            S[j] = S[j] * __shfl(w, j) + sa * __shfl(bv, j) + v * __shfl(ke, j);
            y += S[j] * __shfl(r, j);
        }
        p.YB[((size_t)d * NROW + R) * 256 + c] = y;
    }
}
__global__ void __launch_bounds__(256) k_rwkv_finish(Params p, int l) {
    const int c = threadIdx.x, h = c >> 6;
    for (int R = blockIdx.x; R < NROW; R += gridDim.x) {
        const float* rs = p.RS + (size_t)R * 960;
        const float r = rs[c], k = rs[256 + c], v = rs[512 + c];
        const float y = p.YB[(size_t)R * 256 + c] + p.YB[((size_t)NROW + R) * 256 + c];
        const float mean = wave_sum(y) * (1.f / 64.f);
        const float dv = y - mean;
        const float var = wave_sum(dv * dv) * (1.f / 64.f);
        const float yn = dv * rsqrtf(var + 64e-5f);
        const float ka = p.in[I_KA][l * 256 + c], rk = p.in[I_RK][l * 256 + c];
        float bon = 0.f;
#pragma unroll
        for (int d = 0; d < 2; ++d) {
            const float a = p.AIC[((size_t)d * NROW + R) * 256 + c];
            bon += r * (k * (1.f + (a - 1.f) * ka)) * rk;
        }
        bon = wave_sum(bon);
        const float o = (yn * p.in[I_LNG][l * 256 + c] + p.in[I_LNB][l * 256 + c] + bon * v) * p.GG[(size_t)R * 256 + c];
        p.MIX[(size_t)R * DM + 256 + c] = o;
        (void)h;
    }
}

__global__ void __launch_bounds__(256) k_na(Params p, int l, int do_ctx) {
    __shared__ float qs[4][64];
    __shared__ float pw[4][384];
    const int w = threadIdx.x >> 6, lane = threadIdx.x & 63;
    const int gw = blockIdx.x * 4 + w, nw = gridDim.x * 4;
    const float* rpb = p.in[I_RPB] + (size_t)l * 8 * 15 * 31;
    for (int it = gw; it < NROW * 8; it += nw) {
        const int R = it >> 3, h = it & 7, b = R / TPB, pos = R % TPB;
        if (pos < CTXL && !do_ctx) continue;
        const size_t rb = (size_t)b * TPB;
        qs[w][lane] = p.P[(size_t)R * INC + 1472 + h * 64 + lane] * 0.125f;
        __builtin_amdgcn_wave_barrier();
        const bool lat = pos >= CTXL;
        int r = 0, cc = 0, rs_ = 0, cs = 0;
        if (lat) { const int t = pos - CTXL; r = t >> 6; cc = t & 63; rs_ = min(max(r - 4, 0), 56); cs = min(max(cc - 8, 0), 48); }
        const int nk = lat ? 384 : 256;
        float sc[6];
        float mx = -1e30f;
#pragma unroll
        for (int m = 0; m < 6; ++m) {
            const int n = lane + 64 * m;
            sc[m] = -1e30f;
            if (n < nk) {
                int kpos; float bias = 0.f;
                if (lat && n < 128) { const int i = n >> 4, j = n & 15; kpos = CTXL + (rs_ + i) * 64 + cs + j; bias = rpb[(h * 15 + (rs_ + i - r + 7)) * 31 + (cs + j - cc + 15)]; }
                else kpos = lat ? n - 128 : n;
                const float4* kr = (const float4*)(p.P + (rb + kpos) * INC + 1472 + 512 + h * 64);
                float acc = 0.f;
#pragma unroll
                for (int q = 0; q < 16; ++q) { const float4 kv = kr[q]; const float4 qv = *(const float4*)&qs[w][q * 4]; acc += kv.x * qv.x + kv.y * qv.y + kv.z * qv.z + kv.w * qv.w; }
                sc[m] = acc + bias;
            }
            mx = fmaxf(mx, sc[m]);
        }
        mx = wave_max(mx);
        float sum = 0.f;
#pragma unroll
        for (int m = 0; m < 6; ++m) { const int n = lane + 64 * m; float e = n < nk ? __expf(sc[m] - mx) : 0.f; sum += e; pw[w][n] = e; }
        sum = wave_sum(sum);
        __builtin_amdgcn_wave_barrier();
        float acc = 0.f;
        for (int n = 0; n < nk; ++n) {
            int kpos;
            if (lat && n < 128) kpos = CTXL + (rs_ + (n >> 4)) * 64 + cs + (n & 15); else kpos = lat ? n - 128 : n;
            acc += pw[w][n] * p.P[(rb + kpos) * INC + 1472 + 1024 + h * 64 + lane];
        }
        p.MIX[(size_t)R * DM + 512 + h * 64 + lane] = acc / sum;
        __builtin_amdgcn_wave_barrier();
    }
}

__global__ void __launch_bounds__(256) k_router(Params p, int l, int skip_ctx) {
    const int gw = (blockIdx.x * blockDim.x + threadIdx.x) >> 6, lane = threadIdx.x & 63, nw = (gridDim.x * blockDim.x) >> 6;
    const float* rw = p.in[I_RTW] + (size_t)l * DM * 32;
    const int e = lane & 31, half = lane >> 5;
    for (int R = gw; R < NROW; R += nw) {
        if (skip_ctx && (R % TPB) < CTXL) continue;
        const float* hr = p.H + (size_t)R * DM;
        float acc = 0.f;
        for (int k = half * 512; k < half * 512 + 512; ++k) acc += hr[k] * rw[k * 32 + e];
        acc += __shfl_xor(acc, 32);
        float v = acc + p.in[I_RTB][l * 32 + e];
        if (lane >= 32) v = -3e38f;
        float tv[4]; int ti[4];
#pragma unroll
        for (int k = 0; k < 4; ++k) {
            const float m = wave_max(v);
            const unsigned long long bal = __ballot(v == m);
            const int idx = __ffsll((long long)bal) - 1;
            tv[k] = m; ti[k] = idx;
            if (lane == idx) v = -3e38f;
        }
        if (lane == 0) {
            float e0 = 1.f, e1 = __expf(tv[1] - tv[0]), e2 = __expf(tv[2] - tv[0]), e3 = __expf(tv[3] - tv[0]);
            const float inv = 1.f / (e0 + e1 + e2 + e3);
            const float gs[4] = {e0 * inv, e1 * inv, e2 * inv, e3 * inv};
#pragma unroll
            for (int k = 0; k < 4; ++k) {
                p.TOPG[R * 4 + k] = gs[k]; p.TOPI[R * 4 + k] = ti[k];
                p.TOKPOS[R * 4 + k] = atomicAdd(&p.CNT[ti[k]], 1);
            }
        }
    }
}
__global__ void k_moe_offsets(Params p) {
    if (blockIdx.x == 0 && threadIdx.x == 0) {
        int off = 0, nt = 0;
        for (int e = 0; e < NEXP; ++e) {
            p.OFF[e] = off;
            const int n = (p.CNT[e] + MOE_TM - 1) / MOE_TM;
            for (int i = 0; i < n; ++i) p.TILE_E[nt++] = e;
            off += n * MOE_TM;
        }
        p.OFF[NEXP] = off; p.NTILE[0] = nt;
    }
    const int gtid = blockIdx.x * blockDim.x + threadIdx.x, gsz = gridDim.x * blockDim.x;
    for (int i = gtid; i < CAP; i += gsz) p.SLOT_TOK[i] = 0;
}
__global__ void k_moe_scatter(Params p, int skip_ctx) {
    const int gtid = blockIdx.x * blockDim.x + threadIdx.x, gsz = gridDim.x * blockDim.x;
    for (int i = gtid; i < NROW * 4; i += gsz) {
        const int R = i >> 2;
        if (skip_ctx && (R % TPB) < CTXL) continue;
        p.SLOT_TOK[p.OFF[p.TOPI[i]] + p.TOKPOS[i]] = R;
    }
    if (gtid < 32) p.CNT[32 + gtid] = 0;
}
__global__ void __launch_bounds__(256) k_moe_gemm1(Params p, int l) {
    const int tn = 2048 / 64;
    const int nt = p.NTILE[0];
    gemm_tiles_f32(nt * tn, DM,
        [&](int t, const float*& A, int& lda, const int*& arow, const float*& B, int& ldb, int& r0, int& c0) {
            const int mt = t / tn; r0 = mt * MOE_TM; c0 = (t % tn) * 64; const int e = p.TILE_E[mt];
            A = p.H; lda = DM; arow = p.SLOT_TOK + r0; B = p.in[I_WGU] + ((size_t)(l * NEXP + e) * DM) * 2048 + c0; ldb = 2048; },
        [&](int r, int c, float v) { const int e = p.TILE_E[r / MOE_TM]; p.GU[(size_t)r * 2048 + c] = v + p.in[I_BGU][(l * NEXP + e) * 2048 + c]; });
}
__global__ void k_moe_act(Params p) {
    const int gtid = blockIdx.x * blockDim.x + threadIdx.x, gsz = gridDim.x * blockDim.x;
    const int total = p.OFF[NEXP] * DM;
    for (int i = gtid; i < total; i += gsz) {
        const int s = i >> 10, n = i & 1023;
        float g = p.GU[(size_t)s * 2048 + n], u = p.GU[(size_t)s * 2048 + 1024 + n];
        g = fminf(g, 7.f); u = fminf(fmaxf(u, -7.f), 7.f);
        p.ACT[i] = (u + 1.f) * (g * sigmoidf_(1.702f * g));
    }
}
__global__ void __launch_bounds__(256) k_moe_gemm2(Params p, int l) {
    const int tn = DM / 64;
    const int nt = p.NTILE[0];
    gemm_tiles_f32(nt * tn, DM,
        [&](int t, const float*& A, int& lda, const int*& arow, const float*& B, int& ldb, int& r0, int& c0) {
            const int mt = t / tn; r0 = mt * MOE_TM; c0 = (t % tn) * 64; const int e = p.TILE_E[mt];
            A = p.ACT + (size_t)r0 * DM; lda = DM; arow = nullptr; B = p.in[I_WDN] + ((size_t)(l * NEXP + e) * DM) * DM + c0; ldb = DM; },
        [&](int r, int c, float v) { const int e = p.TILE_E[r / MOE_TM]; p.Y[(size_t)r * DM + c] = v + p.in[I_BDN][(l * NEXP + e) * DM + c]; });
}
__global__ void k_moe_combine(Params p, int l, int skip_ctx) {
    const int gtid = blockIdx.x * blockDim.x + threadIdx.x, gsz = gridDim.x * blockDim.x;
    for (int i = gtid; i < NROW * 256; i += gsz) {
        const int R = i >> 8, q = i & 255, b = R / TPB, pos = R % TPB, mr = pos < CTXL ? 4 : b;
        if (skip_ctx && pos < CTXL) continue;
        float4 acc = {0.f, 0.f, 0.f, 0.f};
#pragma unroll
        for (int k = 0; k < 4; ++k) {
            const float g = p.TOPG[R * 4 + k];
            const int s = p.OFF[p.TOPI[R * 4 + k]] + p.TOKPOS[R * 4 + k];
            const float4 y = *(const float4*)(p.Y + (size_t)s * DM + q * 4);
            acc.x += g * y.x; acc.y += g * y.y; acc.z += g * y.z; acc.w += g * y.w;
        }
        const float4 m = *(const float4*)(p.MOD + (l * 5 + mr) * 6144 + 5 * DM + q * 4);
        float4* xp = (float4*)(p.X + (size_t)R * DM + q * 4);
        float4 x = *xp;
        x.x += m.x * acc.x; x.y += m.y * acc.y; x.z += m.z * acc.z; x.w += m.w * acc.w;
        *xp = x;
    }
}
__global__ void k_reset_cnt(Params p) { if (threadIdx.x < 64) p.CNT[threadIdx.x] = 0; }

__global__ void k_final(Params p) {
    const int wid = (blockIdx.x * blockDim.x + threadIdx.x) >> 6, lane = threadIdx.x & 63, nw = (gridDim.x * blockDim.x) >> 6;
    const float* g = p.in[I_FING];
    for (int o = wid; o < NBATCH * SEQ; o += nw) {
        const int b = o / SEQ, t = o % SEQ;
        const size_t R = (size_t)b * TPB + CTXL + t;
        const float4* xr = (const float4*)(p.X + R * DM);
        float4 v[4]; float ss = 0.f;
#pragma unroll
        for (int i = 0; i < 4; ++i) { v[i] = xr[lane + 64 * i]; ss += v[i].x * v[i].x + v[i].y * v[i].y + v[i].z * v[i].z + v[i].w * v[i].w; }
        ss = wave_sum(ss);
        const float rinv = rsqrtf(ss * (1.f / DM) + 1e-6f);
        float4* orow = (float4*)(p.out + (size_t)o * DM);
#pragma unroll
        for (int i = 0; i < 4; ++i) {
            const float4 gg = *(const float4*)(g + (lane + 64 * i) * 4);
            float4 r; r.x = v[i].x * rinv * gg.x; r.y = v[i].y * rinv * gg.y; r.z = v[i].z * rinv * gg.z; r.w = v[i].w * rinv * gg.w;
            orow[lane + 64 * i] = r;
        }
    }
}

extern "C" void kernel_launch(void* const* d_in, const int* in_sizes, int n_in, void* d_out, int out_size, void* d_ws, size_t ws_size,
                              hipStream_t stream) {
    Params p{};
    for (int i = 0; i < N_IN; ++i) p.in[i] = (const float*)d_in[i];
    p.out = (float*)d_out;
    char* w = (char*)d_ws;
    size_t off = 0;
    auto take = [&](size_t bytes) { void* r = w + off; off += (bytes + 255) & ~(size_t)255; return r; };
    p.X = (float*)take((size_t)NROW * DM * 4);
    p.H = (float*)take((size_t)NROW * DM * 4);
    p.P = (float*)take((size_t)NROW * INC * 4);
    p.MIX = (float*)take((size_t)NROW * DM * 4);
    p.SC = (float*)take(5 * DM * 4);
    p.MOD = (float*)take(2 * 5 * 6144 * 4);
    p.LA = (float*)take((size_t)2 * NROW * 256 * 4);
    p.LB = (float*)take((size_t)2 * NROW * 256 * 4);
    p.LH = (float*)take((size_t)2 * NROW * 256 * 4);
    p.RS = (float*)take((size_t)NROW * 960 * 4);
    p.DEC = (float*)take((size_t)2 * NROW * 256 * 4);
    p.AIC = (float*)take((size_t)2 * NROW * 256 * 4);
    p.KKN = (float*)take((size_t)NROW * 256 * 4);
    p.GG = (float*)take((size_t)NROW * 256 * 4);
    p.YB = (float*)take((size_t)2 * NROW * 256 * 4);
    p.TOPG = (float*)take((size_t)NROW * 4 * 4);
    p.TOPI = (int*)take((size_t)NROW * 4 * 4);
    p.TOKPOS = (int*)take((size_t)NROW * 4 * 4);
    p.CNT = (int*)take(64 * 4);
    p.OFF = (int*)take(64 * 4);
    p.TILE_E = (int*)take((size_t)MAXTILES * 4);
    p.NTILE = (int*)take(256);
    p.SLOT_TOK = (int*)take((size_t)CAP * 4);
    p.GU = (float*)take((size_t)CAP * 2048 * 4);
    p.ACT = (float*)take((size_t)CAP * DM * 4);
    p.Y = (float*)take((size_t)CAP * DM * 4);

    const int G = 2048;
    k_prologue<<<G, 256, 0, stream>>>(p);
    k_ada<<<(2 * 6144 + 255) / 256, 256, 0, stream>>>(p);
    for (int l = 0; l < 2; ++l) {
        const int last = l == 1;
        k_norm_mod<<<G, 256, 0, stream>>>(p, l, 0);
        k_gemm_in<<<G, 256, 0, stream>>>(p, l);
        k_lru_pre<<<G, 256, 0, stream>>>(p, l);
        k_lru_scan<<<8, 256, 0, stream>>>(p);
        k_lru_finish<<<G, 256, 0, stream>>>(p);
        k_rwkv_shift<<<G, 256, 0, stream>>>(p, l);
        k_rwkv_pre<<<G, 256, 0, stream>>>(p, l);
        k_rwkv_scan<<<32, 64, 0, stream>>>(p, l);
        k_rwkv_finish<<<G, 256, 0, stream>>>(p, l);
        k_na<<<G, 256, 0, stream>>>(p, l, !last);
        k_gemm_out<<<G, 256, 0, stream>>>(p, l, last);
        k_norm_mod<<<G, 256, 0, stream>>>(p, l, 1);
        k_router<<<G, 256, 0, stream>>>(p, l, last);
        k_moe_offsets<<<G, 256, 0, stream>>>(p);
        k_moe_scatter<<<G, 256, 0, stream>>>(p, last);
        k_moe_gemm1<<<G, 256, 0, stream>>>(p, l);
        k_moe_act<<<G, 256, 0, stream>>>(p);
        k_moe_gemm2<<<G, 256, 0, stream>>>(p, l);
        k_moe_combine<<<G, 256, 0, stream>>>(p, l, last);
        k_reset_cnt<<<1, 64, 0, stream>>>(p);
    }
    k_final<<<G, 256, 0, stream>>>(p);
}
```

```cpp
#include <hip/hip_runtime.h>
#include <hip/hip_cooperative_groups.h>
#include <stdint.h>
#include <cstdio>
namespace cg = cooperative_groups;

#define DM 1024
#define NBATCH 4
#define SEQ 4096
#define CTXL 256
#define TPB 4352
#define NROW 17408
#define INC 3008
#define INCP 3072
#define NEXP 32
#define MOE_TM 256
#define CAP (NROW * 4 + NEXP * MOE_TM)
#define MAXTILES (CAP / MOE_TM)
#define NTHR 512
#define LDS_GEMM 131072
#define LDS_BYTES (LDS_GEMM + 4096)

typedef unsigned short bf16_t;
typedef short bf16x8 __attribute__((ext_vector_type(8)));
typedef float f32x4 __attribute__((ext_vector_type(4)));
typedef unsigned u32x4 __attribute__((ext_vector_type(4)));

enum { I_X = 0, I_C, I_CTX, I_CCTX, I_ADAW, I_ADAB, I_NMG, I_NFG, I_WIN, I_WOUT, I_CONVW, I_CONVB, I_WR, I_BR, I_WI, I_BI,
       I_LAM, I_MU, I_W0, I_W2, I_A0, I_A2, I_G2, I_KK, I_KA, I_RK, I_LNG, I_LNB, I_RPB, I_RTW, I_RTB, I_WGU, I_BGU, I_WDN,
       I_BDN, I_FING, N_IN };

struct Params {
    const float* in[N_IN];
    float* out;
    float* X;
    bf16_t* H;
    float* P;
    bf16_t* MIX;
    float* MOD;
    float* LA;
    float* LB;
    float* LH;
    float* RS;
    float* DEC;
    float* AIC;
    float* KKN;
    float* GG;
    float* YB;
    float* TOPG;
    int* TOPI;
    int* TOKPOS;
    int* CNT;
    int* SLOT_TOK;
    bf16_t* ACT;
    float* Y;
    bf16_t* WTIN;
    bf16_t* WTOUT;
    bf16_t* WTGU;
    bf16_t* WTDN;
};

typedef const __attribute__((address_space(4))) Params CParams;
extern __shared__ __attribute__((aligned(16))) unsigned char smem[];

__device__ __forceinline__ int opaque_tid(int wv) { int t; asm volatile("v_mbcnt_lo_u32_b32 %0, -1, 0\n\tv_mbcnt_hi_u32_b32 %0, -1, %0" : "=v"(t)); return wv * 64 + t; }
__device__ __forceinline__ float sigmoidf_(float x) { return 1.f / (1.f + __expf(-x)); }
__device__ __forceinline__ float softplusf_(float x) { return x > 20.f ? x : log1pf(__expf(x)); }
#define SWZ_XOR(v, o) __int_as_float(__builtin_amdgcn_ds_swizzle(__float_as_int(v), ((o) << 10) | 0x1f))
__device__ __forceinline__ float rdlane(float v, int l) { return __int_as_float(__builtin_amdgcn_readlane(__float_as_int(v), l)); }
__device__ __forceinline__ float sum_xor32(float v) {
    int a = __float_as_int(v), b = a;
    asm volatile("s_nop 1\n\tv_permlane32_swap_b32 %0, %1\n\ts_nop 1" : "+v"(a), "+v"(b));
    return __int_as_float(a) + __int_as_float(b);
}
__device__ __forceinline__ float wave_sum(float v) {
    v += SWZ_XOR(v, 1); v += SWZ_XOR(v, 2); v += SWZ_XOR(v, 4); v += SWZ_XOR(v, 8); v += SWZ_XOR(v, 16);
    return rdlane(v, 0) + rdlane(v, 32);
}
__device__ __forceinline__ float wave_max(float v) {
    v = fmaxf(v, SWZ_XOR(v, 1)); v = fmaxf(v, SWZ_XOR(v, 2)); v = fmaxf(v, SWZ_XOR(v, 4)); v = fmaxf(v, SWZ_XOR(v, 8)); v = fmaxf(v, SWZ_XOR(v, 16));
    return fmaxf(rdlane(v, 0), rdlane(v, 32));
}
__device__ __forceinline__ unsigned cvt_pk_bf16(float lo, float hi) { unsigned r; asm("v_cvt_pk_bf16_f32 %0, %1, %2" : "=v"(r) : "v"(lo), "v"(hi)); return r; }
__device__ __forceinline__ bf16_t f2bf(float x) { return (bf16_t)(cvt_pk_bf16(x, 0.f) & 0xffffu); }
__device__ __forceinline__ float gelu_tanh(float x) {
    const float u = 0.7978845608028654f * (x + 0.044715f * x * x * x);
    return 0.5f * x * (1.f + tanhf(u));
}

__device__ __forceinline__ int inv_perm32(int cc) { return ((cc >> 2) & 1) * 16 + (cc >> 3) * 4 + (cc & 3); }
__device__ __forceinline__ void transpose_item(const float* W, int K, int N, bf16_t* WT, int k0, int n0, int dst_row0, float* scr, int lane, bool perm = false) {
#pragma unroll 8
    for (int i = 0; i < 32; ++i) { const int kk = 2 * i + (lane >> 5); scr[kk * 33 + (lane & 31)] = W[(size_t)(k0 + kk) * N + n0 + (lane & 31)]; }
    __builtin_amdgcn_wave_barrier();
    const int c = lane & 7;
#pragma unroll
    for (int j = 0; j < 4; ++j) {
        const int n = (lane >> 3) + 8 * j; const float* s = scr + (8 * c) * 33 + n;
        u32x4 o; o.x = cvt_pk_bf16(s[0 * 33], s[1 * 33]); o.y = cvt_pk_bf16(s[2 * 33], s[3 * 33]); o.z = cvt_pk_bf16(s[4 * 33], s[5 * 33]); o.w = cvt_pk_bf16(s[6 * 33], s[7 * 33]);
        *(u32x4*)(WT + (size_t)(dst_row0 + (perm ? inv_perm32(n) : n)) * K + k0 + 8 * c) = o;
    }
    __builtin_amdgcn_wave_barrier();
}

__device__ __forceinline__ void d_prologue(CParams& p, int wv) {
    const int tidx_ = opaque_tid(wv);
    int bidx_ = blockIdx.x, gdim_ = gridDim.x; asm volatile("" : "+s"(bidx_), "+s"(gdim_));
    const int tid = tidx_, lane = tid & 63, wave = tid >> 6;
    const int gtid = bidx_ * NTHR + tid, gsz = gdim_ * NTHR;
    const int gw = bidx_ * 8 + wave, NGW = gdim_ * 8;
    {
        const float4* x4 = (const float4*)p.in[I_X];
        const float4* c4 = (const float4*)p.in[I_CTX];
        float4* X4 = (float4*)p.X;
        for (int i = gtid; i < NROW * 256; i += gsz) {
            const int R = i >> 8, q = i & 255, b = R / TPB, pos = R % TPB;
            X4[i] = pos < CTXL ? c4[(b * CTXL + pos) * 256 + q] : x4[((size_t)b * SEQ + (pos - CTXL)) * 256 + q];
        }
    }
    if (gtid < 64) p.CNT[gtid] = 0;
    for (int i = gtid; i < 2 * 64 * 1024 / 8; i += gsz) {
        const int l = i / (64 * 128), r = i % (64 * 128);
        *(u32x4*)(p.WTIN + ((size_t)l * INCP + INC) * DM + (size_t)r * 8) = (u32x4){0u, 0u, 0u, 0u};
    }
    {
        float* sc = (float*)smem;
        float* part = (float*)(smem + 5 * 1024 * 4);
        for (int i = tid; i < 5 * DM; i += NTHR) { const int r = i / DM, d = i % DM; const float v = r < 4 ? p.in[I_C][r * DM + d] : p.in[I_CCTX][d]; sc[i] = v * sigmoidf_(v); }
        __syncthreads();
        for (int cb = bidx_; cb < 256; cb += gdim_) {
            const int col = tid % 48, ks = tid / 48;
            const int gc = cb * 48 + col, l = gc / 6144, n = gc % 6144;
            if (ks < 8) {
                const float* W = p.in[I_ADAW] + (size_t)l * DM * 6144 + n;
                float a0 = 0.f, a1 = 0.f, a2 = 0.f, a3 = 0.f, a4 = 0.f;
#pragma unroll 8
                for (int k = ks * 128; k < ks * 128 + 128; ++k) {
                    const float w = W[(size_t)k * 6144];
                    a0 += sc[k] * w; a1 += sc[DM + k] * w; a2 += sc[2 * DM + k] * w; a3 += sc[3 * DM + k] * w; a4 += sc[4 * DM + k] * w;
                }
                float* pp = part + (ks * 5) * 48 + col;
                pp[0] = a0; pp[48] = a1; pp[96] = a2; pp[144] = a3; pp[192] = a4;
            }
            __syncthreads();
            if (tid < 240) {
                const int r = tid / 48, c2 = tid % 48, gc2 = cb * 48 + c2, l2 = gc2 / 6144, n2 = gc2 % 6144;
                float s = p.in[I_ADAB][l2 * 6144 + n2];
#pragma unroll
                for (int k = 0; k < 8; ++k) s += part[(k * 5 + r) * 48 + c2];
                p.MOD[(l2 * 5 + r) * 6144 + n2] = s;
            }
            __syncthreads();
        }
    }
    {
        float* scr = (float*)(smem + 32768) + wave * (64 * 33);
        const int N_IN_ = 2 * 16 * 94, N_OUT_ = 2 * 16 * 32, N_GU_ = 64 * 16 * 64, N_DN_ = 64 * 16 * 32;
        for (int it = gw; it < N_IN_ + N_OUT_ + N_GU_ + N_DN_; it += NGW) {
            int r = it;
            if (r < N_IN_) { const int l = r / (16 * 94), q = r % (16 * 94), kb = q / 94, nb = q % 94;
                transpose_item(p.in[I_WIN] + (size_t)l * DM * INC, DM, INC, p.WTIN + (size_t)l * INCP * DM, kb * 64, nb * 32, nb * 32, scr, lane); continue; }
            r -= N_IN_;
            if (r < N_OUT_) { const int l = r / 512, q = r % 512, kb = q / 32, nb = q % 32;
                transpose_item(p.in[I_WOUT] + (size_t)l * DM * DM, DM, DM, p.WTOUT + (size_t)l * DM * DM, kb * 64, nb * 32, nb * 32, scr, lane); continue; }
            r -= N_OUT_;
            if (r < N_GU_) { const int le = r / 1024, q = r % 1024, kb = q / 64, nb = q % 64;
                const int c0 = nb * 32; const int dst = c0 < 1024 ? (c0 / 128) * 256 + (c0 % 128) : ((c0 - 1024) / 128) * 256 + 128 + ((c0 - 1024) % 128);
                transpose_item(p.in[I_WGU] + (size_t)le * DM * 2048, DM, 2048, p.WTGU + (size_t)le * 2048 * DM, kb * 64, c0, dst, scr, lane, true); continue; }
            r -= N_GU_;
            { const int le = r / 512, q = r % 512, kb = q / 32, nb = q % 32;
                transpose_item(p.in[I_WDN] + (size_t)le * DM * DM, DM, DM, p.WTDN + (size_t)le * DM * DM, kb * 64, nb * 32, nb * 32, scr, lane); }
        }
    }
}

__device__ __forceinline__ void norm_row_to_bf16(CParams& p, const float4 (&v)[4], float ss, int l, int which, int mr, bf16_t* hrow, int lane) {
    const float* g = (which == 0 ? p.in[I_NMG] : p.in[I_NFG]) + l * DM;
    const float* mod = p.MOD + (l * 5 + mr) * 6144 + (which == 0 ? 0 : 3 * DM);
    const float rinv = rsqrtf(ss * (1.f / DM) + 1e-6f);
#pragma unroll
    for (int i = 0; i < 4; ++i) {
        const int c = (lane + 64 * i) * 4;
        const float4 gg = *(const float4*)(g + c), sh = *(const float4*)(mod + c), sc = *(const float4*)(mod + DM + c);
        const float o0 = v[i].x * rinv * gg.x * (1.f + sc.x) + sh.x, o1 = v[i].y * rinv * gg.y * (1.f + sc.y) + sh.y;
        const float o2 = v[i].z * rinv * gg.z * (1.f + sc.z) + sh.z, o3 = v[i].w * rinv * gg.w * (1.f + sc.w) + sh.w;
        uint2 o; o.x = cvt_pk_bf16(o0, o1); o.y = cvt_pk_bf16(o2, o3);
        *(uint2*)(hrow + c) = o;
    }
}
__device__ __forceinline__ void d_norm_mix(CParams& p, int wv, int l) {
    const int tidx_ = opaque_tid(wv);
    int bidx_ = blockIdx.x, gdim_ = gridDim.x; asm volatile("" : "+s"(bidx_), "+s"(gdim_));
    const int lane = tidx_ & 63, gw = bidx_ * 8 + (tidx_ >> 6), NGW = gdim_ * 8;
    for (int R = gw; R < NROW; R += NGW) {
        const int b = R / TPB, pos = R % TPB, mr = pos < CTXL ? 4 : b;
        const float4* xr = (const float4*)(p.X + (size_t)R * DM);
        float4 v[4]; float ss = 0.f;
#pragma unroll
        for (int i = 0; i < 4; ++i) { v[i] = xr[lane + 64 * i]; ss += v[i].x * v[i].x + v[i].y * v[i].y + v[i].z * v[i].z + v[i].w * v[i].w; }
        ss = wave_sum(ss);
        norm_row_to_bf16(p, v, ss, l, 0, mr, p.H + (size_t)R * DM, lane);
    }
}

#define LAS __attribute__((address_space(3)))
#define HTB 16384
#define KB_ 2048
__device__ __forceinline__ int lds_byte(int r, int c) {
    const int st = (r >> 4) * 2 + (c >> 5), rr = r & 15, cc = c & 31, ob = rr * 64 + cc * 2;
    return st * 1024 + (ob ^ (((ob >> 9) & 1) << 5));
}
__device__ __forceinline__ void stage_rc(int b, int& R, int& C) {
    const int st = b / 1024, sb = b % 1024, swz = sb ^ (((sb >> 9) & 1) << 5);
    R = (st >> 1) * 16 + swz / 64; C = (st & 1) * 32 + (swz % 64) / 2;
}
struct Unit { int pm, pn; };
__device__ __forceinline__ bool tile_order(int i, int nM, int nN, Unit& u, int bid, int nblk) {
    const int nwg = nM * nN; const long L = (long)i * nblk + bid; if (L >= nwg) return false;
    int wgid = (int)L; { const int q = nwg / 8, r = nwg % 8, xcd = wgid % 8, off = wgid / 8; wgid = (xcd < r ? xcd * (q + 1) : r * (q + 1) + (xcd - r) * q) + off; }
    const int nig = 8 * nN, gid = wgid / nig, fm = gid * 8, gsz = (nM - fm) < 8 ? (nM - fm) : 8;
    u.pm = fm + ((wgid % nig) % gsz); u.pn = (wgid % nig) / gsz; return true;
}

#define PG_SA(b, h) (((b) * 2 + (h)) * HTB)
#define PG_SB(b, h) ((4 + (b) * 2 + (h)) * HTB)
#define PG_STAGE(bufoff, gbase, v0, v1) do { \
    __builtin_amdgcn_global_load_lds((const unsigned*)((const char*)(gbase) + (v0)), (LAS unsigned*)(lds + (bufoff) + ldsw), 16, 0, 0); \
    __builtin_amdgcn_global_load_lds((const unsigned*)((const char*)(gbase) + (v1)), (LAS unsigned*)(lds + (bufoff) + ldsw + 8192), 16, 0, 0); } while (0)
#define PG_STAGE_B(bufoff, gbase) PG_STAGE(bufoff, gbase, voffB[0], voffB[1])
#define PG_STAGE_A(bufoff, gb, h, usenext) do { if (GATHER) PG_STAGE(bufoff, gb, gc[h][0], gc[h][1]); \
    else PG_STAGE(bufoff, (gb) + (h) * hstep, voffA[0], voffA[1]); } while (0)
#define PG_LDA(dst, b, h) do { _Pragma("unroll") for (int m = 0; m < 4; ++m) _Pragma("unroll") for (int k = 0; k < 2; ++k) dst[m][k] = *(const LAS bf16x8*)(lds + PG_SA(b, h) + aoff + m * 2048 + k * 1024); } while (0)
#define PG_LDB(dst, b, h) do { _Pragma("unroll") for (int n = 0; n < 2; ++n) _Pragma("unroll") for (int k = 0; k < 2; ++k) dst[n][k] = *(const LAS bf16x8*)(lds + PG_SB(b, h) + boff + n * 2048 + k * 1024); } while (0)
#define PG_MMA(ai, bj, At_, Bt_) do { __builtin_amdgcn_s_setprio(1); _Pragma("unroll") for (int m = 0; m < 4; ++m) _Pragma("unroll") for (int n = 0; n < 2; ++n) _Pragma("unroll") for (int k = 0; k < 2; ++k) \
    acc[ai][bj][m][n] = __builtin_amdgcn_mfma_f32_16x16x32_bf16(Bt_[n][k], At_[m][k], acc[ai][bj][m][n], 0, 0, 0); __builtin_amdgcn_s_setprio(0); } while (0)
#define PG_WAIT_V(n) asm volatile("s_waitcnt vmcnt(" #n ")" ::: "memory")
#define PG_WAIT_L(n) asm volatile("s_waitcnt lgkmcnt(" #n ")" ::: "memory")
#define PG_BAR __builtin_amdgcn_s_barrier()
#define PG_SCHED __builtin_amdgcn_sched_barrier(0)

template <bool GATHER, class Prob>
__device__ __forceinline__ void gemm_phase(Prob P, int wv) {
    const int tidx_ = opaque_tid(wv);
    int bidx_ = blockIdx.x, gdim_ = gridDim.x; asm volatile("" : "+s"(bidx_), "+s"(gdim_));
    LAS unsigned char* lds = (LAS unsigned char*)smem;
    P.bid = bidx_; P.nblk = gdim_;
    const int tid = tidx_, wid = __builtin_amdgcn_readfirstlane(tid >> 6), lane = tid & 63, wr = wid >> 2, wc = wid & 3, fr = lane & 15, fq = lane >> 4;
    constexpr int nt = 16;
    unsigned voffA[2], voffB[2]; int Rr[2], Cc[2];
#pragma unroll
    for (int i = 0; i < 2; ++i) { stage_rc(tid * 16 + i * 8192, Rr[i], Cc[i]); voffA[i] = (unsigned)(Rr[i] * 1024 + Cc[i]) * 2u; voffB[i] = voffA[i]; }
    const size_t kstep = 128, hstep = (size_t)128 * KB_;
    const unsigned ldsw = (unsigned)wid * 1024u;
    const int aoff = lds_byte(wr * 64 + fr, fq * 8), boff = lds_byte(wc * 32 + fr, fq * 8);
    Unit cur, nxt; int ui = 0;
    if (!P.next(0, cur)) return;
    f32x4 acc[2][2][4][2];
#pragma unroll
    for (int a = 0; a < 2; ++a)
#pragma unroll
        for (int b = 0; b < 2; ++b)
#pragma unroll
            for (int m = 0; m < 4; ++m)
#pragma unroll
                for (int n = 0; n < 2; ++n) acc[a][b][m][n] = (f32x4){0.f, 0.f, 0.f, 0.f};
    bf16x8 At[4][2], B0[2][2], B1[2][2];
    unsigned gc[2][2] = {{0u, 0u}, {0u, 0u}};
    if (GATHER) {
#pragma unroll
        for (int h = 0; h < 2; ++h)
#pragma unroll
            for (int i = 0; i < 2; ++i) gc[h][i] = (unsigned)P.gather_row(cur, h * 128 + Rr[i]) * (unsigned)KB_ + (unsigned)Cc[i] * 2u;
    }
    const char* cA = P.a_ptr(cur); const char* cB = P.b_ptr(cur);
    PG_STAGE_B(PG_SB(0, 0), cB); PG_STAGE_A(PG_SA(0, 0), cA, 0, false); PG_STAGE_B(PG_SB(0, 1), cB + hstep); PG_STAGE_A(PG_SA(0, 1), cA, 1, false);
    if (wr == 1) PG_BAR;
    PG_WAIT_V(4); PG_BAR;
    PG_STAGE_B(PG_SB(1, 0), cB + kstep); PG_STAGE_A(PG_SA(1, 0), cA + kstep, 0, false); PG_STAGE_B(PG_SB(1, 1), cB + hstep + kstep);
    PG_WAIT_V(6); PG_BAR;
    for (;;) {
        const bool has_next = P.next(ui + 1, nxt);
        const char* nA = has_next ? P.a_ptr(nxt) : cA; const char* nB = has_next ? P.b_ptr(nxt) : cB;
        for (int t = 0; t < nt; t += 2) {
            const bool last = (t == nt - 2);
            if (GATHER && last && has_next) {
#pragma unroll
                for (int i = 0; i < 2; ++i) gc[0][i] = (unsigned)P.gather_row(nxt, Rr[i]) * (unsigned)KB_ + (unsigned)Cc[i] * 2u;
            }
            const char* a1 = cA + (size_t)(t + 1) * kstep;
            const char* a2 = last ? nA : cA + (size_t)(t + 2) * kstep; const char* b2 = last ? nB : cB + (size_t)(t + 2) * kstep;
            const char* a3 = a2 + kstep; const char* b3 = b2 + kstep;
            PG_LDB(B0, 0, 0); PG_SCHED; PG_LDA(At, 0, 0); PG_STAGE_A(PG_SA(1, 1), a1, 1, false);
            PG_WAIT_L(8); PG_BAR; PG_WAIT_L(0); PG_MMA(0, 0, At, B0); PG_BAR; PG_SCHED;
            if (GATHER && last && has_next) {
#pragma unroll
                for (int i = 0; i < 2; ++i) gc[1][i] = (unsigned)P.gather_row(nxt, 128 + Rr[i]) * (unsigned)KB_ + (unsigned)Cc[i] * 2u;
            }
            PG_LDB(B1, 0, 1); PG_STAGE_B(PG_SB(0, 0), b2);
            PG_BAR; PG_WAIT_L(0); PG_MMA(0, 1, At, B1); PG_BAR;
            PG_LDA(At, 0, 1); PG_STAGE_A(PG_SA(0, 0), a2, 0, last);
            PG_BAR; PG_WAIT_L(0); PG_MMA(1, 0, At, B0); PG_BAR; PG_SCHED;
            PG_STAGE_B(PG_SB(0, 1), b2 + hstep);
            PG_WAIT_V(6); PG_BAR; PG_MMA(1, 1, At, B1); PG_BAR;
            PG_LDB(B0, 1, 0); PG_SCHED; PG_LDA(At, 1, 0); PG_STAGE_A(PG_SA(0, 1), a2, 1, last);
            PG_WAIT_L(8); PG_BAR; PG_WAIT_L(0); PG_MMA(0, 0, At, B0); PG_BAR; PG_SCHED;
            PG_LDB(B1, 1, 1); PG_STAGE_B(PG_SB(1, 0), b3);
            PG_BAR; PG_WAIT_L(0); PG_MMA(0, 1, At, B1); PG_BAR;
            PG_LDA(At, 1, 1); PG_STAGE_A(PG_SA(1, 0), a3, 0, last);
            PG_BAR; PG_WAIT_L(0); PG_MMA(1, 0, At, B0); PG_BAR; PG_SCHED;
            PG_STAGE_B(PG_SB(1, 1), b3 + hstep);
            PG_WAIT_V(6); PG_BAR; PG_MMA(1, 1, At, B1); PG_BAR;
        }
        P.epi(acc, cur, wr, wc, fr, fq);
        if (!has_next) break;
#pragma unroll
        for (int a = 0; a < 2; ++a)
#pragma unroll
            for (int b = 0; b < 2; ++b)
#pragma unroll
                for (int m = 0; m < 4; ++m)
#pragma unroll
                    for (int n = 0; n < 2; ++n) acc[a][b][m][n] = (f32x4){0.f, 0.f, 0.f, 0.f};
        cur = nxt; cA = nA; cB = nB; ++ui;
    }
    PG_WAIT_V(0);
    if (wr == 0) PG_BAR;
    PG_BAR;
}

struct ProbIn {
    CParams& p; int l; int bid, nblk;
    __device__ __forceinline__ bool next(int i, Unit& u) const { return tile_order(i, NROW / 256, INCP / 256, u, bid, nblk); }
    __device__ __forceinline__ const char* a_ptr(const Unit& u) const { return (const char*)p.H + (size_t)u.pm * 256 * KB_; }
    __device__ __forceinline__ const char* b_ptr(const Unit& u) const { return (const char*)p.WTIN + ((size_t)l * INCP + (size_t)u.pn * 256) * KB_; }
    __device__ __forceinline__ int gather_row(const Unit&, int) const { return 0; }
    __device__ __forceinline__ void epi(const f32x4 (&acc)[2][2][4][2], const Unit& u, int wr, int wc, int fr, int fq) const {
        const int brow = u.pm * 256, bcol = u.pn * 256;
#pragma unroll
        for (int ai = 0; ai < 2; ++ai)
#pragma unroll
            for (int m = 0; m < 4; ++m) {
                float* prow = p.P + (size_t)(brow + ai * 128 + wr * 64 + m * 16 + fr) * INC;
#pragma unroll
                for (int bj = 0; bj < 2; ++bj)
#pragma unroll
                    for (int n = 0; n < 2; ++n) {
                        const int col = bcol + bj * 128 + wc * 32 + n * 16 + fq * 4;
                        if (col < INC) *(f32x4*)(prow + col) = acc[ai][bj][m][n];
                    }
            }
    }
};
__device__ __forceinline__ void d_gemm_in(CParams& p, int wv, int l) { ProbIn P{p, l, 0, 0}; gemm_phase<false>(P, wv); }

struct ProbOut {
    CParams& p; int l; int skip_ctx; int bid, nblk;
    __device__ __forceinline__ bool next(int i, Unit& u) const {
        if (!tile_order(i, skip_ctx ? 64 : 68, 4, u, bid, nblk)) return false;
        if (skip_ctx) u.pm = (u.pm / 16) * 17 + 1 + (u.pm % 16);
        return true; }
    __device__ __forceinline__ const char* a_ptr(const Unit& u) const { return (const char*)p.MIX + (size_t)u.pm * 256 * KB_; }
    __device__ __forceinline__ const char* b_ptr(const Unit& u) const { return (const char*)p.WTOUT + ((size_t)l * DM + (size_t)u.pn * 256) * KB_; }
    __device__ __forceinline__ int gather_row(const Unit&, int) const { return 0; }
    __device__ __forceinline__ void epi(const f32x4 (&acc)[2][2][4][2], const Unit& u, int wr, int wc, int fr, int fq) const {
        const int brow = u.pm * 256, bcol = u.pn * 256;
        const int b = u.pm / 17, mr = (u.pm % 17) == 0 ? 4 : b;
        const float* gate = p.MOD + (l * 5 + mr) * 6144 + 2 * DM;
#pragma unroll
        for (int ai = 0; ai < 2; ++ai)
#pragma unroll
            for (int m = 0; m < 4; ++m) {
                float* xrow = p.X + (size_t)(brow + ai * 128 + wr * 64 + m * 16 + fr) * DM;
#pragma unroll
                for (int bj = 0; bj < 2; ++bj)
#pragma unroll
                    for (int n = 0; n < 2; ++n) {
                        const int col = bcol + bj * 128 + wc * 32 + n * 16 + fq * 4;
                        const f32x4 gt = *(const f32x4*)(gate + col);
                        f32x4* xp = (f32x4*)(xrow + col);
                        *xp = *xp + gt * acc[ai][bj][m][n];
                    }
                asm volatile("" ::: "memory");
            }
    }
};
__device__ __forceinline__ void d_gemm_out(CParams& p, int wv, int l, int skip_ctx) { ProbOut P{p, l, skip_ctx, 0, 0}; gemm_phase<false>(P, wv); }

__device__ __forceinline__ void d_lru_pre(CParams& p, int wv, int l) {
    const int tidx_ = opaque_tid(wv);
    int bidx_ = blockIdx.x, gdim_ = gridDim.x; asm volatile("" : "+s"(bidx_), "+s"(gdim_));
    const int lane = tidx_ & 63, wave = tidx_ >> 6, gw = bidx_ * 8 + wave, NGW = gdim_ * 8;
    float* xcw = (float*)smem + wave * 64;
    for (int it = gw; it < 2 * NROW * 4; it += NGW) {
        const int h = it & 3, R = (it >> 2) % NROW, d = (it >> 2) / NROW, pos = R % TPB;
        const int seg0 = pos < CTXL ? 0 : CTXL, seg1 = pos < CTXL ? CTXL : TPB;
        const int c = h * 64 + lane;
        const float* cw = p.in[I_CONVW] + ((l * 2 + d) * 4) * 256;
        float acc = p.in[I_CONVB][(l * 2 + d) * 256 + c];
#pragma unroll
        for (int j = 0; j < 4; ++j) {
            const int q = d == 0 ? pos - j : pos + j;
            if (q >= seg0 && q < seg1) acc += cw[j * 256 + c] * p.P[(size_t)(R + (q - pos)) * INC + c];
        }
        __builtin_amdgcn_wave_barrier();
        xcw[lane] = acc;
        __builtin_amdgcn_wave_barrier();
        const float* wr = p.in[I_WR] + (size_t)((l * 2 + d) * 4 + h) * 4096 + lane;
        const float* wi = p.in[I_WI] + (size_t)((l * 2 + d) * 4 + h) * 4096 + lane;
        float gr = p.in[I_BR][(l * 2 + d) * 256 + c], gi = p.in[I_BI][(l * 2 + d) * 256 + c];
#pragma unroll 8
        for (int i = 0; i < 64; ++i) { const float xv = xcw[i]; gr += xv * wr[i * 64]; gi += xv * wi[i * 64]; }
        gr = sigmoidf_(gr); gi = sigmoidf_(gi);
        const float lam = p.in[I_LAM][(l * 2 + d) * 256 + c];
        const float log_a = -8.0f * gr * softplusf_(-lam);
        const float a = __expf(log_a);
        const float bb = sqrtf(fmaxf(-expm1f(2.f * log_a), 0.f)) * (gi * acc);
        p.LA[((size_t)d * NROW + R) * 256 + c] = a;
        p.LB[((size_t)d * NROW + R) * 256 + c] = bb;
    }
}
__device__ __forceinline__ void d_lru_scan(CParams& p, int widx, int lane) {
    const int gt = widx * 64 + lane;
    const int c = gt & 255, d = (gt >> 8) & 1, b = gt >> 9;
    const float* la = p.LA + ((size_t)d * NROW + (size_t)b * TPB) * 256 + c;
    const float* lb = p.LB + ((size_t)d * NROW + (size_t)b * TPB) * 256 + c;
    float* lh = p.LH + ((size_t)d * NROW + (size_t)b * TPB) * 256 + c;
    float h = 0.f;
    for (int s0 = 0; s0 < TPB; s0 += 16) {
        float av[16], bv[16]; int ps[16];
#pragma unroll
        for (int u = 0; u < 16; ++u) {
            const int s = s0 + u;
            ps[u] = d == 0 ? s : (s < CTXL ? CTXL - 1 - s : TPB - 1 - (s - CTXL));
            av[u] = la[(size_t)ps[u] * 256]; bv[u] = lb[(size_t)ps[u] * 256];
        }
#pragma unroll
        for (int u = 0; u < 16; ++u) { h = av[u] * h + bv[u]; lh[(size_t)ps[u] * 256] = h; }
    }
}

__device__ __forceinline__ void d_rwkv_pre(CParams& p, int wv, int l) {
    const int tidx_ = opaque_tid(wv);
    int bidx_ = blockIdx.x, gdim_ = gridDim.x; asm volatile("" : "+s"(bidx_), "+s"(gdim_));
    const int lane = tidx_ & 63, wave = tidx_ >> 6, gw = bidx_ * 8 + wave, NGW = gdim_ * 8;
    float* tw = (float*)smem + 1024 + wave * 192; float* al = tw + 64; float* sg = tw + 128;
    const float* mu = p.in[I_MU] + l * 2 * 960;
    for (int R = gw; R < NROW; R += NGW) {
        const int pos = R % TPB;
        const int seg0 = pos < CTXL ? 0 : CTXL, seg1 = pos < CTXL ? CTXL : TPB;
        const float* pr = p.P + (size_t)R * INC + 512;
        float sv[15];
#pragma unroll
        for (int q = 0; q < 15; ++q) {
            const int col = lane + 64 * q;
            const float v = pr[col];
            const float pv = pos > seg0 ? pr[col - INC] : 0.f;
            const float nv = pos + 1 < seg1 ? pr[col + INC] : 0.f;
            sv[q] = v + mu[col] * (pv - v) + mu[960 + col] * (nv - v);
        }
#pragma unroll
        for (int q = 0; q < 12; ++q) p.RS[(size_t)R * 768 + lane + 64 * q] = sv[q];
        __builtin_amdgcn_wave_barrier();
        tw[lane] = tanhf(sv[12]); al[lane] = sv[13]; sg[lane] = sigmoidf_(sv[14]);
        __builtin_amdgcn_wave_barrier();
#pragma unroll 1
        for (int d = 0; d < 2; ++d) {
#pragma unroll 1
            for (int hq = 0; hq < 4; ++hq) {
                const int c = hq * 64 + lane;
                const float* w2 = p.in[I_W2] + (size_t)(l * 2 + d) * 64 * 256 + c;
                const float* a2 = p.in[I_A2] + (size_t)(l * 2 + d) * 64 * 256 + c;
                float wl = p.in[I_W0][(l * 2 + d) * 256 + c], aa = p.in[I_A0][(l * 2 + d) * 256 + c];
#pragma unroll 8
                for (int i = 0; i < 64; ++i) { wl += tw[i] * w2[i * 256]; aa += al[i] * a2[i * 256]; }
                const float w = -softplusf_(-wl) - 0.5f;
                p.DEC[((size_t)d * NROW + R) * 256 + c] = __expf(-__expf(w));
                p.AIC[((size_t)d * NROW + R) * 256 + c] = sigmoidf_(aa);
            }
        }
#pragma unroll
        for (int hq = 0; hq < 4; ++hq) {
            const int c = hq * 64 + lane;
            const float* g2 = p.in[I_G2] + (size_t)l * 64 * 256 + c;
            float g = 0.f;
#pragma unroll 8
            for (int i = 0; i < 64; ++i) g += sg[i] * g2[i * 256];
            p.GG[(size_t)R * 256 + c] = g;
            const float kk = sv[4 + hq] * p.in[I_KK][l * 256 + c];
            const float n2 = wave_sum(kk * kk);
            p.KKN[(size_t)R * 256 + c] = kk / fmaxf(sqrtf(n2), 1e-12f);
        }
    }
}
__device__ __forceinline__ void d_rwkv_scan(CParams& p, int l, int widx, int lane) {
    const int d = widx & 1, h = (widx >> 1) & 3, b = widx >> 3;
    const int c = h * 64 + lane;
    const float ka = p.in[I_KA][l * 256 + c];
    float S[64];
#pragma unroll
    for (int j = 0; j < 64; ++j) S[j] = 0.f;
    for (int s = 0; s < TPB; ++s) {
        const int pos = d == 0 ? s : (s < CTXL ? CTXL - 1 - s : TPB - 1 - (s - CTXL));
        const size_t R = (size_t)b * TPB + pos;
        const float* rs = p.RS + R * 768;
        const float r = rs[c], k = rs[256 + c], v = rs[512 + c];
        const float w = p.DEC[((size_t)d * NROW + R) * 256 + c];
        const float a = p.AIC[((size_t)d * NROW + R) * 256 + c];
        const float kkn = p.KKN[R * 256 + c];
        const float av = -kkn, bv = kkn * a, ke = k * (1.f + (a - 1.f) * ka);
        float sa = 0.f;
#pragma unroll
        for (int j = 0; j < 64; ++j) sa += S[j] * rdlane(av, j);
        float y = 0.f;
#pragma unroll
        for (int j = 0; j < 64; ++j) {
            S[j] = S[j] * rdlane(w, j) + sa * rdlane(bv, j) + v * rdlane(ke, j);
            y += S[j] * rdlane(r, j);
        }
        p.YB[((size_t)d * NROW + R) * 256 + c] = y;
    }
}

__device__ __forceinline__ void d_na(CParams& p, int wv, int l, int do_ctx) {
    const int tidx_ = opaque_tid(wv);
    int bidx_ = blockIdx.x, gdim_ = gridDim.x; asm volatile("" : "+s"(bidx_), "+s"(gdim_));
    const int w = tidx_ >> 6, lane = tidx_ & 63;
    float* qs = (float*)smem + 4096 + w * 64;
    float* pw = (float*)smem + 8192 + w * 384;
    const int gw = bidx_ * 8 + w, nw = gdim_ * 8;
    const float* rpb = p.in[I_RPB] + (size_t)l * 8 * 15 * 31;
    for (int it = gw; it < NROW * 8; it += nw) {
        const int R = it >> 3, h = it & 7, b = R / TPB, pos = R % TPB;
        if (pos < CTXL && !do_ctx) continue;
        const size_t rb = (size_t)b * TPB;
        __builtin_amdgcn_wave_barrier();
        qs[lane] = p.P[(size_t)R * INC + 1472 + h * 64 + lane] * 0.125f;
        __builtin_amdgcn_wave_barrier();
        const bool lat = pos >= CTXL;
        int r = 0, cc = 0, rs_ = 0, cs = 0;
        if (lat) { const int t = pos - CTXL; r = t >> 6; cc = t & 63; rs_ = min(max(r - 4, 0), 56); cs = min(max(cc - 8, 0), 48); }
        const int nk = lat ? 384 : 256;
        float sc[6];
        float mx = -1e30f;
#pragma unroll
        for (int m = 0; m < 6; ++m) {
            const int n = lane + 64 * m;
            sc[m] = -1e30f;
            if (n < nk) {
                int kpos; float bias = 0.f;
                if (lat && n < 128) { const int i = n >> 4, j = n & 15; kpos = CTXL + (rs_ + i) * 64 + cs + j; bias = rpb[(h * 15 + (rs_ + i - r + 7)) * 31 + (cs + j - cc + 15)]; }
                else kpos = lat ? n - 128 : n;
                const float4* kr = (const float4*)(p.P + (rb + kpos) * INC + 1472 + 512 + h * 64);
                float acc = 0.f;
#pragma unroll
                for (int q = 0; q < 16; ++q) { const float4 kv = kr[q]; const float4 qv = *(const float4*)&qs[q * 4]; acc += kv.x * qv.x + kv.y * qv.y + kv.z * qv.z + kv.w * qv.w; }
                sc[m] = acc + bias;
            }
            mx = fmaxf(mx, sc[m]);
        }
        mx = wave_max(mx);
        float sum = 0.f;
#pragma unroll
        for (int m = 0; m < 6; ++m) { const int n = lane + 64 * m; float e = n < nk ? __expf(sc[m] - mx) : 0.f; sum += e; pw[n] = e; }
        sum = wave_sum(sum);
        __builtin_amdgcn_wave_barrier();
        float acc = 0.f;
        for (int n = 0; n < nk; ++n) {
            int kpos;
            if (lat && n < 128) kpos = CTXL + (rs_ + (n >> 4)) * 64 + cs + (n & 15); else kpos = lat ? n - 128 : n;
            acc += pw[n] * p.P[(rb + kpos) * INC + 1472 + 1024 + h * 64 + lane];
        }
        p.MIX[(size_t)R * DM + 512 + h * 64 + lane] = f2bf(acc / sum);
    }
}

__device__ __forceinline__ void d_scan_attn(CParams& p, int wv, int l, int do_ctx) {
    const int tidx_ = opaque_tid(wv);
    int bidx_ = blockIdx.x, gdim_ = gridDim.x; asm volatile("" : "+s"(bidx_), "+s"(gdim_));
    const int wave = tidx_ >> 6, lane = tidx_ & 63;
    if (bidx_ < 32 && wave == 0) d_rwkv_scan(p, l, bidx_, lane);
    else if (bidx_ < 32 && wave == 1) d_lru_scan(p, bidx_, lane);
    d_na(p, wv, l, do_ctx);
}

__device__ __forceinline__ void d_finish(CParams& p, int wv, int l, int skip_ctx) {
    const int tidx_ = opaque_tid(wv);
    int bidx_ = blockIdx.x, gdim_ = gridDim.x; asm volatile("" : "+s"(bidx_), "+s"(gdim_));
    const int lane = tidx_ & 63, gw = bidx_ * 8 + (tidx_ >> 6), NGW = gdim_ * 8;
    for (int it = gw; it < NROW * 4; it += NGW) {
        const int R = it >> 2, h = it & 3, c = h * 64 + lane;
        if (skip_ctx && (R % TPB) < CTXL) continue;
        const float g = p.P[(size_t)R * INC + 256 + c];
        p.MIX[(size_t)R * DM + c] = f2bf(gelu_tanh(g) * (p.LH[(size_t)R * 256 + c] + p.LH[((size_t)NROW + R) * 256 + c]));
        const float* rs = p.RS + (size_t)R * 768;
        const float r = rs[c], k = rs[256 + c], v = rs[512 + c];
        const float y = p.YB[(size_t)R * 256 + c] + p.YB[((size_t)NROW + R) * 256 + c];
        const float mean = wave_sum(y) * (1.f / 64.f);
        const float dv = y - mean;
        const float var = wave_sum(dv * dv) * (1.f / 64.f);
        const float yn = dv * rsqrtf(var + 64e-5f);
        const float ka = p.in[I_KA][l * 256 + c], rk = p.in[I_RK][l * 256 + c];
        float bon = 0.f;
#pragma unroll
        for (int d = 0; d < 2; ++d) {
            const float a = p.AIC[((size_t)d * NROW + R) * 256 + c];
            bon += r * (k * (1.f + (a - 1.f) * ka)) * rk;
        }
        bon = wave_sum(bon);
        const float o = (yn * p.in[I_LNG][l * 256 + c] + p.in[I_LNB][l * 256 + c] + bon * v) * p.GG[(size_t)R * 256 + c];
        p.MIX[(size_t)R * DM + 256 + c] = f2bf(o);
    }
}

__device__ __forceinline__ void d_norm_router(CParams& p, int wv, int l, int skip_ctx) {
    const int tidx_ = opaque_tid(wv);
    int bidx_ = blockIdx.x, gdim_ = gridDim.x; asm volatile("" : "+s"(bidx_), "+s"(gdim_));
    const int lane = tidx_ & 63, wave = tidx_ >> 6, gw = bidx_ * 8 + wave, NGW = gdim_ * 8;
    const int gtid = bidx_ * NTHR + tidx_, gsz = gdim_ * NTHR;
    for (int i = gtid; i < CAP; i += gsz) p.SLOT_TOK[i] = 0;
    float* hs = (float*)smem + wave * 1024;
    const float* rw = p.in[I_RTW] + (size_t)l * DM * 32;
    const float* g = p.in[I_NFG] + l * DM;
    const int e = lane & 31, half = lane >> 5;
    int* cnt = p.CNT + l * 32;
    for (int R = gw; R < NROW; R += NGW) {
        const int b = R / TPB, pos = R % TPB, mr = pos < CTXL ? 4 : b;
        if (skip_ctx && pos < CTXL) continue;
        const float4* xr = (const float4*)(p.X + (size_t)R * DM);
        float4 v[4]; float ss = 0.f;
#pragma unroll
        for (int i = 0; i < 4; ++i) { v[i] = xr[lane + 64 * i]; ss += v[i].x * v[i].x + v[i].y * v[i].y + v[i].z * v[i].z + v[i].w * v[i].w; }
        ss = wave_sum(ss);
        const float* mod = p.MOD + (l * 5 + mr) * 6144 + 3 * DM;
        const float rinv = rsqrtf(ss * (1.f / DM) + 1e-6f);
        __builtin_amdgcn_wave_barrier();
#pragma unroll
        for (int i = 0; i < 4; ++i) {
            const int c = (lane + 64 * i) * 4;
            const float4 gg = *(const float4*)(g + c), sh = *(const float4*)(mod + c), sc = *(const float4*)(mod + DM + c);
            float4 o;
            o.x = v[i].x * rinv * gg.x * (1.f + sc.x) + sh.x; o.y = v[i].y * rinv * gg.y * (1.f + sc.y) + sh.y;
            o.z = v[i].z * rinv * gg.z * (1.f + sc.z) + sh.z; o.w = v[i].w * rinv * gg.w * (1.f + sc.w) + sh.w;
            uint2 ob; ob.x = cvt_pk_bf16(o.x, o.y); ob.y = cvt_pk_bf16(o.z, o.w);
            *(uint2*)(p.H + (size_t)R * DM + c) = ob;
            *(float4*)(hs + c) = o;
        }
        __builtin_amdgcn_wave_barrier();
        float acc = 0.f;
#pragma unroll 8
        for (int k = half * 512; k < half * 512 + 512; ++k) acc += hs[k] * rw[k * 32 + e];
        acc = sum_xor32(acc);
        float val = acc + p.in[I_RTB][l * 32 + e];
        if (lane >= 32) val = -3e38f;
        float tv[4]; int ti[4];
#pragma unroll
        for (int k = 0; k < 4; ++k) {
            const float m = wave_max(val);
            const unsigned long long bal = __ballot(val == m);
            const int idx = __ffsll((long long)bal) - 1;
            tv[k] = m; ti[k] = idx;
            if (lane == idx) val = -3e38f;
        }
        if (lane == 0) {
            const float e1 = __expf(tv[1] - tv[0]), e2 = __expf(tv[2] - tv[0]), e3 = __expf(tv[3] - tv[0]);
            const float inv = 1.f / (1.f + e1 + e2 + e3);
            const float gs[4] = {inv, e1 * inv, e2 * inv, e3 * inv};
#pragma unroll
            for (int k = 0; k < 4; ++k) {
                p.TOPG[R * 4 + k] = gs[k]; p.TOPI[R * 4 + k] = ti[k];
                p.TOKPOS[R * 4 + k] = atomicAdd(&cnt[ti[k]], 1);
            }
        }
    }
}
__device__ __forceinline__ void moe_offsets_lds(CParams& p, int wv, int l) {
    const int tidx_ = opaque_tid(wv);
    int bidx_ = blockIdx.x, gdim_ = gridDim.x; asm volatile("" : "+s"(bidx_), "+s"(gdim_));
    int* li = (int*)(smem + LDS_GEMM);
    __syncthreads();
    if (tidx_ == 0) {
        int off = 0, nt = 0;
#pragma unroll 1
        for (int e = 0; e < NEXP; ++e) {
            li[e] = off;
            const int n = (p.CNT[l * 32 + e] + MOE_TM - 1) / MOE_TM;
#pragma unroll 1
            for (int i = 0; i < n; ++i) li[64 + nt++] = e;
            off += n * MOE_TM;
        }
        li[32] = off; li[40] = nt;
    }
    __syncthreads();
}
__device__ __forceinline__ void d_moe_scatter(CParams& p, int wv, int l, int skip_ctx) {
    const int tidx_ = opaque_tid(wv);
    int bidx_ = blockIdx.x, gdim_ = gridDim.x; asm volatile("" : "+s"(bidx_), "+s"(gdim_));
    moe_offsets_lds(p, wv, l);
    const int* li = (const int*)(smem + LDS_GEMM);
    const int gtid = bidx_ * NTHR + tidx_, gsz = gdim_ * NTHR;
    for (int i = gtid; i < NROW * 4; i += gsz) {
        const int R = i >> 2;
        if (skip_ctx && (R % TPB) < CTXL) continue;
        p.SLOT_TOK[li[p.TOPI[i]] + p.TOKPOS[i]] = R;
    }
}
struct ProbG1 {
    CParams& p; int l; const int* li; int ntile; int bid, nblk;
    __device__ __forceinline__ bool next(int i, Unit& u) const { return tile_order(i, ntile, 8, u, bid, nblk); }
    __device__ __forceinline__ int expert(const Unit& u) const { return __builtin_amdgcn_readfirstlane(li[64 + u.pm]); }
    __device__ __forceinline__ const char* a_ptr(const Unit&) const { return (const char*)p.H; }
    __device__ __forceinline__ const char* b_ptr(const Unit& u) const { return (const char*)p.WTGU + ((size_t)(l * NEXP + expert(u)) * 2048 + (size_t)u.pn * 256) * KB_; }
    __device__ __forceinline__ int gather_row(const Unit& u, int r) const { return p.SLOT_TOK[u.pm * 256 + r]; }
    __device__ __forceinline__ void epi(const f32x4 (&acc)[2][2][4][2], const Unit& u, int wr, int wc, int fr, int fq) const {
        const int brow = u.pm * 256;
        const float* bias = p.in[I_BGU] + (size_t)(l * NEXP + expert(u)) * 2048;
        const int c = u.pn * 128 + wc * 32 + 8 * fq;
        const f32x4 bg0 = *(const f32x4*)(bias + c), bg1 = *(const f32x4*)(bias + c + 4);
        const f32x4 bu0 = *(const f32x4*)(bias + 1024 + c), bu1 = *(const f32x4*)(bias + 1024 + c + 4);
#pragma unroll
        for (int ai = 0; ai < 2; ++ai)
#pragma unroll
            for (int m = 0; m < 4; ++m) {
                float a[8];
#pragma unroll
                for (int n = 0; n < 2; ++n)
#pragma unroll
                    for (int j = 0; j < 4; ++j) {
                        float gv = acc[ai][0][m][n][j] + (n == 0 ? bg0[j] : bg1[j]), uv = acc[ai][1][m][n][j] + (n == 0 ? bu0[j] : bu1[j]);
                        gv = fminf(gv, 7.f); uv = fminf(fmaxf(uv, -7.f), 7.f);
                        a[n * 4 + j] = (uv + 1.f) * (gv * sigmoidf_(1.702f * gv));
                    }
                u32x4 o; o.x = cvt_pk_bf16(a[0], a[1]); o.y = cvt_pk_bf16(a[2], a[3]); o.z = cvt_pk_bf16(a[4], a[5]); o.w = cvt_pk_bf16(a[6], a[7]);
                *(u32x4*)(p.ACT + (size_t)(brow + ai * 128 + wr * 64 + m * 16 + fr) * DM + c) = o;
            }
    }
};
__device__ __forceinline__ void d_moe_gemm1(CParams& p, int wv, int l) {
    moe_offsets_lds(p, wv, l);
    const int* li = (const int*)(smem + LDS_GEMM);
    ProbG1 P{p, l, li, __builtin_amdgcn_readfirstlane(li[40]), 0, 0};
    gemm_phase<true>(P, wv);
}
struct ProbG2 {
    CParams& p; int l; const int* li; int ntile; int bid, nblk;
    __device__ __forceinline__ bool next(int i, Unit& u) const { return tile_order(i, ntile, 4, u, bid, nblk); }
    __device__ __forceinline__ int expert(const Unit& u) const { return __builtin_amdgcn_readfirstlane(li[64 + u.pm]); }
    __device__ __forceinline__ const char* a_ptr(const Unit& u) const { return (const char*)p.ACT + (size_t)u.pm * 256 * KB_; }
    __device__ __forceinline__ const char* b_ptr(const Unit& u) const { return (const char*)p.WTDN + ((size_t)(l * NEXP + expert(u)) * DM + (size_t)u.pn * 256) * KB_; }
    __device__ __forceinline__ int gather_row(const Unit&, int) const { return 0; }
    __device__ __forceinline__ void epi(const f32x4 (&acc)[2][2][4][2], const Unit& u, int wr, int wc, int fr, int fq) const {
        const int brow = u.pm * 256, bcol = u.pn * 256;
        const float* bias = p.in[I_BDN] + (size_t)(l * NEXP + expert(u)) * DM;
#pragma unroll
        for (int ai = 0; ai < 2; ++ai)
#pragma unroll
            for (int m = 0; m < 4; ++m) {
                float* yrow = p.Y + (size_t)(brow + ai * 128 + wr * 64 + m * 16 + fr) * DM;
#pragma unroll
                for (int bj = 0; bj < 2; ++bj)
#pragma unroll
                    for (int n = 0; n < 2; ++n) {
                        const int col = bcol + bj * 128 + wc * 32 + n * 16 + fq * 4;
                        *(f32x4*)(yrow + col) = acc[ai][bj][m][n] + *(const f32x4*)(bias + col);
                    }
            }
    }
};
__device__ __forceinline__ void d_moe_gemm2(CParams& p, int wv, int l) {
    moe_offsets_lds(p, wv, l);
    const int* li = (const int*)(smem + LDS_GEMM);
    ProbG2 P{p, l, li, __builtin_amdgcn_readfirstlane(li[40]), 0, 0};
    gemm_phase<false>(P, wv);
}
__device__ __forceinline__ void d_moe_combine(CParams& p, int wv, int l, int last) {
    const int tidx_ = opaque_tid(wv);
    int bidx_ = blockIdx.x, gdim_ = gridDim.x; asm volatile("" : "+s"(bidx_), "+s"(gdim_));
    moe_offsets_lds(p, wv, l);
    const int* li = (const int*)(smem + LDS_GEMM);
    const int lane = tidx_ & 63, gw = bidx_ * 8 + (tidx_ >> 6), NGW = gdim_ * 8;
    for (int R = gw; R < NROW; R += NGW) {
        const int b = R / TPB, pos = R % TPB, mr = pos < CTXL ? 4 : b;
        if (last && pos < CTXL) continue;
        float4 acc[4];
#pragma unroll
        for (int i = 0; i < 4; ++i) acc[i] = make_float4(0.f, 0.f, 0.f, 0.f);
#pragma unroll
        for (int k = 0; k < 4; ++k) {
            const float g = p.TOPG[R * 4 + k];
            const int s = li[p.TOPI[R * 4 + k]] + p.TOKPOS[R * 4 + k];
            const float4* yr = (const float4*)(p.Y + (size_t)s * DM);
#pragma unroll
            for (int i = 0; i < 4; ++i) { const float4 y = yr[lane + 64 * i]; acc[i].x += g * y.x; acc[i].y += g * y.y; acc[i].z += g * y.z; acc[i].w += g * y.w; }
        }
        const float* m5 = p.MOD + (l * 5 + mr) * 6144 + 5 * DM;
        float4* xr = (float4*)(p.X + (size_t)R * DM);
        float4 v[4]; float ss = 0.f;
#pragma unroll
        for (int i = 0; i < 4; ++i) {
            const float4 m = *(const float4*)(m5 + (lane + 64 * i) * 4);
            float4 x = xr[lane + 64 * i];
            x.x += m.x * acc[i].x; x.y += m.y * acc[i].y; x.z += m.z * acc[i].z; x.w += m.w * acc[i].w;
            v[i] = x; ss += x.x * x.x + x.y * x.y + x.z * x.z + x.w * x.w;
        }
        ss = wave_sum(ss);
        if (!last) {
#pragma unroll
            for (int i = 0; i < 4; ++i) xr[lane + 64 * i] = v[i];
            norm_row_to_bf16(p, v, ss, l + 1, 0, mr, p.H + (size_t)R * DM, lane);
        } else {
            const float rinv = rsqrtf(ss * (1.f / DM) + 1e-6f);
            float4* orow = (float4*)(p.out + ((size_t)b * SEQ + (pos - CTXL)) * DM);
#pragma unroll
            for (int i = 0; i < 4; ++i) {
                const float4 gg = *(const float4*)(p.in[I_FING] + (lane + 64 * i) * 4);
                float4 r; r.x = v[i].x * rinv * gg.x; r.y = v[i].y * rinv * gg.y; r.z = v[i].z * rinv * gg.z; r.w = v[i].w * rinv * gg.w;
                orow[lane + 64 * i] = r;
            }
        }
    }
}

#ifndef MULTI
#define MULTI 0
#endif
__device__ __forceinline__ void run_phase(CParams& p, int wv, int ph) {
    if (ph == 0) { d_prologue(p, wv); return; }
    if (ph == 1) { d_norm_mix(p, wv, 0); return; }
    const int l = (ph - 2) / 10, q = (ph - 2) % 10, last = l == 1;
    if (ph >= 22) return;
    switch (q) {
        case 0: d_gemm_in(p, wv, l); break;
        case 1: d_lru_pre(p, wv, l); d_rwkv_pre(p, wv, l); break;
        case 2: d_scan_attn(p, wv, l, !last); break;
        case 3: d_finish(p, wv, l, last); break;
        case 4: d_gemm_out(p, wv, l, last); break;
        case 5: d_norm_router(p, wv, l, last); break;
        case 6: d_moe_scatter(p, wv, l, last); break;
        case 7: d_moe_gemm1(p, wv, l); break;
        case 8: d_moe_gemm2(p, wv, l); break;
        case 9: d_moe_combine(p, wv, l, last); break;
    }
}
#if MULTI
template <int PH> __global__ void __launch_bounds__(NTHR) mega_ph(Params p) { run_phase(p, __builtin_amdgcn_readfirstlane(threadIdx.x >> 6), PH); }
__global__ void __launch_bounds__(NTHR) mega(Params p) {}
template <int PH> static void launch_all(CParams& p, int grid, hipStream_t stream) {
    static bool attr = false; if (!attr) { (void)hipFuncSetAttribute((const void*)mega_ph<PH>, hipFuncAttributeMaxDynamicSharedMemorySize, LDS_BYTES); attr = true; }
    mega_ph<PH><<<grid, NTHR, LDS_BYTES, stream>>>(p);
    if constexpr (PH + 1 < 22) launch_all<PH + 1>(p, grid, stream);
}
#else
__global__ void __launch_bounds__(NTHR) mega(Params p) {
    cg::grid_group grid = cg::this_grid();
    const int wv = __builtin_amdgcn_readfirstlane(threadIdx.x >> 6);
#define RUNPH(n) { CParams* pp = (CParams*)__builtin_amdgcn_kernarg_segment_ptr(); asm volatile("" : "+s"(pp)); run_phase(*pp, wv, n); if (n < 21) grid.sync(); }
    RUNPH(0) RUNPH(1) RUNPH(2) RUNPH(3) RUNPH(4) RUNPH(5) RUNPH(6) RUNPH(7) RUNPH(8) RUNPH(9) RUNPH(10)
    RUNPH(11) RUNPH(12) RUNPH(13) RUNPH(14) RUNPH(15) RUNPH(16) RUNPH(17) RUNPH(18) RUNPH(19) RUNPH(20) RUNPH(21)
}
#endif

extern "C" void kernel_launch(void* const* d_in, const int* in_sizes, int n_in, void* d_out, int out_size, void* d_ws, size_t ws_size,
                              hipStream_t stream) {
    Params p{};
    for (int i = 0; i < N_IN; ++i) p.in[i] = (const float*)d_in[i];
    p.out = (float*)d_out;
    char* w = (char*)d_ws;
    size_t off = 0;
    auto take = [&](size_t bytes) { void* r = w + off; off += (bytes + 255) & ~(size_t)255; return r; };
    p.X = (float*)take((size_t)NROW * DM * 4);
    p.H = (bf16_t*)take((size_t)NROW * DM * 2);
    p.P = (float*)take((size_t)NROW * INC * 4);
    p.MIX = (bf16_t*)take((size_t)NROW * DM * 2);
    p.MOD = (float*)take(2 * 5 * 6144 * 4);
    p.LA = (float*)take((size_t)2 * NROW * 256 * 4);
    p.LB = (float*)take((size_t)2 * NROW * 256 * 4);
    p.LH = (float*)take((size_t)2 * NROW * 256 * 4);
    p.RS = (float*)take((size_t)NROW * 768 * 4);
    p.DEC = (float*)take((size_t)2 * NROW * 256 * 4);
    p.AIC = (float*)take((size_t)2 * NROW * 256 * 4);
    p.KKN = (float*)take((size_t)NROW * 256 * 4);
    p.GG = (float*)take((size_t)NROW * 256 * 4);
    p.YB = (float*)take((size_t)2 * NROW * 256 * 4);
    p.TOPG = (float*)take((size_t)NROW * 4 * 4);
    p.TOPI = (int*)take((size_t)NROW * 4 * 4);
    p.TOKPOS = (int*)take((size_t)NROW * 4 * 4);
    p.CNT = (int*)take(64 * 4);
    p.SLOT_TOK = (int*)take((size_t)CAP * 4);
    p.ACT = (bf16_t*)take((size_t)CAP * DM * 2);
    p.Y = (float*)take((size_t)CAP * DM * 4);
    p.WTIN = (bf16_t*)take((size_t)2 * INCP * DM * 2);
    p.WTOUT = (bf16_t*)take((size_t)2 * DM * DM * 2);
    p.WTGU = (bf16_t*)take((size_t)2 * NEXP * 2048 * DM * 2);
    p.WTDN = (bf16_t*)take((size_t)2 * NEXP * DM * DM * 2);

    static int grid_blocks = 0;
    if (!grid_blocks) {
        int dev = 0, cus = 0, per_cu = 0;
        (void)hipGetDevice(&dev);
        (void)hipDeviceGetAttribute(&cus, hipDeviceAttributeMultiprocessorCount, dev);
        (void)hipFuncSetAttribute((const void*)mega, hipFuncAttributeMaxDynamicSharedMemorySize, LDS_BYTES);
        (void)hipOccupancyMaxActiveBlocksPerMultiprocessor(&per_cu, (const void*)mega, NTHR, LDS_BYTES);
        if (per_cu > 1) per_cu = 1;
        if (per_cu < 1) { fprintf(stderr, "occupancy query says %d blocks/CU\n", per_cu); per_cu = 1; }
        grid_blocks = cus * per_cu;
        (void)hipGetLastError();
    }
#if MULTI
    launch_all<0>(p, grid_blocks, stream);
#else
    void* args[] = {&p};
    hipError_t e = hipLaunchCooperativeKernel((void*)mega, dim3(grid_blocks), dim3(NTHR), args, LDS_BYTES, stream);
    if (e != hipSuccess) fprintf(stderr, "cooperative launch failed: %s (grid %d)\n", hipGetErrorString(e), grid_blocks);
#endif
}
```

```cpp
#include <hip/hip_runtime.h>
#include <hip/hip_cooperative_groups.h>
#include <stdint.h>
#include <cstdio>
namespace cg = cooperative_groups;

#define DM 1024
#define NBATCH 4
#define SEQ 4096
#define CTXL 256
#define TPB 4352
#define NROW 17408
#define INC 3008
#define INCP 3072
#define NEXP 32
#define MOE_TM 256
#define CAP (NROW * 4 + NEXP * MOE_TM)
#define MAXTILES (CAP / MOE_TM)
#define NTHR 512
#define LDS_GEMM 131072
#define LDS_BYTES 155648

typedef unsigned short bf16_t;
typedef short bf16x8 __attribute__((ext_vector_type(8)));
typedef float f32x4 __attribute__((ext_vector_type(4)));
typedef unsigned u32x4 __attribute__((ext_vector_type(4)));
typedef unsigned u32x2 __attribute__((ext_vector_type(2)));

enum { I_X = 0, I_C, I_CTX, I_CCTX, I_ADAW, I_ADAB, I_NMG, I_NFG, I_WIN, I_WOUT, I_CONVW, I_CONVB, I_WR, I_BR, I_WI, I_BI,
       I_LAM, I_MU, I_W0, I_W2, I_A0, I_A2, I_G2, I_KK, I_KA, I_RK, I_LNG, I_LNB, I_RPB, I_RTW, I_RTB, I_WGU, I_BGU, I_WDN,
       I_BDN, I_FING, N_IN };

struct Params {
    const float* in[N_IN];
    float* out;
    float* X;
    bf16_t* H;
    float* P;
    bf16_t* MIX;
    float* MOD;
    float* LA;
    float* LB;
    float* LH;
    float* RS;
    float* DEC;
    float* AIC;
    float* KKN;
    float* GG;
    float* YB;
    float* TOPG;
    int* TOPI;
    int* TOKPOS;
    int* CNT;
    int* SLOT_TOK;
    bf16_t* ACT;
    float* Y;
    bf16_t* RMF;
    bf16_t* RQF;
    float* RNF;
    float* RYF;
    bf16_t* WTIN;
    bf16_t* WTOUT;
    bf16_t* WTGU;
    bf16_t* WTDN;
};

typedef const __attribute__((address_space(4))) Params CParams;
extern __shared__ __attribute__((aligned(16))) unsigned char smem[];

__device__ __forceinline__ int opaque_tid(int wv) { int t; asm volatile("v_mbcnt_lo_u32_b32 %0, -1, 0\n\tv_mbcnt_hi_u32_b32 %0, -1, %0" : "=v"(t)); return wv * 64 + t; }
__device__ __forceinline__ float sigmoidf_(float x) { return 1.f / (1.f + __expf(-x)); }
__device__ __forceinline__ float softplusf_(float x) { return x > 20.f ? x : log1pf(__expf(x)); }
#define SWZ_XOR(v, o) __int_as_float(__builtin_amdgcn_ds_swizzle(__float_as_int(v), ((o) << 10) | 0x1f))
__device__ __forceinline__ float rdlane(float v, int l) { return __int_as_float(__builtin_amdgcn_readlane(__float_as_int(v), l)); }
__device__ __forceinline__ float sum_xor32(float v) {
    int a = __float_as_int(v), b = a;
    asm volatile("s_nop 1\n\tv_permlane32_swap_b32 %0, %1\n\ts_nop 1" : "+v"(a), "+v"(b));
    return __int_as_float(a) + __int_as_float(b);
}
__device__ __forceinline__ float wave_sum(float v) {
    v += SWZ_XOR(v, 1); v += SWZ_XOR(v, 2); v += SWZ_XOR(v, 4); v += SWZ_XOR(v, 8); v += SWZ_XOR(v, 16);
    return rdlane(v, 0) + rdlane(v, 32);
}
__device__ __forceinline__ float wave_max(float v) {
    v = fmaxf(v, SWZ_XOR(v, 1)); v = fmaxf(v, SWZ_XOR(v, 2)); v = fmaxf(v, SWZ_XOR(v, 4)); v = fmaxf(v, SWZ_XOR(v, 8)); v = fmaxf(v, SWZ_XOR(v, 16));
    return fmaxf(rdlane(v, 0), rdlane(v, 32));
}
typedef __bf16 bf16x2_n __attribute__((ext_vector_type(2)));
__device__ __forceinline__ unsigned cvt_pk_bf16(float lo, float hi) { bf16x2_n v; v[0] = (__bf16)lo; v[1] = (__bf16)hi; return __builtin_bit_cast(unsigned, v); }
__device__ __forceinline__ bf16_t f2bf(float x) { return __builtin_bit_cast(bf16_t, (__bf16)x); }
__device__ __forceinline__ float gelu_tanh(float x) {
    const float u = 0.7978845608028654f * (x + 0.044715f * x * x * x);
    return 0.5f * x * (1.f + tanhf(u));
}

__device__ __forceinline__ int inv_perm32(int cc) { return ((cc >> 2) & 1) * 16 + (cc >> 3) * 4 + (cc & 3); }
__device__ __forceinline__ void transpose_item(const float* W, int K, int N, bf16_t* WT, int k0, int n0, int dst_row0, float* scr, int lane, bool perm = false) {
#pragma unroll 8
    for (int i = 0; i < 32; ++i) { const int kk = 2 * i + (lane >> 5); scr[kk * 33 + (lane & 31)] = W[(size_t)(k0 + kk) * N + n0 + (lane & 31)]; }
    __builtin_amdgcn_wave_barrier();
    const int c = lane & 7;
#pragma unroll
    for (int j = 0; j < 4; ++j) {
        const int n = (lane >> 3) + 8 * j; const float* s = scr + (8 * c) * 33 + n;
        u32x4 o; o.x = cvt_pk_bf16(s[0 * 33], s[1 * 33]); o.y = cvt_pk_bf16(s[2 * 33], s[3 * 33]); o.z = cvt_pk_bf16(s[4 * 33], s[5 * 33]); o.w = cvt_pk_bf16(s[6 * 33], s[7 * 33]);
        *(u32x4*)(WT + (size_t)(dst_row0 + (perm ? inv_perm32(n) : n)) * K + k0 + 8 * c) = o;
    }
    __builtin_amdgcn_wave_barrier();
}

__device__ __forceinline__ void d_prologue(CParams& p, int wv) {
    const int tidx_ = opaque_tid(wv);
    int bidx_ = blockIdx.x, gdim_ = gridDim.x; asm volatile("" : "+s"(bidx_), "+s"(gdim_));
    const int tid = tidx_, lane = tid & 63, wave = tid >> 6;
    const int gtid = bidx_ * NTHR + tid, gsz = gdim_ * NTHR;
    const int gw = bidx_ * 8 + wave, NGW = gdim_ * 8;
    {
        const float4* x4 = (const float4*)p.in[I_X];
        const float4* c4 = (const float4*)p.in[I_CTX];
        float4* X4 = (float4*)p.X;
        for (int i = gtid; i < NROW * 256; i += gsz) {
            const int R = i >> 8, q = i & 255, b = R / TPB, pos = R % TPB;
            X4[i] = pos < CTXL ? c4[(b * CTXL + pos) * 256 + q] : x4[((size_t)b * SEQ + (pos - CTXL)) * 256 + q];
        }
    }
    if (gtid < 64) p.CNT[gtid] = 0;
    for (int i = gtid; i < 2 * 64 * 1024 / 8; i += gsz) {
        const int l = i / (64 * 128), r = i % (64 * 128);
        *(u32x4*)(p.WTIN + ((size_t)l * INCP + INC) * DM + (size_t)r * 8) = (u32x4){0u, 0u, 0u, 0u};
    }
    {
        float* sc = (float*)smem;
        float* part = (float*)(smem + 5 * 1024 * 4);
        for (int i = tid; i < 5 * DM; i += NTHR) { const int r = i / DM, d = i % DM; const float v = r < 4 ? p.in[I_C][r * DM + d] : p.in[I_CCTX][d]; sc[i] = v * sigmoidf_(v); }
        __syncthreads();
        for (int cb = bidx_; cb < 256; cb += gdim_) {
            const int col = tid % 48, ks = tid / 48;
            const int gc = cb * 48 + col, l = gc / 6144, n = gc % 6144;
            if (ks < 8) {
                const float* W = p.in[I_ADAW] + (size_t)l * DM * 6144 + n;
                float a0 = 0.f, a1 = 0.f, a2 = 0.f, a3 = 0.f, a4 = 0.f;
#pragma unroll 8
                for (int k = ks * 128; k < ks * 128 + 128; ++k) {
                    const float w = W[(size_t)k * 6144];
                    a0 += sc[k] * w; a1 += sc[DM + k] * w; a2 += sc[2 * DM + k] * w; a3 += sc[3 * DM + k] * w; a4 += sc[4 * DM + k] * w;
                }
                float* pp = part + (ks * 5) * 48 + col;
                pp[0] = a0; pp[48] = a1; pp[96] = a2; pp[144] = a3; pp[192] = a4;
            }
            __syncthreads();
            if (tid < 240) {
                const int r = tid / 48, c2 = tid % 48, gc2 = cb * 48 + c2, l2 = gc2 / 6144, n2 = gc2 % 6144;
                float s = p.in[I_ADAB][l2 * 6144 + n2];
#pragma unroll
                for (int k = 0; k < 8; ++k) s += part[(k * 5 + r) * 48 + c2];
                p.MOD[(l2 * 5 + r) * 6144 + n2] = s;
            }
            __syncthreads();
        }
    }
    {
        float* scr = (float*)(smem + 32768) + wave * (64 * 33);
        const int N_IN_ = 2 * 16 * 94, N_OUT_ = 2 * 16 * 32, N_GU_ = 64 * 16 * 64, N_DN_ = 64 * 16 * 32;
        for (int it = gw; it < N_IN_ + N_OUT_ + N_GU_ + N_DN_; it += NGW) {
            int r = it;
            if (r < N_IN_) { const int l = r / (16 * 94), q = r % (16 * 94), kb = q / 94, nb = q % 94;
                transpose_item(p.in[I_WIN] + (size_t)l * DM * INC, DM, INC, p.WTIN + (size_t)l * INCP * DM, kb * 64, nb * 32, nb * 32, scr, lane); continue; }
            r -= N_IN_;
            if (r < N_OUT_) { const int l = r / 512, q = r % 512, kb = q / 32, nb = q % 32;
                transpose_item(p.in[I_WOUT] + (size_t)l * DM * DM, DM, DM, p.WTOUT + (size_t)l * DM * DM, kb * 64, nb * 32, nb * 32, scr, lane); continue; }
            r -= N_OUT_;
            if (r < N_GU_) { const int le = r / 1024, q = r % 1024, kb = q / 64, nb = q % 64;
                const int c0 = nb * 32; const int dst = c0 < 1024 ? (c0 / 128) * 256 + (c0 % 128) : ((c0 - 1024) / 128) * 256 + 128 + ((c0 - 1024) % 128);
                transpose_item(p.in[I_WGU] + (size_t)le * DM * 2048, DM, 2048, p.WTGU + (size_t)le * 2048 * DM, kb * 64, c0, dst, scr, lane, true); continue; }
            r -= N_GU_;
            { const int le = r / 512, q = r % 512, kb = q / 32, nb = q % 32;
                transpose_item(p.in[I_WDN] + (size_t)le * DM * DM, DM, DM, p.WTDN + (size_t)le * DM * DM, kb * 64, nb * 32, nb * 32, scr, lane); }
        }
    }
}

__device__ __forceinline__ void norm_row_to_bf16(CParams& p, const float4 (&v)[4], float ss, int l, int which, int mr, bf16_t* hrow, int lane) {
    const float* g = (which == 0 ? p.in[I_NMG] : p.in[I_NFG]) + l * DM;
    const float* mod = p.MOD + (l * 5 + mr) * 6144 + (which == 0 ? 0 : 3 * DM);
    const float rinv = rsqrtf(ss * (1.f / DM) + 1e-6f);
#pragma unroll
    for (int i = 0; i < 4; ++i) {
        const int c = (lane + 64 * i) * 4;
        const float4 gg = *(const float4*)(g + c), sh = *(const float4*)(mod + c), sc = *(const float4*)(mod + DM + c);
        const float o0 = v[i].x * rinv * gg.x * (1.f + sc.x) + sh.x, o1 = v[i].y * rinv * gg.y * (1.f + sc.y) + sh.y;
        const float o2 = v[i].z * rinv * gg.z * (1.f + sc.z) + sh.z, o3 = v[i].w * rinv * gg.w * (1.f + sc.w) + sh.w;
        uint2 o; o.x = cvt_pk_bf16(o0, o1); o.y = cvt_pk_bf16(o2, o3);
        *(uint2*)(hrow + c) = o;
    }
}
__device__ __forceinline__ void d_norm_mix(CParams& p, int wv, int l) {
    const int tidx_ = opaque_tid(wv);
    int bidx_ = blockIdx.x, gdim_ = gridDim.x; asm volatile("" : "+s"(bidx_), "+s"(gdim_));
    const int lane = tidx_ & 63, gw = bidx_ * 8 + (tidx_ >> 6), NGW = gdim_ * 8;
    for (int R = gw; R < NROW; R += NGW) {
        const int b = R / TPB, pos = R % TPB, mr = pos < CTXL ? 4 : b;
        const float4* xr = (const float4*)(p.X + (size_t)R * DM);
        float4 v[4]; float ss = 0.f;
#pragma unroll
        for (int i = 0; i < 4; ++i) { v[i] = xr[lane + 64 * i]; ss += v[i].x * v[i].x + v[i].y * v[i].y + v[i].z * v[i].z + v[i].w * v[i].w; }
        ss = wave_sum(ss);
        norm_row_to_bf16(p, v, ss, l, 0, mr, p.H + (size_t)R * DM, lane);
    }
}

#define LAS __attribute__((address_space(3)))
#define HTB 16384
#define KB_ 2048
__device__ __forceinline__ int lds_byte(int r, int c) {
    const int st = (r >> 4) * 2 + (c >> 5), rr = r & 15, cc = c & 31, ob = rr * 64 + cc * 2;
    return st * 1024 + (ob ^ (((ob >> 9) & 1) << 5));
}
__device__ __forceinline__ void stage_rc(int b, int& R, int& C) {
    const int st = b / 1024, sb = b % 1024, swz = sb ^ (((sb >> 9) & 1) << 5);
    R = (st >> 1) * 16 + swz / 64; C = (st & 1) * 32 + (swz % 64) / 2;
}
struct Unit { int pm, pn; };
__device__ __forceinline__ bool tile_order(int i, int nM, int nN, Unit& u, int bid, int nblk) {
    const int nwg = nM * nN; const long L = (long)i * nblk + bid; if (L >= nwg) return false;
    int wgid = (int)L; { const int q = nwg / 8, r = nwg % 8, xcd = wgid % 8, off = wgid / 8; wgid = (xcd < r ? xcd * (q + 1) : r * (q + 1) + (xcd - r) * q) + off; }
    const int nig = 8 * nN, gid = wgid / nig, fm = gid * 8, gsz = (nM - fm) < 8 ? (nM - fm) : 8;
    u.pm = fm + ((wgid % nig) % gsz); u.pn = (wgid % nig) / gsz; return true;
}

#define PG_SA(b, h) (((b) * 2 + (h)) * HTB)
#define PG_SB(b, h) ((4 + (b) * 2 + (h)) * HTB)
#define PG_STAGE(bufoff, gbase, v0, v1) do { \
    __builtin_amdgcn_global_load_lds((const unsigned*)((const char*)(gbase) + (v0)), (LAS unsigned*)(lds + (bufoff) + ldsw), 16, 0, 0); \
    __builtin_amdgcn_global_load_lds((const unsigned*)((const char*)(gbase) + (v1)), (LAS unsigned*)(lds + (bufoff) + ldsw + 8192), 16, 0, 0); } while (0)
#define PG_STAGE_B(bufoff, gbase) PG_STAGE(bufoff, gbase, voffB[0], voffB[1])
#define PG_STAGE_A(bufoff, gb, h, usenext) do { if (GATHER) PG_STAGE(bufoff, gb, gc[h][0], gc[h][1]); \
    else PG_STAGE(bufoff, (gb) + (h) * hstep, voffA[0], voffA[1]); } while (0)
#define PG_LDA(dst, b, h) do { _Pragma("unroll") for (int m = 0; m < 4; ++m) _Pragma("unroll") for (int k = 0; k < 2; ++k) dst[m][k] = *(const LAS bf16x8*)(lds + PG_SA(b, h) + aoff + m * 2048 + k * 1024); } while (0)
#define PG_LDB(dst, b, h) do { _Pragma("unroll") for (int n = 0; n < 2; ++n) _Pragma("unroll") for (int k = 0; k < 2; ++k) dst[n][k] = *(const LAS bf16x8*)(lds + PG_SB(b, h) + boff + n * 2048 + k * 1024); } while (0)
#define PG_MMA(ai, bj, At_, Bt_) do { __builtin_amdgcn_s_setprio(1); _Pragma("unroll") for (int m = 0; m < 4; ++m) _Pragma("unroll") for (int n = 0; n < 2; ++n) _Pragma("unroll") for (int k = 0; k < 2; ++k) \
    acc[ai][bj][m][n] = __builtin_amdgcn_mfma_f32_16x16x32_bf16(Bt_[n][k], At_[m][k], acc[ai][bj][m][n], 0, 0, 0); __builtin_amdgcn_s_setprio(0); } while (0)
#define PG_WAIT_V(n) asm volatile("s_waitcnt vmcnt(" #n ")" ::: "memory")
#define PG_WAIT_L(n) asm volatile("s_waitcnt lgkmcnt(" #n ")" ::: "memory")
#define PG_BAR __builtin_amdgcn_s_barrier()
#define PG_SCHED __builtin_amdgcn_sched_barrier(0)

template <bool GATHER, class Prob>
__device__ __forceinline__ void gemm_phase(Prob P, int wv) {
    const int tidx_ = opaque_tid(wv);
    int bidx_ = blockIdx.x, gdim_ = gridDim.x; asm volatile("" : "+s"(bidx_), "+s"(gdim_));
    LAS unsigned char* lds = (LAS unsigned char*)smem;
    P.bid = bidx_; P.nblk = gdim_;
    const int tid = tidx_, wid = __builtin_amdgcn_readfirstlane(tid >> 6), lane = tid & 63, wr = wid >> 2, wc = wid & 3, fr = lane & 15, fq = lane >> 4;
    constexpr int nt = 16;
    unsigned voffA[2], voffB[2]; int Rr[2], Cc[2];
#pragma unroll
    for (int i = 0; i < 2; ++i) { stage_rc(tid * 16 + i * 8192, Rr[i], Cc[i]); voffA[i] = (unsigned)(Rr[i] * 1024 + Cc[i]) * 2u; voffB[i] = voffA[i]; }
    const size_t kstep = 128, hstep = (size_t)128 * KB_;
    const unsigned ldsw = (unsigned)wid * 1024u;
    const int aoff = lds_byte(wr * 64 + fr, fq * 8), boff = lds_byte(wc * 32 + fr, fq * 8);
    Unit cur, nxt; int ui = 0;
    if (!P.next(0, cur)) return;
    f32x4 acc[2][2][4][2];
#pragma unroll
    for (int a = 0; a < 2; ++a)
#pragma unroll
        for (int b = 0; b < 2; ++b)
#pragma unroll
            for (int m = 0; m < 4; ++m)
#pragma unroll
                for (int n = 0; n < 2; ++n) acc[a][b][m][n] = (f32x4){0.f, 0.f, 0.f, 0.f};
    bf16x8 At[4][2], B0[2][2], B1[2][2];
    unsigned gc[2][2] = {{0u, 0u}, {0u, 0u}};
    if (GATHER) {
#pragma unroll
        for (int h = 0; h < 2; ++h)
#pragma unroll
            for (int i = 0; i < 2; ++i) gc[h][i] = (unsigned)P.gather_row(cur, h * 128 + Rr[i]) * (unsigned)KB_ + (unsigned)Cc[i] * 2u;
    }
    const char* cA = P.a_ptr(cur); const char* cB = P.b_ptr(cur);
    PG_STAGE_B(PG_SB(0, 0), cB); PG_STAGE_A(PG_SA(0, 0), cA, 0, false); PG_STAGE_B(PG_SB(0, 1), cB + hstep); PG_STAGE_A(PG_SA(0, 1), cA, 1, false);
    if (wr == 1) PG_BAR;
    PG_WAIT_V(4); PG_BAR;
    PG_STAGE_B(PG_SB(1, 0), cB + kstep); PG_STAGE_A(PG_SA(1, 0), cA + kstep, 0, false); PG_STAGE_B(PG_SB(1, 1), cB + hstep + kstep);
    PG_WAIT_V(6); PG_BAR;
    for (;;) {
        const bool has_next = P.next(ui + 1, nxt);
        const char* nA = has_next ? P.a_ptr(nxt) : cA; const char* nB = has_next ? P.b_ptr(nxt) : cB;
        for (int t = 0; t < nt; t += 2) {
            const bool last = (t == nt - 2);
            if (GATHER && last && has_next) {
#pragma unroll
                for (int i = 0; i < 2; ++i) gc[0][i] = (unsigned)P.gather_row(nxt, Rr[i]) * (unsigned)KB_ + (unsigned)Cc[i] * 2u;
            }
            const char* a1 = cA + (size_t)(t + 1) * kstep;
            const char* a2 = last ? nA : cA + (size_t)(t + 2) * kstep; const char* b2 = last ? nB : cB + (size_t)(t + 2) * kstep;
            const char* a3 = a2 + kstep; const char* b3 = b2 + kstep;
            PG_LDB(B0, 0, 0); PG_SCHED; PG_LDA(At, 0, 0); PG_STAGE_A(PG_SA(1, 1), a1, 1, false);
            PG_WAIT_L(8); PG_BAR; PG_WAIT_L(0); PG_MMA(0, 0, At, B0); PG_BAR; PG_SCHED;
            if (GATHER && last && has_next) {
#pragma unroll
                for (int i = 0; i < 2; ++i) gc[1][i] = (unsigned)P.gather_row(nxt, 128 + Rr[i]) * (unsigned)KB_ + (unsigned)Cc[i] * 2u;
            }
            PG_LDB(B1, 0, 1); PG_STAGE_B(PG_SB(0, 0), b2);
            PG_BAR; PG_WAIT_L(0); PG_MMA(0, 1, At, B1); PG_BAR;
            PG_LDA(At, 0, 1); PG_STAGE_A(PG_SA(0, 0), a2, 0, last);
            PG_BAR; PG_WAIT_L(0); PG_MMA(1, 0, At, B0); PG_BAR; PG_SCHED;
            PG_STAGE_B(PG_SB(0, 1), b2 + hstep);
            PG_WAIT_V(6); PG_BAR; PG_MMA(1, 1, At, B1); PG_BAR;
            PG_LDB(B0, 1, 0); PG_SCHED; PG_LDA(At, 1, 0); PG_STAGE_A(PG_SA(0, 1), a2, 1, last);
            PG_WAIT_L(8); PG_BAR; PG_WAIT_L(0); PG_MMA(0, 0, At, B0); PG_BAR; PG_SCHED;
            PG_LDB(B1, 1, 1); PG_STAGE_B(PG_SB(1, 0), b3);
            PG_BAR; PG_WAIT_L(0); PG_MMA(0, 1, At, B1); PG_BAR;
            PG_LDA(At, 1, 1); PG_STAGE_A(PG_SA(1, 0), a3, 0, last);
            PG_BAR; PG_WAIT_L(0); PG_MMA(1, 0, At, B0); PG_BAR; PG_SCHED;
            PG_STAGE_B(PG_SB(1, 1), b3 + hstep);
            PG_WAIT_V(6); PG_BAR; PG_MMA(1, 1, At, B1); PG_BAR;
        }
        P.epi(acc, cur, wr, wc, fr, fq);
        if (!has_next) break;
#pragma unroll
        for (int a = 0; a < 2; ++a)
#pragma unroll
            for (int b = 0; b < 2; ++b)
#pragma unroll
                for (int m = 0; m < 4; ++m)
#pragma unroll
                    for (int n = 0; n < 2; ++n) acc[a][b][m][n] = (f32x4){0.f, 0.f, 0.f, 0.f};
        cur = nxt; cA = nA; cB = nB; ++ui;
    }
    PG_WAIT_V(0);
    if (wr == 0) PG_BAR;
    PG_BAR;
}

struct ProbIn {
    CParams& p; int l; int bid, nblk;
    __device__ __forceinline__ bool next(int i, Unit& u) const { return tile_order(i, NROW / 256, INCP / 256, u, bid, nblk); }
    __device__ __forceinline__ const char* a_ptr(const Unit& u) const { return (const char*)p.H + (size_t)u.pm * 256 * KB_; }
    __device__ __forceinline__ const char* b_ptr(const Unit& u) const { return (const char*)p.WTIN + ((size_t)l * INCP + (size_t)u.pn * 256) * KB_; }
    __device__ __forceinline__ int gather_row(const Unit&, int) const { return 0; }
    __device__ __forceinline__ void epi(const f32x4 (&acc)[2][2][4][2], const Unit& u, int wr, int wc, int fr, int fq) const {
        const int brow = u.pm * 256, bcol = u.pn * 256;
#pragma unroll
        for (int ai = 0; ai < 2; ++ai)
#pragma unroll
            for (int m = 0; m < 4; ++m) {
                float* prow = p.P + (size_t)(brow + ai * 128 + wr * 64 + m * 16 + fr) * INC;
#pragma unroll
                for (int bj = 0; bj < 2; ++bj)
#pragma unroll
                    for (int n = 0; n < 2; ++n) {
                        const int col = bcol + bj * 128 + wc * 32 + n * 16 + fq * 4;
                        if (col < INC) *(f32x4*)(prow + col) = acc[ai][bj][m][n];
                    }
            }
    }
};
__device__ __forceinline__ void d_gemm_in(CParams& p, int wv, int l) { ProbIn P{p, l, 0, 0}; gemm_phase<false>(P, wv); }

struct ProbOut {
    CParams& p; int l; int skip_ctx; int bid, nblk;
    __device__ __forceinline__ bool next(int i, Unit& u) const {
        if (!tile_order(i, skip_ctx ? 64 : 68, 4, u, bid, nblk)) return false;
        if (skip_ctx) u.pm = (u.pm / 16) * 17 + 1 + (u.pm % 16);
        return true; }
    __device__ __forceinline__ const char* a_ptr(const Unit& u) const { return (const char*)p.MIX + (size_t)u.pm * 256 * KB_; }
    __device__ __forceinline__ const char* b_ptr(const Unit& u) const { return (const char*)p.WTOUT + ((size_t)l * DM + (size_t)u.pn * 256) * KB_; }
    __device__ __forceinline__ int gather_row(const Unit&, int) const { return 0; }
    __device__ __forceinline__ void epi(const f32x4 (&acc)[2][2][4][2], const Unit& u, int wr, int wc, int fr, int fq) const {
        const int brow = u.pm * 256, bcol = u.pn * 256;
        const int b = u.pm / 17, mr = (u.pm % 17) == 0 ? 4 : b;
        const float* gate = p.MOD + (l * 5 + mr) * 6144 + 2 * DM;
#pragma unroll
        for (int ai = 0; ai < 2; ++ai)
#pragma unroll
            for (int m = 0; m < 4; ++m) {
                float* xrow = p.X + (size_t)(brow + ai * 128 + wr * 64 + m * 16 + fr) * DM;
#pragma unroll
                for (int bj = 0; bj < 2; ++bj)
#pragma unroll
                    for (int n = 0; n < 2; ++n) {
                        const int col = bcol + bj * 128 + wc * 32 + n * 16 + fq * 4;
                        const f32x4 gt = *(const f32x4*)(gate + col);
                        f32x4* xp = (f32x4*)(xrow + col);
                        *xp = *xp + gt * acc[ai][bj][m][n];
                    }
                asm volatile("" ::: "memory");
            }
    }
};
__device__ __forceinline__ void d_gemm_out(CParams& p, int wv, int l, int skip_ctx) { ProbOut P{p, l, skip_ctx, 0, 0}; gemm_phase<false>(P, wv); }

__device__ __forceinline__ void d_lru_pre(CParams& p, int wv, int l) {
    const int tidx_ = opaque_tid(wv);
    int bidx_ = blockIdx.x, gdim_ = gridDim.x; asm volatile("" : "+s"(bidx_), "+s"(gdim_));
    const int lane = tidx_ & 63, wave = tidx_ >> 6, gw = bidx_ * 8 + wave, NGW = gdim_ * 8;
    float* xcw = (float*)smem + wave * 64;
    for (int it = gw; it < 2 * NROW * 4; it += NGW) {
        const int h = it & 3, R = (it >> 2) % NROW, d = (it >> 2) / NROW, pos = R % TPB;
        const int seg0 = pos < CTXL ? 0 : CTXL, seg1 = pos < CTXL ? CTXL : TPB;
        const int c = h * 64 + lane;
        const float* cw = p.in[I_CONVW] + ((l * 2 + d) * 4) * 256;
        float acc = p.in[I_CONVB][(l * 2 + d) * 256 + c];
#pragma unroll
        for (int j = 0; j < 4; ++j) {
            const int q = d == 0 ? pos - j : pos + j;
            if (q >= seg0 && q < seg1) acc += cw[j * 256 + c] * p.P[(size_t)(R + (q - pos)) * INC + c];
        }
        __builtin_amdgcn_wave_barrier();
        xcw[lane] = acc;
        __builtin_amdgcn_wave_barrier();
        const float* wr = p.in[I_WR] + (size_t)((l * 2 + d) * 4 + h) * 4096 + lane;
        const float* wi = p.in[I_WI] + (size_t)((l * 2 + d) * 4 + h) * 4096 + lane;
        float gr = p.in[I_BR][(l * 2 + d) * 256 + c], gi = p.in[I_BI][(l * 2 + d) * 256 + c];
#pragma unroll 8
        for (int i = 0; i < 64; ++i) { const float xv = xcw[i]; gr += xv * wr[i * 64]; gi += xv * wi[i * 64]; }
        gr = sigmoidf_(gr); gi = sigmoidf_(gi);
        const float lam = p.in[I_LAM][(l * 2 + d) * 256 + c];
        const float log_a = -8.0f * gr * softplusf_(-lam);
        const float a = __expf(log_a);
        const float bb = sqrtf(fmaxf(-expm1f(2.f * log_a), 0.f)) * (gi * acc);
        p.LA[((size_t)d * NROW + R) * 256 + c] = a;
        p.LB[((size_t)d * NROW + R) * 256 + c] = bb;
    }
}
__device__ __forceinline__ void d_lru_scan(CParams& p, int widx, int lane) {
    const int gt = widx * 64 + lane;
    const int c = gt & 255, d = (gt >> 8) & 1, b = gt >> 9;
    const float* la = p.LA + ((size_t)d * NROW + (size_t)b * TPB) * 256 + c;
    const float* lb = p.LB + ((size_t)d * NROW + (size_t)b * TPB) * 256 + c;
    float* lh = p.LH + ((size_t)d * NROW + (size_t)b * TPB) * 256 + c;
    float h = 0.f;
    for (int s0 = 0; s0 < TPB; s0 += 16) {
        float av[16], bv[16]; int ps[16];
#pragma unroll
        for (int u = 0; u < 16; ++u) {
            const int s = s0 + u;
            ps[u] = d == 0 ? s : (s < CTXL ? CTXL - 1 - s : TPB - 1 - (s - CTXL));
            av[u] = la[(size_t)ps[u] * 256]; bv[u] = lb[(size_t)ps[u] * 256];
        }
#pragma unroll
        for (int u = 0; u < 16; ++u) { h = av[u] * h + bv[u]; lh[(size_t)ps[u] * 256] = h; }
    }
}

__device__ __forceinline__ void d_rwkv_pre(CParams& p, int wv, int l) {
    const int tidx_ = opaque_tid(wv);
    int bidx_ = blockIdx.x, gdim_ = gridDim.x; asm volatile("" : "+s"(bidx_), "+s"(gdim_));
    const int lane = tidx_ & 63, wave = tidx_ >> 6, gw = bidx_ * 8 + wave, NGW = gdim_ * 8;
    float* tw = (float*)smem + 1024 + wave * 192; float* al = tw + 64; float* sg = tw + 128;
    const float* mu = p.in[I_MU] + l * 2 * 960;
    for (int R = gw; R < NROW; R += NGW) {
        const int pos = R % TPB;
        const int seg0 = pos < CTXL ? 0 : CTXL, seg1 = pos < CTXL ? CTXL : TPB;
        const float* pr = p.P + (size_t)R * INC + 512;
        float sv[15];
#pragma unroll
        for (int q = 0; q < 15; ++q) {
            const int col = lane + 64 * q;
            const float v = pr[col];
            const float pv = pos > seg0 ? pr[col - INC] : 0.f;
            const float nv = pos + 1 < seg1 ? pr[col + INC] : 0.f;
            sv[q] = v + mu[col] * (pv - v) + mu[960 + col] * (nv - v);
        }
#pragma unroll
        for (int q = 0; q < 12; ++q) p.RS[(size_t)R * 768 + lane + 64 * q] = sv[q];
        __builtin_amdgcn_wave_barrier();
        tw[lane] = tanhf(sv[12]); al[lane] = sv[13]; sg[lane] = sigmoidf_(sv[14]);
        __builtin_amdgcn_wave_barrier();
#pragma unroll 1
        for (int d = 0; d < 2; ++d) {
#pragma unroll 1
            for (int hq = 0; hq < 4; ++hq) {
                const int c = hq * 64 + lane;
                const float* w2 = p.in[I_W2] + (size_t)(l * 2 + d) * 64 * 256 + c;
                const float* a2 = p.in[I_A2] + (size_t)(l * 2 + d) * 64 * 256 + c;
                float wl = p.in[I_W0][(l * 2 + d) * 256 + c], aa = p.in[I_A0][(l * 2 + d) * 256 + c];
#pragma unroll 8
                for (int i = 0; i < 64; ++i) { wl += tw[i] * w2[i * 256]; aa += al[i] * a2[i * 256]; }
                const float w = -softplusf_(-wl) - 0.5f;
                p.DEC[((size_t)d * NROW + R) * 256 + c] = -__expf(w);
                p.AIC[((size_t)d * NROW + R) * 256 + c] = sigmoidf_(aa);
            }
        }
#pragma unroll
        for (int hq = 0; hq < 4; ++hq) {
            const int c = hq * 64 + lane;
            const float* g2 = p.in[I_G2] + (size_t)l * 64 * 256 + c;
            float g = 0.f;
#pragma unroll 8
            for (int i = 0; i < 64; ++i) g += sg[i] * g2[i * 256];
            p.GG[(size_t)R * 256 + c] = g;
            const float kk = sv[4 + hq] * p.in[I_KK][l * 256 + c];
            const float n2 = wave_sum(kk * kk);
            p.KKN[(size_t)R * 256 + c] = kk / fmaxf(sqrtf(n2), 1e-12f);
        }
    }
}
#define RWS 144
#define RSLOT(k) (lds + (k) * 9216)
__device__ __forceinline__ int rwkv_pos(int d, int c, int t) { return d == 0 ? c * 64 + t : (c < 4 ? 255 - (c * 64 + t) : 4351 - ((c - 4) * 64 + t)); }
__device__ __forceinline__ void mm2(const LAS unsigned char* Xr, const LAS unsigned char* Yt, int mi, int ni0, int lane, f32x4 (&acc)[2]) {
    const int m = lane & 15, g = lane >> 4;
#pragma unroll
    for (int ks = 0; ks < 2; ++ks) {
        const bf16x8 a = *(const LAS bf16x8*)(Xr + (mi * 16 + m) * RWS + ks * 64 + g * 16);
#pragma unroll
        for (int n = 0; n < 2; ++n) {
            const bf16x8 b = *(const LAS bf16x8*)(Yt + ((ni0 + n) * 16 + m) * RWS + ks * 64 + g * 16);
            acc[n] = __builtin_amdgcn_mfma_f32_16x16x32_bf16(a, b, acc[n], 0, 0, 0);
        }
    }
}
__device__ __forceinline__ void st_r(LAS unsigned char* dst, int mi, int ni, int lane, const f32x4& v) {
    const int m = lane & 15, g = lane >> 4;
#pragma unroll
    for (int r = 0; r < 4; ++r) *(LAS bf16_t*)(dst + (mi * 16 + 4 * g + r) * RWS + (ni * 16 + m) * 2) = f2bf(v[r]);
}
__device__ __forceinline__ void st_t(LAS unsigned char* dst, int mi, int ni, int lane, const f32x4& v) {
    const int m = lane & 15, g = lane >> 4;
    u32x2 o; o.x = cvt_pk_bf16(v[0], v[1]); o.y = cvt_pk_bf16(v[2], v[3]);
    *(LAS u32x2*)(dst + (ni * 16 + m) * RWS + (mi * 16 + 4 * g) * 2) = o;
}
__device__ __forceinline__ float bfbits2f(unsigned short v) { return __uint_as_float(((unsigned)v) << 16); }

__device__ __forceinline__ void d_rwkv_chunkA(CParams& p, int wv, int l) {
    const int tidx_ = opaque_tid(wv);
    int bidx_ = blockIdx.x, gdim_ = gridDim.x; asm volatile("" : "+s"(bidx_), "+s"(gdim_));
    LAS unsigned char* lds = (LAS unsigned char*)smem;
    LAS float* segtot = (LAS float*)(lds + 16 * 9216);
    LAS float* gam = segtot + 512;
    const int tid = tidx_, lane = tid & 63, w = wv;
    const int mi = w >> 1, ni0 = (w & 1) * 2, m16 = lane & 15, g = lane >> 4;
    for (int task = bidx_; task < 2176; task += gdim_) {
        const int c = task % 68, d = (task / 68) & 1, h = (task / 136) & 3, b = task / 544;
        __syncthreads();
        {
            const int j = lane, tq = w, hc = h * 64 + j;
            const float ka = p.in[I_KA][l * 256 + hc];
            float lw[8], aa[8], bb[8], ke[8], rr[8], vv[8];
#pragma unroll
            for (int u = 0; u < 8; ++u) {
                const size_t R = (size_t)b * TPB + rwkv_pos(d, c, 8 * tq + u);
                lw[u] = p.DEC[((size_t)d * NROW + R) * 256 + hc];
                const float aic = p.AIC[((size_t)d * NROW + R) * 256 + hc], kkn = p.KKN[R * 256 + hc];
                const float* rs = p.RS + R * 768;
                rr[u] = rs[hc]; const float k = rs[256 + hc]; vv[u] = rs[512 + hc];
                aa[u] = -kkn; bb[u] = kkn * aic; ke[u] = k * (1.f + (aic - 1.f) * ka);
            }
            float cs[8]; cs[0] = lw[0];
#pragma unroll
            for (int u = 1; u < 8; ++u) cs[u] = cs[u - 1] + lw[u];
            segtot[tq * 64 + j] = cs[7];
            __syncthreads();
            float pre = 0.f, tot = 0.f;
#pragma unroll
            for (int q = 0; q < 8; ++q) { const float sgt = segtot[q * 64 + j]; tot += sgt; if (q < tq) pre += sgt; }
            if (tq == 0) gam[j] = __expf(tot);
            float at[8], bt[8], kt[8];
#pragma unroll
            for (int u = 0; u < 8; ++u) {
                const float Lc = pre + cs[u], Lp = Lc - lw[u];
                const float ep = __expf(Lp), ec = __expf(Lc), en = __expf(-Lc), ee = __expf(tot - Lc);
                const int t = 8 * tq + u;
                at[u] = aa[u] * ep; bt[u] = bb[u] * ee; kt[u] = ke[u] * ee;
                *(LAS bf16_t*)(RSLOT(0) + t * RWS + j * 2) = f2bf(at[u]);
                *(LAS bf16_t*)(RSLOT(1) + t * RWS + j * 2) = f2bf(rr[u] * ec);
                *(LAS bf16_t*)(RSLOT(2) + t * RWS + j * 2) = f2bf(bb[u] * en);
                *(LAS bf16_t*)(RSLOT(3) + t * RWS + j * 2) = f2bf(ke[u] * en);
            }
            u32x4 o;
            o.x = cvt_pk_bf16(at[0], at[1]); o.y = cvt_pk_bf16(at[2], at[3]); o.z = cvt_pk_bf16(at[4], at[5]); o.w = cvt_pk_bf16(at[6], at[7]);
            *(LAS u32x4*)(RSLOT(4) + j * RWS + tq * 16) = o;
            o.x = cvt_pk_bf16(bt[0], bt[1]); o.y = cvt_pk_bf16(bt[2], bt[3]); o.z = cvt_pk_bf16(bt[4], bt[5]); o.w = cvt_pk_bf16(bt[6], bt[7]);
            *(LAS u32x4*)(RSLOT(5) + j * RWS + tq * 16) = o;
            o.x = cvt_pk_bf16(kt[0], kt[1]); o.y = cvt_pk_bf16(kt[2], kt[3]); o.z = cvt_pk_bf16(kt[4], kt[5]); o.w = cvt_pk_bf16(kt[6], kt[7]);
            *(LAS u32x4*)(RSLOT(6) + j * RWS + tq * 16) = o;
            o.x = cvt_pk_bf16(vv[0], vv[1]); o.y = cvt_pk_bf16(vv[2], vv[3]); o.z = cvt_pk_bf16(vv[4], vv[5]); o.w = cvt_pk_bf16(vv[6], vv[7]);
            *(LAS u32x4*)(RSLOT(7) + j * RWS + tq * 16) = o;
        }
        __syncthreads();
        {
            f32x4 aab[2] = {}, aak[2] = {}, brb[2] = {}, brk[2] = {};
            mm2(RSLOT(0), RSLOT(2), mi, ni0, lane, aab); mm2(RSLOT(0), RSLOT(3), mi, ni0, lane, aak);
            mm2(RSLOT(1), RSLOT(2), mi, ni0, lane, brb); mm2(RSLOT(1), RSLOT(3), mi, ni0, lane, brk);
#pragma unroll
            for (int n = 0; n < 2; ++n) {
                f32x4 p0;
#pragma unroll
                for (int r = 0; r < 4; ++r) {
                    const int t = mi * 16 + 4 * g + r, sidx = (ni0 + n) * 16 + m16;
                    if (!(sidx < t)) { aab[n][r] = 0.f; aak[n][r] = 0.f; }
                    if (!(sidx <= t)) { brb[n][r] = 0.f; brk[n][r] = 0.f; }
                    p0[r] = aab[n][r] + (sidx == t ? 1.f : 0.f);
                }
                st_r(RSLOT(11), mi, ni0 + n, lane, aab[n]); st_t(RSLOT(12), mi, ni0 + n, lane, aab[n]);
                st_t(RSLOT(13), mi, ni0 + n, lane, p0);
                st_r(RSLOT(8), mi, ni0 + n, lane, aak[n]); st_r(RSLOT(9), mi, ni0 + n, lane, brb[n]); st_r(RSLOT(10), mi, ni0 + n, lane, brk[n]);
            }
        }
        __syncthreads();
#pragma unroll 1
        for (int st = 1; st <= 6; ++st) {
            LAS unsigned char* qsr = (st & 1) ? RSLOT(11) : RSLOT(0);
            LAS unsigned char* qst = (st & 1) ? RSLOT(12) : RSLOT(2);
            LAS unsigned char* qdr = (st & 1) ? RSLOT(0) : RSLOT(11);
            LAS unsigned char* qdt = (st & 1) ? RSLOT(2) : RSLOT(12);
            if (st <= 5) {
                f32x4 q[2] = {};
                mm2(qsr, qst, mi, ni0, lane, q);
#pragma unroll
                for (int n = 0; n < 2; ++n) { st_r(qdr, mi, ni0 + n, lane, q[n]); st_t(qdt, mi, ni0 + n, lane, q[n]); }
            }
            if (st >= 2) {
                LAS unsigned char* ps = (st & 1) ? RSLOT(3) : RSLOT(13);
                LAS unsigned char* pd = (st & 1) ? RSLOT(13) : RSLOT(3);
                f32x4 pp[2];
#pragma unroll
                for (int n = 0; n < 2; ++n) {
                    const u32x2 o = *(const LAS u32x2*)(ps + ((ni0 + n) * 16 + m16) * RWS + (mi * 16 + 4 * g) * 2);
                    pp[n][0] = __uint_as_float(o.x << 16); pp[n][1] = __uint_as_float(o.x & 0xffff0000u); pp[n][2] = __uint_as_float(o.y << 16); pp[n][3] = __uint_as_float(o.y & 0xffff0000u);
                }
                mm2(qsr, ps, mi, ni0, lane, pp);
#pragma unroll
                for (int n = 0; n < 2; ++n) { st_t(pd, mi, ni0 + n, lane, pp[n]); if (st == 6) st_r(RSLOT(15), mi, ni0 + n, lane, pp[n]); }
            }
            if (st == 1) {
                f32x4 akv[2] = {};
                mm2(RSLOT(8), RSLOT(7), mi, ni0, lane, akv);
#pragma unroll
                for (int n = 0; n < 2; ++n) st_t(RSLOT(14), mi, ni0 + n, lane, akv[n]);
            }
            __syncthreads();
        }
        {
            f32x4 w1[2] = {}, z[2] = {};
            mm2(RSLOT(15), RSLOT(4), mi, ni0, lane, w1); mm2(RSLOT(15), RSLOT(14), mi, ni0, lane, z);
#pragma unroll
            for (int n = 0; n < 2; ++n) { st_t(RSLOT(11), mi, ni0 + n, lane, w1[n]); st_t(RSLOT(12), mi, ni0 + n, lane, z[n]); }
        }
        __syncthreads();
        {
            f32x4 mm_[2] = {}, nn[2] = {}, qq[2] = {}, yl[2] = {};
            mm2(RSLOT(5), RSLOT(11), mi, ni0, lane, mm_);
            mm2(RSLOT(5), RSLOT(12), mi, ni0, lane, nn); mm2(RSLOT(6), RSLOT(7), mi, ni0, lane, nn);
            mm2(RSLOT(9), RSLOT(11), mi, ni0, lane, qq);
            mm2(RSLOT(9), RSLOT(12), mi, ni0, lane, yl); mm2(RSLOT(10), RSLOT(7), mi, ni0, lane, yl);
#pragma unroll
            for (int n = 0; n < 2; ++n) {
#pragma unroll
                for (int r = 0; r < 4; ++r) {
                    const int row = mi * 16 + 4 * g + r, col = (ni0 + n) * 16 + m16;
                    if (row == col) mm_[n][r] += gam[row];
                    qq[n][r] += bfbits2f(*(const LAS bf16_t*)(RSLOT(1) + row * RWS + col * 2));
                }
                st_r(RSLOT(0), mi, ni0 + n, lane, mm_[n]); st_r(RSLOT(2), mi, ni0 + n, lane, qq[n]);
                *(f32x4*)(p.RNF + (size_t)task * 4096 + (((ni0 + n) * 4 + mi) * 64 + lane) * 4) = nn[n];
                *(f32x4*)(p.RYF + (size_t)task * 4096 + (((ni0 + n) * 4 + mi) * 64 + lane) * 4) = yl[n];
            }
        }
        __syncthreads();
        {
            const int jb = tid >> 7, sk = (tid >> 6) & 1;
            const int row = jb * 16 + m16;
            const u32x2 m0 = *(const LAS u32x2*)(RSLOT(0) + row * RWS + (32 * sk + 4 * g) * 2), m1 = *(const LAS u32x2*)(RSLOT(0) + row * RWS + (32 * sk + 16 + 4 * g) * 2);
            const u32x2 q0 = *(const LAS u32x2*)(RSLOT(2) + row * RWS + (32 * sk + 4 * g) * 2), q1 = *(const LAS u32x2*)(RSLOT(2) + row * RWS + (32 * sk + 16 + 4 * g) * 2);
            *(u32x4*)(p.RMF + (size_t)task * 4096 + (size_t)tid * 8) = (u32x4){m0.x, m0.y, m1.x, m1.y};
            *(u32x4*)(p.RQF + (size_t)task * 4096 + (size_t)tid * 8) = (u32x4){q0.x, q0.y, q1.x, q1.y};
        }
    }
    __syncthreads();
}

__device__ __forceinline__ void d_rwkv_seq(CParams& p, int widx, int ib, int lane) {
    const int d = widx & 1, h = (widx >> 1) & 3, b = widx >> 3;
    const int m16 = lane & 15, g = lane >> 4;
    f32x4 S[4];
#pragma unroll
    for (int jb = 0; jb < 4; ++jb) S[jb] = (f32x4){0.f, 0.f, 0.f, 0.f};
    const size_t task0 = (size_t)((b * 4 + h) * 2 + d) * 68;
#pragma unroll 1
    for (int c = 0; c < 68; ++c) {
        const size_t tk = task0 + c;
        const bf16x8* mf = (const bf16x8*)(p.RMF + tk * 4096) + lane;
        const bf16x8* qf = (const bf16x8*)(p.RQF + tk * 4096) + lane;
        const f32x4* nf = (const f32x4*)(p.RNF + tk * 4096) + (ib * 4) * 64 + lane;
        const f32x4* yf = (const f32x4*)(p.RYF + tk * 4096) + (ib * 4) * 64 + lane;
        bf16x8 M[4][2], Q[4][2]; f32x4 N[4], Y[4];
#pragma unroll
        for (int jb = 0; jb < 4; ++jb) {
#pragma unroll
            for (int sk = 0; sk < 2; ++sk) { M[jb][sk] = mf[(jb * 2 + sk) * 64]; Q[jb][sk] = qf[(jb * 2 + sk) * 64]; }
            N[jb] = nf[jb * 64]; Y[jb] = yf[jb * 64];
        }
        bf16x8 bfr[2];
#pragma unroll
        for (int sk = 0; sk < 2; ++sk) {
            union { u32x4 u; bf16x8 v; } cv;
            cv.u.x = cvt_pk_bf16(S[2 * sk][0], S[2 * sk][1]); cv.u.y = cvt_pk_bf16(S[2 * sk][2], S[2 * sk][3]);
            cv.u.z = cvt_pk_bf16(S[2 * sk + 1][0], S[2 * sk + 1][1]); cv.u.w = cvt_pk_bf16(S[2 * sk + 1][2], S[2 * sk + 1][3]);
            bfr[sk] = cv.v;
        }
#pragma unroll
        for (int jb = 0; jb < 4; ++jb)
#pragma unroll
            for (int sk = 0; sk < 2; ++sk) {
                N[jb] = __builtin_amdgcn_mfma_f32_16x16x32_bf16(M[jb][sk], bfr[sk], N[jb], 0, 0, 0);
                Y[jb] = __builtin_amdgcn_mfma_f32_16x16x32_bf16(Q[jb][sk], bfr[sk], Y[jb], 0, 0, 0);
            }
#pragma unroll
        for (int jb = 0; jb < 4; ++jb) {
            S[jb] = N[jb];
#pragma unroll
            for (int r = 0; r < 4; ++r) {
                const size_t R = (size_t)b * TPB + rwkv_pos(d, c, jb * 16 + 4 * g + r);
                p.YB[((size_t)d * NROW + R) * 256 + h * 64 + ib * 16 + m16] = Y[jb][r];
            }
        }
    }
}

__device__ __forceinline__ void d_na(CParams& p, int wv, int l, int do_ctx) {
    const int tidx_ = opaque_tid(wv);
    int bidx_ = blockIdx.x, gdim_ = gridDim.x; asm volatile("" : "+s"(bidx_), "+s"(gdim_));
    const int w = tidx_ >> 6, lane = tidx_ & 63;
    float* qs = (float*)smem + 4096 + w * 64;
    float* pw = (float*)smem + 8192 + w * 384;
    const int gw = bidx_ * 8 + w, nw = gdim_ * 8;
    const float* rpb = p.in[I_RPB] + (size_t)l * 8 * 15 * 31;
    for (int it = gw; it < NROW * 8; it += nw) {
        const int R = it >> 3, h = it & 7, b = R / TPB, pos = R % TPB;
        if (pos < CTXL && !do_ctx) continue;
        const size_t rb = (size_t)b * TPB;
        __builtin_amdgcn_wave_barrier();
        qs[lane] = p.P[(size_t)R * INC + 1472 + h * 64 + lane] * 0.125f;
        __builtin_amdgcn_wave_barrier();
        const bool lat = pos >= CTXL;
        int r = 0, cc = 0, rs_ = 0, cs = 0;
        if (lat) { const int t = pos - CTXL; r = t >> 6; cc = t & 63; rs_ = min(max(r - 4, 0), 56); cs = min(max(cc - 8, 0), 48); }
        const int nk = lat ? 384 : 256;
        float sc[6];
        float mx = -1e30f;
#pragma unroll
        for (int m = 0; m < 6; ++m) {
            const int n = lane + 64 * m;
            sc[m] = -1e30f;
            if (n < nk) {
                int kpos; float bias = 0.f;
                if (lat && n < 128) { const int i = n >> 4, j = n & 15; kpos = CTXL + (rs_ + i) * 64 + cs + j; bias = rpb[(h * 15 + (rs_ + i - r + 7)) * 31 + (cs + j - cc + 15)]; }
                else kpos = lat ? n - 128 : n;
                const float4* kr = (const float4*)(p.P + (rb + kpos) * INC + 1472 + 512 + h * 64);
                float acc = 0.f;
#pragma unroll
                for (int q = 0; q < 16; ++q) { const float4 kv = kr[q]; const float4 qv = *(const float4*)&qs[q * 4]; acc += kv.x * qv.x + kv.y * qv.y + kv.z * qv.z + kv.w * qv.w; }
                sc[m] = acc + bias;
            }
            mx = fmaxf(mx, sc[m]);
        }
        mx = wave_max(mx);
        float sum = 0.f;
#pragma unroll
        for (int m = 0; m < 6; ++m) { const int n = lane + 64 * m; float e = n < nk ? __expf(sc[m] - mx) : 0.f; sum += e; pw[n] = e; }
        sum = wave_sum(sum);
        __builtin_amdgcn_wave_barrier();
        float acc = 0.f;
        for (int n = 0; n < nk; ++n) {
            int kpos;
            if (lat && n < 128) kpos = CTXL + (rs_ + (n >> 4)) * 64 + cs + (n & 15); else kpos = lat ? n - 128 : n;
            acc += pw[n] * p.P[(rb + kpos) * INC + 1472 + 1024 + h * 64 + lane];
        }
        p.MIX[(size_t)R * DM + 512 + h * 64 + lane] = f2bf(acc / sum);
    }
}

__device__ __forceinline__ void d_scan_attn(CParams& p, int wv, int l, int do_ctx) {
    const int tidx_ = opaque_tid(wv);
    int bidx_ = blockIdx.x, gdim_ = gridDim.x; asm volatile("" : "+s"(bidx_), "+s"(gdim_));
    const int wave = tidx_ >> 6, lane = tidx_ & 63;
    if (bidx_ < 32 && wave < 4) d_rwkv_seq(p, bidx_, wave, lane);
    else if (bidx_ < 32 && wave == 4) d_lru_scan(p, bidx_, lane);
    d_na(p, wv, l, do_ctx);
}

__device__ __forceinline__ void d_finish(CParams& p, int wv, int l, int skip_ctx) {
    const int tidx_ = opaque_tid(wv);
    int bidx_ = blockIdx.x, gdim_ = gridDim.x; asm volatile("" : "+s"(bidx_), "+s"(gdim_));
    const int lane = tidx_ & 63, gw = bidx_ * 8 + (tidx_ >> 6), NGW = gdim_ * 8;
    for (int it = gw; it < NROW * 4; it += NGW) {
        const int R = it >> 2, h = it & 3, c = h * 64 + lane;
        if (skip_ctx && (R % TPB) < CTXL) continue;
        const float g = p.P[(size_t)R * INC + 256 + c];
        p.MIX[(size_t)R * DM + c] = f2bf(gelu_tanh(g) * (p.LH[(size_t)R * 256 + c] + p.LH[((size_t)NROW + R) * 256 + c]));
        const float* rs = p.RS + (size_t)R * 768;
        const float r = rs[c], k = rs[256 + c], v = rs[512 + c];
        const float y = p.YB[(size_t)R * 256 + c] + p.YB[((size_t)NROW + R) * 256 + c];
        const float mean = wave_sum(y) * (1.f / 64.f);
        const float dv = y - mean;
        const float var = wave_sum(dv * dv) * (1.f / 64.f);
        const float yn = dv * rsqrtf(var + 64e-5f);
        const float ka = p.in[I_KA][l * 256 + c], rk = p.in[I_RK][l * 256 + c];
        float bon = 0.f;
#pragma unroll
        for (int d = 0; d < 2; ++d) {
            const float a = p.AIC[((size_t)d * NROW + R) * 256 + c];
            bon += r * (k * (1.f + (a - 1.f) * ka)) * rk;
        }
        bon = wave_sum(bon);
        const float o = (yn * p.in[I_LNG][l * 256 + c] + p.in[I_LNB][l * 256 + c] + bon * v) * p.GG[(size_t)R * 256 + c];
        p.MIX[(size_t)R * DM + 256 + c] = f2bf(o);
    }
}

__device__ __forceinline__ void d_norm_router(CParams& p, int wv, int l, int skip_ctx) {
    const int tidx_ = opaque_tid(wv);
    int bidx_ = blockIdx.x, gdim_ = gridDim.x; asm volatile("" : "+s"(bidx_), "+s"(gdim_));
    const int lane = tidx_ & 63, wave = tidx_ >> 6, gw = bidx_ * 8 + wave, NGW = gdim_ * 8;
    const int gtid = bidx_ * NTHR + tidx_, gsz = gdim_ * NTHR;
    for (int i = gtid; i < CAP; i += gsz) p.SLOT_TOK[i] = 0;
    float* hs = (float*)smem + wave * 1024;
    const float* rw = p.in[I_RTW] + (size_t)l * DM * 32;
    const float* g = p.in[I_NFG] + l * DM;
    const int e = lane & 31, half = lane >> 5;
    int* cnt = p.CNT + l * 32;
    for (int R = gw; R < NROW; R += NGW) {
        const int b = R / TPB, pos = R % TPB, mr = pos < CTXL ? 4 : b;
        if (skip_ctx && pos < CTXL) continue;
        const float4* xr = (const float4*)(p.X + (size_t)R * DM);
        float4 v[4]; float ss = 0.f;
#pragma unroll
        for (int i = 0; i < 4; ++i) { v[i] = xr[lane + 64 * i]; ss += v[i].x * v[i].x + v[i].y * v[i].y + v[i].z * v[i].z + v[i].w * v[i].w; }
        ss = wave_sum(ss);
        const float* mod = p.MOD + (l * 5 + mr) * 6144 + 3 * DM;
        const float rinv = rsqrtf(ss * (1.f / DM) + 1e-6f);
        __builtin_amdgcn_wave_barrier();
#pragma unroll
        for (int i = 0; i < 4; ++i) {
            const int c = (lane + 64 * i) * 4;
            const float4 gg = *(const float4*)(g + c), sh = *(const float4*)(mod + c), sc = *(const float4*)(mod + DM + c);
            float4 o;
            o.x = v[i].x * rinv * gg.x * (1.f + sc.x) + sh.x; o.y = v[i].y * rinv * gg.y * (1.f + sc.y) + sh.y;
            o.z = v[i].z * rinv * gg.z * (1.f + sc.z) + sh.z; o.w = v[i].w * rinv * gg.w * (1.f + sc.w) + sh.w;
            uint2 ob; ob.x = cvt_pk_bf16(o.x, o.y); ob.y = cvt_pk_bf16(o.z, o.w);
            *(uint2*)(p.H + (size_t)R * DM + c) = ob;
            *(float4*)(hs + c) = o;
        }
        __builtin_amdgcn_wave_barrier();
        float acc = 0.f;
#pragma unroll 8
        for (int k = half * 512; k < half * 512 + 512; ++k) acc += hs[k] * rw[k * 32 + e];
        acc = sum_xor32(acc);
        float val = acc + p.in[I_RTB][l * 32 + e];
        if (lane >= 32) val = -3e38f;
        float tv[4]; int ti[4];
#pragma unroll
        for (int k = 0; k < 4; ++k) {
            const float m = wave_max(val);
            const unsigned long long bal = __ballot(val == m);
            const int idx = __ffsll((long long)bal) - 1;
            tv[k] = m; ti[k] = idx;
            if (lane == idx) val = -3e38f;
        }
        if (lane == 0) {
            const float e1 = __expf(tv[1] - tv[0]), e2 = __expf(tv[2] - tv[0]), e3 = __expf(tv[3] - tv[0]);
            const float inv = 1.f / (1.f + e1 + e2 + e3);
            const float gs[4] = {inv, e1 * inv, e2 * inv, e3 * inv};
#pragma unroll
            for (int k = 0; k < 4; ++k) {
                p.TOPG[R * 4 + k] = gs[k]; p.TOPI[R * 4 + k] = ti[k];
                p.TOKPOS[R * 4 + k] = atomicAdd(&cnt[ti[k]], 1);
            }
        }
    }
}
__device__ __forceinline__ void moe_offsets_lds(CParams& p, int wv, int l) {
    const int tidx_ = opaque_tid(wv);
    int bidx_ = blockIdx.x, gdim_ = gridDim.x; asm volatile("" : "+s"(bidx_), "+s"(gdim_));
    int* li = (int*)(smem + LDS_GEMM);
    __syncthreads();
    if (tidx_ == 0) {
        int off = 0, nt = 0;
#pragma unroll 1
        for (int e = 0; e < NEXP; ++e) {
            li[e] = off;
            const int n = (p.CNT[l * 32 + e] + MOE_TM - 1) / MOE_TM;
#pragma unroll 1
            for (int i = 0; i < n; ++i) li[64 + nt++] = e;
            off += n * MOE_TM;
        }
        li[32] = off; li[40] = nt;
    }
    __syncthreads();
}
__device__ __forceinline__ void d_moe_scatter(CParams& p, int wv, int l, int skip_ctx) {
    const int tidx_ = opaque_tid(wv);
    int bidx_ = blockIdx.x, gdim_ = gridDim.x; asm volatile("" : "+s"(bidx_), "+s"(gdim_));
    moe_offsets_lds(p, wv, l);
    const int* li = (const int*)(smem + LDS_GEMM);
    const int gtid = bidx_ * NTHR + tidx_, gsz = gdim_ * NTHR;
    for (int i = gtid; i < NROW * 4; i += gsz) {
        const int R = i >> 2;
        if (skip_ctx && (R % TPB) < CTXL) continue;
        p.SLOT_TOK[li[p.TOPI[i]] + p.TOKPOS[i]] = R;
    }
}
struct ProbG1 {
    CParams& p; int l; const int* li; int ntile; int bid, nblk;
    __device__ __forceinline__ bool next(int i, Unit& u) const { return tile_order(i, ntile, 8, u, bid, nblk); }
    __device__ __forceinline__ int expert(const Unit& u) const { return __builtin_amdgcn_readfirstlane(li[64 + u.pm]); }
    __device__ __forceinline__ const char* a_ptr(const Unit&) const { return (const char*)p.H; }
    __device__ __forceinline__ const char* b_ptr(const Unit& u) const { return (const char*)p.WTGU + ((size_t)(l * NEXP + expert(u)) * 2048 + (size_t)u.pn * 256) * KB_; }
    __device__ __forceinline__ int gather_row(const Unit& u, int r) const { return p.SLOT_TOK[u.pm * 256 + r]; }
    __device__ __forceinline__ void epi(const f32x4 (&acc)[2][2][4][2], const Unit& u, int wr, int wc, int fr, int fq) const {
        const int brow = u.pm * 256;
        const float* bias = p.in[I_BGU] + (size_t)(l * NEXP + expert(u)) * 2048;
        const int c = u.pn * 128 + wc * 32 + 8 * fq;
        const f32x4 bg0 = *(const f32x4*)(bias + c), bg1 = *(const f32x4*)(bias + c + 4);
        const f32x4 bu0 = *(const f32x4*)(bias + 1024 + c), bu1 = *(const f32x4*)(bias + 1024 + c + 4);
#pragma unroll
        for (int ai = 0; ai < 2; ++ai)
#pragma unroll
            for (int m = 0; m < 4; ++m) {
                float a[8];
#pragma unroll
                for (int n = 0; n < 2; ++n)
#pragma unroll
                    for (int j = 0; j < 4; ++j) {
                        float gv = acc[ai][0][m][n][j] + (n == 0 ? bg0[j] : bg1[j]), uv = acc[ai][1][m][n][j] + (n == 0 ? bu0[j] : bu1[j]);
                        gv = fminf(gv, 7.f); uv = fminf(fmaxf(uv, -7.f), 7.f);
                        a[n * 4 + j] = (uv + 1.f) * (gv * sigmoidf_(1.702f * gv));
                    }
                u32x4 o; o.x = cvt_pk_bf16(a[0], a[1]); o.y = cvt_pk_bf16(a[2], a[3]); o.z = cvt_pk_bf16(a[4], a[5]); o.w = cvt_pk_bf16(a[6], a[7]);
                *(u32x4*)(p.ACT + (size_t)(brow + ai * 128 + wr * 64 + m * 16 + fr) * DM + c) = o;
            }
    }
};
__device__ __forceinline__ void d_moe_gemm1(CParams& p, int wv, int l) {
    moe_offsets_lds(p, wv, l);
    const int* li = (const int*)(smem + LDS_GEMM);
    ProbG1 P{p, l, li, __builtin_amdgcn_readfirstlane(li[40]), 0, 0};
    gemm_phase<true>(P, wv);
}
struct ProbG2 {
    CParams& p; int l; const int* li; int ntile; int bid, nblk;
    __device__ __forceinline__ bool next(int i, Unit& u) const { return tile_order(i, ntile, 4, u, bid, nblk); }
    __device__ __forceinline__ int expert(const Unit& u) const { return __builtin_amdgcn_readfirstlane(li[64 + u.pm]); }
    __device__ __forceinline__ const char* a_ptr(const Unit& u) const { return (const char*)p.ACT + (size_t)u.pm * 256 * KB_; }
    __device__ __forceinline__ const char* b_ptr(const Unit& u) const { return (const char*)p.WTDN + ((size_t)(l * NEXP + expert(u)) * DM + (size_t)u.pn * 256) * KB_; }
    __device__ __forceinline__ int gather_row(const Unit&, int) const { return 0; }
    __device__ __forceinline__ void epi(const f32x4 (&acc)[2][2][4][2], const Unit& u, int wr, int wc, int fr, int fq) const {
        const int brow = u.pm * 256, bcol = u.pn * 256;
        const float* bias = p.in[I_BDN] + (size_t)(l * NEXP + expert(u)) * DM;
#pragma unroll
        for (int ai = 0; ai < 2; ++ai)
#pragma unroll
            for (int m = 0; m < 4; ++m) {
                float* yrow = p.Y + (size_t)(brow + ai * 128 + wr * 64 + m * 16 + fr) * DM;
#pragma unroll
                for (int bj = 0; bj < 2; ++bj)
#pragma unroll
                    for (int n = 0; n < 2; ++n) {
                        const int col = bcol + bj * 128 + wc * 32 + n * 16 + fq * 4;
                        *(f32x4*)(yrow + col) = acc[ai][bj][m][n] + *(const f32x4*)(bias + col);
                    }
            }
    }
};
__device__ __forceinline__ void d_moe_gemm2(CParams& p, int wv, int l) {
    moe_offsets_lds(p, wv, l);
    const int* li = (const int*)(smem + LDS_GEMM);
    ProbG2 P{p, l, li, __builtin_amdgcn_readfirstlane(li[40]), 0, 0};
    gemm_phase<false>(P, wv);
}
__device__ __forceinline__ void d_moe_combine(CParams& p, int wv, int l, int last) {
    const int tidx_ = opaque_tid(wv);
    int bidx_ = blockIdx.x, gdim_ = gridDim.x; asm volatile("" : "+s"(bidx_), "+s"(gdim_));
    moe_offsets_lds(p, wv, l);
    const int* li = (const int*)(smem + LDS_GEMM);
    const int lane = tidx_ & 63, gw = bidx_ * 8 + (tidx_ >> 6), NGW = gdim_ * 8;
    for (int R = gw; R < NROW; R += NGW) {
        const int b = R / TPB, pos = R % TPB, mr = pos < CTXL ? 4 : b;
        if (last && pos < CTXL) continue;
        float4 acc[4];
#pragma unroll
        for (int i = 0; i < 4; ++i) acc[i] = make_float4(0.f, 0.f, 0.f, 0.f);
#pragma unroll
        for (int k = 0; k < 4; ++k) {
            const float g = p.TOPG[R * 4 + k];
            const int s = li[p.TOPI[R * 4 + k]] + p.TOKPOS[R * 4 + k];
            const float4* yr = (const float4*)(p.Y + (size_t)s * DM);
#pragma unroll
            for (int i = 0; i < 4; ++i) { const float4 y = yr[lane + 64 * i]; acc[i].x += g * y.x; acc[i].y += g * y.y; acc[i].z += g * y.z; acc[i].w += g * y.w; }
        }
        const float* m5 = p.MOD + (l * 5 + mr) * 6144 + 5 * DM;
        float4* xr = (float4*)(p.X + (size_t)R * DM);
        float4 v[4]; float ss = 0.f;
#pragma unroll
        for (int i = 0; i < 4; ++i) {
            const float4 m = *(const float4*)(m5 + (lane + 64 * i) * 4);
            float4 x = xr[lane + 64 * i];
            x.x += m.x * acc[i].x; x.y += m.y * acc[i].y; x.z += m.z * acc[i].z; x.w += m.w * acc[i].w;
            v[i] = x; ss += x.x * x.x + x.y * x.y + x.z * x.z + x.w * x.w;
        }
        ss = wave_sum(ss);
        if (!last) {
#pragma unroll
            for (int i = 0; i < 4; ++i) xr[lane + 64 * i] = v[i];
            norm_row_to_bf16(p, v, ss, l + 1, 0, mr, p.H + (size_t)R * DM, lane);
        } else {
            const float rinv = rsqrtf(ss * (1.f / DM) + 1e-6f);
            float4* orow = (float4*)(p.out + ((size_t)b * SEQ + (pos - CTXL)) * DM);
#pragma unroll
            for (int i = 0; i < 4; ++i) {
                const float4 gg = *(const float4*)(p.in[I_FING] + (lane + 64 * i) * 4);
                float4 r; r.x = v[i].x * rinv * gg.x; r.y = v[i].y * rinv * gg.y; r.z = v[i].z * rinv * gg.z; r.w = v[i].w * rinv * gg.w;
                orow[lane + 64 * i] = r;
            }
        }
    }
}

#ifndef MULTI
#define MULTI 0
#endif
__device__ __forceinline__ void run_phase(CParams& p, int wv, int ph) {
    if (ph == 0) { d_prologue(p, wv); return; }
    if (ph == 1) { d_norm_mix(p, wv, 0); return; }
    const int l = (ph - 2) / 11, q = (ph - 2) % 11, last = l == 1;
    if (ph >= 24) return;
    switch (q) {
        case 0: d_gemm_in(p, wv, l); break;
        case 1: d_lru_pre(p, wv, l); d_rwkv_pre(p, wv, l); break;
        case 2: d_rwkv_chunkA(p, wv, l); break;
        case 3: d_scan_attn(p, wv, l, !last); break;
        case 4: d_finish(p, wv, l, last); break;
        case 5: d_gemm_out(p, wv, l, last); break;
        case 6: d_norm_router(p, wv, l, last); break;
        case 7: d_moe_scatter(p, wv, l, last); break;
        case 8: d_moe_gemm1(p, wv, l); break;
        case 9: d_moe_gemm2(p, wv, l); break;
        case 10: d_moe_combine(p, wv, l, last); break;
    }
}
#if MULTI
template <int PH> __global__ void __launch_bounds__(NTHR) mega_ph(Params p) { run_phase(p, __builtin_amdgcn_readfirstlane(threadIdx.x >> 6), PH); }
__global__ void __launch_bounds__(NTHR) mega(Params p) {}
template <int PH> static void launch_all(CParams& p, int grid, hipStream_t stream) {
    static bool attr = false; if (!attr) { (void)hipFuncSetAttribute((const void*)mega_ph<PH>, hipFuncAttributeMaxDynamicSharedMemorySize, LDS_BYTES); attr = true; }
    mega_ph<PH><<<grid, NTHR, LDS_BYTES, stream>>>(p);
    if constexpr (PH + 1 < 24) launch_all<PH + 1>(p, grid, stream);
}
#else
__global__ void __launch_bounds__(NTHR) mega(Params p) {
    cg::grid_group grid = cg::this_grid();
    const int wv = __builtin_amdgcn_readfirstlane(threadIdx.x >> 6);
#define RUNPH(n) { CParams* pp = (CParams*)__builtin_amdgcn_kernarg_segment_ptr(); asm volatile("" : "+s"(pp)); run_phase(*pp, wv, n); if (n < 23) grid.sync(); }
    RUNPH(0) RUNPH(1) RUNPH(2) RUNPH(3) RUNPH(4) RUNPH(5) RUNPH(6) RUNPH(7) RUNPH(8) RUNPH(9) RUNPH(10)
    RUNPH(11) RUNPH(12) RUNPH(13) RUNPH(14) RUNPH(15) RUNPH(16) RUNPH(17) RUNPH(18) RUNPH(19) RUNPH(20) RUNPH(21) RUNPH(22) RUNPH(23)
}
#endif

extern "C" void kernel_launch(void* const* d_in, const int* in_sizes, int n_in, void* d_out, int out_size, void* d_ws, size_t ws_size,
                              hipStream_t stream) {
    Params p{};
    for (int i = 0; i < N_IN; ++i) p.in[i] = (const float*)d_in[i];
    p.out = (float*)d_out;
    char* w = (char*)d_ws;
    size_t off = 0;
    auto take = [&](size_t bytes) { void* r = w + off; off += (bytes + 255) & ~(size_t)255; return r; };
    p.X = (float*)take((size_t)NROW * DM * 4);
    p.H = (bf16_t*)take((size_t)NROW * DM * 2);
    p.P = (float*)take((size_t)NROW * INC * 4);
    p.MIX = (bf16_t*)take((size_t)NROW * DM * 2);
    p.MOD = (float*)take(2 * 5 * 6144 * 4);
    p.LA = (float*)take((size_t)2 * NROW * 256 * 4);
    p.LB = (float*)take((size_t)2 * NROW * 256 * 4);
    p.LH = (float*)take((size_t)2 * NROW * 256 * 4);
    p.RS = (float*)take((size_t)NROW * 768 * 4);
    p.DEC = (float*)take((size_t)2 * NROW * 256 * 4);
    p.AIC = (float*)take((size_t)2 * NROW * 256 * 4);
    p.KKN = (float*)take((size_t)NROW * 256 * 4);
    p.GG = (float*)take((size_t)NROW * 256 * 4);
    p.YB = (float*)take((size_t)2 * NROW * 256 * 4);
    p.TOPG = (float*)take((size_t)NROW * 4 * 4);
    p.TOPI = (int*)take((size_t)NROW * 4 * 4);
    p.TOKPOS = (int*)take((size_t)NROW * 4 * 4);
    p.CNT = (int*)take(64 * 4);
    p.SLOT_TOK = (int*)take((size_t)CAP * 4);
    p.ACT = (bf16_t*)take((size_t)CAP * DM * 2);
    p.Y = (float*)take((size_t)CAP * DM * 4);
    p.RMF = (bf16_t*)take((size_t)2176 * 4096 * 2);
    p.RQF = (bf16_t*)take((size_t)2176 * 4096 * 2);
    p.RNF = (float*)take((size_t)2176 * 4096 * 4);
    p.RYF = (float*)take((size_t)2176 * 4096 * 4);
    p.WTIN = (bf16_t*)take((size_t)2 * INCP * DM * 2);
    p.WTOUT = (bf16_t*)take((size_t)2 * DM * DM * 2);
    p.WTGU = (bf16_t*)take((size_t)2 * NEXP * 2048 * DM * 2);
    p.WTDN = (bf16_t*)take((size_t)2 * NEXP * DM * DM * 2);

    static int grid_blocks = 0;
    if (!grid_blocks) {
        int dev = 0, cus = 0, per_cu = 0;
        (void)hipGetDevice(&dev);
        (void)hipDeviceGetAttribute(&cus, hipDeviceAttributeMultiprocessorCount, dev);
        (void)hipFuncSetAttribute((const void*)mega, hipFuncAttributeMaxDynamicSharedMemorySize, LDS_BYTES);
        (void)hipOccupancyMaxActiveBlocksPerMultiprocessor(&per_cu, (const void*)mega, NTHR, LDS_BYTES);
        if (per_cu > 1) per_cu = 1;
        if (per_cu < 1) { fprintf(stderr, "occupancy query says %d blocks/CU\n", per_cu); per_cu = 1; }
        grid_blocks = cus * per_cu;
        (void)hipGetLastError();
    }
#if MULTI
    launch_all<0>(p, grid_blocks, stream);
#else
    void* args[] = {&p};
    hipError_t e = hipLaunchCooperativeKernel((void*)mega, dim3(grid_blocks), dim3(NTHR), args, LDS_BYTES, stream);
    if (e != hipSuccess) fprintf(stderr, "cooperative launch failed: %s (grid %d)\n", hipGetErrorString(e), grid_blocks);
#endif
}
```

```cpp
#include <hip/hip_runtime.h>
#include <hip/hip_cooperative_groups.h>
#include <stdint.h>
#include <cstdio>
namespace cg = cooperative_groups;

#define DM 1024
#define NBATCH 4
#define SEQ 4096
#define CTXL 256
#define TPB 4352
#define NROW 17408
#define INC 3008
#define INCP 3072
#define PST 1472
#define NEXP 32
#define MOE_TM 256
#define CAP (NROW * 4 + NEXP * MOE_TM)
#define MAXTILES (CAP / MOE_TM)
#define NTHR 512
#define LDS_GEMM 131072
#define LDS_BYTES 155648

typedef unsigned short bf16_t;
typedef short bf16x8 __attribute__((ext_vector_type(8)));
typedef float f32x4 __attribute__((ext_vector_type(4)));
typedef unsigned u32x4 __attribute__((ext_vector_type(4)));
typedef unsigned u32x2 __attribute__((ext_vector_type(2)));

enum { I_X = 0, I_C, I_CTX, I_CCTX, I_ADAW, I_ADAB, I_NMG, I_NFG, I_WIN, I_WOUT, I_CONVW, I_CONVB, I_WR, I_BR, I_WI, I_BI,
       I_LAM, I_MU, I_W0, I_W2, I_A0, I_A2, I_G2, I_KK, I_KA, I_RK, I_LNG, I_LNB, I_RPB, I_RTW, I_RTB, I_WGU, I_BGU, I_WDN,
       I_BDN, I_FING, N_IN };

struct Params {
    const float* in[N_IN];
    float* out;
    float* X;
    bf16_t* H;
    float* P;
    bf16_t* QH;
    bf16_t* KH;
    bf16_t* VT;
    bf16_t* MIX;
    float* MOD;
    float* LA;
    float* LB;
    float* LH;
    float* RS;
    float* DEC;
    float* AIC;
    float* KKN;
    float* GG;
    float* YB;
    float* TOPG;
    int* TOPI;
    int* TOKPOS;
    int* CNT;
    int* SLOT_TOK;
    bf16_t* ACT;
    float* Y;
    bf16_t* RMF;
    bf16_t* RQF;
    float* RNF;
    float* RYF;
    bf16_t* WTIN;
    bf16_t* WTOUT;
    bf16_t* WTGU;
    bf16_t* WTDN;
};

typedef const __attribute__((address_space(4))) Params CParams;
extern __shared__ __attribute__((aligned(16))) unsigned char smem[];

__device__ __forceinline__ int opaque_tid(int wv) { int t; asm volatile("v_mbcnt_lo_u32_b32 %0, -1, 0\n\tv_mbcnt_hi_u32_b32 %0, -1, %0" : "=v"(t)); return wv * 64 + t; }
__device__ __forceinline__ float sigmoidf_(float x) { return 1.f / (1.f + __expf(-x)); }
__device__ __forceinline__ float softplusf_(float x) { return x > 20.f ? x : log1pf(__expf(x)); }
#define SWZ_XOR(v, o) __int_as_float(__builtin_amdgcn_ds_swizzle(__float_as_int(v), ((o) << 10) | 0x1f))
__device__ __forceinline__ float rdlane(float v, int l) { return __int_as_float(__builtin_amdgcn_readlane(__float_as_int(v), l)); }
__device__ __forceinline__ float sum_xor32(float v) {
    int a = __float_as_int(v), b = a;
    asm volatile("s_nop 1\n\tv_permlane32_swap_b32 %0, %1\n\ts_nop 1" : "+v"(a), "+v"(b));
    return __int_as_float(a) + __int_as_float(b);
}
__device__ __forceinline__ float wave_sum(float v) {
    v += SWZ_XOR(v, 1); v += SWZ_XOR(v, 2); v += SWZ_XOR(v, 4); v += SWZ_XOR(v, 8); v += SWZ_XOR(v, 16);
    return rdlane(v, 0) + rdlane(v, 32);
}
__device__ __forceinline__ float wave_max(float v) {
    v = fmaxf(v, SWZ_XOR(v, 1)); v = fmaxf(v, SWZ_XOR(v, 2)); v = fmaxf(v, SWZ_XOR(v, 4)); v = fmaxf(v, SWZ_XOR(v, 8)); v = fmaxf(v, SWZ_XOR(v, 16));
    return fmaxf(rdlane(v, 0), rdlane(v, 32));
}
typedef __bf16 bf16x2_n __attribute__((ext_vector_type(2)));
__device__ __forceinline__ unsigned cvt_pk_bf16(float lo, float hi) { bf16x2_n v; v[0] = (__bf16)lo; v[1] = (__bf16)hi; return __builtin_bit_cast(unsigned, v); }
__device__ __forceinline__ bf16_t f2bf(float x) { return __builtin_bit_cast(bf16_t, (__bf16)x); }
__device__ __forceinline__ float gelu_tanh(float x) {
    const float u = 0.7978845608028654f * (x + 0.044715f * x * x * x);
    return 0.5f * x * (1.f + tanhf(u));
}

__device__ __forceinline__ int inv_perm32(int cc) { return ((cc >> 2) & 1) * 16 + (cc >> 3) * 4 + (cc & 3); }
__device__ __forceinline__ void transpose_item(const float* W, int K, int N, bf16_t* WT, int k0, int n0, int dst_row0, float* scr, int lane, bool perm = false) {
#pragma unroll 8
    for (int i = 0; i < 32; ++i) { const int kk = 2 * i + (lane >> 5); scr[kk * 33 + (lane & 31)] = W[(size_t)(k0 + kk) * N + n0 + (lane & 31)]; }
    __builtin_amdgcn_wave_barrier();
    const int c = lane & 7;
#pragma unroll
    for (int j = 0; j < 4; ++j) {
        const int n = (lane >> 3) + 8 * j; const float* s = scr + (8 * c) * 33 + n;
        u32x4 o; o.x = cvt_pk_bf16(s[0 * 33], s[1 * 33]); o.y = cvt_pk_bf16(s[2 * 33], s[3 * 33]); o.z = cvt_pk_bf16(s[4 * 33], s[5 * 33]); o.w = cvt_pk_bf16(s[6 * 33], s[7 * 33]);
        *(u32x4*)(WT + (size_t)(dst_row0 + (perm ? inv_perm32(n) : n)) * K + k0 + 8 * c) = o;
    }
    __builtin_amdgcn_wave_barrier();
}

__device__ __forceinline__ void d_prologue(CParams& p, int wv) {
    const int tidx_ = opaque_tid(wv);
    int bidx_ = blockIdx.x, gdim_ = gridDim.x; asm volatile("" : "+s"(bidx_), "+s"(gdim_));
    const int tid = tidx_, lane = tid & 63, wave = tid >> 6;
    const int gtid = bidx_ * NTHR + tid, gsz = gdim_ * NTHR;
    const int gw = bidx_ * 8 + wave, NGW = gdim_ * 8;
    {
        const float4* x4 = (const float4*)p.in[I_X];
        const float4* c4 = (const float4*)p.in[I_CTX];
        float4* X4 = (float4*)p.X;
        for (int i = gtid; i < NROW * 256; i += gsz) {
            const int R = i >> 8, q = i & 255, b = R / TPB, pos = R % TPB;
            X4[i] = pos < CTXL ? c4[(b * CTXL + pos) * 256 + q] : x4[((size_t)b * SEQ + (pos - CTXL)) * 256 + q];
        }
    }
    if (gtid < 64) p.CNT[gtid] = 0;
    for (int i = gtid; i < 2 * 64 * 1024 / 8; i += gsz) {
        const int l = i / (64 * 128), r = i % (64 * 128);
        *(u32x4*)(p.WTIN + ((size_t)l * INCP + INC) * DM + (size_t)r * 8) = (u32x4){0u, 0u, 0u, 0u};
    }
    {
        float* sc = (float*)smem;
        float* part = (float*)(smem + 5 * 1024 * 4);
        for (int i = tid; i < 5 * DM; i += NTHR) { const int r = i / DM, d = i % DM; const float v = r < 4 ? p.in[I_C][r * DM + d] : p.in[I_CCTX][d]; sc[i] = v * sigmoidf_(v); }
        __syncthreads();
        for (int cb = bidx_; cb < 256; cb += gdim_) {
            const int col = tid % 48, ks = tid / 48;
            const int gc = cb * 48 + col, l = gc / 6144, n = gc % 6144;
            if (ks < 8) {
                const float* W = p.in[I_ADAW] + (size_t)l * DM * 6144 + n;
                float a0 = 0.f, a1 = 0.f, a2 = 0.f, a3 = 0.f, a4 = 0.f;
#pragma unroll 8
                for (int k = ks * 128; k < ks * 128 + 128; ++k) {
                    const float w = W[(size_t)k * 6144];
                    a0 += sc[k] * w; a1 += sc[DM + k] * w; a2 += sc[2 * DM + k] * w; a3 += sc[3 * DM + k] * w; a4 += sc[4 * DM + k] * w;
                }
                float* pp = part + (ks * 5) * 48 + col;
                pp[0] = a0; pp[48] = a1; pp[96] = a2; pp[144] = a3; pp[192] = a4;
            }
            __syncthreads();
            if (tid < 240) {
                const int r = tid / 48, c2 = tid % 48, gc2 = cb * 48 + c2, l2 = gc2 / 6144, n2 = gc2 % 6144;
                float s = p.in[I_ADAB][l2 * 6144 + n2];
#pragma unroll
                for (int k = 0; k < 8; ++k) s += part[(k * 5 + r) * 48 + c2];
                p.MOD[(l2 * 5 + r) * 6144 + n2] = s;
            }
            __syncthreads();
        }
    }
    {
        float* scr = (float*)(smem + 32768) + wave * (64 * 33);
        const int N_IN_ = 2 * 16 * 94, N_OUT_ = 2 * 16 * 32, N_GU_ = 64 * 16 * 64, N_DN_ = 64 * 16 * 32;
        for (int it = gw; it < N_IN_ + N_OUT_ + N_GU_ + N_DN_; it += NGW) {
            int r = it;
            if (r < N_IN_) { const int l = r / (16 * 94), q = r % (16 * 94), kb = q / 94, nb = q % 94;
                transpose_item(p.in[I_WIN] + (size_t)l * DM * INC, DM, INC, p.WTIN + (size_t)l * INCP * DM, kb * 64, nb * 32, nb * 32, scr, lane); continue; }
            r -= N_IN_;
            if (r < N_OUT_) { const int l = r / 512, q = r % 512, kb = q / 32, nb = q % 32;
                transpose_item(p.in[I_WOUT] + (size_t)l * DM * DM, DM, DM, p.WTOUT + (size_t)l * DM * DM, kb * 64, nb * 32, nb * 32, scr, lane); continue; }
            r -= N_OUT_;
            if (r < N_GU_) { const int le = r / 1024, q = r % 1024, kb = q / 64, nb = q % 64;
                const int c0 = nb * 32; const int dst = c0 < 1024 ? (c0 / 128) * 256 + (c0 % 128) : ((c0 - 1024) / 128) * 256 + 128 + ((c0 - 1024) % 128);
                transpose_item(p.in[I_WGU] + (size_t)le * DM * 2048, DM, 2048, p.WTGU + (size_t)le * 2048 * DM, kb * 64, c0, dst, scr, lane, true); continue; }
            r -= N_GU_;
            { const int le = r / 512, q = r % 512, kb = q / 32, nb = q % 32;
                transpose_item(p.in[I_WDN] + (size_t)le * DM * DM, DM, DM, p.WTDN + (size_t)le * DM * DM, kb * 64, nb * 32, nb * 32, scr, lane); }
        }
    }
}

__device__ __forceinline__ void norm_row_to_bf16(CParams& p, const float4 (&v)[4], float ss, int l, int which, int mr, bf16_t* hrow, int lane) {
    const float* g = (which == 0 ? p.in[I_NMG] : p.in[I_NFG]) + l * DM;
    const float* mod = p.MOD + (l * 5 + mr) * 6144 + (which == 0 ? 0 : 3 * DM);
    const float rinv = rsqrtf(ss * (1.f / DM) + 1e-6f);
#pragma unroll
    for (int i = 0; i < 4; ++i) {
        const int c = (lane + 64 * i) * 4;
        const float4 gg = *(const float4*)(g + c), sh = *(const float4*)(mod + c), sc = *(const float4*)(mod + DM + c);
        const float o0 = v[i].x * rinv * gg.x * (1.f + sc.x) + sh.x, o1 = v[i].y * rinv * gg.y * (1.f + sc.y) + sh.y;
        const float o2 = v[i].z * rinv * gg.z * (1.f + sc.z) + sh.z, o3 = v[i].w * rinv * gg.w * (1.f + sc.w) + sh.w;
        uint2 o; o.x = cvt_pk_bf16(o0, o1); o.y = cvt_pk_bf16(o2, o3);
        *(uint2*)(hrow + c) = o;
    }
}
__device__ __forceinline__ void d_norm_mix(CParams& p, int wv, int l) {
    const int tidx_ = opaque_tid(wv);
    int bidx_ = blockIdx.x, gdim_ = gridDim.x; asm volatile("" : "+s"(bidx_), "+s"(gdim_));
    const int lane = tidx_ & 63, gw = bidx_ * 8 + (tidx_ >> 6), NGW = gdim_ * 8;
    for (int R = gw; R < NROW; R += NGW) {
        const int b = R / TPB, pos = R % TPB, mr = pos < CTXL ? 4 : b;
        const float4* xr = (const float4*)(p.X + (size_t)R * DM);
        float4 v[4]; float ss = 0.f;
#pragma unroll
        for (int i = 0; i < 4; ++i) { v[i] = xr[lane + 64 * i]; ss += v[i].x * v[i].x + v[i].y * v[i].y + v[i].z * v[i].z + v[i].w * v[i].w; }
        ss = wave_sum(ss);
        norm_row_to_bf16(p, v, ss, l, 0, mr, p.H + (size_t)R * DM, lane);
    }
}

#define LAS __attribute__((address_space(3)))
#define HTB 16384
#define KB_ 2048
__device__ __forceinline__ int lds_byte(int r, int c) {
    const int st = (r >> 4) * 2 + (c >> 5), rr = r & 15, cc = c & 31, ob = rr * 64 + cc * 2;
    return st * 1024 + (ob ^ (((ob >> 9) & 1) << 5));
}
__device__ __forceinline__ void stage_rc(int b, int& R, int& C) {
    const int st = b / 1024, sb = b % 1024, swz = sb ^ (((sb >> 9) & 1) << 5);
    R = (st >> 1) * 16 + swz / 64; C = (st & 1) * 32 + (swz % 64) / 2;
}
struct Unit { int pm, pn; };
__device__ __forceinline__ bool tile_order(int i, int nM, int nN, Unit& u, int bid, int nblk) {
    const int nwg = nM * nN; const long L = (long)i * nblk + bid; if (L >= nwg) return false;
    int wgid = (int)L; { const int q = nwg / 8, r = nwg % 8, xcd = wgid % 8, off = wgid / 8; wgid = (xcd < r ? xcd * (q + 1) : r * (q + 1) + (xcd - r) * q) + off; }
    const int nig = 8 * nN, gid = wgid / nig, fm = gid * 8, gsz = (nM - fm) < 8 ? (nM - fm) : 8;
    u.pm = fm + ((wgid % nig) % gsz); u.pn = (wgid % nig) / gsz; return true;
}

#define PG_SA(b, h) (((b) * 2 + (h)) * HTB)
#define PG_SB(b, h) ((4 + (b) * 2 + (h)) * HTB)
#define PG_STAGE(bufoff, gbase, v0, v1) do { \
    __builtin_amdgcn_global_load_lds((const unsigned*)((const char*)(gbase) + (v0)), (LAS unsigned*)(lds + (bufoff) + ldsw), 16, 0, 0); \
    __builtin_amdgcn_global_load_lds((const unsigned*)((const char*)(gbase) + (v1)), (LAS unsigned*)(lds + (bufoff) + ldsw + 8192), 16, 0, 0); } while (0)
#define PG_STAGE_B(bufoff, gbase) PG_STAGE(bufoff, gbase, voffB[0], voffB[1])
#define PG_STAGE_A(bufoff, gb, h, usenext) do { if (GATHER) PG_STAGE(bufoff, gb, gc[h][0], gc[h][1]); \
    else PG_STAGE(bufoff, (gb) + (h) * hstep, voffA[0], voffA[1]); } while (0)
#define PG_LDA(dst, b, h) do { _Pragma("unroll") for (int m = 0; m < 4; ++m) _Pragma("unroll") for (int k = 0; k < 2; ++k) dst[m][k] = *(const LAS bf16x8*)(lds + PG_SA(b, h) + aoff + m * 2048 + k * 1024); } while (0)
#define PG_LDB(dst, b, h) do { _Pragma("unroll") for (int n = 0; n < 2; ++n) _Pragma("unroll") for (int k = 0; k < 2; ++k) dst[n][k] = *(const LAS bf16x8*)(lds + PG_SB(b, h) + boff + n * 2048 + k * 1024); } while (0)
#define PG_MMA(ai, bj, At_, Bt_) do { __builtin_amdgcn_s_setprio(1); _Pragma("unroll") for (int m = 0; m < 4; ++m) _Pragma("unroll") for (int n = 0; n < 2; ++n) _Pragma("unroll") for (int k = 0; k < 2; ++k) \
    acc[ai][bj][m][n] = __builtin_amdgcn_mfma_f32_16x16x32_bf16(Bt_[n][k], At_[m][k], acc[ai][bj][m][n], 0, 0, 0); __builtin_amdgcn_s_setprio(0); } while (0)
#define PG_WAIT_V(n) asm volatile("s_waitcnt vmcnt(" #n ")" ::: "memory")
#define PG_WAIT_L(n) asm volatile("s_waitcnt lgkmcnt(" #n ")" ::: "memory")
#define PG_BAR __builtin_amdgcn_s_barrier()
#define PG_SCHED __builtin_amdgcn_sched_barrier(0)

template <bool GATHER, class Prob>
__device__ __forceinline__ void gemm_phase(Prob P, int wv) {
    const int tidx_ = opaque_tid(wv);
    int bidx_ = blockIdx.x, gdim_ = gridDim.x; asm volatile("" : "+s"(bidx_), "+s"(gdim_));
    LAS unsigned char* lds = (LAS unsigned char*)smem;
    P.bid = bidx_; P.nblk = gdim_;
    const int tid = tidx_, wid = __builtin_amdgcn_readfirstlane(tid >> 6), lane = tid & 63, wr = wid >> 2, wc = wid & 3, fr = lane & 15, fq = lane >> 4;
    constexpr int nt = 16;
    unsigned voffA[2], voffB[2]; int Rr[2], Cc[2];
#pragma unroll
    for (int i = 0; i < 2; ++i) { stage_rc(tid * 16 + i * 8192, Rr[i], Cc[i]); voffA[i] = (unsigned)(Rr[i] * 1024 + Cc[i]) * 2u; voffB[i] = voffA[i]; }
    const size_t kstep = 128, hstep = (size_t)128 * KB_;
    const unsigned ldsw = (unsigned)wid * 1024u;
    const int aoff = lds_byte(wr * 64 + fr, fq * 8), boff = lds_byte(wc * 32 + fr, fq * 8);
    Unit cur, nxt; int ui = 0;
    if (!P.next(0, cur)) return;
    f32x4 acc[2][2][4][2];
#pragma unroll
    for (int a = 0; a < 2; ++a)
#pragma unroll
        for (int b = 0; b < 2; ++b)
#pragma unroll
            for (int m = 0; m < 4; ++m)
#pragma unroll
                for (int n = 0; n < 2; ++n) acc[a][b][m][n] = (f32x4){0.f, 0.f, 0.f, 0.f};
    bf16x8 At[4][2], B0[2][2], B1[2][2];
    unsigned gc[2][2] = {{0u, 0u}, {0u, 0u}};
    if (GATHER) {
#pragma unroll
        for (int h = 0; h < 2; ++h)
#pragma unroll
            for (int i = 0; i < 2; ++i) gc[h][i] = (unsigned)P.gather_row(cur, h * 128 + Rr[i]) * (unsigned)KB_ + (unsigned)Cc[i] * 2u;
    }
    const char* cA = P.a_ptr(cur); const char* cB = P.b_ptr(cur);
    PG_STAGE_B(PG_SB(0, 0), cB); PG_STAGE_A(PG_SA(0, 0), cA, 0, false); PG_STAGE_B(PG_SB(0, 1), cB + hstep); PG_STAGE_A(PG_SA(0, 1), cA, 1, false);
    if (wr == 1) PG_BAR;
    PG_WAIT_V(4); PG_BAR;
    PG_STAGE_B(PG_SB(1, 0), cB + kstep); PG_STAGE_A(PG_SA(1, 0), cA + kstep, 0, false); PG_STAGE_B(PG_SB(1, 1), cB + hstep + kstep);
    PG_WAIT_V(6); PG_BAR;
    for (;;) {
        const bool has_next = P.next(ui + 1, nxt);
        const char* nA = has_next ? P.a_ptr(nxt) : cA; const char* nB = has_next ? P.b_ptr(nxt) : cB;
        for (int t = 0; t < nt; t += 2) {
            const bool last = (t == nt - 2);
            if (GATHER && last && has_next) {
#pragma unroll
                for (int i = 0; i < 2; ++i) gc[0][i] = (unsigned)P.gather_row(nxt, Rr[i]) * (unsigned)KB_ + (unsigned)Cc[i] * 2u;
            }
            const char* a1 = cA + (size_t)(t + 1) * kstep;
            const char* a2 = last ? nA : cA + (size_t)(t + 2) * kstep; const char* b2 = last ? nB : cB + (size_t)(t + 2) * kstep;
            const char* a3 = a2 + kstep; const char* b3 = b2 + kstep;
            PG_LDB(B0, 0, 0); PG_SCHED; PG_LDA(At, 0, 0); PG_STAGE_A(PG_SA(1, 1), a1, 1, false);
            PG_WAIT_L(8); PG_BAR; PG_WAIT_L(0); PG_MMA(0, 0, At, B0); PG_BAR; PG_SCHED;
            if (GATHER && last && has_next) {
#pragma unroll
                for (int i = 0; i < 2; ++i) gc[1][i] = (unsigned)P.gather_row(nxt, 128 + Rr[i]) * (unsigned)KB_ + (unsigned)Cc[i] * 2u;
            }
            PG_LDB(B1, 0, 1); PG_STAGE_B(PG_SB(0, 0), b2);
            PG_BAR; PG_WAIT_L(0); PG_MMA(0, 1, At, B1); PG_BAR;
            PG_LDA(At, 0, 1); PG_STAGE_A(PG_SA(0, 0), a2, 0, last);
            PG_BAR; PG_WAIT_L(0); PG_MMA(1, 0, At, B0); PG_BAR; PG_SCHED;
            PG_STAGE_B(PG_SB(0, 1), b2 + hstep);
            PG_WAIT_V(6); PG_BAR; PG_MMA(1, 1, At, B1); PG_BAR;
            PG_LDB(B0, 1, 0); PG_SCHED; PG_LDA(At, 1, 0); PG_STAGE_A(PG_SA(0, 1), a2, 1, last);
            PG_WAIT_L(8); PG_BAR; PG_WAIT_L(0); PG_MMA(0, 0, At, B0); PG_BAR; PG_SCHED;
            PG_LDB(B1, 1, 1); PG_STAGE_B(PG_SB(1, 0), b3);
            PG_BAR; PG_WAIT_L(0); PG_MMA(0, 1, At, B1); PG_BAR;
            PG_LDA(At, 1, 1); PG_STAGE_A(PG_SA(1, 0), a3, 0, last);
            PG_BAR; PG_WAIT_L(0); PG_MMA(1, 0, At, B0); PG_BAR; PG_SCHED;
            PG_STAGE_B(PG_SB(1, 1), b3 + hstep);
            PG_WAIT_V(6); PG_BAR; PG_MMA(1, 1, At, B1); PG_BAR;
        }
        P.epi(acc, cur, wr, wc, fr, fq);
        if (!has_next) break;
#pragma unroll
        for (int a = 0; a < 2; ++a)
#pragma unroll
            for (int b = 0; b < 2; ++b)
#pragma unroll
                for (int m = 0; m < 4; ++m)
#pragma unroll
                    for (int n = 0; n < 2; ++n) acc[a][b][m][n] = (f32x4){0.f, 0.f, 0.f, 0.f};
        cur = nxt; cA = nA; cB = nB; ++ui;
    }
    PG_WAIT_V(0);
    if (wr == 0) PG_BAR;
    PG_BAR;
}

struct ProbIn {
    CParams& p; int l; int bid, nblk;
    __device__ __forceinline__ bool next(int i, Unit& u) const { return tile_order(i, NROW / 256, INCP / 256, u, bid, nblk); }
    __device__ __forceinline__ const char* a_ptr(const Unit& u) const { return (const char*)p.H + (size_t)u.pm * 256 * KB_; }
    __device__ __forceinline__ const char* b_ptr(const Unit& u) const { return (const char*)p.WTIN + ((size_t)l * INCP + (size_t)u.pn * 256) * KB_; }
    __device__ __forceinline__ int gather_row(const Unit&, int) const { return 0; }
    __device__ __forceinline__ void epi(const f32x4 (&acc)[2][2][4][2], const Unit& u, int wr, int wc, int fr, int fq) const {
        const int brow = u.pm * 256, bcol = u.pn * 256;
        const int bb = u.pm / 17, pos0 = (u.pm % 17) * 256;
#pragma unroll
        for (int bj = 0; bj < 2; ++bj)
#pragma unroll
            for (int n = 0; n < 2; ++n) {
                const int gcol = bcol + bj * 128 + wc * 32 + n * 16;
                const int col = gcol + fq * 4;
                if (gcol < 1472) {
#pragma unroll
                    for (int ai = 0; ai < 2; ++ai)
#pragma unroll
                        for (int m = 0; m < 4; ++m) *(f32x4*)(p.P + (size_t)(brow + ai * 128 + wr * 64 + m * 16 + fr) * PST + col) = acc[ai][bj][m][n];
                } else if (gcol < 2496) {
                    const bool isq = gcol < 1984; const int cq = col - (isq ? 1472 : 1984), hh = cq >> 6, dim = cq & 63;
                    bf16_t* base = (isq ? p.QH : p.KH) + ((size_t)(bb * 8 + hh) * TPB) * 64 + dim;
                    const float sc = isq ? 0.125f : 1.f;
#pragma unroll
                    for (int ai = 0; ai < 2; ++ai)
#pragma unroll
                        for (int m = 0; m < 4; ++m) {
                            const int pos = pos0 + ai * 128 + wr * 64 + m * 16 + fr; const f32x4 v = acc[ai][bj][m][n] * sc;
                            u32x2 o; o.x = cvt_pk_bf16(v[0], v[1]); o.y = cvt_pk_bf16(v[2], v[3]);
                            *(u32x2*)(base + (size_t)pos * 64) = o;
                        }
                } else if (gcol < INC) {
                    const int cq = col - 2496, hh = cq >> 6, dim = cq & 63;
                    bf16_t* base = p.VT + ((size_t)(bb * 8 + hh) * 64 + dim) * TPB;
#pragma unroll
                    for (int ai = 0; ai < 2; ++ai)
#pragma unroll
                        for (int m = 0; m < 4; ++m) {
                            const int pos = pos0 + ai * 128 + wr * 64 + m * 16 + fr;
#pragma unroll
                            for (int j = 0; j < 4; ++j) base[(size_t)j * TPB + pos] = f2bf(acc[ai][bj][m][n][j]);
                        }
                }
            }
    }
};
__device__ __forceinline__ void d_gemm_in(CParams& p, int wv, int l) { ProbIn P{p, l, 0, 0}; gemm_phase<false>(P, wv); }

struct ProbOut {
    CParams& p; int l; int skip_ctx; int bid, nblk;
    __device__ __forceinline__ bool next(int i, Unit& u) const {
        if (!tile_order(i, skip_ctx ? 64 : 68, 4, u, bid, nblk)) return false;
        if (skip_ctx) u.pm = (u.pm / 16) * 17 + 1 + (u.pm % 16);
        return true; }
    __device__ __forceinline__ const char* a_ptr(const Unit& u) const { return (const char*)p.MIX + (size_t)u.pm * 256 * KB_; }
    __device__ __forceinline__ const char* b_ptr(const Unit& u) const { return (const char*)p.WTOUT + ((size_t)l * DM + (size_t)u.pn * 256) * KB_; }
    __device__ __forceinline__ int gather_row(const Unit&, int) const { return 0; }
    __device__ __forceinline__ void epi(const f32x4 (&acc)[2][2][4][2], const Unit& u, int wr, int wc, int fr, int fq) const {
        const int brow = u.pm * 256, bcol = u.pn * 256;
        const int b = u.pm / 17, mr = (u.pm % 17) == 0 ? 4 : b;
        const float* gate = p.MOD + (l * 5 + mr) * 6144 + 2 * DM;
#pragma unroll
        for (int ai = 0; ai < 2; ++ai)
#pragma unroll
            for (int m = 0; m < 4; ++m) {
                float* xrow = p.X + (size_t)(brow + ai * 128 + wr * 64 + m * 16 + fr) * DM;
#pragma unroll
                for (int bj = 0; bj < 2; ++bj)
#pragma unroll
                    for (int n = 0; n < 2; ++n) {
                        const int col = bcol + bj * 128 + wc * 32 + n * 16 + fq * 4;
                        const f32x4 gt = *(const f32x4*)(gate + col);
                        f32x4* xp = (f32x4*)(xrow + col);
                        *xp = *xp + gt * acc[ai][bj][m][n];
                    }
                asm volatile("" ::: "memory");
            }
    }
};
__device__ __forceinline__ void d_gemm_out(CParams& p, int wv, int l, int skip_ctx) { ProbOut P{p, l, skip_ctx, 0, 0}; gemm_phase<false>(P, wv); }

__device__ __forceinline__ void d_lru_pre(CParams& p, int wv, int l) {
    const int tidx_ = opaque_tid(wv);
    int bidx_ = blockIdx.x, gdim_ = gridDim.x; asm volatile("" : "+s"(bidx_), "+s"(gdim_));
    const int lane = tidx_ & 63, wave = tidx_ >> 6, gw = bidx_ * 8 + wave, NGW = gdim_ * 8;
    float* xcw = (float*)smem + wave * 64;
    for (int it = gw; it < 2 * NROW * 4; it += NGW) {
        const int h = it & 3, R = (it >> 2) % NROW, d = (it >> 2) / NROW, pos = R % TPB;
        const int seg0 = pos < CTXL ? 0 : CTXL, seg1 = pos < CTXL ? CTXL : TPB;
        const int c = h * 64 + lane;
        const float* cw = p.in[I_CONVW] + ((l * 2 + d) * 4) * 256;
        float acc = p.in[I_CONVB][(l * 2 + d) * 256 + c];
#pragma unroll
        for (int j = 0; j < 4; ++j) {
            const int q = d == 0 ? pos - j : pos + j;
            if (q >= seg0 && q < seg1) acc += cw[j * 256 + c] * p.P[(size_t)(R + (q - pos)) * PST + c];
        }
        __builtin_amdgcn_wave_barrier();
        xcw[lane] = acc;
        __builtin_amdgcn_wave_barrier();
        const float* wr = p.in[I_WR] + (size_t)((l * 2 + d) * 4 + h) * 4096 + lane;
        const float* wi = p.in[I_WI] + (size_t)((l * 2 + d) * 4 + h) * 4096 + lane;
        float gr = p.in[I_BR][(l * 2 + d) * 256 + c], gi = p.in[I_BI][(l * 2 + d) * 256 + c];
#pragma unroll 8
        for (int i = 0; i < 64; ++i) { const float xv = xcw[i]; gr += xv * wr[i * 64]; gi += xv * wi[i * 64]; }
        gr = sigmoidf_(gr); gi = sigmoidf_(gi);
        const float lam = p.in[I_LAM][(l * 2 + d) * 256 + c];
        const float log_a = -8.0f * gr * softplusf_(-lam);
        const float a = __expf(log_a);
        const float bb = sqrtf(fmaxf(-expm1f(2.f * log_a), 0.f)) * (gi * acc);
        p.LA[((size_t)d * NROW + R) * 256 + c] = a;
        p.LB[((size_t)d * NROW + R) * 256 + c] = bb;
    }
}
__device__ __forceinline__ void d_lru_scan(CParams& p, int widx, int lane) {
    const int gt = widx * 64 + lane;
    const int c = gt & 255, d = (gt >> 8) & 1, b = gt >> 9;
    const float* la = p.LA + ((size_t)d * NROW + (size_t)b * TPB) * 256 + c;
    const float* lb = p.LB + ((size_t)d * NROW + (size_t)b * TPB) * 256 + c;
    float* lh = p.LH + ((size_t)d * NROW + (size_t)b * TPB) * 256 + c;
    float h = 0.f;
    for (int s0 = 0; s0 < TPB; s0 += 16) {
        float av[16], bv[16]; int ps[16];
#pragma unroll
        for (int u = 0; u < 16; ++u) {
            const int s = s0 + u;
            ps[u] = d == 0 ? s : (s < CTXL ? CTXL - 1 - s : TPB - 1 - (s - CTXL));
            av[u] = la[(size_t)ps[u] * 256]; bv[u] = lb[(size_t)ps[u] * 256];
        }
#pragma unroll
        for (int u = 0; u < 16; ++u) { h = av[u] * h + bv[u]; lh[(size_t)ps[u] * 256] = h; }
    }
}

__device__ __forceinline__ void d_rwkv_pre(CParams& p, int wv, int l) {
    const int tidx_ = opaque_tid(wv);
    int bidx_ = blockIdx.x, gdim_ = gridDim.x; asm volatile("" : "+s"(bidx_), "+s"(gdim_));
    const int lane = tidx_ & 63, wave = tidx_ >> 6, gw = bidx_ * 8 + wave, NGW = gdim_ * 8;
    float* tw = (float*)smem + 1024 + wave * 192; float* al = tw + 64; float* sg = tw + 128;
    const float* mu = p.in[I_MU] + l * 2 * 960;
    for (int R = gw; R < NROW; R += NGW) {
        const int pos = R % TPB;
        const int seg0 = pos < CTXL ? 0 : CTXL, seg1 = pos < CTXL ? CTXL : TPB;
        const float* pr = p.P + (size_t)R * PST + 512;
        float sv[15];
#pragma unroll
        for (int q = 0; q < 15; ++q) {
            const int col = lane + 64 * q;
            const float v = pr[col];
            const float pv = pos > seg0 ? pr[col - PST] : 0.f;
            const float nv = pos + 1 < seg1 ? pr[col + PST] : 0.f;
            sv[q] = v + mu[col] * (pv - v) + mu[960 + col] * (nv - v);
        }
#pragma unroll
        for (int q = 0; q < 12; ++q) p.RS[(size_t)R * 768 + lane + 64 * q] = sv[q];
        __builtin_amdgcn_wave_barrier();
        tw[lane] = tanhf(sv[12]); al[lane] = sv[13]; sg[lane] = sigmoidf_(sv[14]);
        __builtin_amdgcn_wave_barrier();
#pragma unroll 1
        for (int d = 0; d < 2; ++d) {
#pragma unroll 1
            for (int hq = 0; hq < 4; ++hq) {
                const int c = hq * 64 + lane;
                const float* w2 = p.in[I_W2] + (size_t)(l * 2 + d) * 64 * 256 + c;
                const float* a2 = p.in[I_A2] + (size_t)(l * 2 + d) * 64 * 256 + c;
                float wl = p.in[I_W0][(l * 2 + d) * 256 + c], aa = p.in[I_A0][(l * 2 + d) * 256 + c];
#pragma unroll 8
                for (int i = 0; i < 64; ++i) { wl += tw[i] * w2[i * 256]; aa += al[i] * a2[i * 256]; }
                const float w = -softplusf_(-wl) - 0.5f;
                p.DEC[((size_t)d * NROW + R) * 256 + c] = -__expf(w);
                p.AIC[((size_t)d * NROW + R) * 256 + c] = sigmoidf_(aa);
            }
        }
#pragma unroll
        for (int hq = 0; hq < 4; ++hq) {
            const int c = hq * 64 + lane;
            const float* g2 = p.in[I_G2] + (size_t)l * 64 * 256 + c;
            float g = 0.f;
#pragma unroll 8
            for (int i = 0; i < 64; ++i) g += sg[i] * g2[i * 256];
            p.GG[(size_t)R * 256 + c] = g;
            const float kk = sv[4 + hq] * p.in[I_KK][l * 256 + c];
            const float n2 = wave_sum(kk * kk);
            p.KKN[(size_t)R * 256 + c] = kk / fmaxf(sqrtf(n2), 1e-12f);
        }
    }
}
#define RWS 144
#define RSLOT(k) (lds + (k) * 9216)
__device__ __forceinline__ int rwkv_pos(int d, int c, int t) { return d == 0 ? c * 64 + t : (c < 4 ? 255 - (c * 64 + t) : 4351 - ((c - 4) * 64 + t)); }
__device__ __forceinline__ void mm2(const LAS unsigned char* Xr, const LAS unsigned char* Yt, int mi, int ni0, int lane, f32x4 (&acc)[2]) {
    const int m = lane & 15, g = lane >> 4;
#pragma unroll
    for (int ks = 0; ks < 2; ++ks) {
        const bf16x8 a = *(const LAS bf16x8*)(Xr + (mi * 16 + m) * RWS + ks * 64 + g * 16);
#pragma unroll
        for (int n = 0; n < 2; ++n) {
            const bf16x8 b = *(const LAS bf16x8*)(Yt + ((ni0 + n) * 16 + m) * RWS + ks * 64 + g * 16);
            acc[n] = __builtin_amdgcn_mfma_f32_16x16x32_bf16(a, b, acc[n], 0, 0, 0);
        }
    }
}
__device__ __forceinline__ void st_r(LAS unsigned char* dst, int mi, int ni, int lane, const f32x4& v) {
    const int m = lane & 15, g = lane >> 4;
#pragma unroll
    for (int r = 0; r < 4; ++r) *(LAS bf16_t*)(dst + (mi * 16 + 4 * g + r) * RWS + (ni * 16 + m) * 2) = f2bf(v[r]);
}
__device__ __forceinline__ void st_t(LAS unsigned char* dst, int mi, int ni, int lane, const f32x4& v) {
    const int m = lane & 15, g = lane >> 4;
    u32x2 o; o.x = cvt_pk_bf16(v[0], v[1]); o.y = cvt_pk_bf16(v[2], v[3]);
    *(LAS u32x2*)(dst + (ni * 16 + m) * RWS + (mi * 16 + 4 * g) * 2) = o;
}
__device__ __forceinline__ float bfbits2f(unsigned short v) { return __uint_as_float(((unsigned)v) << 16); }

__device__ __forceinline__ void d_rwkv_chunkA(CParams& p, int wv, int l) {
    const int tidx_ = opaque_tid(wv);
    int bidx_ = blockIdx.x, gdim_ = gridDim.x; asm volatile("" : "+s"(bidx_), "+s"(gdim_));
    LAS unsigned char* lds = (LAS unsigned char*)smem;
    LAS float* segtot = (LAS float*)(lds + 16 * 9216);
    LAS float* gam = segtot + 512;
    const int tid = tidx_, lane = tid & 63, w = wv;
    const int mi = w >> 1, ni0 = (w & 1) * 2, m16 = lane & 15, g = lane >> 4;
    for (int task = bidx_; task < 2176; task += gdim_) {
        const int c = task % 68, d = (task / 68) & 1, h = (task / 136) & 3, b = task / 544;
        __syncthreads();
        {
            const int j = lane, tq = w, hc = h * 64 + j;
            const float ka = p.in[I_KA][l * 256 + hc];
            float lw[8], aa[8], bb[8], ke[8], rr[8], vv[8];
#pragma unroll
            for (int u = 0; u < 8; ++u) {
                const size_t R = (size_t)b * TPB + rwkv_pos(d, c, 8 * tq + u);
                lw[u] = p.DEC[((size_t)d * NROW + R) * 256 + hc];
                const float aic = p.AIC[((size_t)d * NROW + R) * 256 + hc], kkn = p.KKN[R * 256 + hc];
                const float* rs = p.RS + R * 768;
                rr[u] = rs[hc]; const float k = rs[256 + hc]; vv[u] = rs[512 + hc];
                aa[u] = -kkn; bb[u] = kkn * aic; ke[u] = k * (1.f + (aic - 1.f) * ka);
            }
            float cs[8]; cs[0] = lw[0];
#pragma unroll
            for (int u = 1; u < 8; ++u) cs[u] = cs[u - 1] + lw[u];
            segtot[tq * 64 + j] = cs[7];
            __syncthreads();
            float pre = 0.f, tot = 0.f;
#pragma unroll
            for (int q = 0; q < 8; ++q) { const float sgt = segtot[q * 64 + j]; tot += sgt; if (q < tq) pre += sgt; }
            if (tq == 0) gam[j] = __expf(tot);
            float at[8], bt[8], kt[8];
#pragma unroll
            for (int u = 0; u < 8; ++u) {
                const float Lc = pre + cs[u], Lp = Lc - lw[u];
                const float ep = __expf(Lp), ec = __expf(Lc), en = __expf(-Lc), ee = __expf(tot - Lc);
                const int t = 8 * tq + u;
                at[u] = aa[u] * ep; bt[u] = bb[u] * ee; kt[u] = ke[u] * ee;
                *(LAS bf16_t*)(RSLOT(0) + t * RWS + j * 2) = f2bf(at[u]);
                *(LAS bf16_t*)(RSLOT(1) + t * RWS + j * 2) = f2bf(rr[u] * ec);
                *(LAS bf16_t*)(RSLOT(2) + t * RWS + j * 2) = f2bf(bb[u] * en);
                *(LAS bf16_t*)(RSLOT(3) + t * RWS + j * 2) = f2bf(ke[u] * en);
            }
            u32x4 o;
            o.x = cvt_pk_bf16(at[0], at[1]); o.y = cvt_pk_bf16(at[2], at[3]); o.z = cvt_pk_bf16(at[4], at[5]); o.w = cvt_pk_bf16(at[6], at[7]);
            *(LAS u32x4*)(RSLOT(4) + j * RWS + tq * 16) = o;
            o.x = cvt_pk_bf16(bt[0], bt[1]); o.y = cvt_pk_bf16(bt[2], bt[3]); o.z = cvt_pk_bf16(bt[4], bt[5]); o.w = cvt_pk_bf16(bt[6], bt[7]);
            *(LAS u32x4*)(RSLOT(5) + j * RWS + tq * 16) = o;
            o.x = cvt_pk_bf16(kt[0], kt[1]); o.y = cvt_pk_bf16(kt[2], kt[3]); o.z = cvt_pk_bf16(kt[4], kt[5]); o.w = cvt_pk_bf16(kt[6], kt[7]);
            *(LAS u32x4*)(RSLOT(6) + j * RWS + tq * 16) = o;
            o.x = cvt_pk_bf16(vv[0], vv[1]); o.y = cvt_pk_bf16(vv[2], vv[3]); o.z = cvt_pk_bf16(vv[4], vv[5]); o.w = cvt_pk_bf16(vv[6], vv[7]);
            *(LAS u32x4*)(RSLOT(7) + j * RWS + tq * 16) = o;
        }
        __syncthreads();
        {
            f32x4 aab[2] = {}, aak[2] = {}, brb[2] = {}, brk[2] = {};
            mm2(RSLOT(0), RSLOT(2), mi, ni0, lane, aab); mm2(RSLOT(0), RSLOT(3), mi, ni0, lane, aak);
            mm2(RSLOT(1), RSLOT(2), mi, ni0, lane, brb); mm2(RSLOT(1), RSLOT(3), mi, ni0, lane, brk);
#pragma unroll
            for (int n = 0; n < 2; ++n) {
                f32x4 p0;
#pragma unroll
                for (int r = 0; r < 4; ++r) {
                    const int t = mi * 16 + 4 * g + r, sidx = (ni0 + n) * 16 + m16;
                    if (!(sidx < t)) { aab[n][r] = 0.f; aak[n][r] = 0.f; }
                    if (!(sidx <= t)) { brb[n][r] = 0.f; brk[n][r] = 0.f; }
                    p0[r] = aab[n][r] + (sidx == t ? 1.f : 0.f);
                }
                st_r(RSLOT(11), mi, ni0 + n, lane, aab[n]); st_t(RSLOT(12), mi, ni0 + n, lane, aab[n]);
                st_t(RSLOT(13), mi, ni0 + n, lane, p0);
                st_r(RSLOT(8), mi, ni0 + n, lane, aak[n]); st_r(RSLOT(9), mi, ni0 + n, lane, brb[n]); st_r(RSLOT(10), mi, ni0 + n, lane, brk[n]);
            }
        }
        __syncthreads();
#pragma unroll 1
        for (int st = 1; st <= 6; ++st) {
            LAS unsigned char* qsr = (st & 1) ? RSLOT(11) : RSLOT(0);
            LAS unsigned char* qst = (st & 1) ? RSLOT(12) : RSLOT(2);
            LAS unsigned char* qdr = (st & 1) ? RSLOT(0) : RSLOT(11);
            LAS unsigned char* qdt = (st & 1) ? RSLOT(2) : RSLOT(12);
            if (st <= 5) {
                f32x4 q[2] = {};
                mm2(qsr, qst, mi, ni0, lane, q);
#pragma unroll
                for (int n = 0; n < 2; ++n) { st_r(qdr, mi, ni0 + n, lane, q[n]); st_t(qdt, mi, ni0 + n, lane, q[n]); }
            }
            if (st >= 2) {
                LAS unsigned char* ps = (st & 1) ? RSLOT(3) : RSLOT(13);
                LAS unsigned char* pd = (st & 1) ? RSLOT(13) : RSLOT(3);
                f32x4 pp[2];
#pragma unroll
                for (int n = 0; n < 2; ++n) {
                    const u32x2 o = *(const LAS u32x2*)(ps + ((ni0 + n) * 16 + m16) * RWS + (mi * 16 + 4 * g) * 2);
                    pp[n][0] = __uint_as_float(o.x << 16); pp[n][1] = __uint_as_float(o.x & 0xffff0000u); pp[n][2] = __uint_as_float(o.y << 16); pp[n][3] = __uint_as_float(o.y & 0xffff0000u);
                }
                mm2(qsr, ps, mi, ni0, lane, pp);
#pragma unroll
                for (int n = 0; n < 2; ++n) { st_t(pd, mi, ni0 + n, lane, pp[n]); if (st == 6) st_r(RSLOT(15), mi, ni0 + n, lane, pp[n]); }
            }
            if (st == 1) {
                f32x4 akv[2] = {};
                mm2(RSLOT(8), RSLOT(7), mi, ni0, lane, akv);
#pragma unroll
                for (int n = 0; n < 2; ++n) st_t(RSLOT(14), mi, ni0 + n, lane, akv[n]);
            }
            __syncthreads();
        }
        {
            f32x4 w1[2] = {}, z[2] = {};
            mm2(RSLOT(15), RSLOT(4), mi, ni0, lane, w1); mm2(RSLOT(15), RSLOT(14), mi, ni0, lane, z);
#pragma unroll
            for (int n = 0; n < 2; ++n) { st_t(RSLOT(11), mi, ni0 + n, lane, w1[n]); st_t(RSLOT(12), mi, ni0 + n, lane, z[n]); }
        }
        __syncthreads();
        {
            f32x4 mm_[2] = {}, nn[2] = {}, qq[2] = {}, yl[2] = {};
            mm2(RSLOT(5), RSLOT(11), mi, ni0, lane, mm_);
            mm2(RSLOT(5), RSLOT(12), mi, ni0, lane, nn); mm2(RSLOT(6), RSLOT(7), mi, ni0, lane, nn);
            mm2(RSLOT(9), RSLOT(11), mi, ni0, lane, qq);
            mm2(RSLOT(9), RSLOT(12), mi, ni0, lane, yl); mm2(RSLOT(10), RSLOT(7), mi, ni0, lane, yl);
#pragma unroll
            for (int n = 0; n < 2; ++n) {
#pragma unroll
                for (int r = 0; r < 4; ++r) {
                    const int row = mi * 16 + 4 * g + r, col = (ni0 + n) * 16 + m16;
                    if (row == col) mm_[n][r] += gam[row];
                    qq[n][r] += bfbits2f(*(const LAS bf16_t*)(RSLOT(1) + row * RWS + col * 2));
                }
                st_r(RSLOT(0), mi, ni0 + n, lane, mm_[n]); st_r(RSLOT(2), mi, ni0 + n, lane, qq[n]);
                *(f32x4*)(p.RNF + (size_t)task * 4096 + (((ni0 + n) * 4 + mi) * 64 + lane) * 4) = nn[n];
                *(f32x4*)(p.RYF + (size_t)task * 4096 + (((ni0 + n) * 4 + mi) * 64 + lane) * 4) = yl[n];
            }
        }
        __syncthreads();
        {
            const int jb = tid >> 7, sk = (tid >> 6) & 1;
            const int row = jb * 16 + m16;
            const u32x2 m0 = *(const LAS u32x2*)(RSLOT(0) + row * RWS + (32 * sk + 4 * g) * 2), m1 = *(const LAS u32x2*)(RSLOT(0) + row * RWS + (32 * sk + 16 + 4 * g) * 2);
            const u32x2 q0 = *(const LAS u32x2*)(RSLOT(2) + row * RWS + (32 * sk + 4 * g) * 2), q1 = *(const LAS u32x2*)(RSLOT(2) + row * RWS + (32 * sk + 16 + 4 * g) * 2);
            *(u32x4*)(p.RMF + (size_t)task * 4096 + (size_t)tid * 8) = (u32x4){m0.x, m0.y, m1.x, m1.y};
            *(u32x4*)(p.RQF + (size_t)task * 4096 + (size_t)tid * 8) = (u32x4){q0.x, q0.y, q1.x, q1.y};
        }
    }
    __syncthreads();
}

__device__ __forceinline__ void d_rwkv_seq(CParams& p, int widx, int ib, int lane) {
    const int d = widx & 1, h = (widx >> 1) & 3, b = widx >> 3;
    const int m16 = lane & 15, g = lane >> 4;
    f32x4 S[4];
#pragma unroll
    for (int jb = 0; jb < 4; ++jb) S[jb] = (f32x4){0.f, 0.f, 0.f, 0.f};
    const size_t task0 = (size_t)((b * 4 + h) * 2 + d) * 68;
#pragma unroll 1
    for (int c = 0; c < 68; ++c) {
        const size_t tk = task0 + c;
        const bf16x8* mf = (const bf16x8*)(p.RMF + tk * 4096) + lane;
        const bf16x8* qf = (const bf16x8*)(p.RQF + tk * 4096) + lane;
        const f32x4* nf = (const f32x4*)(p.RNF + tk * 4096) + (ib * 4) * 64 + lane;
        const f32x4* yf = (const f32x4*)(p.RYF + tk * 4096) + (ib * 4) * 64 + lane;
        bf16x8 M[4][2], Q[4][2]; f32x4 N[4], Y[4];
#pragma unroll
        for (int jb = 0; jb < 4; ++jb) {
#pragma unroll
            for (int sk = 0; sk < 2; ++sk) { M[jb][sk] = mf[(jb * 2 + sk) * 64]; Q[jb][sk] = qf[(jb * 2 + sk) * 64]; }
            N[jb] = nf[jb * 64]; Y[jb] = yf[jb * 64];
        }
        bf16x8 bfr[2];
#pragma unroll
        for (int sk = 0; sk < 2; ++sk) {
            union { u32x4 u; bf16x8 v; } cv;
            cv.u.x = cvt_pk_bf16(S[2 * sk][0], S[2 * sk][1]); cv.u.y = cvt_pk_bf16(S[2 * sk][2], S[2 * sk][3]);
            cv.u.z = cvt_pk_bf16(S[2 * sk + 1][0], S[2 * sk + 1][1]); cv.u.w = cvt_pk_bf16(S[2 * sk + 1][2], S[2 * sk + 1][3]);
            bfr[sk] = cv.v;
        }
#pragma unroll
        for (int jb = 0; jb < 4; ++jb)
#pragma unroll
            for (int sk = 0; sk < 2; ++sk) {
                N[jb] = __builtin_amdgcn_mfma_f32_16x16x32_bf16(M[jb][sk], bfr[sk], N[jb], 0, 0, 0);
                Y[jb] = __builtin_amdgcn_mfma_f32_16x16x32_bf16(Q[jb][sk], bfr[sk], Y[jb], 0, 0, 0);
            }
#pragma unroll
        for (int jb = 0; jb < 4; ++jb) {
            S[jb] = N[jb];
#pragma unroll
            for (int r = 0; r < 4; ++r) {
                const size_t R = (size_t)b * TPB + rwkv_pos(d, c, jb * 16 + 4 * g + r);
                p.YB[((size_t)d * NROW + R) * 256 + h * 64 + ib * 16 + m16] = Y[jb][r];
            }
        }
    }
}

__device__ __forceinline__ float xor16_max(float v) { return fmaxf(v, SWZ_XOR(v, 16)); }
__device__ __forceinline__ float max_xor32(float v) {
    int a = __float_as_int(v), b = a;
    asm volatile("s_nop 1\n\tv_permlane32_swap_b32 %0, %1\n\ts_nop 1" : "+v"(a), "+v"(b));
    return fmaxf(__int_as_float(a), __int_as_float(b));
}
template <bool BAND, class KB>
__device__ __forceinline__ void attn_block(CParams& p, const bf16_t* KHh, const bf16_t* VTh, const bf16x8 (&qf)[2], KB kbase, const float* rpbh  ,
                                           int c, int rr, int rs, int kc0, int lane, float& mrow, float& lrow, f32x4 (&o)[4]) {
    const int m16 = lane & 15, g = lane >> 4;
    f32x4 sc[16];
#pragma unroll
    for (int u = 0; u < 8; ++u) {
        const int kb = kbase(u);
#pragma unroll
        for (int j2 = 0; j2 < 2; ++j2) {
            const bf16_t* kr = KHh + (size_t)(kb + 16 * j2 + m16) * 64 + 8 * g;
            const bf16x8 k0 = *(const bf16x8*)kr, k1 = *(const bf16x8*)(kr + 32);
            f32x4 a = {0.f, 0.f, 0.f, 0.f};
            a = __builtin_amdgcn_mfma_f32_16x16x32_bf16(k0, qf[0], a, 0, 0, 0);
            a = __builtin_amdgcn_mfma_f32_16x16x32_bf16(k1, qf[1], a, 0, 0, 0);
            if (BAND) {
                const int cs = min(max(c - 8, 0), 48);
#pragma unroll
                for (int r = 0; r < 4; ++r) {
                    const int kc = kc0 + 16 * j2 + 4 * g + r;
                    const int cb = min(max(kc - c + 15, 0), 30);
                    const float bias = rpbh[(rs + u - rr + 7) * 31 + cb];
                    a[r] = (kc >= cs && kc < cs + 16) ? a[r] + bias : -1e30f;
                }
            }
            sc[2 * u + j2] = a;
        }
    }
    float mx = -1e30f;
#pragma unroll
    for (int t = 0; t < 16; ++t) mx = fmaxf(mx, fmaxf(fmaxf(sc[t][0], sc[t][1]), fmaxf(sc[t][2], sc[t][3])));
    mx = xor16_max(mx); mx = max_xor32(mx);
    float sum = 0.f;
#pragma unroll
    for (int t = 0; t < 16; ++t)
#pragma unroll
        for (int r = 0; r < 4; ++r) { const float e = __expf(sc[t][r] - mx); sc[t][r] = e; sum += e; }
    sum += SWZ_XOR(sum, 16); sum = sum_xor32(sum);
    mrow = mx; lrow = sum;
#pragma unroll
    for (int dt = 0; dt < 4; ++dt) o[dt] = (f32x4){0.f, 0.f, 0.f, 0.f};
#pragma unroll
    for (int u = 0; u < 8; ++u) {
        union { u32x4 w; bf16x8 v; } pf;
        pf.w.x = cvt_pk_bf16(sc[2 * u][0], sc[2 * u][1]); pf.w.y = cvt_pk_bf16(sc[2 * u][2], sc[2 * u][3]);
        pf.w.z = cvt_pk_bf16(sc[2 * u + 1][0], sc[2 * u + 1][1]); pf.w.w = cvt_pk_bf16(sc[2 * u + 1][2], sc[2 * u + 1][3]);
        const int kb = kbase(u);
#pragma unroll
        for (int dt = 0; dt < 4; ++dt) {
            const bf16_t* vr = VTh + (size_t)(dt * 16 + m16) * TPB + kb + 4 * g;
            union { u32x4 w; bf16x8 v; } vf;
            const u32x2 v0 = *(const u32x2*)vr, v1 = *(const u32x2*)(vr + 16);
            vf.w = (u32x4){v0.x, v0.y, v1.x, v1.y};
            o[dt] = __builtin_amdgcn_mfma_f32_16x16x32_bf16(vf.v, pf.v, o[dt], 0, 0, 0);
        }
    }
}
__device__ __forceinline__ void d_na(CParams& p, int wv, int l, int do_ctx) {
    const int tidx_ = opaque_tid(wv);
    int bidx_ = blockIdx.x, gdim_ = gridDim.x; asm volatile("" : "+s"(bidx_), "+s"(gdim_));
    const int lane = tidx_ & 63, m16 = lane & 15, g = lane >> 4;
    const float* rpbs = (const float*)smem;
    const int ngrp = (8192 + (do_ctx ? 512 : 0)) / 8;
    for (int grp = bidx_; grp < ngrp; grp += gdim_) {
        const int task = grp * 8 + wv;
        int b, h, qpos0, c = 0, rr = 0, rs = 0, kc0 = 0; bool lat;
        if (task < 8192) { const int ct = task & 3; rr = (task >> 2) & 63; h = (task >> 8) & 7; b = task >> 11; lat = true;
            const int c0 = ct * 16; c = c0 + m16; rs = min(max(rr - 4, 0), 56); kc0 = min(max(c0 - 8, 0), 32); qpos0 = CTXL + rr * 64 + c0; }
        else { const int t2 = task - 8192; const int qt = t2 & 15; h = (t2 >> 4) & 7; b = t2 >> 7; lat = false; qpos0 = qt * 16; }
        const bf16_t* QHh = p.QH + (size_t)(b * 8 + h) * TPB * 64;
        const bf16_t* KHh = p.KH + (size_t)(b * 8 + h) * TPB * 64;
        const bf16_t* VTh = p.VT + (size_t)(b * 8 + h) * 64 * TPB;
        bf16x8 qf[2];
        { const bf16_t* qr = QHh + (size_t)(qpos0 + m16) * 64 + 8 * g; qf[0] = *(const bf16x8*)qr; qf[1] = *(const bf16x8*)(qr + 32); }
        float m2, l2; f32x4 o2[4];
        attn_block<false>(p, KHh, VTh, qf, [&](int u) { return 32 * u; }, nullptr, 0, 0, 0, 0, lane, m2, l2, o2);
        float inv;
        if (lat) {
            float m1, l1; f32x4 o1[4];
            attn_block<true>(p, KHh, VTh, qf, [&](int u) { return CTXL + (rs + u) * 64 + kc0; }, rpbs + h * 465, c, rr, rs, kc0, lane, m1, l1, o1);
            const float mm = fmaxf(m1, m2), f1 = __expf(m1 - mm), f2 = __expf(m2 - mm);
            inv = 1.f / (l1 * f1 + l2 * f2);
#pragma unroll
            for (int dt = 0; dt < 4; ++dt) o2[dt] = o1[dt] * f1 + o2[dt] * f2;
        } else inv = 1.f / l2;
        bf16_t* orow = p.MIX + (size_t)(b * TPB + qpos0 + m16) * DM + 512 + h * 64 + 4 * g;
#pragma unroll
        for (int dt = 0; dt < 4; ++dt) {
            const f32x4 v = o2[dt] * inv;
            u32x2 ov; ov.x = cvt_pk_bf16(v[0], v[1]); ov.y = cvt_pk_bf16(v[2], v[3]);
            *(u32x2*)(orow + dt * 16) = ov;
        }
    }
}

__device__ __forceinline__ void d_scan_attn(CParams& p, int wv, int l, int do_ctx) {
    const int tidx_ = opaque_tid(wv);
    int bidx_ = blockIdx.x, gdim_ = gridDim.x; asm volatile("" : "+s"(bidx_), "+s"(gdim_));
    const int wave = tidx_ >> 6, lane = tidx_ & 63;
    { float* rpbs = (float*)smem; for (int i = tidx_; i < 8 * 15 * 31; i += NTHR) rpbs[i] = p.in[I_RPB][(size_t)l * 8 * 15 * 31 + i]; }
    __syncthreads();
    if (bidx_ < 32 && wave < 4) d_rwkv_seq(p, bidx_, wave, lane);
    else if (bidx_ < 32 && wave == 4) d_lru_scan(p, bidx_, lane);
    d_na(p, wv, l, do_ctx);
}

__device__ __forceinline__ void d_finish(CParams& p, int wv, int l, int skip_ctx) {
    const int tidx_ = opaque_tid(wv);
    int bidx_ = blockIdx.x, gdim_ = gridDim.x; asm volatile("" : "+s"(bidx_), "+s"(gdim_));
    const int lane = tidx_ & 63, gw = bidx_ * 8 + (tidx_ >> 6), NGW = gdim_ * 8;
    for (int it = gw; it < NROW * 4; it += NGW) {
        const int R = it >> 2, h = it & 3, c = h * 64 + lane;
        if (skip_ctx && (R % TPB) < CTXL) continue;
        const float g = p.P[(size_t)R * PST + 256 + c];
        p.MIX[(size_t)R * DM + c] = f2bf(gelu_tanh(g) * (p.LH[(size_t)R * 256 + c] + p.LH[((size_t)NROW + R) * 256 + c]));
        const float* rs = p.RS + (size_t)R * 768;
        const float r = rs[c], k = rs[256 + c], v = rs[512 + c];
        const float y = p.YB[(size_t)R * 256 + c] + p.YB[((size_t)NROW + R) * 256 + c];
        const float mean = wave_sum(y) * (1.f / 64.f);
        const float dv = y - mean;
        const float var = wave_sum(dv * dv) * (1.f / 64.f);
        const float yn = dv * rsqrtf(var + 64e-5f);
        const float ka = p.in[I_KA][l * 256 + c], rk = p.in[I_RK][l * 256 + c];
        float bon = 0.f;
#pragma unroll
        for (int d = 0; d < 2; ++d) {
            const float a = p.AIC[((size_t)d * NROW + R) * 256 + c];
            bon += r * (k * (1.f + (a - 1.f) * ka)) * rk;
        }
        bon = wave_sum(bon);
        const float o = (yn * p.in[I_LNG][l * 256 + c] + p.in[I_LNB][l * 256 + c] + bon * v) * p.GG[(size_t)R * 256 + c];
        p.MIX[(size_t)R * DM + 256 + c] = f2bf(o);
    }
}

__device__ __forceinline__ void d_norm_router(CParams& p, int wv, int l, int skip_ctx) {
    const int tidx_ = opaque_tid(wv);
    int bidx_ = blockIdx.x, gdim_ = gridDim.x; asm volatile("" : "+s"(bidx_), "+s"(gdim_));
    const int lane = tidx_ & 63, wave = tidx_ >> 6, gw = bidx_ * 8 + wave, NGW = gdim_ * 8;
    const int gtid = bidx_ * NTHR + tidx_, gsz = gdim_ * NTHR;
    for (int i = gtid; i < CAP; i += gsz) p.SLOT_TOK[i] = 0;
    float* hs = (float*)smem + wave * 1024;
    const float* rw = p.in[I_RTW] + (size_t)l * DM * 32;
    const float* g = p.in[I_NFG] + l * DM;
    const int e = lane & 31, half = lane >> 5;
    int* cnt = p.CNT + l * 32;
    for (int R = gw; R < NROW; R += NGW) {
        const int b = R / TPB, pos = R % TPB, mr = pos < CTXL ? 4 : b;
        if (skip_ctx && pos < CTXL) continue;
        const float4* xr = (const float4*)(p.X + (size_t)R * DM);
        float4 v[4]; float ss = 0.f;
#pragma unroll
        for (int i = 0; i < 4; ++i) { v[i] = xr[lane + 64 * i]; ss += v[i].x * v[i].x + v[i].y * v[i].y + v[i].z * v[i].z + v[i].w * v[i].w; }
        ss = wave_sum(ss);
        const float* mod = p.MOD + (l * 5 + mr) * 6144 + 3 * DM;
        const float rinv = rsqrtf(ss * (1.f / DM) + 1e-6f);
        __builtin_amdgcn_wave_barrier();
#pragma unroll
        for (int i = 0; i < 4; ++i) {
            const int c = (lane + 64 * i) * 4;
            const float4 gg = *(const float4*)(g + c), sh = *(const float4*)(mod + c), sc = *(const float4*)(mod + DM + c);
            float4 o;
            o.x = v[i].x * rinv * gg.x * (1.f + sc.x) + sh.x; o.y = v[i].y * rinv * gg.y * (1.f + sc.y) + sh.y;
            o.z = v[i].z * rinv * gg.z * (1.f + sc.z) + sh.z; o.w = v[i].w * rinv * gg.w * (1.f + sc.w) + sh.w;
            uint2 ob; ob.x = cvt_pk_bf16(o.x, o.y); ob.y = cvt_pk_bf16(o.z, o.w);
            *(uint2*)(p.H + (size_t)R * DM + c) = ob;
            *(float4*)(hs + c) = o;
        }
        __builtin_amdgcn_wave_barrier();
        float acc = 0.f;
#pragma unroll 8
        for (int k = half * 512; k < half * 512 + 512; ++k) acc += hs[k] * rw[k * 32 + e];
        acc = sum_xor32(acc);
        float val = acc + p.in[I_RTB][l * 32 + e];
        if (lane >= 32) val = -3e38f;
        float tv[4]; int ti[4];
#pragma unroll
        for (int k = 0; k < 4; ++k) {
            const float m = wave_max(val);
            const unsigned long long bal = __ballot(val == m);
            const int idx = __ffsll((long long)bal) - 1;
            tv[k] = m; ti[k] = idx;
            if (lane == idx) val = -3e38f;
        }
        if (lane == 0) {
            const float e1 = __expf(tv[1] - tv[0]), e2 = __expf(tv[2] - tv[0]), e3 = __expf(tv[3] - tv[0]);
            const float inv = 1.f / (1.f + e1 + e2 + e3);
            const float gs[4] = {inv, e1 * inv, e2 * inv, e3 * inv};
#pragma unroll
            for (int k = 0; k < 4; ++k) {
                p.TOPG[R * 4 + k] = gs[k]; p.TOPI[R * 4 + k] = ti[k];
                p.TOKPOS[R * 4 + k] = atomicAdd(&cnt[ti[k]], 1);
            }
        }
    }
}
__device__ __forceinline__ void moe_offsets_lds(CParams& p, int wv, int l) {
    const int tidx_ = opaque_tid(wv);
    int bidx_ = blockIdx.x, gdim_ = gridDim.x; asm volatile("" : "+s"(bidx_), "+s"(gdim_));
    int* li = (int*)(smem + LDS_GEMM);
    __syncthreads();
    if (tidx_ == 0) {
        int off = 0, nt = 0;
#pragma unroll 1
        for (int e = 0; e < NEXP; ++e) {
            li[e] = off;
            const int n = (p.CNT[l * 32 + e] + MOE_TM - 1) / MOE_TM;
#pragma unroll 1
            for (int i = 0; i < n; ++i) li[64 + nt++] = e;
            off += n * MOE_TM;
        }
        li[32] = off; li[40] = nt;
    }
    __syncthreads();
}
__device__ __forceinline__ void d_moe_scatter(CParams& p, int wv, int l, int skip_ctx) {
    const int tidx_ = opaque_tid(wv);
    int bidx_ = blockIdx.x, gdim_ = gridDim.x; asm volatile("" : "+s"(bidx_), "+s"(gdim_));
    moe_offsets_lds(p, wv, l);
    const int* li = (const int*)(smem + LDS_GEMM);
    const int gtid = bidx_ * NTHR + tidx_, gsz = gdim_ * NTHR;
    for (int i = gtid; i < NROW * 4; i += gsz) {
        const int R = i >> 2;
        if (skip_ctx && (R % TPB) < CTXL) continue;
        p.SLOT_TOK[li[p.TOPI[i]] + p.TOKPOS[i]] = R;
    }
}
struct ProbG1 {
    CParams& p; int l; const int* li; int ntile; int bid, nblk;
    __device__ __forceinline__ bool next(int i, Unit& u) const { return tile_order(i, ntile, 8, u, bid, nblk); }
    __device__ __forceinline__ int expert(const Unit& u) const { return __builtin_amdgcn_readfirstlane(li[64 + u.pm]); }
    __device__ __forceinline__ const char* a_ptr(const Unit&) const { return (const char*)p.H; }
    __device__ __forceinline__ const char* b_ptr(const Unit& u) const { return (const char*)p.WTGU + ((size_t)(l * NEXP + expert(u)) * 2048 + (size_t)u.pn * 256) * KB_; }
    __device__ __forceinline__ int gather_row(const Unit& u, int r) const { return p.SLOT_TOK[u.pm * 256 + r]; }
    __device__ __forceinline__ void epi(const f32x4 (&acc)[2][2][4][2], const Unit& u, int wr, int wc, int fr, int fq) const {
        const int brow = u.pm * 256;
        const float* bias = p.in[I_BGU] + (size_t)(l * NEXP + expert(u)) * 2048;
        const int c = u.pn * 128 + wc * 32 + 8 * fq;
        const f32x4 bg0 = *(const f32x4*)(bias + c), bg1 = *(const f32x4*)(bias + c + 4);
        const f32x4 bu0 = *(const f32x4*)(bias + 1024 + c), bu1 = *(const f32x4*)(bias + 1024 + c + 4);
#pragma unroll
        for (int ai = 0; ai < 2; ++ai)
#pragma unroll
            for (int m = 0; m < 4; ++m) {
                float a[8];
#pragma unroll
                for (int n = 0; n < 2; ++n)
#pragma unroll
                    for (int j = 0; j < 4; ++j) {
                        float gv = acc[ai][0][m][n][j] + (n == 0 ? bg0[j] : bg1[j]), uv = acc[ai][1][m][n][j] + (n == 0 ? bu0[j] : bu1[j]);
                        gv = fminf(gv, 7.f); uv = fminf(fmaxf(uv, -7.f), 7.f);
                        a[n * 4 + j] = (uv + 1.f) * (gv * sigmoidf_(1.702f * gv));
                    }
                u32x4 o; o.x = cvt_pk_bf16(a[0], a[1]); o.y = cvt_pk_bf16(a[2], a[3]); o.z = cvt_pk_bf16(a[4], a[5]); o.w = cvt_pk_bf16(a[6], a[7]);
                *(u32x4*)(p.ACT + (size_t)(brow + ai * 128 + wr * 64 + m * 16 + fr) * DM + c) = o;
            }
    }
};
__device__ __forceinline__ void d_moe_gemm1(CParams& p, int wv, int l) {
    moe_offsets_lds(p, wv, l);
    const int* li = (const int*)(smem + LDS_GEMM);
    ProbG1 P{p, l, li, __builtin_amdgcn_readfirstlane(li[40]), 0, 0};
    gemm_phase<true>(P, wv);
}
struct ProbG2 {
    CParams& p; int l; const int* li; int ntile; int bid, nblk;
    __device__ __forceinline__ bool next(int i, Unit& u) const { return tile_order(i, ntile, 4, u, bid, nblk); }
    __device__ __forceinline__ int expert(const Unit& u) const { return __builtin_amdgcn_readfirstlane(li[64 + u.pm]); }
    __device__ __forceinline__ const char* a_ptr(const Unit& u) const { return (const char*)p.ACT + (size_t)u.pm * 256 * KB_; }
    __device__ __forceinline__ const char* b_ptr(const Unit& u) const { return (const char*)p.WTDN + ((size_t)(l * NEXP + expert(u)) * DM + (size_t)u.pn * 256) * KB_; }
    __device__ __forceinline__ int gather_row(const Unit&, int) const { return 0; }
    __device__ __forceinline__ void epi(const f32x4 (&acc)[2][2][4][2], const Unit& u, int wr, int wc, int fr, int fq) const {
        const int brow = u.pm * 256, bcol = u.pn * 256;
        const float* bias = p.in[I_BDN] + (size_t)(l * NEXP + expert(u)) * DM;
#pragma unroll
        for (int ai = 0; ai < 2; ++ai)
#pragma unroll
            for (int m = 0; m < 4; ++m) {
                float* yrow = p.Y + (size_t)(brow + ai * 128 + wr * 64 + m * 16 + fr) * DM;
#pragma unroll
                for (int bj = 0; bj < 2; ++bj)
#pragma unroll
                    for (int n = 0; n < 2; ++n) {
                        const int col = bcol + bj * 128 + wc * 32 + n * 16 + fq * 4;
                        *(f32x4*)(yrow + col) = acc[ai][bj][m][n] + *(const f32x4*)(bias + col);
                    }
            }
    }
};
__device__ __forceinline__ void d_moe_gemm2(CParams& p, int wv, int l) {
    moe_offsets_lds(p, wv, l);
    const int* li = (const int*)(smem + LDS_GEMM);
    ProbG2 P{p, l, li, __builtin_amdgcn_readfirstlane(li[40]), 0, 0};
    gemm_phase<false>(P, wv);
}
__device__ __forceinline__ void d_moe_combine(CParams& p, int wv, int l, int last) {
    const int tidx_ = opaque_tid(wv);
    int bidx_ = blockIdx.x, gdim_ = gridDim.x; asm volatile("" : "+s"(bidx_), "+s"(gdim_));
    moe_offsets_lds(p, wv, l);
    const int* li = (const int*)(smem + LDS_GEMM);
    const int lane = tidx_ & 63, gw = bidx_ * 8 + (tidx_ >> 6), NGW = gdim_ * 8;
    for (int R = gw; R < NROW; R += NGW) {
        const int b = R / TPB, pos = R % TPB, mr = pos < CTXL ? 4 : b;
        if (last && pos < CTXL) continue;
        float4 acc[4];
#pragma unroll
        for (int i = 0; i < 4; ++i) acc[i] = make_float4(0.f, 0.f, 0.f, 0.f);
#pragma unroll
        for (int k = 0; k < 4; ++k) {
            const float g = p.TOPG[R * 4 + k];
            const int s = li[p.TOPI[R * 4 + k]] + p.TOKPOS[R * 4 + k];
            const float4* yr = (const float4*)(p.Y + (size_t)s * DM);
#pragma unroll
            for (int i = 0; i < 4; ++i) { const float4 y = yr[lane + 64 * i]; acc[i].x += g * y.x; acc[i].y += g * y.y; acc[i].z += g * y.z; acc[i].w += g * y.w; }
        }
        const float* m5 = p.MOD + (l * 5 + mr) * 6144 + 5 * DM;
        float4* xr = (float4*)(p.X + (size_t)R * DM);
        float4 v[4]; float ss = 0.f;
#pragma unroll
        for (int i = 0; i < 4; ++i) {
            const float4 m = *(const float4*)(m5 + (lane + 64 * i) * 4);
            float4 x = xr[lane + 64 * i];
            x.x += m.x * acc[i].x; x.y += m.y * acc[i].y; x.z += m.z * acc[i].z; x.w += m.w * acc[i].w;
            v[i] = x; ss += x.x * x.x + x.y * x.y + x.z * x.z + x.w * x.w;
        }
        ss = wave_sum(ss);
        if (!last) {
#pragma unroll
            for (int i = 0; i < 4; ++i) xr[lane + 64 * i] = v[i];
            norm_row_to_bf16(p, v, ss, l + 1, 0, mr, p.H + (size_t)R * DM, lane);
        } else {
            const float rinv = rsqrtf(ss * (1.f / DM) + 1e-6f);
            float4* orow = (float4*)(p.out + ((size_t)b * SEQ + (pos - CTXL)) * DM);
#pragma unroll
            for (int i = 0; i < 4; ++i) {
                const float4 gg = *(const float4*)(p.in[I_FING] + (lane + 64 * i) * 4);
                float4 r; r.x = v[i].x * rinv * gg.x; r.y = v[i].y * rinv * gg.y; r.z = v[i].z * rinv * gg.z; r.w = v[i].w * rinv * gg.w;
                orow[lane + 64 * i] = r;
            }
        }
    }
}

#ifndef MULTI
#define MULTI 0
#endif
__device__ __forceinline__ void run_phase(CParams& p, int wv, int ph) {
    if (ph == 0) { d_prologue(p, wv); return; }
    if (ph == 1) { d_norm_mix(p, wv, 0); return; }
    const int l = (ph - 2) / 11, q = (ph - 2) % 11, last = l == 1;
    if (ph >= 24) return;
    switch (q) {
        case 0: d_gemm_in(p, wv, l); break;
        case 1: d_lru_pre(p, wv, l); d_rwkv_pre(p, wv, l); break;
        case 2: d_rwkv_chunkA(p, wv, l); break;
        case 3: d_scan_attn(p, wv, l, !last); break;
        case 4: d_finish(p, wv, l, last); break;
        case 5: d_gemm_out(p, wv, l, last); break;
        case 6: d_norm_router(p, wv, l, last); break;
        case 7: d_moe_scatter(p, wv, l, last); break;
        case 8: d_moe_gemm1(p, wv, l); break;
        case 9: d_moe_gemm2(p, wv, l); break;
        case 10: d_moe_combine(p, wv, l, last); break;
    }
}
#if MULTI
template <int PH> __global__ void __launch_bounds__(NTHR) mega_ph(Params p) { run_phase(p, __builtin_amdgcn_readfirstlane(threadIdx.x >> 6), PH); }
__global__ void __launch_bounds__(NTHR) mega(Params p) {}
template <int PH> static void launch_all(CParams& p, int grid, hipStream_t stream) {
    static bool attr = false; if (!attr) { (void)hipFuncSetAttribute((const void*)mega_ph<PH>, hipFuncAttributeMaxDynamicSharedMemorySize, LDS_BYTES); attr = true; }
    mega_ph<PH><<<grid, NTHR, LDS_BYTES, stream>>>(p);
    if constexpr (PH + 1 < 24) launch_all<PH + 1>(p, grid, stream);
}
#else
__global__ void __launch_bounds__(NTHR) mega(Params p) {
    cg::grid_group grid = cg::this_grid();
    const int wv = __builtin_amdgcn_readfirstlane(threadIdx.x >> 6);
#define RUNPH(n) { CParams* pp = (CParams*)__builtin_amdgcn_kernarg_segment_ptr(); asm volatile("" : "+s"(pp)); run_phase(*pp, wv, n); if (n < 23) grid.sync(); }
    RUNPH(0) RUNPH(1) RUNPH(2) RUNPH(3) RUNPH(4) RUNPH(5) RUNPH(6) RUNPH(7) RUNPH(8) RUNPH(9) RUNPH(10)
    RUNPH(11) RUNPH(12) RUNPH(13) RUNPH(14) RUNPH(15) RUNPH(16) RUNPH(17) RUNPH(18) RUNPH(19) RUNPH(20) RUNPH(21) RUNPH(22) RUNPH(23)
}
#endif

extern "C" void kernel_launch(void* const* d_in, const int* in_sizes, int n_in, void* d_out, int out_size, void* d_ws, size_t ws_size,
                              hipStream_t stream) {
    Params p{};
    for (int i = 0; i < N_IN; ++i) p.in[i] = (const float*)d_in[i];
    p.out = (float*)d_out;
    char* w = (char*)d_ws;
    size_t off = 0;
    auto take = [&](size_t bytes) { void* r = w + off; off += (bytes + 255) & ~(size_t)255; return r; };
    p.X = (float*)take((size_t)NROW * DM * 4);
    p.H = (bf16_t*)take((size_t)NROW * DM * 2);
    p.P = (float*)take((size_t)NROW * PST * 4);
    p.QH = (bf16_t*)take((size_t)NROW * 512 * 2);
    p.KH = (bf16_t*)take((size_t)NROW * 512 * 2);
    p.VT = (bf16_t*)take((size_t)NROW * 512 * 2);
    p.MIX = (bf16_t*)take((size_t)NROW * DM * 2);
    p.MOD = (float*)take(2 * 5 * 6144 * 4);
    p.LA = (float*)take((size_t)2 * NROW * 256 * 4);
    p.LB = (float*)take((size_t)2 * NROW * 256 * 4);
    p.LH = (float*)take((size_t)2 * NROW * 256 * 4);
    p.RS = (float*)take((size_t)NROW * 768 * 4);
    p.DEC = (float*)take((size_t)2 * NROW * 256 * 4);
    p.AIC = (float*)take((size_t)2 * NROW * 256 * 4);
    p.KKN = (float*)take((size_t)NROW * 256 * 4);
    p.GG = (float*)take((size_t)NROW * 256 * 4);
    p.YB = (float*)take((size_t)2 * NROW * 256 * 4);
    p.TOPG = (float*)take((size_t)NROW * 4 * 4);
    p.TOPI = (int*)take((size_t)NROW * 4 * 4);
    p.TOKPOS = (int*)take((size_t)NROW * 4 * 4);
    p.CNT = (int*)take(64 * 4);
    p.SLOT_TOK = (int*)take((size_t)CAP * 4);
    p.ACT = (bf16_t*)take((size_t)CAP * DM * 2);
    p.Y = (float*)take((size_t)CAP * DM * 4);
    p.RMF = (bf16_t*)take((size_t)2176 * 4096 * 2);
    p.RQF = (bf16_t*)take((size_t)2176 * 4096 * 2);
    p.RNF = (float*)take((size_t)2176 * 4096 * 4);
    p.RYF = (float*)take((size_t)2176 * 4096 * 4);
    p.WTIN = (bf16_t*)take((size_t)2 * INCP * DM * 2);
    p.WTOUT = (bf16_t*)take((size_t)2 * DM * DM * 2);
    p.WTGU = (bf16_t*)take((size_t)2 * NEXP * 2048 * DM * 2);
    p.WTDN = (bf16_t*)take((size_t)2 * NEXP * DM * DM * 2);

    static int grid_blocks = 0;
    if (!grid_blocks) {
        int dev = 0, cus = 0, per_cu = 0;
        (void)hipGetDevice(&dev);
        (void)hipDeviceGetAttribute(&cus, hipDeviceAttributeMultiprocessorCount, dev);
        (void)hipFuncSetAttribute((const void*)mega, hipFuncAttributeMaxDynamicSharedMemorySize, LDS_BYTES);
        (void)hipOccupancyMaxActiveBlocksPerMultiprocessor(&per_cu, (const void*)mega, NTHR, LDS_BYTES);
        if (per_cu > 1) per_cu = 1;
        if (per_cu < 1) { fprintf(stderr, "occupancy query says %d blocks/CU\n", per_cu); per_cu = 1; }
        grid_blocks = cus * per_cu;
        (void)hipGetLastError();
    }
#if MULTI
    launch_all<0>(p, grid_blocks, stream);
#else
    void* args[] = {&p};
    hipError_t e = hipLaunchCooperativeKernel((void*)mega, dim3(grid_blocks), dim3(NTHR), args, LDS_BYTES, stream);
    if (e != hipSuccess) fprintf(stderr, "cooperative launch failed: %s (grid %d)\n", hipGetErrorString(e), grid_blocks);
#endif
}
```

```cpp
#include <hip/hip_runtime.h>
#include <hip/hip_cooperative_groups.h>
#include <stdint.h>
#include <cstdio>
namespace cg = cooperative_groups;

#define DM 1024
#define NBATCH 4
#define SEQ 4096
#define CTXL 256
#define TPB 4352
#define NROW 17408
#define INC 3008
#define INCP 3072
#define PST 1472
#define NEXP 32
#define MOE_TM 256
#define CAP (NROW * 4 + NEXP * MOE_TM)
#define MAXTILES (CAP / MOE_TM)
#define NTHR 512
#define LDS_GEMM 131072
#define LDS_BYTES 155648

typedef unsigned short bf16_t;
typedef short bf16x8 __attribute__((ext_vector_type(8)));
typedef float f32x4 __attribute__((ext_vector_type(4)));
typedef unsigned u32x4 __attribute__((ext_vector_type(4)));
typedef unsigned u32x2 __attribute__((ext_vector_type(2)));

enum { I_X = 0, I_C, I_CTX, I_CCTX, I_ADAW, I_ADAB, I_NMG, I_NFG, I_WIN, I_WOUT, I_CONVW, I_CONVB, I_WR, I_BR, I_WI, I_BI,
       I_LAM, I_MU, I_W0, I_W2, I_A0, I_A2, I_G2, I_KK, I_KA, I_RK, I_LNG, I_LNB, I_RPB, I_RTW, I_RTB, I_WGU, I_BGU, I_WDN,
       I_BDN, I_FING, N_IN };

struct Params {
    const float* in[N_IN];
    float* out;
    float* X;
    bf16_t* H;
    float* P;
    bf16_t* QH;
    bf16_t* KH;
    bf16_t* VT;
    bf16_t* MIX;
    float* MOD;
    float* LA;
    float* LB;
    float* LCE;
    float* LCI;
    float* RS;
    float* DEC;
    float* AIC;
    float* KKN;
    float* GG;
    float* YB;
    float* TOPG;
    int* TOPI;
    int* TOKPOS;
    int* CNT;
    int* SLOT_TOK;
    bf16_t* ACT;
    float* Y;
    unsigned* BAR;
    bf16_t* LWT;
    bf16_t* RWT;
    bf16_t* RMF;
    bf16_t* RQF;
    float* RNF;
    float* RYF;
    bf16_t* WTIN;
    bf16_t* WTOUT;
    bf16_t* WTGU;
    bf16_t* WTDN;
};

typedef const __attribute__((address_space(4))) Params CParams;
extern __shared__ __attribute__((aligned(16))) unsigned char smem[];

__device__ __forceinline__ int opaque_tid(int wv) { int t; asm volatile("v_mbcnt_lo_u32_b32 %0, -1, 0\n\tv_mbcnt_hi_u32_b32 %0, -1, %0" : "=v"(t)); return wv * 64 + t; }
__device__ __forceinline__ float sigmoidf_(float x) { return 1.f / (1.f + __expf(-x)); }
__device__ __forceinline__ float softplusf_(float x) { return x > 20.f ? x : log1pf(__expf(x)); }
#define SWZ_XOR(v, o) __int_as_float(__builtin_amdgcn_ds_swizzle(__float_as_int(v), ((o) << 10) | 0x1f))
__device__ __forceinline__ float rdlane(float v, int l) { return __int_as_float(__builtin_amdgcn_readlane(__float_as_int(v), l)); }
__device__ __forceinline__ float sum_xor32(float v) {
    int a = __float_as_int(v), b = a;
    asm volatile("s_nop 1\n\tv_permlane32_swap_b32 %0, %1\n\ts_nop 1" : "+v"(a), "+v"(b));
    return __int_as_float(a) + __int_as_float(b);
}
__device__ __forceinline__ float wave_sum(float v) {
    v += SWZ_XOR(v, 1); v += SWZ_XOR(v, 2); v += SWZ_XOR(v, 4); v += SWZ_XOR(v, 8); v += SWZ_XOR(v, 16);
    return rdlane(v, 0) + rdlane(v, 32);
}
__device__ __forceinline__ float wave_max(float v) {
    v = fmaxf(v, SWZ_XOR(v, 1)); v = fmaxf(v, SWZ_XOR(v, 2)); v = fmaxf(v, SWZ_XOR(v, 4)); v = fmaxf(v, SWZ_XOR(v, 8)); v = fmaxf(v, SWZ_XOR(v, 16));
    return fmaxf(rdlane(v, 0), rdlane(v, 32));
}
typedef __bf16 bf16x2_n __attribute__((ext_vector_type(2)));
__device__ __forceinline__ unsigned cvt_pk_bf16(float lo, float hi) { bf16x2_n v; v[0] = (__bf16)lo; v[1] = (__bf16)hi; return __builtin_bit_cast(unsigned, v); }
__device__ __forceinline__ bf16_t f2bf(float x) { return __builtin_bit_cast(bf16_t, (__bf16)x); }
__device__ __forceinline__ float gelu_tanh(float x) {
    const float u = 0.7978845608028654f * (x + 0.044715f * x * x * x);
    return 0.5f * x * (1.f + tanhf(u));
}

__device__ __forceinline__ int inv_perm32(int cc) { return ((cc >> 2) & 1) * 16 + (cc >> 3) * 4 + (cc & 3); }
__device__ __forceinline__ void transpose_item(const float* W, int K, int N, bf16_t* WT, int k0, int n0, int dst_row0, float* scr, int lane, bool perm = false) {
#pragma unroll 8
    for (int i = 0; i < 32; ++i) { const int kk = 2 * i + (lane >> 5); scr[kk * 33 + (lane & 31)] = W[(size_t)(k0 + kk) * N + n0 + (lane & 31)]; }
    __builtin_amdgcn_wave_barrier();
    const int c = lane & 7;
#pragma unroll
    for (int j = 0; j < 4; ++j) {
        const int n = (lane >> 3) + 8 * j; const float* s = scr + (8 * c) * 33 + n;
        u32x4 o; o.x = cvt_pk_bf16(s[0 * 33], s[1 * 33]); o.y = cvt_pk_bf16(s[2 * 33], s[3 * 33]); o.z = cvt_pk_bf16(s[4 * 33], s[5 * 33]); o.w = cvt_pk_bf16(s[6 * 33], s[7 * 33]);
        *(u32x4*)(WT + (size_t)(dst_row0 + (perm ? inv_perm32(n) : n)) * K + k0 + 8 * c) = o;
    }
    __builtin_amdgcn_wave_barrier();
}

__device__ __forceinline__ void d_prologue(CParams& p, int wv) {
    const int tidx_ = opaque_tid(wv);
    int bidx_ = blockIdx.x, gdim_ = gridDim.x; asm volatile("" : "+s"(bidx_), "+s"(gdim_));
    const int tid = tidx_, lane = tid & 63, wave = tid >> 6;
    const int gtid = bidx_ * NTHR + tid, gsz = gdim_ * NTHR;
    const int gw = bidx_ * 8 + wave, NGW = gdim_ * 8;
    {
        const float4* x4 = (const float4*)p.in[I_X];
        const float4* c4 = (const float4*)p.in[I_CTX];
        float4* X4 = (float4*)p.X;
        for (int i = gtid; i < NROW * 256; i += gsz) {
            const int R = i >> 8, q = i & 255, b = R / TPB, pos = R % TPB;
            X4[i] = pos < CTXL ? c4[(b * CTXL + pos) * 256 + q] : x4[((size_t)b * SEQ + (pos - CTXL)) * 256 + q];
        }
    }
    if (gtid < 64) p.CNT[gtid] = 0;
    for (int i = gtid; i < 2 * 2 * 4 * 2 * 4096; i += gsz) {
        const int ii = i & 63, j = (i >> 6) & 63, gt = (i >> 12) & 1, ldh = i >> 13;
        p.LWT[i] = f2bf((gt ? p.in[I_WI] : p.in[I_WR])[(size_t)ldh * 4096 + ii * 64 + j]);
    }
    for (int i = gtid; i < 2 * 5 * 16384; i += gsz) {
        const int k = i & 63, n = (i >> 6) & 255, mtx = (i >> 14) % 5, l = i / (5 * 16384);
        const float v = mtx < 2 ? p.in[I_W2][((size_t)(l * 2 + mtx) * 64 + k) * 256 + n] : (mtx < 4 ? p.in[I_A2][((size_t)(l * 2 + mtx - 2) * 64 + k) * 256 + n] : p.in[I_G2][((size_t)l * 64 + k) * 256 + n]);
        p.RWT[i] = f2bf(v);
    }
    for (int i = gtid; i < 2 * 64 * 1024 / 8; i += gsz) {
        const int l = i / (64 * 128), r = i % (64 * 128);
        *(u32x4*)(p.WTIN + ((size_t)l * INCP + INC) * DM + (size_t)r * 8) = (u32x4){0u, 0u, 0u, 0u};
    }
    {
        float* sc = (float*)smem;
        float* part = (float*)(smem + 5 * 1024 * 4);
        for (int i = tid; i < 5 * DM; i += NTHR) { const int r = i / DM, d = i % DM; const float v = r < 4 ? p.in[I_C][r * DM + d] : p.in[I_CCTX][d]; sc[i] = v * sigmoidf_(v); }
        __syncthreads();
        for (int cb = bidx_; cb < 256; cb += gdim_) {
            const int col = tid % 48, ks = tid / 48;
            const int gc = cb * 48 + col, l = gc / 6144, n = gc % 6144;
            if (ks < 8) {
                const float* W = p.in[I_ADAW] + (size_t)l * DM * 6144 + n;
                float a0 = 0.f, a1 = 0.f, a2 = 0.f, a3 = 0.f, a4 = 0.f;
#pragma unroll 8
                for (int k = ks * 128; k < ks * 128 + 128; ++k) {
                    const float w = W[(size_t)k * 6144];
                    a0 += sc[k] * w; a1 += sc[DM + k] * w; a2 += sc[2 * DM + k] * w; a3 += sc[3 * DM + k] * w; a4 += sc[4 * DM + k] * w;
                }
                float* pp = part + (ks * 5) * 48 + col;
                pp[0] = a0; pp[48] = a1; pp[96] = a2; pp[144] = a3; pp[192] = a4;
            }
            __syncthreads();
            if (tid < 240) {
                const int r = tid / 48, c2 = tid % 48, gc2 = cb * 48 + c2, l2 = gc2 / 6144, n2 = gc2 % 6144;
                float s = p.in[I_ADAB][l2 * 6144 + n2];
#pragma unroll
                for (int k = 0; k < 8; ++k) s += part[(k * 5 + r) * 48 + c2];
                p.MOD[(l2 * 5 + r) * 6144 + n2] = s;
            }
            __syncthreads();
        }
    }
    {
        float* scr = (float*)(smem + 32768) + wave * (64 * 33);
        const int N_IN_ = 2 * 16 * 94, N_OUT_ = 2 * 16 * 32, N_GU_ = 64 * 16 * 64, N_DN_ = 64 * 16 * 32;
        for (int it = gw; it < N_IN_ + N_OUT_ + N_GU_ + N_DN_; it += NGW) {
            int r = it;
            if (r < N_IN_) { const int l = r / (16 * 94), q = r % (16 * 94), kb = q / 94, nb = q % 94;
                transpose_item(p.in[I_WIN] + (size_t)l * DM * INC, DM, INC, p.WTIN + (size_t)l * INCP * DM, kb * 64, nb * 32, nb * 32, scr, lane); continue; }
            r -= N_IN_;
            if (r < N_OUT_) { const int l = r / 512, q = r % 512, kb = q / 32, nb = q % 32;
                transpose_item(p.in[I_WOUT] + (size_t)l * DM * DM, DM, DM, p.WTOUT + (size_t)l * DM * DM, kb * 64, nb * 32, nb * 32, scr, lane); continue; }
            r -= N_OUT_;
            if (r < N_GU_) { const int le = r / 1024, q = r % 1024, kb = q / 64, nb = q % 64;
                const int c0 = nb * 32; const int dst = c0 < 1024 ? (c0 / 128) * 256 + (c0 % 128) : ((c0 - 1024) / 128) * 256 + 128 + ((c0 - 1024) % 128);
                transpose_item(p.in[I_WGU] + (size_t)le * DM * 2048, DM, 2048, p.WTGU + (size_t)le * 2048 * DM, kb * 64, c0, dst, scr, lane, true); continue; }
            r -= N_GU_;
            { const int le = r / 512, q = r % 512, kb = q / 32, nb = q % 32;
                transpose_item(p.in[I_WDN] + (size_t)le * DM * DM, DM, DM, p.WTDN + (size_t)le * DM * DM, kb * 64, nb * 32, nb * 32, scr, lane); }
        }
    }
}

__device__ __forceinline__ void norm_row_to_bf16(CParams& p, const float4 (&v)[4], float ss, int l, int which, int mr, bf16_t* hrow, int lane) {
    const float* g = (which == 0 ? p.in[I_NMG] : p.in[I_NFG]) + l * DM;
    const float* mod = p.MOD + (l * 5 + mr) * 6144 + (which == 0 ? 0 : 3 * DM);
    const float rinv = rsqrtf(ss * (1.f / DM) + 1e-6f);
#pragma unroll
    for (int i = 0; i < 4; ++i) {
        const int c = (lane + 64 * i) * 4;
        const float4 gg = *(const float4*)(g + c), sh = *(const float4*)(mod + c), sc = *(const float4*)(mod + DM + c);
        const float o0 = v[i].x * rinv * gg.x * (1.f + sc.x) + sh.x, o1 = v[i].y * rinv * gg.y * (1.f + sc.y) + sh.y;
        const float o2 = v[i].z * rinv * gg.z * (1.f + sc.z) + sh.z, o3 = v[i].w * rinv * gg.w * (1.f + sc.w) + sh.w;
        uint2 o; o.x = cvt_pk_bf16(o0, o1); o.y = cvt_pk_bf16(o2, o3);
        *(uint2*)(hrow + c) = o;
    }
}
__device__ __forceinline__ void d_norm_mix(CParams& p, int wv, int l) {
    const int tidx_ = opaque_tid(wv);
    int bidx_ = blockIdx.x, gdim_ = gridDim.x; asm volatile("" : "+s"(bidx_), "+s"(gdim_));
    const int lane = tidx_ & 63, gw = bidx_ * 8 + (tidx_ >> 6), NGW = gdim_ * 8;
    for (int R = gw; R < NROW; R += NGW) {
        const int b = R / TPB, pos = R % TPB, mr = pos < CTXL ? 4 : b;
        const float4* xr = (const float4*)(p.X + (size_t)R * DM);
        float4 v[4]; float ss = 0.f;
#pragma unroll
        for (int i = 0; i < 4; ++i) { v[i] = xr[lane + 64 * i]; ss += v[i].x * v[i].x + v[i].y * v[i].y + v[i].z * v[i].z + v[i].w * v[i].w; }
        ss = wave_sum(ss);
        norm_row_to_bf16(p, v, ss, l, 0, mr, p.H + (size_t)R * DM, lane);
    }
}

#define LAS __attribute__((address_space(3)))
#define RWS 144
#define HTB 16384
#define KB_ 2048
__device__ __forceinline__ int lds_byte(int r, int c) {
    const int st = (r >> 4) * 2 + (c >> 5), rr = r & 15, cc = c & 31, ob = rr * 64 + cc * 2;
    return st * 1024 + (ob ^ (((ob >> 9) & 1) << 5));
}
__device__ __forceinline__ void stage_rc(int b, int& R, int& C) {
    const int st = b / 1024, sb = b % 1024, swz = sb ^ (((sb >> 9) & 1) << 5);
    R = (st >> 1) * 16 + swz / 64; C = (st & 1) * 32 + (swz % 64) / 2;
}
struct Unit { int pm, pn; };
__device__ __forceinline__ bool tile_order(int i, int nM, int nN, Unit& u, int bid, int nblk) {
    const int nwg = nM * nN; const long L = (long)i * nblk + bid; if (L >= nwg) return false;
    int wgid = (int)L; { const int q = nwg / 8, r = nwg % 8, xcd = wgid % 8, off = wgid / 8; wgid = (xcd < r ? xcd * (q + 1) : r * (q + 1) + (xcd - r) * q) + off; }
    const int nig = 8 * nN, gid = wgid / nig, fm = gid * 8, gsz = (nM - fm) < 8 ? (nM - fm) : 8;
    u.pm = fm + ((wgid % nig) % gsz); u.pn = (wgid % nig) / gsz; return true;
}

#define PG_SA(b, h) (((b) * 2 + (h)) * HTB)
#define PG_SB(b, h) ((4 + (b) * 2 + (h)) * HTB)
#define PG_STAGE(bufoff, gbase, v0, v1) do { \
    __builtin_amdgcn_global_load_lds((const unsigned*)((const char*)(gbase) + (v0)), (LAS unsigned*)(lds + (bufoff) + ldsw), 16, 0, 0); \
    __builtin_amdgcn_global_load_lds((const unsigned*)((const char*)(gbase) + (v1)), (LAS unsigned*)(lds + (bufoff) + ldsw + 8192), 16, 0, 0); } while (0)
#define PG_STAGE_B(bufoff, gbase) PG_STAGE(bufoff, gbase, voffB[0], voffB[1])
#define PG_STAGE_A(bufoff, gb, h, usenext) do { if (GATHER) PG_STAGE(bufoff, gb, gc[h][0], gc[h][1]); \
    else PG_STAGE(bufoff, (gb) + (h) * hstep, voffA[0], voffA[1]); } while (0)
#define PG_LDA(dst, b, h) do { _Pragma("unroll") for (int m = 0; m < 4; ++m) _Pragma("unroll") for (int k = 0; k < 2; ++k) dst[m][k] = *(const LAS bf16x8*)(lds + PG_SA(b, h) + aoff + m * 2048 + k * 1024); } while (0)
#define PG_LDB(dst, b, h) do { _Pragma("unroll") for (int n = 0; n < 2; ++n) _Pragma("unroll") for (int k = 0; k < 2; ++k) dst[n][k] = *(const LAS bf16x8*)(lds + PG_SB(b, h) + boff + n * 2048 + k * 1024); } while (0)
#define PG_MMA(ai, bj, At_, Bt_) do { __builtin_amdgcn_s_setprio(1); _Pragma("unroll") for (int m = 0; m < 4; ++m) _Pragma("unroll") for (int n = 0; n < 2; ++n) _Pragma("unroll") for (int k = 0; k < 2; ++k) \
    acc[ai][bj][m][n] = __builtin_amdgcn_mfma_f32_16x16x32_bf16(Bt_[n][k], At_[m][k], acc[ai][bj][m][n], 0, 0, 0); __builtin_amdgcn_s_setprio(0); } while (0)
#define PG_WAIT_V(n) asm volatile("s_waitcnt vmcnt(" #n ")" ::: "memory")
#define PG_WAIT_L(n) asm volatile("s_waitcnt lgkmcnt(" #n ")" ::: "memory")
#define PG_BAR __builtin_amdgcn_s_barrier()
#define PG_SCHED __builtin_amdgcn_sched_barrier(0)

template <bool GATHER, class Prob>
__device__ __forceinline__ void gemm_phase(Prob P, int wv) {
    const int tidx_ = opaque_tid(wv);
    int bidx_ = blockIdx.x, gdim_ = gridDim.x; asm volatile("" : "+s"(bidx_), "+s"(gdim_));
    LAS unsigned char* lds = (LAS unsigned char*)smem;
    P.bid = bidx_; P.nblk = gdim_;
    const int tid = tidx_, wid = __builtin_amdgcn_readfirstlane(tid >> 6), lane = tid & 63, wr = wid >> 2, wc = wid & 3, fr = lane & 15, fq = lane >> 4;
    constexpr int nt = 16;
    unsigned voffA[2], voffB[2]; int Rr[2], Cc[2];
#pragma unroll
    for (int i = 0; i < 2; ++i) { stage_rc(tid * 16 + i * 8192, Rr[i], Cc[i]); voffA[i] = (unsigned)(Rr[i] * 1024 + Cc[i]) * 2u; voffB[i] = voffA[i]; }
    const size_t kstep = 128, hstep = (size_t)128 * KB_;
    const unsigned ldsw = (unsigned)wid * 1024u;
    const int aoff = lds_byte(wr * 64 + fr, fq * 8), boff = lds_byte(wc * 32 + fr, fq * 8);
    Unit cur, nxt; int ui = 0;
    if (!P.next(0, cur)) return;
    f32x4 acc[2][2][4][2];
#pragma unroll
    for (int a = 0; a < 2; ++a)
#pragma unroll
        for (int b = 0; b < 2; ++b)
#pragma unroll
            for (int m = 0; m < 4; ++m)
#pragma unroll
                for (int n = 0; n < 2; ++n) acc[a][b][m][n] = (f32x4){0.f, 0.f, 0.f, 0.f};
    bf16x8 At[4][2], B0[2][2], B1[2][2];
    unsigned gc[2][2] = {{0u, 0u}, {0u, 0u}};
    if (GATHER) {
#pragma unroll
        for (int h = 0; h < 2; ++h)
#pragma unroll
            for (int i = 0; i < 2; ++i) gc[h][i] = (unsigned)P.gather_row(cur, h * 128 + Rr[i]) * (unsigned)KB_ + (unsigned)Cc[i] * 2u;
    }
    const char* cA = P.a_ptr(cur); const char* cB = P.b_ptr(cur);
    PG_STAGE_B(PG_SB(0, 0), cB); PG_STAGE_A(PG_SA(0, 0), cA, 0, false); PG_STAGE_B(PG_SB(0, 1), cB + hstep); PG_STAGE_A(PG_SA(0, 1), cA, 1, false);
    if (wr == 1) PG_BAR;
    PG_WAIT_V(4); PG_BAR;
    PG_STAGE_B(PG_SB(1, 0), cB + kstep); PG_STAGE_A(PG_SA(1, 0), cA + kstep, 0, false); PG_STAGE_B(PG_SB(1, 1), cB + hstep + kstep);
    PG_WAIT_V(6); PG_BAR;
    for (;;) {
        const bool has_next = P.next(ui + 1, nxt);
        const char* nA = has_next ? P.a_ptr(nxt) : cA; const char* nB = has_next ? P.b_ptr(nxt) : cB;
        for (int t = 0; t < nt; t += 2) {
            const bool last = (t == nt - 2);
            if (GATHER && last && has_next) {
#pragma unroll
                for (int i = 0; i < 2; ++i) gc[0][i] = (unsigned)P.gather_row(nxt, Rr[i]) * (unsigned)KB_ + (unsigned)Cc[i] * 2u;
            }
            const char* a1 = cA + (size_t)(t + 1) * kstep;
            const char* a2 = last ? nA : cA + (size_t)(t + 2) * kstep; const char* b2 = last ? nB : cB + (size_t)(t + 2) * kstep;
            const char* a3 = a2 + kstep; const char* b3 = b2 + kstep;
            PG_LDB(B0, 0, 0); PG_SCHED; PG_LDA(At, 0, 0); PG_STAGE_A(PG_SA(1, 1), a1, 1, false);
            PG_WAIT_L(8); PG_BAR; PG_WAIT_L(0); PG_MMA(0, 0, At, B0); PG_BAR; PG_SCHED;
            if (GATHER && last && has_next) {
#pragma unroll
                for (int i = 0; i < 2; ++i) gc[1][i] = (unsigned)P.gather_row(nxt, 128 + Rr[i]) * (unsigned)KB_ + (unsigned)Cc[i] * 2u;
            }
            PG_LDB(B1, 0, 1); PG_STAGE_B(PG_SB(0, 0), b2);
            PG_BAR; PG_WAIT_L(0); PG_MMA(0, 1, At, B1); PG_BAR;
            PG_LDA(At, 0, 1); PG_STAGE_A(PG_SA(0, 0), a2, 0, last);
            PG_BAR; PG_WAIT_L(0); PG_MMA(1, 0, At, B0); PG_BAR; PG_SCHED;
            PG_STAGE_B(PG_SB(0, 1), b2 + hstep);
            PG_WAIT_V(6); PG_BAR; PG_MMA(1, 1, At, B1); PG_BAR;
            PG_LDB(B0, 1, 0); PG_SCHED; PG_LDA(At, 1, 0); PG_STAGE_A(PG_SA(0, 1), a2, 1, last);
            PG_WAIT_L(8); PG_BAR; PG_WAIT_L(0); PG_MMA(0, 0, At, B0); PG_BAR; PG_SCHED;
            PG_LDB(B1, 1, 1); PG_STAGE_B(PG_SB(1, 0), b3);
            PG_BAR; PG_WAIT_L(0); PG_MMA(0, 1, At, B1); PG_BAR;
            PG_LDA(At, 1, 1); PG_STAGE_A(PG_SA(1, 0), a3, 0, last);
            PG_BAR; PG_WAIT_L(0); PG_MMA(1, 0, At, B0); PG_BAR; PG_SCHED;
            PG_STAGE_B(PG_SB(1, 1), b3 + hstep);
            PG_WAIT_V(6); PG_BAR; PG_MMA(1, 1, At, B1); PG_BAR;
        }
        P.epi(acc, cur, wr, wc, fr, fq);
        if (!has_next) break;
#pragma unroll
        for (int a = 0; a < 2; ++a)
#pragma unroll
            for (int b = 0; b < 2; ++b)
#pragma unroll
                for (int m = 0; m < 4; ++m)
#pragma unroll
                    for (int n = 0; n < 2; ++n) acc[a][b][m][n] = (f32x4){0.f, 0.f, 0.f, 0.f};
        cur = nxt; cA = nA; cB = nB; ++ui;
    }
    PG_WAIT_V(0);
    if (wr == 0) PG_BAR;
    PG_BAR;
}

struct ProbIn {
    CParams& p; int l; int bid, nblk;
    __device__ __forceinline__ bool next(int i, Unit& u) const { return tile_order(i, NROW / 256, INCP / 256, u, bid, nblk); }
    __device__ __forceinline__ const char* a_ptr(const Unit& u) const { return (const char*)p.H + (size_t)u.pm * 256 * KB_; }
    __device__ __forceinline__ const char* b_ptr(const Unit& u) const { return (const char*)p.WTIN + ((size_t)l * INCP + (size_t)u.pn * 256) * KB_; }
    __device__ __forceinline__ int gather_row(const Unit&, int) const { return 0; }
    __device__ __forceinline__ void epi(const f32x4 (&acc)[2][2][4][2], const Unit& u, int wr, int wc, int fr, int fq) const {
        const int brow = u.pm * 256, bcol = u.pn * 256;
        const int bb = u.pm / 17, pos0 = (u.pm % 17) * 256;
#pragma unroll
        for (int bj = 0; bj < 2; ++bj)
#pragma unroll
            for (int n = 0; n < 2; ++n) {
                const int gcol = bcol + bj * 128 + wc * 32 + n * 16;
                const int col = gcol + fq * 4;
                if (gcol < 1472) {
#pragma unroll
                    for (int ai = 0; ai < 2; ++ai)
#pragma unroll
                        for (int m = 0; m < 4; ++m) *(f32x4*)(p.P + (size_t)(brow + ai * 128 + wr * 64 + m * 16 + fr) * PST + col) = acc[ai][bj][m][n];
                } else if (gcol < 2496) {
                    const bool isq = gcol < 1984; const int cq = col - (isq ? 1472 : 1984), hh = cq >> 6, dim = cq & 63;
                    bf16_t* base = (isq ? p.QH : p.KH) + ((size_t)(bb * 8 + hh) * TPB) * 64 + dim;
                    const float sc = isq ? 0.125f : 1.f;
#pragma unroll
                    for (int ai = 0; ai < 2; ++ai)
#pragma unroll
                        for (int m = 0; m < 4; ++m) {
                            const int pos = pos0 + ai * 128 + wr * 64 + m * 16 + fr; const f32x4 v = acc[ai][bj][m][n] * sc;
                            u32x2 o; o.x = cvt_pk_bf16(v[0], v[1]); o.y = cvt_pk_bf16(v[2], v[3]);
                            *(u32x2*)(base + (size_t)pos * 64) = o;
                        }
                } else if (gcol < INC) {
                    const int cq = col - 2496, hh = cq >> 6, dim = cq & 63;
                    bf16_t* base = p.VT + ((size_t)(bb * 8 + hh) * 64 + dim) * TPB;
#pragma unroll
                    for (int ai = 0; ai < 2; ++ai)
#pragma unroll
                        for (int m = 0; m < 4; ++m) {
                            const int pos = pos0 + ai * 128 + wr * 64 + m * 16 + fr;
#pragma unroll
                            for (int j = 0; j < 4; ++j) base[(size_t)j * TPB + pos] = f2bf(acc[ai][bj][m][n][j]);
                        }
                }
            }
    }
};
__device__ __forceinline__ void d_gemm_in(CParams& p, int wv, int l) { ProbIn P{p, l, 0, 0}; gemm_phase<false>(P, wv); }

struct ProbOut {
    CParams& p; int l; int skip_ctx; int bid, nblk;
    __device__ __forceinline__ bool next(int i, Unit& u) const {
        if (!tile_order(i, skip_ctx ? 64 : 68, 4, u, bid, nblk)) return false;
        if (skip_ctx) u.pm = (u.pm / 16) * 17 + 1 + (u.pm % 16);
        return true; }
    __device__ __forceinline__ const char* a_ptr(const Unit& u) const { return (const char*)p.MIX + (size_t)u.pm * 256 * KB_; }
    __device__ __forceinline__ const char* b_ptr(const Unit& u) const { return (const char*)p.WTOUT + ((size_t)l * DM + (size_t)u.pn * 256) * KB_; }
    __device__ __forceinline__ int gather_row(const Unit&, int) const { return 0; }
    __device__ __forceinline__ void epi(const f32x4 (&acc)[2][2][4][2], const Unit& u, int wr, int wc, int fr, int fq) const {
        const int brow = u.pm * 256, bcol = u.pn * 256;
        const int b = u.pm / 17, mr = (u.pm % 17) == 0 ? 4 : b;
        const float* gate = p.MOD + (l * 5 + mr) * 6144 + 2 * DM;
#pragma unroll
        for (int ai = 0; ai < 2; ++ai)
#pragma unroll
            for (int m = 0; m < 4; ++m) {
                float* xrow = p.X + (size_t)(brow + ai * 128 + wr * 64 + m * 16 + fr) * DM;
#pragma unroll
                for (int bj = 0; bj < 2; ++bj)
#pragma unroll
                    for (int n = 0; n < 2; ++n) {
                        const int col = bcol + bj * 128 + wc * 32 + n * 16 + fq * 4;
                        const f32x4 gt = *(const f32x4*)(gate + col);
                        f32x4* xp = (f32x4*)(xrow + col);
                        *xp = *xp + gt * acc[ai][bj][m][n];
                    }
                asm volatile("" ::: "memory");
            }
    }
};
__device__ __forceinline__ void d_gemm_out(CParams& p, int wv, int l, int skip_ctx) { ProbOut P{p, l, skip_ctx, 0, 0}; gemm_phase<false>(P, wv); }

__device__ __forceinline__ int rwkv_pos(int d, int c, int t) { return d == 0 ? c * 64 + t : (c < 4 ? 255 - (c * 64 + t) : 4351 - ((c - 4) * 64 + t)); }
#define DPP_SHR(oldv, v, n) __int_as_float(__builtin_amdgcn_update_dpp(__float_as_int(oldv), __float_as_int(v), 0x110 + (n), 0xf, 0xf, false))
#define BCAST15(v) __int_as_float(__builtin_amdgcn_ds_swizzle(__float_as_int(v), (0x0f << 5) | 0x10))
__device__ __forceinline__ void d_lru_local(CParams& p, int wv, int l) {
    const int tidx_ = opaque_tid(wv);
    int bidx_ = blockIdx.x, gdim_ = gridDim.x; asm volatile("" : "+s"(bidx_), "+s"(gdim_));
    const int lane = tidx_ & 63, gw = bidx_ * 8 + wv, NGW = gdim_ * 8, m16 = lane & 15, g = lane >> 4;
    LAS unsigned char* xcs = (LAS unsigned char*)smem + 8192 + wv * (64 * RWS);
    for (int task = gw; task < 2176; task += NGW) {
        const int c = task % 68, h = (task / 68) & 3, d = (task / 272) & 1, b = task / 544;
        const size_t rb = (size_t)b * TPB;
        {
            const int ch = h * 64 + lane;
            const float* cw = p.in[I_CONVW] + ((l * 2 + d) * 4) * 256 + ch;
            const float cw0 = cw[0], cw1 = cw[256], cw2 = cw[512], cw3 = cw[768], cb = p.in[I_CONVB][(l * 2 + d) * 256 + ch];
            float x1 = 0.f, x2 = 0.f, x3 = 0.f;
            if (c != 0 && c != 4) { x1 = p.P[(rb + rwkv_pos(d, c - 1, 63)) * PST + ch]; x2 = p.P[(rb + rwkv_pos(d, c - 1, 62)) * PST + ch]; x3 = p.P[(rb + rwkv_pos(d, c - 1, 61)) * PST + ch]; }
            __builtin_amdgcn_wave_barrier();
#pragma unroll 8
            for (int t = 0; t < 64; ++t) {
                const float x0 = p.P[(rb + rwkv_pos(d, c, t)) * PST + ch];
                const float xc = cb + cw0 * x0 + cw1 * x1 + cw2 * x2 + cw3 * x3;
                x3 = x2; x2 = x1; x1 = x0;
                *(LAS bf16_t*)(xcs + t * RWS + lane * 2) = f2bf(xc);
            }
            __builtin_amdgcn_wave_barrier();
        }
        bf16x8 xb[4][2];
#pragma unroll
        for (int tt = 0; tt < 4; ++tt)
#pragma unroll
            for (int ks = 0; ks < 2; ++ks) xb[tt][ks] = *(const LAS bf16x8*)(xcs + (tt * 16 + m16) * RWS + ks * 64 + g * 16);
        const bf16_t* wt = p.LWT + (size_t)((l * 2 + d) * 4 + h) * 2 * 4096;
#pragma unroll 1
        for (int jt = 0; jt < 4; ++jt) {
            const int j0 = jt * 16 + 4 * g, chj = h * 64 + j0;
            bf16x8 wa[2][2];
#pragma unroll
            for (int gt = 0; gt < 2; ++gt)
#pragma unroll
                for (int ks = 0; ks < 2; ++ks) wa[gt][ks] = *(const bf16x8*)(wt + (size_t)gt * 4096 + (jt * 16 + m16) * 64 + ks * 32 + 8 * g);
            const f32x4 brv = *(const f32x4*)(p.in[I_BR] + (l * 2 + d) * 256 + chj), biv = *(const f32x4*)(p.in[I_BI] + (l * 2 + d) * 256 + chj);
            const f32x4 lamv = *(const f32x4*)(p.in[I_LAM] + (l * 2 + d) * 256 + chj);
            float ca[4] = {1.f, 1.f, 1.f, 1.f}, chh[4] = {0.f, 0.f, 0.f, 0.f};
#pragma unroll
            for (int tt = 0; tt < 4; ++tt) {
                f32x4 dr = {0.f, 0.f, 0.f, 0.f}, di = {0.f, 0.f, 0.f, 0.f};
#pragma unroll
                for (int ks = 0; ks < 2; ++ks) { dr = __builtin_amdgcn_mfma_f32_16x16x32_bf16(wa[0][ks], xb[tt][ks], dr, 0, 0, 0); di = __builtin_amdgcn_mfma_f32_16x16x32_bf16(wa[1][ks], xb[tt][ks], di, 0, 0, 0); }
                const int t = tt * 16 + m16;
                const u32x2 xw = *(const LAS u32x2*)(xcs + t * RWS + j0 * 2);
                const float xcv[4] = {__uint_as_float(xw.x << 16), __uint_as_float(xw.x & 0xffff0000u), __uint_as_float(xw.y << 16), __uint_as_float(xw.y & 0xffff0000u)};
                f32x4 av, bv;
#pragma unroll
                for (int r = 0; r < 4; ++r) {
                    const float gr = sigmoidf_(dr[r] + brv[r]), gi = sigmoidf_(di[r] + biv[r]);
                    const float log_a = -8.0f * gr * softplusf_(-lamv[r]);
                    float a = __expf(log_a), bb = sqrtf(fmaxf(-expm1f(2.f * log_a), 0.f)) * (gi * xcv[r]);
#define SCAN_STEP(sh) { const float ap = DPP_SHR(1.f, a, sh), bp = DPP_SHR(0.f, bb, sh); bb = a * bp + bb; a = a * ap; }
                    SCAN_STEP(1) SCAN_STEP(2) SCAN_STEP(4) SCAN_STEP(8)
#undef SCAN_STEP
                    bb = a * chh[r] + bb; a = a * ca[r];
                    av[r] = a; bv[r] = bb;
                    ca[r] = BCAST15(a); chh[r] = BCAST15(bb);
                }
                const size_t R = rb + rwkv_pos(d, c, t);
                *(f32x4*)(p.LA + ((size_t)d * NROW + R) * 256 + chj) = bv;
                *(f32x4*)(p.LB + ((size_t)d * NROW + R) * 256 + chj) = av;
                if (tt == 3 && m16 == 15) { *(f32x4*)(p.LCE + (size_t)task * 128 + j0) = av; *(f32x4*)(p.LCE + (size_t)task * 128 + 64 + j0) = bv; }
            }
        }
    }
}
__device__ __forceinline__ void d_lru_carry(CParams& p, int widx, int lane) {
    const int gt = widx * 64 + lane;
    const int ch = gt & 255, d = (gt >> 8) & 1, b = gt >> 9, h = ch >> 6, j = ch & 63;
    const float* ce = p.LCE + (size_t)(((b * 2 + d) * 4 + h) * 68) * 128 + j;
    float* ci = p.LCI + (size_t)((b * 2 + d) * 68) * 256 + ch;
    float carry = 0.f;
#pragma unroll 1
    for (int c0 = 0; c0 < 68; c0 += 17) {
        float a[17], e[17];
#pragma unroll
        for (int u = 0; u < 17; ++u) { a[u] = ce[(size_t)(c0 + u) * 128]; e[u] = ce[(size_t)(c0 + u) * 128 + 64]; }
#pragma unroll
        for (int u = 0; u < 17; ++u) { ci[(size_t)(c0 + u) * 256] = carry; carry = a[u] * carry + e[u]; }
    }
}
__device__ __forceinline__ float lru_h(CParams& p, int b, int pos, size_t R, int d, int ch) {
    const int sidx = d == 0 ? pos : (pos < CTXL ? CTXL - 1 - pos : CTXL + (TPB - 1 - pos));
    const float ci = p.LCI[(size_t)((b * 2 + d) * 68 + (sidx >> 6)) * 256 + ch];
    return p.LA[((size_t)d * NROW + R) * 256 + ch] + p.LB[((size_t)d * NROW + R) * 256 + ch] * ci;
}

__device__ __forceinline__ void d_rwkv_pre(CParams& p, int wv, int l) {
    const int tidx_ = opaque_tid(wv);
    int bidx_ = blockIdx.x, gdim_ = gridDim.x; asm volatile("" : "+s"(bidx_), "+s"(gdim_));
    const int lane = tidx_ & 63, gw = bidx_ * 8 + wv, NGW = gdim_ * 8, m16 = lane & 15, g = lane >> 4;
    LAS unsigned char* stash = (LAS unsigned char*)smem + 90112 + wv * (3 * 16 * RWS);
    const float* mu = p.in[I_MU] + l * 2 * 960;
    for (int tile = gw; tile < NROW / 16; tile += NGW) {
        const int R0 = tile * 16;
#pragma unroll 1
        for (int rr = 0; rr < 16; ++rr) {
            const int R = R0 + rr, pos = R % TPB;
            const int seg0 = pos < CTXL ? 0 : CTXL, seg1 = pos < CTXL ? CTXL : TPB;
            const float* pr = p.P + (size_t)R * PST + 512;
            float sv[15];
#pragma unroll
            for (int q = 0; q < 15; ++q) {
                const int col = lane + 64 * q;
                const float v = pr[col];
                const float pv = pos > seg0 ? pr[col - PST] : 0.f;
                const float nv = pos + 1 < seg1 ? pr[col + PST] : 0.f;
                sv[q] = v + mu[col] * (pv - v) + mu[960 + col] * (nv - v);
            }
#pragma unroll
            for (int q = 0; q < 12; ++q) p.RS[(size_t)R * 768 + lane + 64 * q] = sv[q];
            *(LAS bf16_t*)(stash + (0 * 16 + rr) * RWS + lane * 2) = f2bf(tanhf(sv[12]));
            *(LAS bf16_t*)(stash + (1 * 16 + rr) * RWS + lane * 2) = f2bf(sv[13]);
            *(LAS bf16_t*)(stash + (2 * 16 + rr) * RWS + lane * 2) = f2bf(sigmoidf_(sv[14]));
#pragma unroll
            for (int hq = 0; hq < 4; ++hq) {
                const int c = hq * 64 + lane;
                const float kk = sv[4 + hq] * p.in[I_KK][l * 256 + c];
                const float n2 = wave_sum(kk * kk);
                p.KKN[(size_t)R * 256 + c] = kk / fmaxf(sqrtf(n2), 1e-12f);
            }
        }
        __builtin_amdgcn_wave_barrier();
#pragma unroll 1
        for (int mtx = 0; mtx < 5; ++mtx) {
            const int src = mtx < 2 ? 0 : (mtx < 4 ? 1 : 2), d = mtx & 1;
            const bf16x8 a0 = *(const LAS bf16x8*)(stash + (src * 16 + m16) * RWS + g * 16), a1 = *(const LAS bf16x8*)(stash + (src * 16 + m16) * RWS + 64 + g * 16);
            const bf16_t* wt = p.RWT + (size_t)(l * 5 + mtx) * 16384;
#pragma unroll 4
            for (int ct = 0; ct < 16; ++ct) {
                const bf16_t* wr_ = wt + (size_t)(ct * 16 + m16) * 64 + 8 * g;
                const bf16x8 b0 = *(const bf16x8*)wr_, b1 = *(const bf16x8*)(wr_ + 32);
                f32x4 acc = {0.f, 0.f, 0.f, 0.f};
                acc = __builtin_amdgcn_mfma_f32_16x16x32_bf16(a0, b0, acc, 0, 0, 0);
                acc = __builtin_amdgcn_mfma_f32_16x16x32_bf16(a1, b1, acc, 0, 0, 0);
                const int ch = ct * 16 + m16;
                if (mtx < 2) {
                    const float w0 = p.in[I_W0][(l * 2 + d) * 256 + ch];
#pragma unroll
                    for (int r = 0; r < 4; ++r) { const float w = -softplusf_(-(w0 + acc[r])) - 0.5f; p.DEC[((size_t)d * NROW + R0 + 4 * g + r) * 256 + ch] = -__expf(w); }
                } else if (mtx < 4) {
                    const float a0_ = p.in[I_A0][(l * 2 + d) * 256 + ch];
#pragma unroll
                    for (int r = 0; r < 4; ++r) p.AIC[((size_t)d * NROW + R0 + 4 * g + r) * 256 + ch] = sigmoidf_(a0_ + acc[r]);
                } else {
#pragma unroll
                    for (int r = 0; r < 4; ++r) p.GG[(size_t)(R0 + 4 * g + r) * 256 + ch] = acc[r];
                }
            }
        }
        __builtin_amdgcn_wave_barrier();
    }
}
#define RSLOT(k) (lds + (k) * 9216)
__device__ __forceinline__ void mm2(const LAS unsigned char* Xr, const LAS unsigned char* Yt, int mi, int ni0, int lane, f32x4 (&acc)[2]) {
    const int m = lane & 15, g = lane >> 4;
#pragma unroll
    for (int ks = 0; ks < 2; ++ks) {
        const bf16x8 a = *(const LAS bf16x8*)(Xr + (mi * 16 + m) * RWS + ks * 64 + g * 16);
#pragma unroll
        for (int n = 0; n < 2; ++n) {
            const bf16x8 b = *(const LAS bf16x8*)(Yt + ((ni0 + n) * 16 + m) * RWS + ks * 64 + g * 16);
            acc[n] = __builtin_amdgcn_mfma_f32_16x16x32_bf16(a, b, acc[n], 0, 0, 0);
        }
    }
}
__device__ __forceinline__ void st_r(LAS unsigned char* dst, int mi, int ni, int lane, const f32x4& v) {
    const int m = lane & 15, g = lane >> 4;
#pragma unroll
    for (int r = 0; r < 4; ++r) *(LAS bf16_t*)(dst + (mi * 16 + 4 * g + r) * RWS + (ni * 16 + m) * 2) = f2bf(v[r]);
}
__device__ __forceinline__ void st_t(LAS unsigned char* dst, int mi, int ni, int lane, const f32x4& v) {
    const int m = lane & 15, g = lane >> 4;
    u32x2 o; o.x = cvt_pk_bf16(v[0], v[1]); o.y = cvt_pk_bf16(v[2], v[3]);
    *(LAS u32x2*)(dst + (ni * 16 + m) * RWS + (mi * 16 + 4 * g) * 2) = o;
}
__device__ __forceinline__ float bfbits2f(unsigned short v) { return __uint_as_float(((unsigned)v) << 16); }

__device__ __forceinline__ void d_rwkv_chunkA(CParams& p, int wv, int l) {
    const int tidx_ = opaque_tid(wv);
    int bidx_ = blockIdx.x, gdim_ = gridDim.x; asm volatile("" : "+s"(bidx_), "+s"(gdim_));
    LAS unsigned char* lds = (LAS unsigned char*)smem;
    LAS float* segtot = (LAS float*)(lds + 16 * 9216);
    LAS float* gam = segtot + 512;
    const int tid = tidx_, lane = tid & 63, w = wv;
    const int mi = w >> 1, ni0 = (w & 1) * 2, m16 = lane & 15, g = lane >> 4;
    for (int task = bidx_; task < 2176; task += gdim_) {
        const int c = task % 68, d = (task / 68) & 1, h = (task / 136) & 3, b = task / 544;
        __syncthreads();
        {
            const int j = lane, tq = w, hc = h * 64 + j;
            const float ka = p.in[I_KA][l * 256 + hc];
            float lw[8], aa[8], bb[8], ke[8], rr[8], vv[8];
#pragma unroll
            for (int u = 0; u < 8; ++u) {
                const size_t R = (size_t)b * TPB + rwkv_pos(d, c, 8 * tq + u);
                lw[u] = p.DEC[((size_t)d * NROW + R) * 256 + hc];
                const float aic = p.AIC[((size_t)d * NROW + R) * 256 + hc], kkn = p.KKN[R * 256 + hc];
                const float* rs = p.RS + R * 768;
                rr[u] = rs[hc]; const float k = rs[256 + hc]; vv[u] = rs[512 + hc];
                aa[u] = -kkn; bb[u] = kkn * aic; ke[u] = k * (1.f + (aic - 1.f) * ka);
            }
            float cs[8]; cs[0] = lw[0];
#pragma unroll
            for (int u = 1; u < 8; ++u) cs[u] = cs[u - 1] + lw[u];
            segtot[tq * 64 + j] = cs[7];
            __syncthreads();
            float pre = 0.f, tot = 0.f;
#pragma unroll
            for (int q = 0; q < 8; ++q) { const float sgt = segtot[q * 64 + j]; tot += sgt; if (q < tq) pre += sgt; }
            if (tq == 0) gam[j] = __expf(tot);
            float at[8], bt[8], kt[8];
#pragma unroll
            for (int u = 0; u < 8; ++u) {
                const float Lc = pre + cs[u], Lp = Lc - lw[u];
                const float ep = __expf(Lp), ec = __expf(Lc), en = __expf(-Lc), ee = __expf(tot - Lc);
                const int t = 8 * tq + u;
                at[u] = aa[u] * ep; bt[u] = bb[u] * ee; kt[u] = ke[u] * ee;
                *(LAS bf16_t*)(RSLOT(0) + t * RWS + j * 2) = f2bf(at[u]);
                *(LAS bf16_t*)(RSLOT(1) + t * RWS + j * 2) = f2bf(rr[u] * ec);
                *(LAS bf16_t*)(RSLOT(2) + t * RWS + j * 2) = f2bf(bb[u] * en);
                *(LAS bf16_t*)(RSLOT(3) + t * RWS + j * 2) = f2bf(ke[u] * en);
            }
            u32x4 o;
            o.x = cvt_pk_bf16(at[0], at[1]); o.y = cvt_pk_bf16(at[2], at[3]); o.z = cvt_pk_bf16(at[4], at[5]); o.w = cvt_pk_bf16(at[6], at[7]);
            *(LAS u32x4*)(RSLOT(4) + j * RWS + tq * 16) = o;
            o.x = cvt_pk_bf16(bt[0], bt[1]); o.y = cvt_pk_bf16(bt[2], bt[3]); o.z = cvt_pk_bf16(bt[4], bt[5]); o.w = cvt_pk_bf16(bt[6], bt[7]);
            *(LAS u32x4*)(RSLOT(5) + j * RWS + tq * 16) = o;
            o.x = cvt_pk_bf16(kt[0], kt[1]); o.y = cvt_pk_bf16(kt[2], kt[3]); o.z = cvt_pk_bf16(kt[4], kt[5]); o.w = cvt_pk_bf16(kt[6], kt[7]);
            *(LAS u32x4*)(RSLOT(6) + j * RWS + tq * 16) = o;
            o.x = cvt_pk_bf16(vv[0], vv[1]); o.y = cvt_pk_bf16(vv[2], vv[3]); o.z = cvt_pk_bf16(vv[4], vv[5]); o.w = cvt_pk_bf16(vv[6], vv[7]);
            *(LAS u32x4*)(RSLOT(7) + j * RWS + tq * 16) = o;
        }
        __syncthreads();
        {
            f32x4 aab[2] = {}, aak[2] = {}, brb[2] = {}, brk[2] = {};
            mm2(RSLOT(0), RSLOT(2), mi, ni0, lane, aab); mm2(RSLOT(0), RSLOT(3), mi, ni0, lane, aak);
            mm2(RSLOT(1), RSLOT(2), mi, ni0, lane, brb); mm2(RSLOT(1), RSLOT(3), mi, ni0, lane, brk);
#pragma unroll
            for (int n = 0; n < 2; ++n) {
                f32x4 p0;
#pragma unroll
                for (int r = 0; r < 4; ++r) {
                    const int t = mi * 16 + 4 * g + r, sidx = (ni0 + n) * 16 + m16;
                    if (!(sidx < t)) { aab[n][r] = 0.f; aak[n][r] = 0.f; }
                    if (!(sidx <= t)) { brb[n][r] = 0.f; brk[n][r] = 0.f; }
                    p0[r] = aab[n][r] + (sidx == t ? 1.f : 0.f);
                }
                st_r(RSLOT(11), mi, ni0 + n, lane, aab[n]); st_t(RSLOT(12), mi, ni0 + n, lane, aab[n]);
                st_t(RSLOT(13), mi, ni0 + n, lane, p0);
                st_r(RSLOT(8), mi, ni0 + n, lane, aak[n]); st_r(RSLOT(9), mi, ni0 + n, lane, brb[n]); st_r(RSLOT(10), mi, ni0 + n, lane, brk[n]);
            }
        }
        __syncthreads();
#pragma unroll 1
        for (int st = 1; st <= 6; ++st) {
            LAS unsigned char* qsr = (st & 1) ? RSLOT(11) : RSLOT(0);
            LAS unsigned char* qst = (st & 1) ? RSLOT(12) : RSLOT(2);
            LAS unsigned char* qdr = (st & 1) ? RSLOT(0) : RSLOT(11);
            LAS unsigned char* qdt = (st & 1) ? RSLOT(2) : RSLOT(12);
            if (st <= 5) {
                f32x4 q[2] = {};
                mm2(qsr, qst, mi, ni0, lane, q);
#pragma unroll
                for (int n = 0; n < 2; ++n) { st_r(qdr, mi, ni0 + n, lane, q[n]); st_t(qdt, mi, ni0 + n, lane, q[n]); }
            }
            if (st >= 2) {
                LAS unsigned char* ps = (st & 1) ? RSLOT(3) : RSLOT(13);
                LAS unsigned char* pd = (st & 1) ? RSLOT(13) : RSLOT(3);
                f32x4 pp[2];
#pragma unroll
                for (int n = 0; n < 2; ++n) {
                    const u32x2 o = *(const LAS u32x2*)(ps + ((ni0 + n) * 16 + m16) * RWS + (mi * 16 + 4 * g) * 2);
                    pp[n][0] = __uint_as_float(o.x << 16); pp[n][1] = __uint_as_float(o.x & 0xffff0000u); pp[n][2] = __uint_as_float(o.y << 16); pp[n][3] = __uint_as_float(o.y & 0xffff0000u);
                }
                mm2(qsr, ps, mi, ni0, lane, pp);
#pragma unroll
                for (int n = 0; n < 2; ++n) { st_t(pd, mi, ni0 + n, lane, pp[n]); if (st == 6) st_r(RSLOT(15), mi, ni0 + n, lane, pp[n]); }
            }
            if (st == 1) {
                f32x4 akv[2] = {};
                mm2(RSLOT(8), RSLOT(7), mi, ni0, lane, akv);
#pragma unroll
                for (int n = 0; n < 2; ++n) st_t(RSLOT(14), mi, ni0 + n, lane, akv[n]);
            }
            __syncthreads();
        }
        {
            f32x4 w1[2] = {}, z[2] = {};
            mm2(RSLOT(15), RSLOT(4), mi, ni0, lane, w1); mm2(RSLOT(15), RSLOT(14), mi, ni0, lane, z);
#pragma unroll
            for (int n = 0; n < 2; ++n) { st_t(RSLOT(11), mi, ni0 + n, lane, w1[n]); st_t(RSLOT(12), mi, ni0 + n, lane, z[n]); }
        }
        __syncthreads();
        {
            f32x4 mm_[2] = {}, nn[2] = {}, qq[2] = {}, yl[2] = {};
            mm2(RSLOT(5), RSLOT(11), mi, ni0, lane, mm_);
            mm2(RSLOT(5), RSLOT(12), mi, ni0, lane, nn); mm2(RSLOT(6), RSLOT(7), mi, ni0, lane, nn);
            mm2(RSLOT(9), RSLOT(11), mi, ni0, lane, qq);
            mm2(RSLOT(9), RSLOT(12), mi, ni0, lane, yl); mm2(RSLOT(10), RSLOT(7), mi, ni0, lane, yl);
#pragma unroll
            for (int n = 0; n < 2; ++n) {
#pragma unroll
                for (int r = 0; r < 4; ++r) {
                    const int row = mi * 16 + 4 * g + r, col = (ni0 + n) * 16 + m16;
                    if (row == col) mm_[n][r] += gam[row];
                    qq[n][r] += bfbits2f(*(const LAS bf16_t*)(RSLOT(1) + row * RWS + col * 2));
                }
                st_r(RSLOT(0), mi, ni0 + n, lane, mm_[n]); st_r(RSLOT(2), mi, ni0 + n, lane, qq[n]);
                *(f32x4*)(p.RNF + (size_t)task * 4096 + (((ni0 + n) * 4 + mi) * 64 + lane) * 4) = nn[n];
                *(f32x4*)(p.RYF + (size_t)task * 4096 + (((ni0 + n) * 4 + mi) * 64 + lane) * 4) = yl[n];
            }
        }
        __syncthreads();
        {
            const int jb = tid >> 7, sk = (tid >> 6) & 1;
            const int row = jb * 16 + m16;
            const u32x2 m0 = *(const LAS u32x2*)(RSLOT(0) + row * RWS + (32 * sk + 4 * g) * 2), m1 = *(const LAS u32x2*)(RSLOT(0) + row * RWS + (32 * sk + 16 + 4 * g) * 2);
            const u32x2 q0 = *(const LAS u32x2*)(RSLOT(2) + row * RWS + (32 * sk + 4 * g) * 2), q1 = *(const LAS u32x2*)(RSLOT(2) + row * RWS + (32 * sk + 16 + 4 * g) * 2);
            *(u32x4*)(p.RMF + (size_t)task * 4096 + (size_t)tid * 8) = (u32x4){m0.x, m0.y, m1.x, m1.y};
            *(u32x4*)(p.RQF + (size_t)task * 4096 + (size_t)tid * 8) = (u32x4){q0.x, q0.y, q1.x, q1.y};
        }
    }
    __syncthreads();
}

__device__ __forceinline__ void d_rwkv_seq(CParams& p, int widx, int ib, int lane) {
    const int d = widx & 1, h = (widx >> 1) & 3, b = widx >> 3;
    const int m16 = lane & 15, g = lane >> 4;
    f32x4 S[4];
#pragma unroll
    for (int jb = 0; jb < 4; ++jb) S[jb] = (f32x4){0.f, 0.f, 0.f, 0.f};
    const size_t task0 = (size_t)((b * 4 + h) * 2 + d) * 68;
#pragma unroll 1
    for (int c = 0; c < 68; ++c) {
        const size_t tk = task0 + c;
        const bf16x8* mf = (const bf16x8*)(p.RMF + tk * 4096) + lane;
        const bf16x8* qf = (const bf16x8*)(p.RQF + tk * 4096) + lane;
        const f32x4* nf = (const f32x4*)(p.RNF + tk * 4096) + (ib * 4) * 64 + lane;
        const f32x4* yf = (const f32x4*)(p.RYF + tk * 4096) + (ib * 4) * 64 + lane;
        bf16x8 M[4][2], Q[4][2]; f32x4 N[4], Y[4];
#pragma unroll
        for (int jb = 0; jb < 4; ++jb) {
#pragma unroll
            for (int sk = 0; sk < 2; ++sk) { M[jb][sk] = mf[(jb * 2 + sk) * 64]; Q[jb][sk] = qf[(jb * 2 + sk) * 64]; }
            N[jb] = nf[jb * 64]; Y[jb] = yf[jb * 64];
        }
        bf16x8 bfr[2];
#pragma unroll
        for (int sk = 0; sk < 2; ++sk) {
            union { u32x4 u; bf16x8 v; } cv;
            cv.u.x = cvt_pk_bf16(S[2 * sk][0], S[2 * sk][1]); cv.u.y = cvt_pk_bf16(S[2 * sk][2], S[2 * sk][3]);
            cv.u.z = cvt_pk_bf16(S[2 * sk + 1][0], S[2 * sk + 1][1]); cv.u.w = cvt_pk_bf16(S[2 * sk + 1][2], S[2 * sk + 1][3]);
            bfr[sk] = cv.v;
        }
#pragma unroll
        for (int jb = 0; jb < 4; ++jb)
#pragma unroll
            for (int sk = 0; sk < 2; ++sk) {
                N[jb] = __builtin_amdgcn_mfma_f32_16x16x32_bf16(M[jb][sk], bfr[sk], N[jb], 0, 0, 0);
                Y[jb] = __builtin_amdgcn_mfma_f32_16x16x32_bf16(Q[jb][sk], bfr[sk], Y[jb], 0, 0, 0);
            }
#pragma unroll
        for (int jb = 0; jb < 4; ++jb) {
            S[jb] = N[jb];
#pragma unroll
            for (int r = 0; r < 4; ++r) {
                const size_t R = (size_t)b * TPB + rwkv_pos(d, c, jb * 16 + 4 * g + r);
                p.YB[((size_t)d * NROW + R) * 256 + h * 64 + ib * 16 + m16] = Y[jb][r];
            }
        }
    }
}

__device__ __forceinline__ float xor16_max(float v) { return fmaxf(v, SWZ_XOR(v, 16)); }
__device__ __forceinline__ float max_xor32(float v) {
    int a = __float_as_int(v), b = a;
    asm volatile("s_nop 1\n\tv_permlane32_swap_b32 %0, %1\n\ts_nop 1" : "+v"(a), "+v"(b));
    return fmaxf(__int_as_float(a), __int_as_float(b));
}
template <bool BAND, class KB>
__device__ __forceinline__ void attn_block(CParams& p, const bf16_t* KHh, const bf16_t* VTh, const bf16x8 (&qf)[2], KB kbase, const float* rpbh  ,
                                           int c, int rr, int rs, int kc0, int lane, float& mrow, float& lrow, f32x4 (&o)[4]) {
    const int m16 = lane & 15, g = lane >> 4;
    f32x4 sc[16];
#pragma unroll
    for (int u = 0; u < 8; ++u) {
        const int kb = kbase(u);
#pragma unroll
        for (int j2 = 0; j2 < 2; ++j2) {
            const bf16_t* kr = KHh + (size_t)(kb + 16 * j2 + m16) * 64 + 8 * g;
            const bf16x8 k0 = *(const bf16x8*)kr, k1 = *(const bf16x8*)(kr + 32);
            f32x4 a = {0.f, 0.f, 0.f, 0.f};
            a = __builtin_amdgcn_mfma_f32_16x16x32_bf16(k0, qf[0], a, 0, 0, 0);
            a = __builtin_amdgcn_mfma_f32_16x16x32_bf16(k1, qf[1], a, 0, 0, 0);
            if (BAND) {
                const int cs = min(max(c - 8, 0), 48);
#pragma unroll
                for (int r = 0; r < 4; ++r) {
                    const int kc = kc0 + 16 * j2 + 4 * g + r;
                    const int cb = min(max(kc - c + 15, 0), 30);
                    const float bias = rpbh[(rs + u - rr + 7) * 31 + cb];
                    a[r] = (kc >= cs && kc < cs + 16) ? a[r] + bias : -1e30f;
                }
            }
            sc[2 * u + j2] = a;
        }
    }
    float mx = -1e30f;
#pragma unroll
    for (int t = 0; t < 16; ++t) mx = fmaxf(mx, fmaxf(fmaxf(sc[t][0], sc[t][1]), fmaxf(sc[t][2], sc[t][3])));
    mx = xor16_max(mx); mx = max_xor32(mx);
    float sum = 0.f;
#pragma unroll
    for (int t = 0; t < 16; ++t)
#pragma unroll
        for (int r = 0; r < 4; ++r) { const float e = __expf(sc[t][r] - mx); sc[t][r] = e; sum += e; }
    sum += SWZ_XOR(sum, 16); sum = sum_xor32(sum);
    mrow = mx; lrow = sum;
#pragma unroll
    for (int dt = 0; dt < 4; ++dt) o[dt] = (f32x4){0.f, 0.f, 0.f, 0.f};
#pragma unroll
    for (int u = 0; u < 8; ++u) {
        union { u32x4 w; bf16x8 v; } pf;
        pf.w.x = cvt_pk_bf16(sc[2 * u][0], sc[2 * u][1]); pf.w.y = cvt_pk_bf16(sc[2 * u][2], sc[2 * u][3]);
        pf.w.z = cvt_pk_bf16(sc[2 * u + 1][0], sc[2 * u + 1][1]); pf.w.w = cvt_pk_bf16(sc[2 * u + 1][2], sc[2 * u + 1][3]);
        const int kb = kbase(u);
#pragma unroll
        for (int dt = 0; dt < 4; ++dt) {
            const bf16_t* vr = VTh + (size_t)(dt * 16 + m16) * TPB + kb + 4 * g;
            union { u32x4 w; bf16x8 v; } vf;
            const u32x2 v0 = *(const u32x2*)vr, v1 = *(const u32x2*)(vr + 16);
            vf.w = (u32x4){v0.x, v0.y, v1.x, v1.y};
            o[dt] = __builtin_amdgcn_mfma_f32_16x16x32_bf16(vf.v, pf.v, o[dt], 0, 0, 0);
        }
    }
}
__device__ __forceinline__ void d_na(CParams& p, int wv, int l, int do_ctx) {
    const int tidx_ = opaque_tid(wv);
    int bidx_ = blockIdx.x, gdim_ = gridDim.x; asm volatile("" : "+s"(bidx_), "+s"(gdim_));
    const int lane = tidx_ & 63, m16 = lane & 15, g = lane >> 4;
    const float* rpbs = (const float*)smem;
    const int ngrp = (8192 + (do_ctx ? 512 : 0)) / 8;
    for (int grp = bidx_; grp < ngrp; grp += gdim_) {
        const int task = grp * 8 + wv;
        int b, h, qpos0, c = 0, rr = 0, rs = 0, kc0 = 0; bool lat;
        if (task < 8192) { const int ct = task & 3; rr = (task >> 2) & 63; h = (task >> 8) & 7; b = task >> 11; lat = true;
            const int c0 = ct * 16; c = c0 + m16; rs = min(max(rr - 4, 0), 56); kc0 = min(max(c0 - 8, 0), 32); qpos0 = CTXL + rr * 64 + c0; }
        else { const int t2 = task - 8192; const int qt = t2 & 15; h = (t2 >> 4) & 7; b = t2 >> 7; lat = false; qpos0 = qt * 16; }
        const bf16_t* QHh = p.QH + (size_t)(b * 8 + h) * TPB * 64;
        const bf16_t* KHh = p.KH + (size_t)(b * 8 + h) * TPB * 64;
        const bf16_t* VTh = p.VT + (size_t)(b * 8 + h) * 64 * TPB;
        bf16x8 qf[2];
        { const bf16_t* qr = QHh + (size_t)(qpos0 + m16) * 64 + 8 * g; qf[0] = *(const bf16x8*)qr; qf[1] = *(const bf16x8*)(qr + 32); }
        float m2, l2; f32x4 o2[4];
        attn_block<false>(p, KHh, VTh, qf, [&](int u) { return 32 * u; }, nullptr, 0, 0, 0, 0, lane, m2, l2, o2);
        float inv;
        if (lat) {
            float m1, l1; f32x4 o1[4];
            attn_block<true>(p, KHh, VTh, qf, [&](int u) { return CTXL + (rs + u) * 64 + kc0; }, rpbs + h * 465, c, rr, rs, kc0, lane, m1, l1, o1);
            const float mm = fmaxf(m1, m2), f1 = __expf(m1 - mm), f2 = __expf(m2 - mm);
            inv = 1.f / (l1 * f1 + l2 * f2);
#pragma unroll
            for (int dt = 0; dt < 4; ++dt) o2[dt] = o1[dt] * f1 + o2[dt] * f2;
        } else inv = 1.f / l2;
        bf16_t* orow = p.MIX + (size_t)(b * TPB + qpos0 + m16) * DM + 512 + h * 64 + 4 * g;
#pragma unroll
        for (int dt = 0; dt < 4; ++dt) {
            const f32x4 v = o2[dt] * inv;
            u32x2 ov; ov.x = cvt_pk_bf16(v[0], v[1]); ov.y = cvt_pk_bf16(v[2], v[3]);
            *(u32x2*)(orow + dt * 16) = ov;
        }
    }
}

__device__ __forceinline__ void d_scan_attn(CParams& p, int wv, int l, int do_ctx) {
    const int tidx_ = opaque_tid(wv);
    int bidx_ = blockIdx.x, gdim_ = gridDim.x; asm volatile("" : "+s"(bidx_), "+s"(gdim_));
    const int wave = tidx_ >> 6, lane = tidx_ & 63;
    { float* rpbs = (float*)smem; for (int i = tidx_; i < 8 * 15 * 31; i += NTHR) rpbs[i] = p.in[I_RPB][(size_t)l * 8 * 15 * 31 + i]; }
    __syncthreads();
    if (bidx_ < 32 && wave < 4) d_rwkv_seq(p, bidx_, wave, lane);
    else if (bidx_ < 32 && wave == 4) d_lru_carry(p, bidx_, lane);
    d_na(p, wv, l, do_ctx);
}

__device__ __forceinline__ void d_finish(CParams& p, int wv, int l, int skip_ctx) {
    const int tidx_ = opaque_tid(wv);
    int bidx_ = blockIdx.x, gdim_ = gridDim.x; asm volatile("" : "+s"(bidx_), "+s"(gdim_));
    const int lane = tidx_ & 63, gw = bidx_ * 8 + (tidx_ >> 6), NGW = gdim_ * 8;
    for (int it = gw; it < NROW * 4; it += NGW) {
        const int R = it >> 2, h = it & 3, c = h * 64 + lane;
        if (skip_ctx && (R % TPB) < CTXL) continue;
        const float g = p.P[(size_t)R * PST + 256 + c];
        p.MIX[(size_t)R * DM + c] = f2bf(gelu_tanh(g) * (lru_h(p, R / TPB, R % TPB, R, 0, c) + lru_h(p, R / TPB, R % TPB, R, 1, c)));
        const float* rs = p.RS + (size_t)R * 768;
        const float r = rs[c], k = rs[256 + c], v = rs[512 + c];
        const float y = p.YB[(size_t)R * 256 + c] + p.YB[((size_t)NROW + R) * 256 + c];
        const float mean = wave_sum(y) * (1.f / 64.f);
        const float dv = y - mean;
        const float var = wave_sum(dv * dv) * (1.f / 64.f);
        const float yn = dv * rsqrtf(var + 64e-5f);
        const float ka = p.in[I_KA][l * 256 + c], rk = p.in[I_RK][l * 256 + c];
        float bon = 0.f;
#pragma unroll
        for (int d = 0; d < 2; ++d) {
            const float a = p.AIC[((size_t)d * NROW + R) * 256 + c];
            bon += r * (k * (1.f + (a - 1.f) * ka)) * rk;
        }
        bon = wave_sum(bon);
        const float o = (yn * p.in[I_LNG][l * 256 + c] + p.in[I_LNB][l * 256 + c] + bon * v) * p.GG[(size_t)R * 256 + c];
        p.MIX[(size_t)R * DM + 256 + c] = f2bf(o);
    }
}

__device__ __forceinline__ void d_norm_router(CParams& p, int wv, int l, int skip_ctx) {
    const int tidx_ = opaque_tid(wv);
    int bidx_ = blockIdx.x, gdim_ = gridDim.x; asm volatile("" : "+s"(bidx_), "+s"(gdim_));
    const int lane = tidx_ & 63, wave = tidx_ >> 6, gw = bidx_ * 8 + wave, NGW = gdim_ * 8;
    const int gtid = bidx_ * NTHR + tidx_, gsz = gdim_ * NTHR;
    for (int i = gtid; i < CAP; i += gsz) p.SLOT_TOK[i] = 0;
    float* hs = (float*)smem + wave * 1024;
    const float* rw = p.in[I_RTW] + (size_t)l * DM * 32;
    const float* g = p.in[I_NFG] + l * DM;
    const int e = lane & 31, half = lane >> 5;
    int* cnt = p.CNT + l * 32;
    for (int R = gw; R < NROW; R += NGW) {
        const int b = R / TPB, pos = R % TPB, mr = pos < CTXL ? 4 : b;
        if (skip_ctx && pos < CTXL) continue;
        const float4* xr = (const float4*)(p.X + (size_t)R * DM);
        float4 v[4]; float ss = 0.f;
#pragma unroll
        for (int i = 0; i < 4; ++i) { v[i] = xr[lane + 64 * i]; ss += v[i].x * v[i].x + v[i].y * v[i].y + v[i].z * v[i].z + v[i].w * v[i].w; }
        ss = wave_sum(ss);
        const float* mod = p.MOD + (l * 5 + mr) * 6144 + 3 * DM;
        const float rinv = rsqrtf(ss * (1.f / DM) + 1e-6f);
        __builtin_amdgcn_wave_barrier();
#pragma unroll
        for (int i = 0; i < 4; ++i) {
            const int c = (lane + 64 * i) * 4;
            const float4 gg = *(const float4*)(g + c), sh = *(const float4*)(mod + c), sc = *(const float4*)(mod + DM + c);
            float4 o;
            o.x = v[i].x * rinv * gg.x * (1.f + sc.x) + sh.x; o.y = v[i].y * rinv * gg.y * (1.f + sc.y) + sh.y;
            o.z = v[i].z * rinv * gg.z * (1.f + sc.z) + sh.z; o.w = v[i].w * rinv * gg.w * (1.f + sc.w) + sh.w;
            uint2 ob; ob.x = cvt_pk_bf16(o.x, o.y); ob.y = cvt_pk_bf16(o.z, o.w);
            *(uint2*)(p.H + (size_t)R * DM + c) = ob;
            *(float4*)(hs + c) = o;
        }
        __builtin_amdgcn_wave_barrier();
        float acc = 0.f;
#pragma unroll 8
        for (int k = half * 512; k < half * 512 + 512; ++k) acc += hs[k] * rw[k * 32 + e];
        acc = sum_xor32(acc);
        float val = acc + p.in[I_RTB][l * 32 + e];
        if (lane >= 32) val = -3e38f;
        float tv[4]; int ti[4];
#pragma unroll
        for (int k = 0; k < 4; ++k) {
            const float m = wave_max(val);
            const unsigned long long bal = __ballot(val == m);
            const int idx = __ffsll((long long)bal) - 1;
            tv[k] = m; ti[k] = idx;
            if (lane == idx) val = -3e38f;
        }
        if (lane == 0) {
            const float e1 = __expf(tv[1] - tv[0]), e2 = __expf(tv[2] - tv[0]), e3 = __expf(tv[3] - tv[0]);
            const float inv = 1.f / (1.f + e1 + e2 + e3);
            const float gs[4] = {inv, e1 * inv, e2 * inv, e3 * inv};
#pragma unroll
            for (int k = 0; k < 4; ++k) {
                p.TOPG[R * 4 + k] = gs[k]; p.TOPI[R * 4 + k] = ti[k];
                p.TOKPOS[R * 4 + k] = atomicAdd(&cnt[ti[k]], 1);
            }
        }
    }
}
__device__ __forceinline__ void moe_offsets_lds(CParams& p, int wv, int l) {
    const int tidx_ = opaque_tid(wv);
    int bidx_ = blockIdx.x, gdim_ = gridDim.x; asm volatile("" : "+s"(bidx_), "+s"(gdim_));
    int* li = (int*)(smem + LDS_GEMM);
    __syncthreads();
    if (tidx_ == 0) {
        int off = 0, nt = 0;
#pragma unroll 1
        for (int e = 0; e < NEXP; ++e) {
            li[e] = off;
            const int n = (p.CNT[l * 32 + e] + MOE_TM - 1) / MOE_TM;
#pragma unroll 1
            for (int i = 0; i < n; ++i) li[64 + nt++] = e;
            off += n * MOE_TM;
        }
        li[32] = off; li[40] = nt;
    }
    __syncthreads();
}
__device__ __forceinline__ void d_moe_scatter(CParams& p, int wv, int l, int skip_ctx) {
    const int tidx_ = opaque_tid(wv);
    int bidx_ = blockIdx.x, gdim_ = gridDim.x; asm volatile("" : "+s"(bidx_), "+s"(gdim_));
    moe_offsets_lds(p, wv, l);
    const int* li = (const int*)(smem + LDS_GEMM);
    const int gtid = bidx_ * NTHR + tidx_, gsz = gdim_ * NTHR;
    for (int i = gtid; i < NROW * 4; i += gsz) {
        const int R = i >> 2;
        if (skip_ctx && (R % TPB) < CTXL) continue;
        p.SLOT_TOK[li[p.TOPI[i]] + p.TOKPOS[i]] = R;
    }
}
struct ProbG1 {
    CParams& p; int l; const int* li; int ntile; int bid, nblk;
    __device__ __forceinline__ bool next(int i, Unit& u) const { return tile_order(i, ntile, 8, u, bid, nblk); }
    __device__ __forceinline__ int expert(const Unit& u) const { return __builtin_amdgcn_readfirstlane(li[64 + u.pm]); }
    __device__ __forceinline__ const char* a_ptr(const Unit&) const { return (const char*)p.H; }
    __device__ __forceinline__ const char* b_ptr(const Unit& u) const { return (const char*)p.WTGU + ((size_t)(l * NEXP + expert(u)) * 2048 + (size_t)u.pn * 256) * KB_; }
    __device__ __forceinline__ int gather_row(const Unit& u, int r) const { return p.SLOT_TOK[u.pm * 256 + r]; }
    __device__ __forceinline__ void epi(const f32x4 (&acc)[2][2][4][2], const Unit& u, int wr, int wc, int fr, int fq) const {
        const int brow = u.pm * 256;
        const float* bias = p.in[I_BGU] + (size_t)(l * NEXP + expert(u)) * 2048;
        const int c = u.pn * 128 + wc * 32 + 8 * fq;
        const f32x4 bg0 = *(const f32x4*)(bias + c), bg1 = *(const f32x4*)(bias + c + 4);
        const f32x4 bu0 = *(const f32x4*)(bias + 1024 + c), bu1 = *(const f32x4*)(bias + 1024 + c + 4);
#pragma unroll
        for (int ai = 0; ai < 2; ++ai)
#pragma unroll
            for (int m = 0; m < 4; ++m) {
                float a[8];
#pragma unroll
                for (int n = 0; n < 2; ++n)
#pragma unroll
                    for (int j = 0; j < 4; ++j) {
                        float gv = acc[ai][0][m][n][j] + (n == 0 ? bg0[j] : bg1[j]), uv = acc[ai][1][m][n][j] + (n == 0 ? bu0[j] : bu1[j]);
                        gv = fminf(gv, 7.f); uv = fminf(fmaxf(uv, -7.f), 7.f);
                        a[n * 4 + j] = (uv + 1.f) * (gv * sigmoidf_(1.702f * gv));
                    }
                u32x4 o; o.x = cvt_pk_bf16(a[0], a[1]); o.y = cvt_pk_bf16(a[2], a[3]); o.z = cvt_pk_bf16(a[4], a[5]); o.w = cvt_pk_bf16(a[6], a[7]);
                *(u32x4*)(p.ACT + (size_t)(brow + ai * 128 + wr * 64 + m * 16 + fr) * DM + c) = o;
            }
    }
};
__device__ __forceinline__ void d_moe_gemm1(CParams& p, int wv, int l) {
    moe_offsets_lds(p, wv, l);
    const int* li = (const int*)(smem + LDS_GEMM);
    ProbG1 P{p, l, li, __builtin_amdgcn_readfirstlane(li[40]), 0, 0};
    gemm_phase<true>(P, wv);
}
struct ProbG2 {
    CParams& p; int l; const int* li; int ntile; int bid, nblk;
    __device__ __forceinline__ bool next(int i, Unit& u) const { return tile_order(i, ntile, 4, u, bid, nblk); }
    __device__ __forceinline__ int expert(const Unit& u) const { return __builtin_amdgcn_readfirstlane(li[64 + u.pm]); }
    __device__ __forceinline__ const char* a_ptr(const Unit& u) const { return (const char*)p.ACT + (size_t)u.pm * 256 * KB_; }
    __device__ __forceinline__ const char* b_ptr(const Unit& u) const { return (const char*)p.WTDN + ((size_t)(l * NEXP + expert(u)) * DM + (size_t)u.pn * 256) * KB_; }
    __device__ __forceinline__ int gather_row(const Unit&, int) const { return 0; }
    __device__ __forceinline__ void epi(const f32x4 (&acc)[2][2][4][2], const Unit& u, int wr, int wc, int fr, int fq) const {
        const int brow = u.pm * 256, bcol = u.pn * 256;
        const float* bias = p.in[I_BDN] + (size_t)(l * NEXP + expert(u)) * DM;
#pragma unroll
        for (int ai = 0; ai < 2; ++ai)
#pragma unroll
            for (int m = 0; m < 4; ++m) {
                float* yrow = p.Y + (size_t)(brow + ai * 128 + wr * 64 + m * 16 + fr) * DM;
#pragma unroll
                for (int bj = 0; bj < 2; ++bj)
#pragma unroll
                    for (int n = 0; n < 2; ++n) {
                        const int col = bcol + bj * 128 + wc * 32 + n * 16 + fq * 4;
                        *(f32x4*)(yrow + col) = acc[ai][bj][m][n] + *(const f32x4*)(bias + col);
                    }
            }
    }
};
__device__ __forceinline__ void d_moe_gemm2(CParams& p, int wv, int l) {
    moe_offsets_lds(p, wv, l);
    const int* li = (const int*)(smem + LDS_GEMM);
    ProbG2 P{p, l, li, __builtin_amdgcn_readfirstlane(li[40]), 0, 0};
    gemm_phase<false>(P, wv);
}
__device__ __forceinline__ void d_moe_combine(CParams& p, int wv, int l, int last) {
    const int tidx_ = opaque_tid(wv);
    int bidx_ = blockIdx.x, gdim_ = gridDim.x; asm volatile("" : "+s"(bidx_), "+s"(gdim_));
    moe_offsets_lds(p, wv, l);
    const int* li = (const int*)(smem + LDS_GEMM);
    const int lane = tidx_ & 63, gw = bidx_ * 8 + (tidx_ >> 6), NGW = gdim_ * 8;
    for (int R = gw; R < NROW; R += NGW) {
        const int b = R / TPB, pos = R % TPB, mr = pos < CTXL ? 4 : b;
        if (last && pos < CTXL) continue;
        float4 acc[4];
#pragma unroll
        for (int i = 0; i < 4; ++i) acc[i] = make_float4(0.f, 0.f, 0.f, 0.f);
#pragma unroll
        for (int k = 0; k < 4; ++k) {
            const float g = p.TOPG[R * 4 + k];
            const int s = li[p.TOPI[R * 4 + k]] + p.TOKPOS[R * 4 + k];
            const float4* yr = (const float4*)(p.Y + (size_t)s * DM);
#pragma unroll
            for (int i = 0; i < 4; ++i) { const float4 y = yr[lane + 64 * i]; acc[i].x += g * y.x; acc[i].y += g * y.y; acc[i].z += g * y.z; acc[i].w += g * y.w; }
        }
        const float* m5 = p.MOD + (l * 5 + mr) * 6144 + 5 * DM;
        float4* xr = (float4*)(p.X + (size_t)R * DM);
        float4 v[4]; float ss = 0.f;
#pragma unroll
        for (int i = 0; i < 4; ++i) {
            const float4 m = *(const float4*)(m5 + (lane + 64 * i) * 4);
            float4 x = xr[lane + 64 * i];
            x.x += m.x * acc[i].x; x.y += m.y * acc[i].y; x.z += m.z * acc[i].z; x.w += m.w * acc[i].w;
            v[i] = x; ss += x.x * x.x + x.y * x.y + x.z * x.z + x.w * x.w;
        }
        ss = wave_sum(ss);
        if (!last) {
#pragma unroll
            for (int i = 0; i < 4; ++i) xr[lane + 64 * i] = v[i];
            norm_row_to_bf16(p, v, ss, l + 1, 0, mr, p.H + (size_t)R * DM, lane);
        } else {
            const float rinv = rsqrtf(ss * (1.f / DM) + 1e-6f);
            float4* orow = (float4*)(p.out + ((size_t)b * SEQ + (pos - CTXL)) * DM);
#pragma unroll
            for (int i = 0; i < 4; ++i) {
                const float4 gg = *(const float4*)(p.in[I_FING] + (lane + 64 * i) * 4);
                float4 r; r.x = v[i].x * rinv * gg.x; r.y = v[i].y * rinv * gg.y; r.z = v[i].z * rinv * gg.z; r.w = v[i].w * rinv * gg.w;
                orow[lane + 64 * i] = r;
            }
        }
    }
}


#define XB_TMO      128
#define XB_XCNT(j)  (256  + 64 * (j))
#define XB_XSUB(j)  (1280 + 64 * (j))
#define XB_XGEN(j)  (2304 + 64 * (j))
#define XB_TOP      3328
#define XB_TOPGEN   3392
#define XCD_BAR_WORDS 3456
#define XB_SPIN_CAP (1u << 18)
__device__ __forceinline__ unsigned xb_ld(unsigned* q)              { return __hip_atomic_load(q, __ATOMIC_RELAXED, __HIP_MEMORY_SCOPE_AGENT); }
__device__ __forceinline__ unsigned xb_add(unsigned* q, unsigned v) { return __hip_atomic_fetch_add(q, v, __ATOMIC_RELAXED, __HIP_MEMORY_SCOPE_AGENT); }
__device__ __forceinline__ unsigned xb_xcc_id() { return (unsigned)__builtin_amdgcn_s_getreg((3 << 11) | 20) & 0xFu; }
#define XB_SPIN(cond, bar) do { unsigned _sp = 0; while (cond) { __builtin_amdgcn_s_sleep(1); \
    if ((++_sp & 255u) == 0u) { if (xb_ld(&(bar)[XB_TMO])) break; if (_sp > XB_SPIN_CAP) { atomicAdd(&(bar)[XB_TMO], 1u); break; } } } } while (0)
__device__ __forceinline__ void xcd_barrier_complete(unsigned* bar, unsigned x, unsigned G, unsigned& nloc, unsigned& nx) {
    unsigned sum, cnt, mine, sp = 0u;
    for (;;) {
        sum = 0u; cnt = 0u; mine = 0u;
#pragma unroll
        for (unsigned j = 0; j < 16; ++j) { const unsigned c = xb_ld(&bar[XB_XCNT(j)]); sum += c; cnt += (c > 0u) ? 1u : 0u; mine = (j == x) ? c : mine; }
        if (sum == G) break;
        __builtin_amdgcn_s_sleep(1);
        if ((++sp & 255u) == 0u) { if (xb_ld(&bar[XB_TMO])) break; if (sp > XB_SPIN_CAP) { atomicAdd(&bar[XB_TMO], 1u); break; } }
    }
    nloc = mine > 0u ? mine : 1u; nx = cnt > 0u ? cnt : 1u;
}
__device__ __forceinline__ void xcd_barrier(unsigned* bar, volatile LAS unsigned* st, bool t0) {
    asm volatile("s_waitcnt vmcnt(0)" ::: "memory");
    __syncthreads();
    if (t0) {
        __builtin_amdgcn_s_waitcnt(0);
        const unsigned x = xb_xcc_id();
        unsigned nloc = st[0], nx = st[1];
        if (nloc == 0u) { xcd_barrier_complete(bar, x, gridDim.x, nloc, nx); st[0] = nloc; st[1] = nx; }
        const unsigned old = xb_add(&bar[XB_XSUB(x)], 1u);
        const unsigned gen = old / nloc;
        if (old + 1u == (gen + 1u) * nloc) {
            __builtin_amdgcn_fence(__ATOMIC_RELEASE, "agent");
            asm volatile("s_waitcnt vmcnt(0)" ::: "memory");
            const unsigned og = xb_add(&bar[XB_TOP], 1u);
            const unsigned tg = og / nx;
            if (og + 1u == (tg + 1u) * nx) xb_add(&bar[XB_TOPGEN], 1u);
            else XB_SPIN(xb_ld(&bar[XB_TOPGEN]) == tg, bar);
            __builtin_amdgcn_fence(__ATOMIC_ACQUIRE, "agent");
            xb_add(&bar[XB_XGEN(x)], 1u);
            asm volatile("s_waitcnt vmcnt(0)" ::: "memory");
        } else {
            XB_SPIN(xb_ld(&bar[XB_XGEN(x)]) == gen, bar);
            __builtin_amdgcn_fence(__ATOMIC_ACQUIRE, "agent");
            asm volatile("s_waitcnt vmcnt(0)" ::: "memory");
        }
    }
    __syncthreads();
}

#ifndef MULTI
#define MULTI 0
#endif
__device__ __forceinline__ void run_phase(CParams& p, int wv, int ph) {
    if (ph == 0) { d_prologue(p, wv); return; }
    if (ph == 1) { d_norm_mix(p, wv, 0); return; }
    const int l = (ph - 2) / 11, q = (ph - 2) % 11, last = l == 1;
    if (ph >= 24) return;
    switch (q) {
        case 0: d_gemm_in(p, wv, l); break;
        case 1: d_lru_local(p, wv, l); d_rwkv_pre(p, wv, l); break;
        case 2: d_rwkv_chunkA(p, wv, l); break;
        case 3: d_scan_attn(p, wv, l, !last); break;
        case 4: d_finish(p, wv, l, last); break;
        case 5: d_gemm_out(p, wv, l, last); break;
        case 6: d_norm_router(p, wv, l, last); break;
        case 7: d_moe_scatter(p, wv, l, last); break;
        case 8: d_moe_gemm1(p, wv, l); break;
        case 9: d_moe_gemm2(p, wv, l); break;
        case 10: d_moe_combine(p, wv, l, last); break;
    }
}
#if MULTI
template <int PH> __global__ void __launch_bounds__(NTHR) mega_ph(Params p) { run_phase(p, __builtin_amdgcn_readfirstlane(threadIdx.x >> 6), PH); }
__global__ void __launch_bounds__(NTHR) mega(Params p) {}
template <int PH> static void launch_all(CParams& p, int grid, hipStream_t stream) {
    static bool attr = false; if (!attr) { (void)hipFuncSetAttribute((const void*)mega_ph<PH>, hipFuncAttributeMaxDynamicSharedMemorySize, LDS_BYTES); attr = true; }
    mega_ph<PH><<<grid, NTHR, LDS_BYTES, stream>>>(p);
    if constexpr (PH + 1 < 24) launch_all<PH + 1>(p, grid, stream);
}
#else
__global__ void __launch_bounds__(NTHR) mega(Params p) {
    cg::grid_group grid = cg::this_grid();
    const int wv = __builtin_amdgcn_readfirstlane(threadIdx.x >> 6);
    volatile LAS unsigned* xst = (volatile LAS unsigned*)((LAS unsigned char*)smem + LDS_BYTES - 16);
    if (threadIdx.x == 0) { xst[0] = 0u; xst[1] = 0u; (void)xb_add(&p.BAR[XB_XCNT(xb_xcc_id())], 1u); }
    __syncthreads();
#define RUNPH(n) { CParams* pp = (CParams*)__builtin_amdgcn_kernarg_segment_ptr(); asm volatile("" : "+s"(pp)); run_phase(*pp, wv, n); \
    if (n == 0) grid.sync(); else if (n < 23) xcd_barrier(pp->BAR, xst, opaque_tid(wv) == 0); }
    RUNPH(0) RUNPH(1) RUNPH(2) RUNPH(3) RUNPH(4) RUNPH(5) RUNPH(6) RUNPH(7) RUNPH(8) RUNPH(9) RUNPH(10)
    RUNPH(11) RUNPH(12) RUNPH(13) RUNPH(14) RUNPH(15) RUNPH(16) RUNPH(17) RUNPH(18) RUNPH(19) RUNPH(20) RUNPH(21) RUNPH(22) RUNPH(23)
}
#endif

extern "C" void kernel_launch(void* const* d_in, const int* in_sizes, int n_in, void* d_out, int out_size, void* d_ws, size_t ws_size,
                              hipStream_t stream) {
    Params p{};
    for (int i = 0; i < N_IN; ++i) p.in[i] = (const float*)d_in[i];
    p.out = (float*)d_out;
    char* w = (char*)d_ws;
    size_t off = 0;
    auto take = [&](size_t bytes) { void* r = w + off; off += (bytes + 255) & ~(size_t)255; return r; };
    p.X = (float*)take((size_t)NROW * DM * 4);
    p.H = (bf16_t*)take((size_t)NROW * DM * 2);
    p.P = (float*)take((size_t)NROW * PST * 4);
    p.QH = (bf16_t*)take((size_t)NROW * 512 * 2);
    p.KH = (bf16_t*)take((size_t)NROW * 512 * 2);
    p.VT = (bf16_t*)take((size_t)NROW * 512 * 2);
    p.MIX = (bf16_t*)take((size_t)NROW * DM * 2);
    p.MOD = (float*)take(2 * 5 * 6144 * 4);
    p.LA = (float*)take((size_t)2 * NROW * 256 * 4);
    p.LB = (float*)take((size_t)2 * NROW * 256 * 4);
    p.LCE = (float*)take((size_t)2176 * 128 * 4);
    p.LCI = (float*)take((size_t)4 * 2 * 68 * 256 * 4);
    p.RS = (float*)take((size_t)NROW * 768 * 4);
    p.DEC = (float*)take((size_t)2 * NROW * 256 * 4);
    p.AIC = (float*)take((size_t)2 * NROW * 256 * 4);
    p.KKN = (float*)take((size_t)NROW * 256 * 4);
    p.GG = (float*)take((size_t)NROW * 256 * 4);
    p.YB = (float*)take((size_t)2 * NROW * 256 * 4);
    p.TOPG = (float*)take((size_t)NROW * 4 * 4);
    p.TOPI = (int*)take((size_t)NROW * 4 * 4);
    p.TOKPOS = (int*)take((size_t)NROW * 4 * 4);
    p.CNT = (int*)take(64 * 4);
    p.SLOT_TOK = (int*)take((size_t)CAP * 4);
    p.ACT = (bf16_t*)take((size_t)CAP * DM * 2);
    p.Y = (float*)take((size_t)CAP * DM * 4);
    p.BAR = (unsigned*)take((size_t)XCD_BAR_WORDS * 4);
    p.LWT = (bf16_t*)take((size_t)2 * 2 * 4 * 2 * 4096 * 2);
    p.RWT = (bf16_t*)take((size_t)2 * 5 * 16384 * 2);
    p.RMF = (bf16_t*)take((size_t)2176 * 4096 * 2);
    p.RQF = (bf16_t*)take((size_t)2176 * 4096 * 2);
    p.RNF = (float*)take((size_t)2176 * 4096 * 4);
    p.RYF = (float*)take((size_t)2176 * 4096 * 4);
    p.WTIN = (bf16_t*)take((size_t)2 * INCP * DM * 2);
    p.WTOUT = (bf16_t*)take((size_t)2 * DM * DM * 2);
    p.WTGU = (bf16_t*)take((size_t)2 * NEXP * 2048 * DM * 2);
    p.WTDN = (bf16_t*)take((size_t)2 * NEXP * DM * DM * 2);

    static int grid_blocks = 0;
    if (!grid_blocks) {
        int dev = 0, cus = 0, per_cu = 0;
        (void)hipGetDevice(&dev);
        (void)hipDeviceGetAttribute(&cus, hipDeviceAttributeMultiprocessorCount, dev);
        (void)hipFuncSetAttribute((const void*)mega, hipFuncAttributeMaxDynamicSharedMemorySize, LDS_BYTES);
        (void)hipOccupancyMaxActiveBlocksPerMultiprocessor(&per_cu, (const void*)mega, NTHR, LDS_BYTES);
        if (per_cu > 1) per_cu = 1;
        if (per_cu < 1) { fprintf(stderr, "occupancy query says %d blocks/CU\n", per_cu); per_cu = 1; }
        grid_blocks = cus * per_cu;
        (void)hipGetLastError();
    }
#if MULTI
    launch_all<0>(p, grid_blocks, stream);
#else
    (void)hipMemsetAsync(p.BAR, 0, (size_t)XCD_BAR_WORDS * 4, stream);
    void* args[] = {&p};
    hipError_t e = hipLaunchCooperativeKernel((void*)mega, dim3(grid_blocks), dim3(NTHR), args, LDS_BYTES, stream);
    if (e != hipSuccess) fprintf(stderr, "cooperative launch failed: %s (grid %d)\n", hipGetErrorString(e), grid_blocks);
#endif
}
```

```cpp
#include <hip/hip_runtime.h>
#include <hip/hip_cooperative_groups.h>
#include <stdint.h>
#include <cstdio>
namespace cg = cooperative_groups;

#define DM 1024
#define NBATCH 4
#define SEQ 4096
#define CTXL 256
#define TPB 4352
#define NROW 17408
#define INC 3008
#define INCP 3072
#define PST 1472
#define NEXP 32
#define MOE_TM 256
#define CAP (NROW * 4 + NEXP * MOE_TM)
#define MAXTILES (CAP / MOE_TM)
#define NTHR 512
#define LDS_GEMM 131072
#define LDS_BYTES 155648

typedef unsigned short bf16_t;
typedef short bf16x8 __attribute__((ext_vector_type(8)));
typedef float f32x4 __attribute__((ext_vector_type(4)));
typedef unsigned u32x4 __attribute__((ext_vector_type(4)));
typedef unsigned u32x2 __attribute__((ext_vector_type(2)));

enum { I_X = 0, I_C, I_CTX, I_CCTX, I_ADAW, I_ADAB, I_NMG, I_NFG, I_WIN, I_WOUT, I_CONVW, I_CONVB, I_WR, I_BR, I_WI, I_BI,
       I_LAM, I_MU, I_W0, I_W2, I_A0, I_A2, I_G2, I_KK, I_KA, I_RK, I_LNG, I_LNB, I_RPB, I_RTW, I_RTB, I_WGU, I_BGU, I_WDN,
       I_BDN, I_FING, N_IN };

struct Params {
    const float* in[N_IN];
    float* out;
    float* X;
    float* X2;
    bf16_t* H;
    float* P;
    bf16_t* QH;
    bf16_t* KH;
    bf16_t* VT;
    bf16_t* MIX;
    float* MOD;
    float* LA;
    float* LB;
    float* LCE;
    float* LCI;
    float* RS;
    float* DEC;
    float* AIC;
    float* KKN;
    float* GG;
    float* YB;
    float* TOPG;
    int* TOPI;
    int* TOKPOS;
    int* CNT;
    int* SLOT_TOK;
    bf16_t* ACT;
    float* Y;
    unsigned* BAR;
    bf16_t* LWT;
    bf16_t* RWT;
    bf16_t* RMF;
    bf16_t* RQF;
    float* RNF;
    float* RYF;
    bf16_t* WTIN;
    bf16_t* WTOUT;
    bf16_t* WTGU;
    bf16_t* WTDN;
};

typedef const __attribute__((address_space(4))) Params CParams;
extern __shared__ __attribute__((aligned(16))) unsigned char smem[];

__device__ __forceinline__ int opaque_tid(int wv) { int t; asm volatile("v_mbcnt_lo_u32_b32 %0, -1, 0\n\tv_mbcnt_hi_u32_b32 %0, -1, %0" : "=v"(t)); return wv * 64 + t; }
__device__ __forceinline__ float sigmoidf_(float x) { return 1.f / (1.f + __expf(-x)); }
__device__ __forceinline__ float softplusf_(float x) { return x > 20.f ? x : log1pf(__expf(x)); }
#define SWZ_XOR(v, o) __int_as_float(__builtin_amdgcn_ds_swizzle(__float_as_int(v), ((o) << 10) | 0x1f))
__device__ __forceinline__ float rdlane(float v, int l) { return __int_as_float(__builtin_amdgcn_readlane(__float_as_int(v), l)); }
__device__ __forceinline__ float sum_xor32(float v) {
    int a = __float_as_int(v), b = a;
    asm volatile("s_nop 1\n\tv_permlane32_swap_b32 %0, %1\n\ts_nop 1" : "+v"(a), "+v"(b));
    return __int_as_float(a) + __int_as_float(b);
}
__device__ __forceinline__ float wave_sum(float v) {
    v += SWZ_XOR(v, 1); v += SWZ_XOR(v, 2); v += SWZ_XOR(v, 4); v += SWZ_XOR(v, 8); v += SWZ_XOR(v, 16);
    return rdlane(v, 0) + rdlane(v, 32);
}
__device__ __forceinline__ float wave_max(float v) {
    v = fmaxf(v, SWZ_XOR(v, 1)); v = fmaxf(v, SWZ_XOR(v, 2)); v = fmaxf(v, SWZ_XOR(v, 4)); v = fmaxf(v, SWZ_XOR(v, 8)); v = fmaxf(v, SWZ_XOR(v, 16));
    return fmaxf(rdlane(v, 0), rdlane(v, 32));
}
typedef __bf16 bf16x2_n __attribute__((ext_vector_type(2)));
__device__ __forceinline__ unsigned cvt_pk_bf16(float lo, float hi) { bf16x2_n v; v[0] = (__bf16)lo; v[1] = (__bf16)hi; return __builtin_bit_cast(unsigned, v); }
__device__ __forceinline__ bf16_t f2bf(float x) { return __builtin_bit_cast(bf16_t, (__bf16)x); }
__device__ __forceinline__ float gelu_tanh(float x) {
    const float u = 0.7978845608028654f * (x + 0.044715f * x * x * x);
    return 0.5f * x * (1.f + tanhf(u));
}

__device__ __forceinline__ int inv_perm32(int cc) { return ((cc >> 2) & 1) * 16 + (cc >> 3) * 4 + (cc & 3); }
__device__ __forceinline__ void transpose_item(const float* W, int K, int N, bf16_t* WT, int k0, int n0, int dst_row0, float* scr, int lane, bool perm = false) {
#pragma unroll 8
    for (int i = 0; i < 32; ++i) { const int kk = 2 * i + (lane >> 5); scr[kk * 33 + (lane & 31)] = W[(size_t)(k0 + kk) * N + n0 + (lane & 31)]; }
    __builtin_amdgcn_wave_barrier();
    const int c = lane & 7;
#pragma unroll
    for (int j = 0; j < 4; ++j) {
        const int n = (lane >> 3) + 8 * j; const float* s = scr + (8 * c) * 33 + n;
        u32x4 o; o.x = cvt_pk_bf16(s[0 * 33], s[1 * 33]); o.y = cvt_pk_bf16(s[2 * 33], s[3 * 33]); o.z = cvt_pk_bf16(s[4 * 33], s[5 * 33]); o.w = cvt_pk_bf16(s[6 * 33], s[7 * 33]);
        *(u32x4*)(WT + (size_t)(dst_row0 + (perm ? inv_perm32(n) : n)) * K + k0 + 8 * c) = o;
    }
    __builtin_amdgcn_wave_barrier();
}

__device__ __forceinline__ void d_prologue(CParams& p, int wv) {
    const int tidx_ = opaque_tid(wv);
    int bidx_ = blockIdx.x, gdim_ = gridDim.x; asm volatile("" : "+s"(bidx_), "+s"(gdim_));
    const int tid = tidx_, lane = tid & 63, wave = tid >> 6;
    const int gtid = bidx_ * NTHR + tid, gsz = gdim_ * NTHR;
    const int gw = bidx_ * 8 + wave, NGW = gdim_ * 8;
    {
        const float4* x4 = (const float4*)p.in[I_X];
        const float4* c4 = (const float4*)p.in[I_CTX];
        float4* X4 = (float4*)p.X;
        for (int i = gtid; i < NROW * 256; i += gsz) {
            const int R = i >> 8, q = i & 255, b = R / TPB, pos = R % TPB;
            X4[i] = pos < CTXL ? c4[(b * CTXL + pos) * 256 + q] : x4[((size_t)b * SEQ + (pos - CTXL)) * 256 + q];
        }
    }
    if (gtid < 64) p.CNT[gtid] = 0;
    for (int i = gtid; i < 2 * 2 * 4 * 2 * 4096; i += gsz) {
        const int ii = i & 63, j = (i >> 6) & 63, gt = (i >> 12) & 1, ldh = i >> 13;
        p.LWT[i] = f2bf((gt ? p.in[I_WI] : p.in[I_WR])[(size_t)ldh * 4096 + ii * 64 + j]);
    }
    for (int i = gtid; i < 2 * 5 * 16384; i += gsz) {
        const int k = i & 63, n = (i >> 6) & 255, mtx = (i >> 14) % 5, l = i / (5 * 16384);
        const float v = mtx < 2 ? p.in[I_W2][((size_t)(l * 2 + mtx) * 64 + k) * 256 + n] : (mtx < 4 ? p.in[I_A2][((size_t)(l * 2 + mtx - 2) * 64 + k) * 256 + n] : p.in[I_G2][((size_t)l * 64 + k) * 256 + n]);
        p.RWT[i] = f2bf(v);
    }
    for (int i = gtid; i < 2 * 64 * 1024 / 8; i += gsz) {
        const int l = i / (64 * 128), r = i % (64 * 128);
        *(u32x4*)(p.WTIN + ((size_t)l * INCP + INC) * DM + (size_t)r * 8) = (u32x4){0u, 0u, 0u, 0u};
    }
    {
        float* sc = (float*)smem;
        float* part = (float*)(smem + 5 * 1024 * 4);
        for (int i = tid; i < 5 * DM; i += NTHR) { const int r = i / DM, d = i % DM; const float v = r < 4 ? p.in[I_C][r * DM + d] : p.in[I_CCTX][d]; sc[i] = v * sigmoidf_(v); }
        __syncthreads();
        for (int cb = bidx_; cb < 256; cb += gdim_) {
            const int col = tid % 48, ks = tid / 48;
            const int gc = cb * 48 + col, l = gc / 6144, n = gc % 6144;
            if (ks < 8) {
                const float* W = p.in[I_ADAW] + (size_t)l * DM * 6144 + n;
                float a0 = 0.f, a1 = 0.f, a2 = 0.f, a3 = 0.f, a4 = 0.f;
#pragma unroll 8
                for (int k = ks * 128; k < ks * 128 + 128; ++k) {
                    const float w = W[(size_t)k * 6144];
                    a0 += sc[k] * w; a1 += sc[DM + k] * w; a2 += sc[2 * DM + k] * w; a3 += sc[3 * DM + k] * w; a4 += sc[4 * DM + k] * w;
                }
                float* pp = part + (ks * 5) * 48 + col;
                pp[0] = a0; pp[48] = a1; pp[96] = a2; pp[144] = a3; pp[192] = a4;
            }
            __syncthreads();
            if (tid < 240) {
                const int r = tid / 48, c2 = tid % 48, gc2 = cb * 48 + c2, l2 = gc2 / 6144, n2 = gc2 % 6144;
                float s = p.in[I_ADAB][l2 * 6144 + n2];
#pragma unroll
                for (int k = 0; k < 8; ++k) s += part[(k * 5 + r) * 48 + c2];
                p.MOD[(l2 * 5 + r) * 6144 + n2] = s;
            }
            __syncthreads();
        }
    }
    {
        float* scr = (float*)(smem + 32768) + wave * (64 * 33);
        const int N_IN_ = 2 * 16 * 94, N_OUT_ = 2 * 16 * 32, N_GU_ = 64 * 16 * 64, N_DN_ = 64 * 16 * 32;
        for (int it = gw; it < N_IN_ + N_OUT_ + N_GU_ + N_DN_; it += NGW) {
            int r = it;
            if (r < N_IN_) { const int l = r / (16 * 94), q = r % (16 * 94), kb = q / 94, nb = q % 94;
                transpose_item(p.in[I_WIN] + (size_t)l * DM * INC, DM, INC, p.WTIN + (size_t)l * INCP * DM, kb * 64, nb * 32, nb * 32, scr, lane); continue; }
            r -= N_IN_;
            if (r < N_OUT_) { const int l = r / 512, q = r % 512, kb = q / 32, nb = q % 32;
                transpose_item(p.in[I_WOUT] + (size_t)l * DM * DM, DM, DM, p.WTOUT + (size_t)l * DM * DM, kb * 64, nb * 32, nb * 32, scr, lane); continue; }
            r -= N_OUT_;
            if (r < N_GU_) { const int le = r / 1024, q = r % 1024, kb = q / 64, nb = q % 64;
                const int c0 = nb * 32; const int dst = c0 < 1024 ? (c0 / 128) * 256 + (c0 % 128) : ((c0 - 1024) / 128) * 256 + 128 + ((c0 - 1024) % 128);
                transpose_item(p.in[I_WGU] + (size_t)le * DM * 2048, DM, 2048, p.WTGU + (size_t)le * 2048 * DM, kb * 64, c0, dst, scr, lane, true); continue; }
            r -= N_GU_;
            { const int le = r / 512, q = r % 512, kb = q / 32, nb = q % 32;
                transpose_item(p.in[I_WDN] + (size_t)le * DM * DM, DM, DM, p.WTDN + (size_t)le * DM * DM, kb * 64, nb * 32, nb * 32, scr, lane); }
        }
    }
}

__device__ __forceinline__ void norm_row_to_bf16(CParams& p, const float4 (&v)[4], float ss, int l, int which, int mr, bf16_t* hrow, int lane) {
    const float* g = (which == 0 ? p.in[I_NMG] : p.in[I_NFG]) + l * DM;
    const float* mod = p.MOD + (l * 5 + mr) * 6144 + (which == 0 ? 0 : 3 * DM);
    const float rinv = rsqrtf(ss * (1.f / DM) + 1e-6f);
#pragma unroll
    for (int i = 0; i < 4; ++i) {
        const int c = (lane + 64 * i) * 4;
        const float4 gg = *(const float4*)(g + c), sh = *(const float4*)(mod + c), sc = *(const float4*)(mod + DM + c);
        const float o0 = v[i].x * rinv * gg.x * (1.f + sc.x) + sh.x, o1 = v[i].y * rinv * gg.y * (1.f + sc.y) + sh.y;
        const float o2 = v[i].z * rinv * gg.z * (1.f + sc.z) + sh.z, o3 = v[i].w * rinv * gg.w * (1.f + sc.w) + sh.w;
        uint2 o; o.x = cvt_pk_bf16(o0, o1); o.y = cvt_pk_bf16(o2, o3);
        *(uint2*)(hrow + c) = o;
    }
}
__device__ __forceinline__ void d_norm_mix(CParams& p, int wv, int l) {
    const int tidx_ = opaque_tid(wv);
    int bidx_ = blockIdx.x, gdim_ = gridDim.x; asm volatile("" : "+s"(bidx_), "+s"(gdim_));
    const int lane = tidx_ & 63, gw = bidx_ * 8 + (tidx_ >> 6), NGW = gdim_ * 8;
    for (int R = gw; R < NROW; R += NGW) {
        const int b = R / TPB, pos = R % TPB, mr = pos < CTXL ? 4 : b;
        const float4* xr = (const float4*)(p.X + (size_t)R * DM);
        float4 v[4]; float ss = 0.f;
#pragma unroll
        for (int i = 0; i < 4; ++i) { v[i] = xr[lane + 64 * i]; ss += v[i].x * v[i].x + v[i].y * v[i].y + v[i].z * v[i].z + v[i].w * v[i].w; }
        ss = wave_sum(ss);
        norm_row_to_bf16(p, v, ss, l, 0, mr, p.H + (size_t)R * DM, lane);
    }
}

#define LAS __attribute__((address_space(3)))
#define RWS 144
#define HTB 16384
#define KB_ 2048
__device__ __forceinline__ int lds_byte(int r, int c) {
    const int st = (r >> 4) * 2 + (c >> 5), rr = r & 15, cc = c & 31, ob = rr * 64 + cc * 2;
    return st * 1024 + (ob ^ (((ob >> 9) & 1) << 5));
}
__device__ __forceinline__ void stage_rc(int b, int& R, int& C) {
    const int st = b / 1024, sb = b % 1024, swz = sb ^ (((sb >> 9) & 1) << 5);
    R = (st >> 1) * 16 + swz / 64; C = (st & 1) * 32 + (swz % 64) / 2;
}
struct Unit { int pm, pn; };
__device__ __forceinline__ bool tile_order(int i, int nM, int nN, Unit& u, int bid, int nblk) {
    const int nwg = nM * nN; const long L = (long)i * nblk + bid; if (L >= nwg) return false;
    int wgid = (int)L; { const int q = nwg / 8, r = nwg % 8, xcd = wgid % 8, off = wgid / 8; wgid = (xcd < r ? xcd * (q + 1) : r * (q + 1) + (xcd - r) * q) + off; }
    const int nig = 8 * nN, gid = wgid / nig, fm = gid * 8, gsz = (nM - fm) < 8 ? (nM - fm) : 8;
    u.pm = fm + ((wgid % nig) % gsz); u.pn = (wgid % nig) / gsz; return true;
}

#define PG_SA(b, h) (((b) * 2 + (h)) * HTB)
#define PG_SB(b, h) ((4 + (b) * 2 + (h)) * HTB)
#define PG_STAGE(bufoff, gbase, v0, v1) do { \
    __builtin_amdgcn_global_load_lds((const unsigned*)((const char*)(gbase) + (v0)), (LAS unsigned*)(lds + (bufoff) + ldsw), 16, 0, 0); \
    __builtin_amdgcn_global_load_lds((const unsigned*)((const char*)(gbase) + (v1)), (LAS unsigned*)(lds + (bufoff) + ldsw + 8192), 16, 0, 0); } while (0)
#define PG_STAGE_B(bufoff, gbase) PG_STAGE(bufoff, gbase, voffB[0], voffB[1])
#define PG_STAGE_A(bufoff, gb, h, usenext) do { if (GATHER) PG_STAGE(bufoff, gb, gc[h][0], gc[h][1]); \
    else PG_STAGE(bufoff, (gb) + (h) * hstep, voffA[0], voffA[1]); } while (0)
#define PG_LDA(dst, b, h) do { _Pragma("unroll") for (int m = 0; m < 4; ++m) _Pragma("unroll") for (int k = 0; k < 2; ++k) dst[m][k] = *(const LAS bf16x8*)(lds + PG_SA(b, h) + aoff + m * 2048 + k * 1024); } while (0)
#define PG_LDB(dst, b, h) do { _Pragma("unroll") for (int n = 0; n < 2; ++n) _Pragma("unroll") for (int k = 0; k < 2; ++k) dst[n][k] = *(const LAS bf16x8*)(lds + PG_SB(b, h) + boff + n * 2048 + k * 1024); } while (0)
#define PG_MMA(ai, bj, At_, Bt_) do { __builtin_amdgcn_s_setprio(1); _Pragma("unroll") for (int m = 0; m < 4; ++m) _Pragma("unroll") for (int n = 0; n < 2; ++n) _Pragma("unroll") for (int k = 0; k < 2; ++k) \
    acc[ai][bj][m][n] = __builtin_amdgcn_mfma_f32_16x16x32_bf16(Bt_[n][k], At_[m][k], acc[ai][bj][m][n], 0, 0, 0); __builtin_amdgcn_s_setprio(0); } while (0)
#define PG_WAIT_V(n) asm volatile("s_waitcnt vmcnt(" #n ")" ::: "memory")
#define PG_WAIT_L(n) asm volatile("s_waitcnt lgkmcnt(" #n ")" ::: "memory")
#define PG_BAR __builtin_amdgcn_s_barrier()
#define PG_SCHED __builtin_amdgcn_sched_barrier(0)

template <bool GATHER, class Prob>
__device__ __forceinline__ void gemm_phase(Prob P, int wv) {
    const int tidx_ = opaque_tid(wv);
    int bidx_ = blockIdx.x, gdim_ = gridDim.x; asm volatile("" : "+s"(bidx_), "+s"(gdim_));
    LAS unsigned char* lds = (LAS unsigned char*)smem;
    P.bid = bidx_; P.nblk = gdim_;
    const int tid = tidx_, wid = __builtin_amdgcn_readfirstlane(tid >> 6), lane = tid & 63, wr = wid >> 2, wc = wid & 3, fr = lane & 15, fq = lane >> 4;
    constexpr int nt = 16;
    unsigned voffA[2], voffB[2]; int Rr[2], Cc[2];
#pragma unroll
    for (int i = 0; i < 2; ++i) { stage_rc(tid * 16 + i * 8192, Rr[i], Cc[i]); voffA[i] = (unsigned)(Rr[i] * 1024 + Cc[i]) * 2u; voffB[i] = voffA[i]; }
    const size_t kstep = 128, hstep = (size_t)128 * KB_;
    const unsigned ldsw = (unsigned)wid * 1024u;
    const int aoff = lds_byte(wr * 64 + fr, fq * 8), boff = lds_byte(wc * 32 + fr, fq * 8);
    Unit cur, nxt; int ui = 0;
    if (!P.next(0, cur)) return;
    f32x4 acc[2][2][4][2];
#pragma unroll
    for (int a = 0; a < 2; ++a)
#pragma unroll
        for (int b = 0; b < 2; ++b)
#pragma unroll
            for (int m = 0; m < 4; ++m)
#pragma unroll
                for (int n = 0; n < 2; ++n) acc[a][b][m][n] = (f32x4){0.f, 0.f, 0.f, 0.f};
    bf16x8 At[4][2], B0[2][2], B1[2][2];
    unsigned gc[2][2] = {{0u, 0u}, {0u, 0u}};
    if (GATHER) {
#pragma unroll
        for (int h = 0; h < 2; ++h)
#pragma unroll
            for (int i = 0; i < 2; ++i) gc[h][i] = (unsigned)P.gather_row(cur, h * 128 + Rr[i]) * (unsigned)KB_ + (unsigned)Cc[i] * 2u;
    }
    const char* cA = P.a_ptr(cur); const char* cB = P.b_ptr(cur);
    PG_STAGE_B(PG_SB(0, 0), cB); PG_STAGE_A(PG_SA(0, 0), cA, 0, false); PG_STAGE_B(PG_SB(0, 1), cB + hstep); PG_STAGE_A(PG_SA(0, 1), cA, 1, false);
    if (wr == 1) PG_BAR;
    PG_WAIT_V(4); PG_BAR;
    PG_STAGE_B(PG_SB(1, 0), cB + kstep); PG_STAGE_A(PG_SA(1, 0), cA + kstep, 0, false); PG_STAGE_B(PG_SB(1, 1), cB + hstep + kstep);
    PG_WAIT_V(6); PG_BAR;
    for (;;) {
        const bool has_next = P.next(ui + 1, nxt);
        const char* nA = has_next ? P.a_ptr(nxt) : cA; const char* nB = has_next ? P.b_ptr(nxt) : cB;
        for (int t = 0; t < nt; t += 2) {
            const bool last = (t == nt - 2);
            if (GATHER && last && has_next) {
#pragma unroll
                for (int i = 0; i < 2; ++i) gc[0][i] = (unsigned)P.gather_row(nxt, Rr[i]) * (unsigned)KB_ + (unsigned)Cc[i] * 2u;
            }
            const char* a1 = cA + (size_t)(t + 1) * kstep;
            const char* a2 = last ? nA : cA + (size_t)(t + 2) * kstep; const char* b2 = last ? nB : cB + (size_t)(t + 2) * kstep;
            const char* a3 = a2 + kstep; const char* b3 = b2 + kstep;
            PG_LDB(B0, 0, 0); PG_SCHED; PG_LDA(At, 0, 0); PG_STAGE_A(PG_SA(1, 1), a1, 1, false);
            PG_WAIT_L(8); PG_BAR; PG_WAIT_L(0); PG_MMA(0, 0, At, B0); PG_BAR; PG_SCHED;
            if (GATHER && last && has_next) {
#pragma unroll
                for (int i = 0; i < 2; ++i) gc[1][i] = (unsigned)P.gather_row(nxt, 128 + Rr[i]) * (unsigned)KB_ + (unsigned)Cc[i] * 2u;
            }
            PG_LDB(B1, 0, 1); PG_STAGE_B(PG_SB(0, 0), b2);
            PG_BAR; PG_WAIT_L(0); PG_MMA(0, 1, At, B1); PG_BAR;
            PG_LDA(At, 0, 1); PG_STAGE_A(PG_SA(0, 0), a2, 0, last);
            PG_BAR; PG_WAIT_L(0); PG_MMA(1, 0, At, B0); PG_BAR; PG_SCHED;
            PG_STAGE_B(PG_SB(0, 1), b2 + hstep);
            PG_WAIT_V(6); PG_BAR; PG_MMA(1, 1, At, B1); PG_BAR;
            PG_LDB(B0, 1, 0); PG_SCHED; PG_LDA(At, 1, 0); PG_STAGE_A(PG_SA(0, 1), a2, 1, last);
            PG_WAIT_L(8); PG_BAR; PG_WAIT_L(0); PG_MMA(0, 0, At, B0); PG_BAR; PG_SCHED;
            PG_LDB(B1, 1, 1); PG_STAGE_B(PG_SB(1, 0), b3);
            PG_BAR; PG_WAIT_L(0); PG_MMA(0, 1, At, B1); PG_BAR;
            PG_LDA(At, 1, 1); PG_STAGE_A(PG_SA(1, 0), a3, 0, last);
            PG_BAR; PG_WAIT_L(0); PG_MMA(1, 0, At, B0); PG_BAR; PG_SCHED;
            PG_STAGE_B(PG_SB(1, 1), b3 + hstep);
            PG_WAIT_V(6); PG_BAR; PG_MMA(1, 1, At, B1); PG_BAR;
        }
        P.epi(acc, cur, wr, wc, fr, fq);
        if (!has_next) break;
#pragma unroll
        for (int a = 0; a < 2; ++a)
#pragma unroll
            for (int b = 0; b < 2; ++b)
#pragma unroll
                for (int m = 0; m < 4; ++m)
#pragma unroll
                    for (int n = 0; n < 2; ++n) acc[a][b][m][n] = (f32x4){0.f, 0.f, 0.f, 0.f};
        cur = nxt; cA = nA; cB = nB; ++ui;
    }
    PG_WAIT_V(0);
    if (wr == 0) PG_BAR;
    PG_BAR;
}

struct ProbIn {
    CParams& p; int l; int bid, nblk;
    __device__ __forceinline__ bool next(int i, Unit& u) const { return tile_order(i, NROW / 256, INCP / 256, u, bid, nblk); }
    __device__ __forceinline__ const char* a_ptr(const Unit& u) const { return (const char*)p.H + (size_t)u.pm * 256 * KB_; }
    __device__ __forceinline__ const char* b_ptr(const Unit& u) const { return (const char*)p.WTIN + ((size_t)l * INCP + (size_t)u.pn * 256) * KB_; }
    __device__ __forceinline__ int gather_row(const Unit&, int) const { return 0; }
    __device__ __forceinline__ void epi(const f32x4 (&acc)[2][2][4][2], const Unit& u, int wr, int wc, int fr, int fq) const {
        const int brow = u.pm * 256, bcol = u.pn * 256;
        const int bb = u.pm / 17, pos0 = (u.pm % 17) * 256;
#pragma unroll
        for (int bj = 0; bj < 2; ++bj)
#pragma unroll
            for (int n = 0; n < 2; ++n) {
                const int gcol = bcol + bj * 128 + wc * 32 + n * 16;
                const int col = gcol + fq * 4;
                if (gcol < 1472) {
#pragma unroll
                    for (int ai = 0; ai < 2; ++ai)
#pragma unroll
                        for (int m = 0; m < 4; ++m) *(f32x4*)(p.P + (size_t)(brow + ai * 128 + wr * 64 + m * 16 + fr) * PST + col) = acc[ai][bj][m][n];
                } else if (gcol < 2496) {
                    const bool isq = gcol < 1984; const int cq = col - (isq ? 1472 : 1984), hh = cq >> 6, dim = cq & 63;
                    bf16_t* base = (isq ? p.QH : p.KH) + ((size_t)(bb * 8 + hh) * TPB) * 64 + dim;
                    const float sc = isq ? 0.125f : 1.f;
#pragma unroll
                    for (int ai = 0; ai < 2; ++ai)
#pragma unroll
                        for (int m = 0; m < 4; ++m) {
                            const int pos = pos0 + ai * 128 + wr * 64 + m * 16 + fr; const f32x4 v = acc[ai][bj][m][n] * sc;
                            u32x2 o; o.x = cvt_pk_bf16(v[0], v[1]); o.y = cvt_pk_bf16(v[2], v[3]);
                            *(u32x2*)(base + (size_t)pos * 64) = o;
                        }
                } else if (gcol < INC) {
                    const int cq = col - 2496, hh = cq >> 6, dim = cq & 63;
                    bf16_t* base = p.VT + ((size_t)(bb * 8 + hh) * 64 + dim) * TPB;
#pragma unroll
                    for (int ai = 0; ai < 2; ++ai)
#pragma unroll
                        for (int m = 0; m < 4; ++m) {
                            const int pos = pos0 + ai * 128 + wr * 64 + m * 16 + fr;
#pragma unroll
                            for (int j = 0; j < 4; ++j) base[(size_t)j * TPB + pos] = f2bf(acc[ai][bj][m][n][j]);
                        }
                }
            }
    }
};
__device__ __forceinline__ void d_gemm_in(CParams& p, int wv, int l) { ProbIn P{p, l, 0, 0}; gemm_phase<false>(P, wv); }

struct ProbOut {
    CParams& p; int l; int skip_ctx; int bid, nblk;
    __device__ __forceinline__ bool next(int i, Unit& u) const {
        if (!tile_order(i, skip_ctx ? 64 : 68, 4, u, bid, nblk)) return false;
        if (skip_ctx) u.pm = (u.pm / 16) * 17 + 1 + (u.pm % 16);
        return true; }
    __device__ __forceinline__ const char* a_ptr(const Unit& u) const { return (const char*)p.MIX + (size_t)u.pm * 256 * KB_; }
    __device__ __forceinline__ const char* b_ptr(const Unit& u) const { return (const char*)p.WTOUT + ((size_t)l * DM + (size_t)u.pn * 256) * KB_; }
    __device__ __forceinline__ int gather_row(const Unit&, int) const { return 0; }
    __device__ __forceinline__ void epi(const f32x4 (&acc)[2][2][4][2], const Unit& u, int wr, int wc, int fr, int fq) const {
        const int brow = u.pm * 256, bcol = u.pn * 256;
        const int b = u.pm / 17, mr = (u.pm % 17) == 0 ? 4 : b;
        const float* gate = p.MOD + (l * 5 + mr) * 6144 + 2 * DM;
#pragma unroll
        for (int ai = 0; ai < 2; ++ai)
#pragma unroll
            for (int m = 0; m < 4; ++m) {
                const size_t roff = (size_t)(brow + ai * 128 + wr * 64 + m * 16 + fr) * DM;
#pragma unroll
                for (int bj = 0; bj < 2; ++bj)
#pragma unroll
                    for (int n = 0; n < 2; ++n) {
                        const int col = bcol + bj * 128 + wc * 32 + n * 16 + fq * 4;
                        const f32x4 gt = *(const f32x4*)(gate + col);
                        *(f32x4*)(p.X2 + roff + col) = *(const f32x4*)(p.X + roff + col) + gt * acc[ai][bj][m][n];
                    }
                asm volatile("" ::: "memory");
            }
    }
};
__device__ __forceinline__ void d_gemm_out(CParams& p, int wv, int l, int skip_ctx) { ProbOut P{p, l, skip_ctx, 0, 0}; gemm_phase<false>(P, wv); }

__device__ __forceinline__ int rwkv_pos(int d, int c, int t) { return d == 0 ? c * 64 + t : (c < 4 ? 255 - (c * 64 + t) : 4351 - ((c - 4) * 64 + t)); }
#define DPP_SHR(oldv, v, n) __int_as_float(__builtin_amdgcn_update_dpp(__float_as_int(oldv), __float_as_int(v), 0x110 + (n), 0xf, 0xf, false))
#define BCAST15(v) __int_as_float(__builtin_amdgcn_ds_swizzle(__float_as_int(v), (0x0f << 5) | 0x10))
__device__ __forceinline__ void d_lru_local(CParams& p, int wv, int l) {
    const int tidx_ = opaque_tid(wv);
    int bidx_ = blockIdx.x, gdim_ = gridDim.x; asm volatile("" : "+s"(bidx_), "+s"(gdim_));
    const int lane = tidx_ & 63, gw = bidx_ * 8 + wv, NGW = gdim_ * 8, m16 = lane & 15, g = lane >> 4;
    LAS unsigned char* xcs = (LAS unsigned char*)smem + 8192 + wv * (64 * RWS);
    for (int task = gw; task < 2176; task += NGW) {
        const int c = task % 68, h = (task / 68) & 3, d = (task / 272) & 1, b = task / 544;
        const size_t rb = (size_t)b * TPB;
        {
            const int ch = h * 64 + lane;
            const float* cw = p.in[I_CONVW] + ((l * 2 + d) * 4) * 256 + ch;
            const float cw0 = cw[0], cw1 = cw[256], cw2 = cw[512], cw3 = cw[768], cb = p.in[I_CONVB][(l * 2 + d) * 256 + ch];
            float x1 = 0.f, x2 = 0.f, x3 = 0.f;
            if (c != 0 && c != 4) { x1 = p.P[(rb + rwkv_pos(d, c - 1, 63)) * PST + ch]; x2 = p.P[(rb + rwkv_pos(d, c - 1, 62)) * PST + ch]; x3 = p.P[(rb + rwkv_pos(d, c - 1, 61)) * PST + ch]; }
            __builtin_amdgcn_wave_barrier();
#pragma unroll 8
            for (int t = 0; t < 64; ++t) {
                const float x0 = p.P[(rb + rwkv_pos(d, c, t)) * PST + ch];
                const float xc = cb + cw0 * x0 + cw1 * x1 + cw2 * x2 + cw3 * x3;
                x3 = x2; x2 = x1; x1 = x0;
                *(LAS bf16_t*)(xcs + t * RWS + lane * 2) = f2bf(xc);
            }
            __builtin_amdgcn_wave_barrier();
        }
        bf16x8 xb[4][2];
#pragma unroll
        for (int tt = 0; tt < 4; ++tt)
#pragma unroll
            for (int ks = 0; ks < 2; ++ks) xb[tt][ks] = *(const LAS bf16x8*)(xcs + (tt * 16 + m16) * RWS + ks * 64 + g * 16);
        const bf16_t* wt = p.LWT + (size_t)((l * 2 + d) * 4 + h) * 2 * 4096;
#pragma unroll 1
        for (int jt = 0; jt < 4; ++jt) {
            const int j0 = jt * 16 + 4 * g, chj = h * 64 + j0;
            bf16x8 wa[2][2];
#pragma unroll
            for (int gt = 0; gt < 2; ++gt)
#pragma unroll
                for (int ks = 0; ks < 2; ++ks) wa[gt][ks] = *(const bf16x8*)(wt + (size_t)gt * 4096 + (jt * 16 + m16) * 64 + ks * 32 + 8 * g);
            const f32x4 brv = *(const f32x4*)(p.in[I_BR] + (l * 2 + d) * 256 + chj), biv = *(const f32x4*)(p.in[I_BI] + (l * 2 + d) * 256 + chj);
            const f32x4 lamv = *(const f32x4*)(p.in[I_LAM] + (l * 2 + d) * 256 + chj);
            float ca[4] = {1.f, 1.f, 1.f, 1.f}, chh[4] = {0.f, 0.f, 0.f, 0.f};
#pragma unroll
            for (int tt = 0; tt < 4; ++tt) {
                f32x4 dr = {0.f, 0.f, 0.f, 0.f}, di = {0.f, 0.f, 0.f, 0.f};
#pragma unroll
                for (int ks = 0; ks < 2; ++ks) { dr = __builtin_amdgcn_mfma_f32_16x16x32_bf16(wa[0][ks], xb[tt][ks], dr, 0, 0, 0); di = __builtin_amdgcn_mfma_f32_16x16x32_bf16(wa[1][ks], xb[tt][ks], di, 0, 0, 0); }
                const int t = tt * 16 + m16;
                const u32x2 xw = *(const LAS u32x2*)(xcs + t * RWS + j0 * 2);
                const float xcv[4] = {__uint_as_float(xw.x << 16), __uint_as_float(xw.x & 0xffff0000u), __uint_as_float(xw.y << 16), __uint_as_float(xw.y & 0xffff0000u)};
                f32x4 av, bv;
#pragma unroll
                for (int r = 0; r < 4; ++r) {
                    const float gr = sigmoidf_(dr[r] + brv[r]), gi = sigmoidf_(di[r] + biv[r]);
                    const float log_a = -8.0f * gr * softplusf_(-lamv[r]);
                    float a = __expf(log_a), bb = sqrtf(fmaxf(-expm1f(2.f * log_a), 0.f)) * (gi * xcv[r]);
#define SCAN_STEP(sh) { const float ap = DPP_SHR(1.f, a, sh), bp = DPP_SHR(0.f, bb, sh); bb = a * bp + bb; a = a * ap; }
                    SCAN_STEP(1) SCAN_STEP(2) SCAN_STEP(4) SCAN_STEP(8)
#undef SCAN_STEP
                    bb = a * chh[r] + bb; a = a * ca[r];
                    av[r] = a; bv[r] = bb;
                    ca[r] = BCAST15(a); chh[r] = BCAST15(bb);
                }
                const size_t R = rb + rwkv_pos(d, c, t);
                *(f32x4*)(p.LA + ((size_t)d * NROW + R) * 256 + chj) = bv;
                *(f32x4*)(p.LB + ((size_t)d * NROW + R) * 256 + chj) = av;
                if (tt == 3 && m16 == 15) { *(f32x4*)(p.LCE + (size_t)task * 128 + j0) = av; *(f32x4*)(p.LCE + (size_t)task * 128 + 64 + j0) = bv; }
            }
        }
    }
}
__device__ __forceinline__ void d_lru_carry(CParams& p, int widx, int lane) {
    const int gt = widx * 64 + lane;
    const int ch = gt & 255, d = (gt >> 8) & 1, b = gt >> 9, h = ch >> 6, j = ch & 63;
    const float* ce = p.LCE + (size_t)(((b * 2 + d) * 4 + h) * 68) * 128 + j;
    float* ci = p.LCI + (size_t)((b * 2 + d) * 68) * 256 + ch;
    float carry = 0.f;
#pragma unroll 1
    for (int c0 = 0; c0 < 68; c0 += 17) {
        float a[17], e[17];
#pragma unroll
        for (int u = 0; u < 17; ++u) { a[u] = ce[(size_t)(c0 + u) * 128]; e[u] = ce[(size_t)(c0 + u) * 128 + 64]; }
#pragma unroll
        for (int u = 0; u < 17; ++u) { ci[(size_t)(c0 + u) * 256] = carry; carry = a[u] * carry + e[u]; }
    }
}
__device__ __forceinline__ float lru_h(CParams& p, int b, int pos, size_t R, int d, int ch) {
    const int sidx = d == 0 ? pos : (pos < CTXL ? CTXL - 1 - pos : CTXL + (TPB - 1 - pos));
    const float ci = p.LCI[(size_t)((b * 2 + d) * 68 + (sidx >> 6)) * 256 + ch];
    return p.LA[((size_t)d * NROW + R) * 256 + ch] + p.LB[((size_t)d * NROW + R) * 256 + ch] * ci;
}

__device__ __forceinline__ void d_rwkv_pre(CParams& p, int wv, int l) {
    const int tidx_ = opaque_tid(wv);
    int bidx_ = blockIdx.x, gdim_ = gridDim.x; asm volatile("" : "+s"(bidx_), "+s"(gdim_));
    const int lane = tidx_ & 63, gw = bidx_ * 8 + wv, NGW = gdim_ * 8, m16 = lane & 15, g = lane >> 4;
    LAS unsigned char* stash = (LAS unsigned char*)smem + 90112 + wv * (3 * 16 * RWS);
    const float* mu = p.in[I_MU] + l * 2 * 960;
    for (int tile = gw; tile < NROW / 16; tile += NGW) {
        const int R0 = tile * 16;
#pragma unroll 1
        for (int rr = 0; rr < 16; ++rr) {
            const int R = R0 + rr, pos = R % TPB;
            const int seg0 = pos < CTXL ? 0 : CTXL, seg1 = pos < CTXL ? CTXL : TPB;
            const float* pr = p.P + (size_t)R * PST + 512;
            float sv[15];
#pragma unroll
            for (int q = 0; q < 15; ++q) {
                const int col = lane + 64 * q;
                const float v = pr[col];
                const float pv = pos > seg0 ? pr[col - PST] : 0.f;
                const float nv = pos + 1 < seg1 ? pr[col + PST] : 0.f;
                sv[q] = v + mu[col] * (pv - v) + mu[960 + col] * (nv - v);
            }
#pragma unroll
            for (int q = 0; q < 12; ++q) p.RS[(size_t)R * 768 + lane + 64 * q] = sv[q];
            *(LAS bf16_t*)(stash + (0 * 16 + rr) * RWS + lane * 2) = f2bf(tanhf(sv[12]));
            *(LAS bf16_t*)(stash + (1 * 16 + rr) * RWS + lane * 2) = f2bf(sv[13]);
            *(LAS bf16_t*)(stash + (2 * 16 + rr) * RWS + lane * 2) = f2bf(sigmoidf_(sv[14]));
#pragma unroll
            for (int hq = 0; hq < 4; ++hq) {
                const int c = hq * 64 + lane;
                const float kk = sv[4 + hq] * p.in[I_KK][l * 256 + c];
                const float n2 = wave_sum(kk * kk);
                p.KKN[(size_t)R * 256 + c] = kk / fmaxf(sqrtf(n2), 1e-12f);
            }
        }
        __builtin_amdgcn_wave_barrier();
#pragma unroll 1
        for (int mtx = 0; mtx < 5; ++mtx) {
            const int src = mtx < 2 ? 0 : (mtx < 4 ? 1 : 2), d = mtx & 1;
            const bf16x8 a0 = *(const LAS bf16x8*)(stash + (src * 16 + m16) * RWS + g * 16), a1 = *(const LAS bf16x8*)(stash + (src * 16 + m16) * RWS + 64 + g * 16);
            const bf16_t* wt = p.RWT + (size_t)(l * 5 + mtx) * 16384;
#pragma unroll 4
            for (int ct = 0; ct < 16; ++ct) {
                const bf16_t* wr_ = wt + (size_t)(ct * 16 + m16) * 64 + 8 * g;
                const bf16x8 b0 = *(const bf16x8*)wr_, b1 = *(const bf16x8*)(wr_ + 32);
                f32x4 acc = {0.f, 0.f, 0.f, 0.f};
                acc = __builtin_amdgcn_mfma_f32_16x16x32_bf16(a0, b0, acc, 0, 0, 0);
                acc = __builtin_amdgcn_mfma_f32_16x16x32_bf16(a1, b1, acc, 0, 0, 0);
                const int ch = ct * 16 + m16;
                if (mtx < 2) {
                    const float w0 = p.in[I_W0][(l * 2 + d) * 256 + ch];
#pragma unroll
                    for (int r = 0; r < 4; ++r) { const float w = -softplusf_(-(w0 + acc[r])) - 0.5f; p.DEC[((size_t)d * NROW + R0 + 4 * g + r) * 256 + ch] = -__expf(w); }
                } else if (mtx < 4) {
                    const float a0_ = p.in[I_A0][(l * 2 + d) * 256 + ch];
#pragma unroll
                    for (int r = 0; r < 4; ++r) p.AIC[((size_t)d * NROW + R0 + 4 * g + r) * 256 + ch] = sigmoidf_(a0_ + acc[r]);
                } else {
#pragma unroll
                    for (int r = 0; r < 4; ++r) p.GG[(size_t)(R0 + 4 * g + r) * 256 + ch] = acc[r];
                }
            }
        }
        __builtin_amdgcn_wave_barrier();
    }
}
#define RSLOT(k) (lds + (k) * 9216)
__device__ __forceinline__ void mm2(const LAS unsigned char* Xr, const LAS unsigned char* Yt, int mi, int ni0, int lane, f32x4 (&acc)[2]) {
    const int m = lane & 15, g = lane >> 4;
#pragma unroll
    for (int ks = 0; ks < 2; ++ks) {
        const bf16x8 a = *(const LAS bf16x8*)(Xr + (mi * 16 + m) * RWS + ks * 64 + g * 16);
#pragma unroll
        for (int n = 0; n < 2; ++n) {
            const bf16x8 b = *(const LAS bf16x8*)(Yt + ((ni0 + n) * 16 + m) * RWS + ks * 64 + g * 16);
            acc[n] = __builtin_amdgcn_mfma_f32_16x16x32_bf16(a, b, acc[n], 0, 0, 0);
        }
    }
}
__device__ __forceinline__ void st_r(LAS unsigned char* dst, int mi, int ni, int lane, const f32x4& v) {
    const int m = lane & 15, g = lane >> 4;
#pragma unroll
    for (int r = 0; r < 4; ++r) *(LAS bf16_t*)(dst + (mi * 16 + 4 * g + r) * RWS + (ni * 16 + m) * 2) = f2bf(v[r]);
}
__device__ __forceinline__ void st_t(LAS unsigned char* dst, int mi, int ni, int lane, const f32x4& v) {
    const int m = lane & 15, g = lane >> 4;
    u32x2 o; o.x = cvt_pk_bf16(v[0], v[1]); o.y = cvt_pk_bf16(v[2], v[3]);
    *(LAS u32x2*)(dst + (ni * 16 + m) * RWS + (mi * 16 + 4 * g) * 2) = o;
}
__device__ __forceinline__ float bfbits2f(unsigned short v) { return __uint_as_float(((unsigned)v) << 16); }

__device__ __forceinline__ void d_rwkv_chunkA(CParams& p, int wv, int l) {
    const int tidx_ = opaque_tid(wv);
    int bidx_ = blockIdx.x, gdim_ = gridDim.x; asm volatile("" : "+s"(bidx_), "+s"(gdim_));
    LAS unsigned char* lds = (LAS unsigned char*)smem;
    LAS float* segtot = (LAS float*)(lds + 16 * 9216);
    LAS float* gam = segtot + 512;
    const int tid = tidx_, lane = tid & 63, w = wv;
    const int mi = w >> 1, ni0 = (w & 1) * 2, m16 = lane & 15, g = lane >> 4;
    for (int task = bidx_; task < 2176; task += gdim_) {
        const int c = task % 68, d = (task / 68) & 1, h = (task / 136) & 3, b = task / 544;
        __syncthreads();
        {
            const int j = lane, tq = w, hc = h * 64 + j;
            const float ka = p.in[I_KA][l * 256 + hc];
            float lw[8], aa[8], bb[8], ke[8], rr[8], vv[8];
#pragma unroll
            for (int u = 0; u < 8; ++u) {
                const size_t R = (size_t)b * TPB + rwkv_pos(d, c, 8 * tq + u);
                lw[u] = p.DEC[((size_t)d * NROW + R) * 256 + hc];
                const float aic = p.AIC[((size_t)d * NROW + R) * 256 + hc], kkn = p.KKN[R * 256 + hc];
                const float* rs = p.RS + R * 768;
                rr[u] = rs[hc]; const float k = rs[256 + hc]; vv[u] = rs[512 + hc];
                aa[u] = -kkn; bb[u] = kkn * aic; ke[u] = k * (1.f + (aic - 1.f) * ka);
            }
            float cs[8]; cs[0] = lw[0];
#pragma unroll
            for (int u = 1; u < 8; ++u) cs[u] = cs[u - 1] + lw[u];
            segtot[tq * 64 + j] = cs[7];
            __syncthreads();
            float pre = 0.f, tot = 0.f;
#pragma unroll
            for (int q = 0; q < 8; ++q) { const float sgt = segtot[q * 64 + j]; tot += sgt; if (q < tq) pre += sgt; }
            if (tq == 0) gam[j] = __expf(tot);
            float at[8], bt[8], kt[8];
#pragma unroll
            for (int u = 0; u < 8; ++u) {
                const float Lc = pre + cs[u], Lp = Lc - lw[u];
                const float ep = __expf(Lp), ec = __expf(Lc), en = __expf(-Lc), ee = __expf(tot - Lc);
                const int t = 8 * tq + u;
                at[u] = aa[u] * ep; bt[u] = bb[u] * ee; kt[u] = ke[u] * ee;
                *(LAS bf16_t*)(RSLOT(0) + t * RWS + j * 2) = f2bf(at[u]);
                *(LAS bf16_t*)(RSLOT(1) + t * RWS + j * 2) = f2bf(rr[u] * ec);
                *(LAS bf16_t*)(RSLOT(2) + t * RWS + j * 2) = f2bf(bb[u] * en);
                *(LAS bf16_t*)(RSLOT(3) + t * RWS + j * 2) = f2bf(ke[u] * en);
            }
            u32x4 o;
            o.x = cvt_pk_bf16(at[0], at[1]); o.y = cvt_pk_bf16(at[2], at[3]); o.z = cvt_pk_bf16(at[4], at[5]); o.w = cvt_pk_bf16(at[6], at[7]);
            *(LAS u32x4*)(RSLOT(4) + j * RWS + tq * 16) = o;
            o.x = cvt_pk_bf16(bt[0], bt[1]); o.y = cvt_pk_bf16(bt[2], bt[3]); o.z = cvt_pk_bf16(bt[4], bt[5]); o.w = cvt_pk_bf16(bt[6], bt[7]);
            *(LAS u32x4*)(RSLOT(5) + j * RWS + tq * 16) = o;
            o.x = cvt_pk_bf16(kt[0], kt[1]); o.y = cvt_pk_bf16(kt[2], kt[3]); o.z = cvt_pk_bf16(kt[4], kt[5]); o.w = cvt_pk_bf16(kt[6], kt[7]);
            *(LAS u32x4*)(RSLOT(6) + j * RWS + tq * 16) = o;
            o.x = cvt_pk_bf16(vv[0], vv[1]); o.y = cvt_pk_bf16(vv[2], vv[3]); o.z = cvt_pk_bf16(vv[4], vv[5]); o.w = cvt_pk_bf16(vv[6], vv[7]);
            *(LAS u32x4*)(RSLOT(7) + j * RWS + tq * 16) = o;
        }
        __syncthreads();
        {
            f32x4 aab[2] = {}, aak[2] = {}, brb[2] = {}, brk[2] = {};
            mm2(RSLOT(0), RSLOT(2), mi, ni0, lane, aab); mm2(RSLOT(0), RSLOT(3), mi, ni0, lane, aak);
            mm2(RSLOT(1), RSLOT(2), mi, ni0, lane, brb); mm2(RSLOT(1), RSLOT(3), mi, ni0, lane, brk);
#pragma unroll
            for (int n = 0; n < 2; ++n) {
                f32x4 p0;
#pragma unroll
                for (int r = 0; r < 4; ++r) {
                    const int t = mi * 16 + 4 * g + r, sidx = (ni0 + n) * 16 + m16;
                    if (!(sidx < t)) { aab[n][r] = 0.f; aak[n][r] = 0.f; }
                    if (!(sidx <= t)) { brb[n][r] = 0.f; brk[n][r] = 0.f; }
                    p0[r] = aab[n][r] + (sidx == t ? 1.f : 0.f);
                }
                st_r(RSLOT(11), mi, ni0 + n, lane, aab[n]); st_t(RSLOT(12), mi, ni0 + n, lane, aab[n]);
                st_t(RSLOT(13), mi, ni0 + n, lane, p0);
                st_r(RSLOT(8), mi, ni0 + n, lane, aak[n]); st_r(RSLOT(9), mi, ni0 + n, lane, brb[n]); st_r(RSLOT(10), mi, ni0 + n, lane, brk[n]);
            }
        }
        __syncthreads();
#pragma unroll 1
        for (int st = 1; st <= 6; ++st) {
            LAS unsigned char* qsr = (st & 1) ? RSLOT(11) : RSLOT(0);
            LAS unsigned char* qst = (st & 1) ? RSLOT(12) : RSLOT(2);
            LAS unsigned char* qdr = (st & 1) ? RSLOT(0) : RSLOT(11);
            LAS unsigned char* qdt = (st & 1) ? RSLOT(2) : RSLOT(12);
            if (st <= 5) {
                f32x4 q[2] = {};
                mm2(qsr, qst, mi, ni0, lane, q);
#pragma unroll
                for (int n = 0; n < 2; ++n) { st_r(qdr, mi, ni0 + n, lane, q[n]); st_t(qdt, mi, ni0 + n, lane, q[n]); }
            }
            if (st >= 2) {
                LAS unsigned char* ps = (st & 1) ? RSLOT(3) : RSLOT(13);
                LAS unsigned char* pd = (st & 1) ? RSLOT(13) : RSLOT(3);
                f32x4 pp[2];
#pragma unroll
                for (int n = 0; n < 2; ++n) {
                    const u32x2 o = *(const LAS u32x2*)(ps + ((ni0 + n) * 16 + m16) * RWS + (mi * 16 + 4 * g) * 2);
                    pp[n][0] = __uint_as_float(o.x << 16); pp[n][1] = __uint_as_float(o.x & 0xffff0000u); pp[n][2] = __uint_as_float(o.y << 16); pp[n][3] = __uint_as_float(o.y & 0xffff0000u);
                }
                mm2(qsr, ps, mi, ni0, lane, pp);
#pragma unroll
                for (int n = 0; n < 2; ++n) { st_t(pd, mi, ni0 + n, lane, pp[n]); if (st == 6) st_r(RSLOT(15), mi, ni0 + n, lane, pp[n]); }
            }
            if (st == 1) {
                f32x4 akv[2] = {};
                mm2(RSLOT(8), RSLOT(7), mi, ni0, lane, akv);
#pragma unroll
                for (int n = 0; n < 2; ++n) st_t(RSLOT(14), mi, ni0 + n, lane, akv[n]);
            }
            __syncthreads();
        }
        {
            f32x4 w1[2] = {}, z[2] = {};
            mm2(RSLOT(15), RSLOT(4), mi, ni0, lane, w1); mm2(RSLOT(15), RSLOT(14), mi, ni0, lane, z);
#pragma unroll
            for (int n = 0; n < 2; ++n) { st_t(RSLOT(11), mi, ni0 + n, lane, w1[n]); st_t(RSLOT(12), mi, ni0 + n, lane, z[n]); }
        }
        __syncthreads();
        {
            f32x4 mm_[2] = {}, nn[2] = {}, qq[2] = {}, yl[2] = {};
            mm2(RSLOT(5), RSLOT(11), mi, ni0, lane, mm_);
            mm2(RSLOT(5), RSLOT(12), mi, ni0, lane, nn); mm2(RSLOT(6), RSLOT(7), mi, ni0, lane, nn);
            mm2(RSLOT(9), RSLOT(11), mi, ni0, lane, qq);
            mm2(RSLOT(9), RSLOT(12), mi, ni0, lane, yl); mm2(RSLOT(10), RSLOT(7), mi, ni0, lane, yl);
#pragma unroll
            for (int n = 0; n < 2; ++n) {
#pragma unroll
                for (int r = 0; r < 4; ++r) {
                    const int row = mi * 16 + 4 * g + r, col = (ni0 + n) * 16 + m16;
                    if (row == col) mm_[n][r] += gam[row];
                    qq[n][r] += bfbits2f(*(const LAS bf16_t*)(RSLOT(1) + row * RWS + col * 2));
                }
                st_r(RSLOT(0), mi, ni0 + n, lane, mm_[n]); st_r(RSLOT(2), mi, ni0 + n, lane, qq[n]);
                *(f32x4*)(p.RNF + (size_t)task * 4096 + (((ni0 + n) * 4 + mi) * 64 + lane) * 4) = nn[n];
                *(f32x4*)(p.RYF + (size_t)task * 4096 + (((ni0 + n) * 4 + mi) * 64 + lane) * 4) = yl[n];
            }
        }
        __syncthreads();
        {
            const int jb = tid >> 7, sk = (tid >> 6) & 1;
            const int row = jb * 16 + m16;
            const u32x2 m0 = *(const LAS u32x2*)(RSLOT(0) + row * RWS + (32 * sk + 4 * g) * 2), m1 = *(const LAS u32x2*)(RSLOT(0) + row * RWS + (32 * sk + 16 + 4 * g) * 2);
            const u32x2 q0 = *(const LAS u32x2*)(RSLOT(2) + row * RWS + (32 * sk + 4 * g) * 2), q1 = *(const LAS u32x2*)(RSLOT(2) + row * RWS + (32 * sk + 16 + 4 * g) * 2);
            *(u32x4*)(p.RMF + (size_t)task * 4096 + (size_t)tid * 8) = (u32x4){m0.x, m0.y, m1.x, m1.y};
            *(u32x4*)(p.RQF + (size_t)task * 4096 + (size_t)tid * 8) = (u32x4){q0.x, q0.y, q1.x, q1.y};
        }
    }
    __syncthreads();
}

__device__ __forceinline__ void d_rwkv_seq(CParams& p, int widx, int ib, int lane) {
    const int d = widx & 1, h = (widx >> 1) & 3, b = widx >> 3;
    const int m16 = lane & 15, g = lane >> 4;
    f32x4 S[4];
#pragma unroll
    for (int jb = 0; jb < 4; ++jb) S[jb] = (f32x4){0.f, 0.f, 0.f, 0.f};
    const size_t task0 = (size_t)((b * 4 + h) * 2 + d) * 68;
#pragma unroll 1
    for (int c = 0; c < 68; ++c) {
        const size_t tk = task0 + c;
        const bf16x8* mf = (const bf16x8*)(p.RMF + tk * 4096) + lane;
        const bf16x8* qf = (const bf16x8*)(p.RQF + tk * 4096) + lane;
        const f32x4* nf = (const f32x4*)(p.RNF + tk * 4096) + (ib * 4) * 64 + lane;
        const f32x4* yf = (const f32x4*)(p.RYF + tk * 4096) + (ib * 4) * 64 + lane;
        bf16x8 M[4][2], Q[4][2]; f32x4 N[4], Y[4];
#pragma unroll
        for (int jb = 0; jb < 4; ++jb) {
#pragma unroll
            for (int sk = 0; sk < 2; ++sk) { M[jb][sk] = mf[(jb * 2 + sk) * 64]; Q[jb][sk] = qf[(jb * 2 + sk) * 64]; }
            N[jb] = nf[jb * 64]; Y[jb] = yf[jb * 64];
        }
        bf16x8 bfr[2];
#pragma unroll
        for (int sk = 0; sk < 2; ++sk) {
            union { u32x4 u; bf16x8 v; } cv;
            cv.u.x = cvt_pk_bf16(S[2 * sk][0], S[2 * sk][1]); cv.u.y = cvt_pk_bf16(S[2 * sk][2], S[2 * sk][3]);
            cv.u.z = cvt_pk_bf16(S[2 * sk + 1][0], S[2 * sk + 1][1]); cv.u.w = cvt_pk_bf16(S[2 * sk + 1][2], S[2 * sk + 1][3]);
            bfr[sk] = cv.v;
        }
#pragma unroll
        for (int jb = 0; jb < 4; ++jb)
#pragma unroll
            for (int sk = 0; sk < 2; ++sk) {
                N[jb] = __builtin_amdgcn_mfma_f32_16x16x32_bf16(M[jb][sk], bfr[sk], N[jb], 0, 0, 0);
                Y[jb] = __builtin_amdgcn_mfma_f32_16x16x32_bf16(Q[jb][sk], bfr[sk], Y[jb], 0, 0, 0);
            }
#pragma unroll
        for (int jb = 0; jb < 4; ++jb) {
            S[jb] = N[jb];
#pragma unroll
            for (int r = 0; r < 4; ++r) {
                const size_t R = (size_t)b * TPB + rwkv_pos(d, c, jb * 16 + 4 * g + r);
                p.YB[((size_t)d * NROW + R) * 256 + h * 64 + ib * 16 + m16] = Y[jb][r];
            }
        }
    }
}

__device__ __forceinline__ float xor16_max(float v) { return fmaxf(v, SWZ_XOR(v, 16)); }
__device__ __forceinline__ float max_xor32(float v) {
    int a = __float_as_int(v), b = a;
    asm volatile("s_nop 1\n\tv_permlane32_swap_b32 %0, %1\n\ts_nop 1" : "+v"(a), "+v"(b));
    return fmaxf(__int_as_float(a), __int_as_float(b));
}
template <bool BAND, class KB>
__device__ __forceinline__ void attn_block(CParams& p, const bf16_t* KHh, const bf16_t* VTh, const bf16x8 (&qf)[2], KB kbase, const float* rpbh  ,
                                           int c, int rr, int rs, int kc0, int lane, float& mrow, float& lrow, f32x4 (&o)[4]) {
    const int m16 = lane & 15, g = lane >> 4;
    f32x4 sc[16];
#pragma unroll
    for (int u = 0; u < 8; ++u) {
        const int kb = kbase(u);
#pragma unroll
        for (int j2 = 0; j2 < 2; ++j2) {
            const bf16_t* kr = KHh + (size_t)(kb + 16 * j2 + m16) * 64 + 8 * g;
            const bf16x8 k0 = *(const bf16x8*)kr, k1 = *(const bf16x8*)(kr + 32);
            f32x4 a = {0.f, 0.f, 0.f, 0.f};
            a = __builtin_amdgcn_mfma_f32_16x16x32_bf16(k0, qf[0], a, 0, 0, 0);
            a = __builtin_amdgcn_mfma_f32_16x16x32_bf16(k1, qf[1], a, 0, 0, 0);
            if (BAND) {
                const int cs = min(max(c - 8, 0), 48);
#pragma unroll
                for (int r = 0; r < 4; ++r) {
                    const int kc = kc0 + 16 * j2 + 4 * g + r;
                    const int cb = min(max(kc - c + 15, 0), 30);
                    const float bias = rpbh[(rs + u - rr + 7) * 31 + cb];
                    a[r] = (kc >= cs && kc < cs + 16) ? a[r] + bias : -1e30f;
                }
            }
            sc[2 * u + j2] = a;
        }
    }
    float mx = -1e30f;
#pragma unroll
    for (int t = 0; t < 16; ++t) mx = fmaxf(mx, fmaxf(fmaxf(sc[t][0], sc[t][1]), fmaxf(sc[t][2], sc[t][3])));
    mx = xor16_max(mx); mx = max_xor32(mx);
    float sum = 0.f;
#pragma unroll
    for (int t = 0; t < 16; ++t)
#pragma unroll
        for (int r = 0; r < 4; ++r) { const float e = __expf(sc[t][r] - mx); sc[t][r] = e; sum += e; }
    sum += SWZ_XOR(sum, 16); sum = sum_xor32(sum);
    mrow = mx; lrow = sum;
#pragma unroll
    for (int dt = 0; dt < 4; ++dt) o[dt] = (f32x4){0.f, 0.f, 0.f, 0.f};
#pragma unroll
    for (int u = 0; u < 8; ++u) {
        union { u32x4 w; bf16x8 v; } pf;
        pf.w.x = cvt_pk_bf16(sc[2 * u][0], sc[2 * u][1]); pf.w.y = cvt_pk_bf16(sc[2 * u][2], sc[2 * u][3]);
        pf.w.z = cvt_pk_bf16(sc[2 * u + 1][0], sc[2 * u + 1][1]); pf.w.w = cvt_pk_bf16(sc[2 * u + 1][2], sc[2 * u + 1][3]);
        const int kb = kbase(u);
#pragma unroll
        for (int dt = 0; dt < 4; ++dt) {
            const bf16_t* vr = VTh + (size_t)(dt * 16 + m16) * TPB + kb + 4 * g;
            union { u32x4 w; bf16x8 v; } vf;
            const u32x2 v0 = *(const u32x2*)vr, v1 = *(const u32x2*)(vr + 16);
            vf.w = (u32x4){v0.x, v0.y, v1.x, v1.y};
            o[dt] = __builtin_amdgcn_mfma_f32_16x16x32_bf16(vf.v, pf.v, o[dt], 0, 0, 0);
        }
    }
}
__device__ __forceinline__ void d_na(CParams& p, int wv, int l, int do_ctx) {
    const int tidx_ = opaque_tid(wv);
    int bidx_ = blockIdx.x, gdim_ = gridDim.x; asm volatile("" : "+s"(bidx_), "+s"(gdim_));
    const int lane = tidx_ & 63, m16 = lane & 15, g = lane >> 4;
    const float* rpbs = (const float*)smem;
    const int ngrp = (8192 + (do_ctx ? 512 : 0)) / 8;
    for (int grp = bidx_; grp < ngrp; grp += gdim_) {
        const int task = grp * 8 + wv;
        int b, h, qpos0, c = 0, rr = 0, rs = 0, kc0 = 0; bool lat;
        if (task < 8192) { const int ct = task & 3; rr = (task >> 2) & 63; h = (task >> 8) & 7; b = task >> 11; lat = true;
            const int c0 = ct * 16; c = c0 + m16; rs = min(max(rr - 4, 0), 56); kc0 = min(max(c0 - 8, 0), 32); qpos0 = CTXL + rr * 64 + c0; }
        else { const int t2 = task - 8192; const int qt = t2 & 15; h = (t2 >> 4) & 7; b = t2 >> 7; lat = false; qpos0 = qt * 16; }
        const bf16_t* QHh = p.QH + (size_t)(b * 8 + h) * TPB * 64;
        const bf16_t* KHh = p.KH + (size_t)(b * 8 + h) * TPB * 64;
        const bf16_t* VTh = p.VT + (size_t)(b * 8 + h) * 64 * TPB;
        bf16x8 qf[2];
        { const bf16_t* qr = QHh + (size_t)(qpos0 + m16) * 64 + 8 * g; qf[0] = *(const bf16x8*)qr; qf[1] = *(const bf16x8*)(qr + 32); }
        float m2, l2; f32x4 o2[4];
        attn_block<false>(p, KHh, VTh, qf, [&](int u) { return 32 * u; }, nullptr, 0, 0, 0, 0, lane, m2, l2, o2);
        float inv;
        if (lat) {
            float m1, l1; f32x4 o1[4];
            attn_block<true>(p, KHh, VTh, qf, [&](int u) { return CTXL + (rs + u) * 64 + kc0; }, rpbs + h * 465, c, rr, rs, kc0, lane, m1, l1, o1);
            const float mm = fmaxf(m1, m2), f1 = __expf(m1 - mm), f2 = __expf(m2 - mm);
            inv = 1.f / (l1 * f1 + l2 * f2);
#pragma unroll
            for (int dt = 0; dt < 4; ++dt) o2[dt] = o1[dt] * f1 + o2[dt] * f2;
        } else inv = 1.f / l2;
        bf16_t* orow = p.MIX + (size_t)(b * TPB + qpos0 + m16) * DM + 512 + h * 64 + 4 * g;
#pragma unroll
        for (int dt = 0; dt < 4; ++dt) {
            const f32x4 v = o2[dt] * inv;
            u32x2 ov; ov.x = cvt_pk_bf16(v[0], v[1]); ov.y = cvt_pk_bf16(v[2], v[3]);
            *(u32x2*)(orow + dt * 16) = ov;
        }
    }
}

__device__ __forceinline__ void d_scan_attn(CParams& p, int wv, int l, int do_ctx) {
    const int tidx_ = opaque_tid(wv);
    int bidx_ = blockIdx.x, gdim_ = gridDim.x; asm volatile("" : "+s"(bidx_), "+s"(gdim_));
    const int wave = tidx_ >> 6, lane = tidx_ & 63;
    { float* rpbs = (float*)smem; for (int i = tidx_; i < 8 * 15 * 31; i += NTHR) rpbs[i] = p.in[I_RPB][(size_t)l * 8 * 15 * 31 + i]; }
    __syncthreads();
    if (bidx_ < 32 && wave < 4) d_rwkv_seq(p, bidx_, wave, lane);
    else if (bidx_ < 32 && wave == 4) d_lru_carry(p, bidx_, lane);
    d_na(p, wv, l, do_ctx);
}

__device__ __forceinline__ void d_finish(CParams& p, int wv, int l, int skip_ctx) {
    const int tidx_ = opaque_tid(wv);
    int bidx_ = blockIdx.x, gdim_ = gridDim.x; asm volatile("" : "+s"(bidx_), "+s"(gdim_));
    const int lane = tidx_ & 63, gw = bidx_ * 8 + (tidx_ >> 6), NGW = gdim_ * 8;
    for (int it = gw; it < NROW * 4; it += NGW) {
        const int R = it >> 2, h = it & 3, c = h * 64 + lane;
        if (skip_ctx && (R % TPB) < CTXL) continue;
        const float g = p.P[(size_t)R * PST + 256 + c];
        p.MIX[(size_t)R * DM + c] = f2bf(gelu_tanh(g) * (lru_h(p, R / TPB, R % TPB, R, 0, c) + lru_h(p, R / TPB, R % TPB, R, 1, c)));
        const float* rs = p.RS + (size_t)R * 768;
        const float r = rs[c], k = rs[256 + c], v = rs[512 + c];
        const float y = p.YB[(size_t)R * 256 + c] + p.YB[((size_t)NROW + R) * 256 + c];
        const float mean = wave_sum(y) * (1.f / 64.f);
        const float dv = y - mean;
        const float var = wave_sum(dv * dv) * (1.f / 64.f);
        const float yn = dv * rsqrtf(var + 64e-5f);
        const float ka = p.in[I_KA][l * 256 + c], rk = p.in[I_RK][l * 256 + c];
        float bon = 0.f;
#pragma unroll
        for (int d = 0; d < 2; ++d) {
            const float a = p.AIC[((size_t)d * NROW + R) * 256 + c];
            bon += r * (k * (1.f + (a - 1.f) * ka)) * rk;
        }
        bon = wave_sum(bon);
        const float o = (yn * p.in[I_LNG][l * 256 + c] + p.in[I_LNB][l * 256 + c] + bon * v) * p.GG[(size_t)R * 256 + c];
        p.MIX[(size_t)R * DM + 256 + c] = f2bf(o);
    }
}

__device__ __forceinline__ void d_norm_router(CParams& p, int wv, int l, int skip_ctx) {
    const int tidx_ = opaque_tid(wv);
    int bidx_ = blockIdx.x, gdim_ = gridDim.x; asm volatile("" : "+s"(bidx_), "+s"(gdim_));
    const int lane = tidx_ & 63, m16 = lane & 15, g = lane >> 4;
    const int gtid = bidx_ * NTHR + tidx_, gsz = gdim_ * NTHR;
    for (int i = gtid; i < CAP; i += gsz) p.SLOT_TOK[i] = 0;
    LAS float* hs = (LAS float*)smem;
    LAS float* part = hs + 16 * 1028;
    LAS int* lcnt = (LAS int*)(part + 8 * 16 * 32);
    if (tidx_ < 64) lcnt[tidx_] = 0;
    const float* rw = p.in[I_RTW] + (size_t)l * DM * 32;
    const float* gn = p.in[I_NFG] + l * DM;
    int* cnt = p.CNT + l * 32;
    for (int tile = bidx_; tile < NROW / 16; tile += gdim_) {
        const int R0 = tile * 16, b = R0 / TPB, pos0 = R0 % TPB, mr = pos0 < CTXL ? 4 : b;
        if (skip_ctx && pos0 < CTXL) continue;
        const float* mod = p.MOD + (l * 5 + mr) * 6144 + 3 * DM;
        __syncthreads();
#pragma unroll 1
        for (int q = 0; q < 2; ++q) {
            const int rr = 2 * wv + q, R = R0 + rr;
            const float4* xr = (const float4*)(p.X2 + (size_t)R * DM);
            float4 v[4]; float ss = 0.f;
#pragma unroll
            for (int i = 0; i < 4; ++i) { v[i] = xr[lane + 64 * i]; ss += v[i].x * v[i].x + v[i].y * v[i].y + v[i].z * v[i].z + v[i].w * v[i].w; }
            ss = wave_sum(ss);
            const float rinv = rsqrtf(ss * (1.f / DM) + 1e-6f);
#pragma unroll
            for (int i = 0; i < 4; ++i) {
                const int c = (lane + 64 * i) * 4;
                const float4 gg = *(const float4*)(gn + c), sh = *(const float4*)(mod + c), sc = *(const float4*)(mod + DM + c);
                f32x4 o;
                o[0] = v[i].x * rinv * gg.x * (1.f + sc.x) + sh.x; o[1] = v[i].y * rinv * gg.y * (1.f + sc.y) + sh.y;
                o[2] = v[i].z * rinv * gg.z * (1.f + sc.z) + sh.z; o[3] = v[i].w * rinv * gg.w * (1.f + sc.w) + sh.w;
                uint2 ob; ob.x = cvt_pk_bf16(o[0], o[1]); ob.y = cvt_pk_bf16(o[2], o[3]);
                *(uint2*)(p.H + (size_t)R * DM + c) = ob;
                *(LAS f32x4*)(hs + rr * 1028 + c) = o;
            }
        }
        __syncthreads();
        {
            f32x4 a0 = {0.f, 0.f, 0.f, 0.f}, a1 = {0.f, 0.f, 0.f, 0.f};
            const int kb = wv * 128 + g;
#pragma unroll 8
            for (int ks = 0; ks < 32; ++ks) {
                const int k = kb + 4 * ks;
                const float av = hs[m16 * 1028 + k];
                const float b0 = rw[k * 32 + m16], b1 = rw[k * 32 + 16 + m16];
                a0 = __builtin_amdgcn_mfma_f32_16x16x4f32(av, b0, a0, 0, 0, 0);
                a1 = __builtin_amdgcn_mfma_f32_16x16x4f32(av, b1, a1, 0, 0, 0);
            }
#pragma unroll
            for (int r = 0; r < 4; ++r) { part[(wv * 16 + 4 * g + r) * 32 + m16] = a0[r]; part[(wv * 16 + 4 * g + r) * 32 + 16 + m16] = a1[r]; }
        }
        __syncthreads();
#pragma unroll 1
        for (int q = 0; q < 2; ++q) {
            const int rr = 2 * wv + q, R = R0 + rr, e = lane & 31;
            float val = p.in[I_RTB][l * 32 + e];
#pragma unroll
            for (int w8 = 0; w8 < 8; ++w8) val += part[(w8 * 16 + rr) * 32 + e];
            if (lane >= 32) val = -3e38f;
            float tv[4]; int ti[4];
#pragma unroll
            for (int k = 0; k < 4; ++k) {
                const float m = wave_max(val);
                const unsigned long long bal = __ballot(val == m);
                const int idx = __ffsll((long long)bal) - 1;
                tv[k] = m; ti[k] = idx;
                if (lane == idx) val = -3e38f;
            }
            if (lane == 0) {
                const float e1 = __expf(tv[1] - tv[0]), e2 = __expf(tv[2] - tv[0]), e3 = __expf(tv[3] - tv[0]);
                const float inv = 1.f / (1.f + e1 + e2 + e3);
                const float gs[4] = {inv, e1 * inv, e2 * inv, e3 * inv};
#pragma unroll
                for (int k = 0; k < 4; ++k) {
                    p.TOPG[R * 4 + k] = gs[k]; p.TOPI[R * 4 + k] = ti[k];
                    p.TOKPOS[R * 4 + k] = __hip_atomic_fetch_add(&lcnt[ti[k]], 1, __ATOMIC_RELAXED, __HIP_MEMORY_SCOPE_WORKGROUP);
                }
            }
        }
    }
    __syncthreads();
    if (tidx_ < 32) lcnt[32 + tidx_] = lcnt[tidx_] ? atomicAdd(&cnt[tidx_], lcnt[tidx_]) : 0;
    __syncthreads();
    for (int tile = bidx_; tile < NROW / 16; tile += gdim_) {
        const int R0 = tile * 16;
        if (skip_ctx && (R0 % TPB) < CTXL) continue;
        if (tidx_ < 64) { const int i = R0 * 4 + tidx_; p.TOKPOS[i] += lcnt[32 + p.TOPI[i]]; }
    }
}
__device__ __forceinline__ void moe_offsets_lds(CParams& p, int wv, int l) {
    const int tidx_ = opaque_tid(wv);
    int bidx_ = blockIdx.x, gdim_ = gridDim.x; asm volatile("" : "+s"(bidx_), "+s"(gdim_));
    int* li = (int*)(smem + LDS_GEMM);
    __syncthreads();
    if (tidx_ == 0) {
        int off = 0, nt = 0;
#pragma unroll 1
        for (int e = 0; e < NEXP; ++e) {
            li[e] = off;
            const int n = (p.CNT[l * 32 + e] + MOE_TM - 1) / MOE_TM;
#pragma unroll 1
            for (int i = 0; i < n; ++i) li[64 + nt++] = e;
            off += n * MOE_TM;
        }
        li[32] = off; li[40] = nt;
    }
    __syncthreads();
}
__device__ __forceinline__ void d_moe_scatter(CParams& p, int wv, int l, int skip_ctx) {
    const int tidx_ = opaque_tid(wv);
    int bidx_ = blockIdx.x, gdim_ = gridDim.x; asm volatile("" : "+s"(bidx_), "+s"(gdim_));
    moe_offsets_lds(p, wv, l);
    const int* li = (const int*)(smem + LDS_GEMM);
    const int gtid = bidx_ * NTHR + tidx_, gsz = gdim_ * NTHR;
    for (int i = gtid; i < NROW * 4; i += gsz) {
        const int R = i >> 2;
        if (skip_ctx && (R % TPB) < CTXL) continue;
        p.SLOT_TOK[li[p.TOPI[i]] + p.TOKPOS[i]] = R;
    }
}
struct ProbG1 {
    CParams& p; int l; const int* li; int ntile; int bid, nblk;
    __device__ __forceinline__ bool next(int i, Unit& u) const { return tile_order(i, ntile, 8, u, bid, nblk); }
    __device__ __forceinline__ int expert(const Unit& u) const { return __builtin_amdgcn_readfirstlane(li[64 + u.pm]); }
    __device__ __forceinline__ const char* a_ptr(const Unit&) const { return (const char*)p.H; }
    __device__ __forceinline__ const char* b_ptr(const Unit& u) const { return (const char*)p.WTGU + ((size_t)(l * NEXP + expert(u)) * 2048 + (size_t)u.pn * 256) * KB_; }
    __device__ __forceinline__ int gather_row(const Unit& u, int r) const { return p.SLOT_TOK[u.pm * 256 + r]; }
    __device__ __forceinline__ void epi(const f32x4 (&acc)[2][2][4][2], const Unit& u, int wr, int wc, int fr, int fq) const {
        const int brow = u.pm * 256;
        const float* bias = p.in[I_BGU] + (size_t)(l * NEXP + expert(u)) * 2048;
        const int c = u.pn * 128 + wc * 32 + 8 * fq;
        const f32x4 bg0 = *(const f32x4*)(bias + c), bg1 = *(const f32x4*)(bias + c + 4);
        const f32x4 bu0 = *(const f32x4*)(bias + 1024 + c), bu1 = *(const f32x4*)(bias + 1024 + c + 4);
#pragma unroll
        for (int ai = 0; ai < 2; ++ai)
#pragma unroll
            for (int m = 0; m < 4; ++m) {
                float a[8];
#pragma unroll
                for (int n = 0; n < 2; ++n)
#pragma unroll
                    for (int j = 0; j < 4; ++j) {
                        float gv = acc[ai][0][m][n][j] + (n == 0 ? bg0[j] : bg1[j]), uv = acc[ai][1][m][n][j] + (n == 0 ? bu0[j] : bu1[j]);
                        gv = fminf(gv, 7.f); uv = fminf(fmaxf(uv, -7.f), 7.f);
                        a[n * 4 + j] = (uv + 1.f) * (gv * sigmoidf_(1.702f * gv));
                    }
                u32x4 o; o.x = cvt_pk_bf16(a[0], a[1]); o.y = cvt_pk_bf16(a[2], a[3]); o.z = cvt_pk_bf16(a[4], a[5]); o.w = cvt_pk_bf16(a[6], a[7]);
                *(u32x4*)(p.ACT + (size_t)(brow + ai * 128 + wr * 64 + m * 16 + fr) * DM + c) = o;
            }
    }
};
__device__ __forceinline__ void d_moe_gemm1(CParams& p, int wv, int l) {
    moe_offsets_lds(p, wv, l);
    const int* li = (const int*)(smem + LDS_GEMM);
    ProbG1 P{p, l, li, __builtin_amdgcn_readfirstlane(li[40]), 0, 0};
    gemm_phase<true>(P, wv);
}
struct ProbG2 {
    CParams& p; int l; const int* li; int ntile; int bid, nblk;
    __device__ __forceinline__ bool next(int i, Unit& u) const { return tile_order(i, ntile, 4, u, bid, nblk); }
    __device__ __forceinline__ int expert(const Unit& u) const { return __builtin_amdgcn_readfirstlane(li[64 + u.pm]); }
    __device__ __forceinline__ const char* a_ptr(const Unit& u) const { return (const char*)p.ACT + (size_t)u.pm * 256 * KB_; }
    __device__ __forceinline__ const char* b_ptr(const Unit& u) const { return (const char*)p.WTDN + ((size_t)(l * NEXP + expert(u)) * DM + (size_t)u.pn * 256) * KB_; }
    __device__ __forceinline__ int gather_row(const Unit&, int) const { return 0; }
    __device__ __forceinline__ void epi(const f32x4 (&acc)[2][2][4][2], const Unit& u, int wr, int wc, int fr, int fq) const {
        const int brow = u.pm * 256, bcol = u.pn * 256;
        const float* bias = p.in[I_BDN] + (size_t)(l * NEXP + expert(u)) * DM;
#pragma unroll
        for (int ai = 0; ai < 2; ++ai)
#pragma unroll
            for (int m = 0; m < 4; ++m) {
                float* yrow = p.Y + (size_t)(brow + ai * 128 + wr * 64 + m * 16 + fr) * DM;
#pragma unroll
                for (int bj = 0; bj < 2; ++bj)
#pragma unroll
                    for (int n = 0; n < 2; ++n) {
                        const int col = bcol + bj * 128 + wc * 32 + n * 16 + fq * 4;
                        *(f32x4*)(yrow + col) = acc[ai][bj][m][n] + *(const f32x4*)(bias + col);
                    }
            }
    }
};
__device__ __forceinline__ void d_moe_gemm2(CParams& p, int wv, int l) {
    moe_offsets_lds(p, wv, l);
    const int* li = (const int*)(smem + LDS_GEMM);
    ProbG2 P{p, l, li, __builtin_amdgcn_readfirstlane(li[40]), 0, 0};
    gemm_phase<false>(P, wv);
}
__device__ __forceinline__ void d_moe_combine(CParams& p, int wv, int l, int last) {
    const int tidx_ = opaque_tid(wv);
    int bidx_ = blockIdx.x, gdim_ = gridDim.x; asm volatile("" : "+s"(bidx_), "+s"(gdim_));
    moe_offsets_lds(p, wv, l);
    const int* li = (const int*)(smem + LDS_GEMM);
    const int lane = tidx_ & 63, gw = bidx_ * 8 + (tidx_ >> 6), NGW = gdim_ * 8;
    for (int R = gw; R < NROW; R += NGW) {
        const int b = R / TPB, pos = R % TPB, mr = pos < CTXL ? 4 : b;
        if (last && pos < CTXL) continue;
        float4 acc[4];
#pragma unroll
        for (int i = 0; i < 4; ++i) acc[i] = make_float4(0.f, 0.f, 0.f, 0.f);
#pragma unroll
        for (int k = 0; k < 4; ++k) {
            const float g = p.TOPG[R * 4 + k];
            const int s = li[p.TOPI[R * 4 + k]] + p.TOKPOS[R * 4 + k];
            const float4* yr = (const float4*)(p.Y + (size_t)s * DM);
#pragma unroll
            for (int i = 0; i < 4; ++i) { const float4 y = yr[lane + 64 * i]; acc[i].x += g * y.x; acc[i].y += g * y.y; acc[i].z += g * y.z; acc[i].w += g * y.w; }
        }
        const float* m5 = p.MOD + (l * 5 + mr) * 6144 + 5 * DM;
        const float4* xin = (const float4*)(p.X2 + (size_t)R * DM);
        float4* xr = (float4*)(p.X + (size_t)R * DM);
        float4 v[4]; float ss = 0.f;
#pragma unroll
        for (int i = 0; i < 4; ++i) {
            const float4 m = *(const float4*)(m5 + (lane + 64 * i) * 4);
            float4 x = xin[lane + 64 * i];
            x.x += m.x * acc[i].x; x.y += m.y * acc[i].y; x.z += m.z * acc[i].z; x.w += m.w * acc[i].w;
            v[i] = x; ss += x.x * x.x + x.y * x.y + x.z * x.z + x.w * x.w;
        }
        ss = wave_sum(ss);
        if (!last) {
#pragma unroll
            for (int i = 0; i < 4; ++i) xr[lane + 64 * i] = v[i];
            norm_row_to_bf16(p, v, ss, l + 1, 0, mr, p.H + (size_t)R * DM, lane);
        } else {
            const float rinv = rsqrtf(ss * (1.f / DM) + 1e-6f);
            float4* orow = (float4*)(p.out + ((size_t)b * SEQ + (pos - CTXL)) * DM);
#pragma unroll
            for (int i = 0; i < 4; ++i) {
                const float4 gg = *(const float4*)(p.in[I_FING] + (lane + 64 * i) * 4);
                float4 r; r.x = v[i].x * rinv * gg.x; r.y = v[i].y * rinv * gg.y; r.z = v[i].z * rinv * gg.z; r.w = v[i].w * rinv * gg.w;
                orow[lane + 64 * i] = r;
            }
        }
    }
}


#define XB_TMO      128
#define XB_XCNT(j)  (256  + 64 * (j))
#define XB_XSUB(j)  (1280 + 64 * (j))
#define XB_XGEN(j)  (2304 + 64 * (j))
#define XB_TOP      3328
#define XB_TOPGEN   3392
#define XCD_BAR_WORDS 3456
#define XB_SPIN_CAP (1u << 18)
__device__ __forceinline__ unsigned xb_ld(unsigned* q)              { return __hip_atomic_load(q, __ATOMIC_RELAXED, __HIP_MEMORY_SCOPE_AGENT); }
__device__ __forceinline__ unsigned xb_add(unsigned* q, unsigned v) { return __hip_atomic_fetch_add(q, v, __ATOMIC_RELAXED, __HIP_MEMORY_SCOPE_AGENT); }
__device__ __forceinline__ unsigned xb_xcc_id() { return (unsigned)__builtin_amdgcn_s_getreg((3 << 11) | 20) & 0xFu; }
#define XB_SPIN(cond, bar) do { unsigned _sp = 0; while (cond) { __builtin_amdgcn_s_sleep(1); \
    if ((++_sp & 255u) == 0u) { if (xb_ld(&(bar)[XB_TMO])) break; if (_sp > XB_SPIN_CAP) { atomicAdd(&(bar)[XB_TMO], 1u); break; } } } } while (0)
__device__ __forceinline__ void xcd_barrier_complete(unsigned* bar, unsigned x, unsigned G, unsigned& nloc, unsigned& nx) {
    unsigned sum, cnt, mine, sp = 0u;
    for (;;) {
        sum = 0u; cnt = 0u; mine = 0u;
#pragma unroll
        for (unsigned j = 0; j < 16; ++j) { const unsigned c = xb_ld(&bar[XB_XCNT(j)]); sum += c; cnt += (c > 0u) ? 1u : 0u; mine = (j == x) ? c : mine; }
        if (sum == G) break;
        __builtin_amdgcn_s_sleep(1);
        if ((++sp & 255u) == 0u) { if (xb_ld(&bar[XB_TMO])) break; if (sp > XB_SPIN_CAP) { atomicAdd(&bar[XB_TMO], 1u); break; } }
    }
    nloc = mine > 0u ? mine : 1u; nx = cnt > 0u ? cnt : 1u;
}
__device__ __forceinline__ void xcd_barrier(unsigned* bar, volatile LAS unsigned* st, bool t0) {
    asm volatile("s_waitcnt vmcnt(0)" ::: "memory");
    __syncthreads();
    if (t0) {
        __builtin_amdgcn_s_waitcnt(0);
        const unsigned x = xb_xcc_id();
        unsigned nloc = st[0], nx = st[1];
        if (nloc == 0u) { xcd_barrier_complete(bar, x, gridDim.x, nloc, nx); st[0] = nloc; st[1] = nx; }
        const unsigned old = xb_add(&bar[XB_XSUB(x)], 1u);
        const unsigned gen = old / nloc;
        if (old + 1u == (gen + 1u) * nloc) {
            __builtin_amdgcn_fence(__ATOMIC_RELEASE, "agent");
            asm volatile("s_waitcnt vmcnt(0)" ::: "memory");
            const unsigned og = xb_add(&bar[XB_TOP], 1u);
            const unsigned tg = og / nx;
            if (og + 1u == (tg + 1u) * nx) xb_add(&bar[XB_TOPGEN], 1u);
            else XB_SPIN(xb_ld(&bar[XB_TOPGEN]) == tg, bar);
            __builtin_amdgcn_fence(__ATOMIC_ACQUIRE, "agent");
            xb_add(&bar[XB_XGEN(x)], 1u);
            asm volatile("s_waitcnt vmcnt(0)" ::: "memory");
        } else {
            XB_SPIN(xb_ld(&bar[XB_XGEN(x)]) == gen, bar);
            __builtin_amdgcn_fence(__ATOMIC_ACQUIRE, "agent");
            asm volatile("s_waitcnt vmcnt(0)" ::: "memory");
        }
    }
    __syncthreads();
}

#ifndef MULTI
#define MULTI 0
#endif
__device__ __forceinline__ void run_phase(CParams& p, int wv, int ph) {
    if (ph == 0) { d_prologue(p, wv); return; }
    if (ph == 1) { d_norm_mix(p, wv, 0); return; }
    const int l = (ph - 2) / 11, q = (ph - 2) % 11, last = l == 1;
    if (ph >= 24) return;
    switch (q) {
        case 0: d_gemm_in(p, wv, l); break;
        case 1: d_lru_local(p, wv, l); d_rwkv_pre(p, wv, l); break;
        case 2: d_rwkv_chunkA(p, wv, l); break;
        case 3: d_scan_attn(p, wv, l, !last); break;
        case 4: d_finish(p, wv, l, last); break;
        case 5: d_gemm_out(p, wv, l, last); break;
        case 6: d_norm_router(p, wv, l, last); break;
        case 7: d_moe_scatter(p, wv, l, last); break;
        case 8: d_moe_gemm1(p, wv, l); break;
        case 9: d_moe_gemm2(p, wv, l); break;
        case 10: d_moe_combine(p, wv, l, last); break;
    }
}
#if MULTI
template <int PH> __global__ void __launch_bounds__(NTHR) mega_ph(Params p) { run_phase(p, __builtin_amdgcn_readfirstlane(threadIdx.x >> 6), PH); }
__global__ void __launch_bounds__(NTHR) mega(Params p) {}
template <int PH> static void launch_all(CParams& p, int grid, hipStream_t stream) {
    static bool attr = false; if (!attr) { (void)hipFuncSetAttribute((const void*)mega_ph<PH>, hipFuncAttributeMaxDynamicSharedMemorySize, LDS_BYTES); attr = true; }
    mega_ph<PH><<<grid, NTHR, LDS_BYTES, stream>>>(p);
    if constexpr (PH + 1 < 24) launch_all<PH + 1>(p, grid, stream);
}
#else
__global__ void __launch_bounds__(NTHR) mega(Params p) {
    cg::grid_group grid = cg::this_grid();
    const int wv = __builtin_amdgcn_readfirstlane(threadIdx.x >> 6);
    volatile LAS unsigned* xst = (volatile LAS unsigned*)((LAS unsigned char*)smem + LDS_BYTES - 16);
    if (threadIdx.x == 0) { xst[0] = 0u; xst[1] = 0u; (void)xb_add(&p.BAR[XB_XCNT(xb_xcc_id())], 1u); }
    __syncthreads();
#define RUNPH(n) { CParams* pp = (CParams*)__builtin_amdgcn_kernarg_segment_ptr(); asm volatile("" : "+s"(pp)); run_phase(*pp, wv, n); \
    if (n == 0) grid.sync(); else if (n < 23) xcd_barrier(pp->BAR, xst, opaque_tid(wv) == 0); }
    RUNPH(0) RUNPH(1) RUNPH(2) RUNPH(3) RUNPH(4) RUNPH(5) RUNPH(6) RUNPH(7) RUNPH(8) RUNPH(9) RUNPH(10)
    RUNPH(11) RUNPH(12) RUNPH(13) RUNPH(14) RUNPH(15) RUNPH(16) RUNPH(17) RUNPH(18) RUNPH(19) RUNPH(20) RUNPH(21) RUNPH(22) RUNPH(23)
}
#endif

extern "C" void kernel_launch(void* const* d_in, const int* in_sizes, int n_in, void* d_out, int out_size, void* d_ws, size_t ws_size,
                              hipStream_t stream) {
    Params p{};
    for (int i = 0; i < N_IN; ++i) p.in[i] = (const float*)d_in[i];
    p.out = (float*)d_out;
    char* w = (char*)d_ws;
    size_t off = 0;
    auto take = [&](size_t bytes) { void* r = w + off; off += (bytes + 255) & ~(size_t)255; return r; };
    p.X = (float*)take((size_t)NROW * DM * 4);
    p.X2 = (float*)take((size_t)NROW * DM * 4);
    p.H = (bf16_t*)take((size_t)NROW * DM * 2);
    p.P = (float*)take((size_t)NROW * PST * 4);
    p.QH = (bf16_t*)take((size_t)NROW * 512 * 2);
    p.KH = (bf16_t*)take((size_t)NROW * 512 * 2);
    p.VT = (bf16_t*)take((size_t)NROW * 512 * 2);
    p.MIX = (bf16_t*)take((size_t)NROW * DM * 2);
    p.MOD = (float*)take(2 * 5 * 6144 * 4);
    p.LA = (float*)take((size_t)2 * NROW * 256 * 4);
    p.LB = (float*)take((size_t)2 * NROW * 256 * 4);
    p.LCE = (float*)take((size_t)2176 * 128 * 4);
    p.LCI = (float*)take((size_t)4 * 2 * 68 * 256 * 4);
    p.RS = (float*)take((size_t)NROW * 768 * 4);
    p.DEC = (float*)take((size_t)2 * NROW * 256 * 4);
    p.AIC = (float*)take((size_t)2 * NROW * 256 * 4);
    p.KKN = (float*)take((size_t)NROW * 256 * 4);
    p.GG = (float*)take((size_t)NROW * 256 * 4);
    p.YB = (float*)take((size_t)2 * NROW * 256 * 4);
    p.TOPG = (float*)take((size_t)NROW * 4 * 4);
    p.TOPI = (int*)take((size_t)NROW * 4 * 4);
    p.TOKPOS = (int*)take((size_t)NROW * 4 * 4);
    p.CNT = (int*)take(64 * 4);
    p.SLOT_TOK = (int*)take((size_t)CAP * 4);
    p.ACT = (bf16_t*)take((size_t)CAP * DM * 2);
    p.Y = (float*)take((size_t)CAP * DM * 4);
    p.BAR = (unsigned*)take((size_t)XCD_BAR_WORDS * 4);
    p.LWT = (bf16_t*)take((size_t)2 * 2 * 4 * 2 * 4096 * 2);
    p.RWT = (bf16_t*)take((size_t)2 * 5 * 16384 * 2);
    p.RMF = (bf16_t*)take((size_t)2176 * 4096 * 2);
    p.RQF = (bf16_t*)take((size_t)2176 * 4096 * 2);
    p.RNF = (float*)take((size_t)2176 * 4096 * 4);
    p.RYF = (float*)take((size_t)2176 * 4096 * 4);
    p.WTIN = (bf16_t*)take((size_t)2 * INCP * DM * 2);
    p.WTOUT = (bf16_t*)take((size_t)2 * DM * DM * 2);
    p.WTGU = (bf16_t*)take((size_t)2 * NEXP * 2048 * DM * 2);
    p.WTDN = (bf16_t*)take((size_t)2 * NEXP * DM * DM * 2);

    static int grid_blocks = 0;
    if (!grid_blocks) {
        int dev = 0, cus = 0, per_cu = 0;
        (void)hipGetDevice(&dev);
        (void)hipDeviceGetAttribute(&cus, hipDeviceAttributeMultiprocessorCount, dev);
        (void)hipFuncSetAttribute((const void*)mega, hipFuncAttributeMaxDynamicSharedMemorySize, LDS_BYTES);
        (void)hipOccupancyMaxActiveBlocksPerMultiprocessor(&per_cu, (const void*)mega, NTHR, LDS_BYTES);
        if (per_cu > 1) per_cu = 1;
        if (per_cu < 1) { fprintf(stderr, "occupancy query says %d blocks/CU\n", per_cu); per_cu = 1; }
        grid_blocks = cus * per_cu;
        (void)hipGetLastError();
    }
#if MULTI
    launch_all<0>(p, grid_blocks, stream);
#else
    (void)hipMemsetAsync(p.BAR, 0, (size_t)XCD_BAR_WORDS * 4, stream);
    void* args[] = {&p};
    hipError_t e = hipLaunchCooperativeKernel((void*)mega, dim3(grid_blocks), dim3(NTHR), args, LDS_BYTES, stream);
    if (e != hipSuccess) fprintf(stderr, "cooperative launch failed: %s (grid %d)\n", hipGetErrorString(e), grid_blocks);
#endif
}
```

```cpp
#include <hip/hip_runtime.h>
#include <hip/hip_cooperative_groups.h>
#include <stdint.h>
#include <cstdio>
namespace cg = cooperative_groups;

#define DM 1024
#define NBATCH 4
#define SEQ 4096
#define CTXL 256
#define TPB 4352
#define NROW 17408
#define INC 3008
#define INCP 3072
#define PST 1472
#define NEXP 32
#define MOE_TM 256
#define CAP (NROW * 4 + NEXP * MOE_TM)
#define MAXTILES (CAP / MOE_TM)
#define NTHR 512
#define LDS_GEMM 131072
#define LDS_BYTES 155648

typedef unsigned short bf16_t;
typedef short bf16x8 __attribute__((ext_vector_type(8)));
typedef float f32x4 __attribute__((ext_vector_type(4)));
typedef unsigned u32x4 __attribute__((ext_vector_type(4)));
typedef unsigned u32x2 __attribute__((ext_vector_type(2)));

enum { I_X = 0, I_C, I_CTX, I_CCTX, I_ADAW, I_ADAB, I_NMG, I_NFG, I_WIN, I_WOUT, I_CONVW, I_CONVB, I_WR, I_BR, I_WI, I_BI,
       I_LAM, I_MU, I_W0, I_W2, I_A0, I_A2, I_G2, I_KK, I_KA, I_RK, I_LNG, I_LNB, I_RPB, I_RTW, I_RTB, I_WGU, I_BGU, I_WDN,
       I_BDN, I_FING, N_IN };

struct Params {
    const float* in[N_IN];
    float* out;
    float* X;
    float* X2;
    bf16_t* H;
    float* P;
    bf16_t* QH;
    bf16_t* KH;
    bf16_t* VT;
    bf16_t* MIX;
    float* MOD;
    float* LA;
    float* LB;
    float* LCE;
    float* LCI;
    float* RS;
    float* DEC;
    float* AIC;
    float* KKN;
    float* GG;
    float* YB;
    float* TOPG;
    int* TOPI;
    int* TOKPOS;
    int* CNT;
    int* SLOT_TOK;
    bf16_t* ACT;
    float* Y;
    unsigned* BAR;
    bf16_t* LWT;
    bf16_t* RWT;
    bf16_t* RMF;
    bf16_t* RQF;
    float* RNF;
    float* RYF;
    bf16_t* S0F;
    bf16_t* WTIN;
    bf16_t* WTOUT;
    bf16_t* WTGU;
    bf16_t* WTDN;
};

typedef const __attribute__((address_space(4))) Params CParams;
extern __shared__ __attribute__((aligned(16))) unsigned char smem[];

__device__ __forceinline__ int opaque_tid(int wv) { int t; asm volatile("v_mbcnt_lo_u32_b32 %0, -1, 0\n\tv_mbcnt_hi_u32_b32 %0, -1, %0" : "=v"(t)); return wv * 64 + t; }
__device__ __forceinline__ float sigmoidf_(float x) { return 1.f / (1.f + __expf(-x)); }
__device__ __forceinline__ float softplusf_(float x) { return x > 20.f ? x : log1pf(__expf(x)); }
__device__ __forceinline__ float softplus_fast(float x) { return x > 15.f ? x : __logf(1.f + __expf(x)); }
__device__ __forceinline__ float tanh_fast(float x) { const float e = __expf(2.f * x); return 1.f - 2.f / (1.f + e); }
#define SWZ_XOR(v, o) __int_as_float(__builtin_amdgcn_ds_swizzle(__float_as_int(v), ((o) << 10) | 0x1f))
__device__ __forceinline__ float rdlane(float v, int l) { return __int_as_float(__builtin_amdgcn_readlane(__float_as_int(v), l)); }
__device__ __forceinline__ float sum_xor32(float v) {
    int a = __float_as_int(v), b = a;
    asm volatile("s_nop 1\n\tv_permlane32_swap_b32 %0, %1\n\ts_nop 1" : "+v"(a), "+v"(b));
    return __int_as_float(a) + __int_as_float(b);
}
__device__ __forceinline__ float wave_sum(float v) {
    v += SWZ_XOR(v, 1); v += SWZ_XOR(v, 2); v += SWZ_XOR(v, 4); v += SWZ_XOR(v, 8); v += SWZ_XOR(v, 16);
    return rdlane(v, 0) + rdlane(v, 32);
}
__device__ __forceinline__ float wave_max(float v) {
    v = fmaxf(v, SWZ_XOR(v, 1)); v = fmaxf(v, SWZ_XOR(v, 2)); v = fmaxf(v, SWZ_XOR(v, 4)); v = fmaxf(v, SWZ_XOR(v, 8)); v = fmaxf(v, SWZ_XOR(v, 16));
    return fmaxf(rdlane(v, 0), rdlane(v, 32));
}
typedef __bf16 bf16x2_n __attribute__((ext_vector_type(2)));
__device__ __forceinline__ unsigned cvt_pk_bf16(float lo, float hi) { bf16x2_n v; v[0] = (__bf16)lo; v[1] = (__bf16)hi; return __builtin_bit_cast(unsigned, v); }
__device__ __forceinline__ bf16_t f2bf(float x) { return __builtin_bit_cast(bf16_t, (__bf16)x); }
__device__ __forceinline__ float gelu_tanh(float x) {
    const float u = 0.7978845608028654f * (x + 0.044715f * x * x * x);
    return 0.5f * x * (1.f + tanhf(u));
}

__device__ __forceinline__ int inv_perm32(int cc) { return ((cc >> 2) & 1) * 16 + (cc >> 3) * 4 + (cc & 3); }
__device__ __forceinline__ void transpose_item(const float* W, int K, int N, bf16_t* WT, int k0, int n0, int dst_row0, float* scr, int lane, bool perm = false) {
#pragma unroll 8
    for (int i = 0; i < 32; ++i) { const int kk = 2 * i + (lane >> 5); scr[kk * 33 + (lane & 31)] = W[(size_t)(k0 + kk) * N + n0 + (lane & 31)]; }
    __builtin_amdgcn_wave_barrier();
    const int c = lane & 7;
#pragma unroll
    for (int j = 0; j < 4; ++j) {
        const int n = (lane >> 3) + 8 * j; const float* s = scr + (8 * c) * 33 + n;
        u32x4 o; o.x = cvt_pk_bf16(s[0 * 33], s[1 * 33]); o.y = cvt_pk_bf16(s[2 * 33], s[3 * 33]); o.z = cvt_pk_bf16(s[4 * 33], s[5 * 33]); o.w = cvt_pk_bf16(s[6 * 33], s[7 * 33]);
        *(u32x4*)(WT + (size_t)(dst_row0 + (perm ? inv_perm32(n) : n)) * K + k0 + 8 * c) = o;
    }
    __builtin_amdgcn_wave_barrier();
}

__device__ __forceinline__ void d_prologue(CParams& p, int wv) {
    const int tidx_ = opaque_tid(wv);
    int bidx_ = blockIdx.x, gdim_ = gridDim.x; asm volatile("" : "+s"(bidx_), "+s"(gdim_));
    const int tid = tidx_, lane = tid & 63, wave = tid >> 6;
    const int gtid = bidx_ * NTHR + tid, gsz = gdim_ * NTHR;
    const int gw = bidx_ * 8 + wave, NGW = gdim_ * 8;
    {
        const float4* x4 = (const float4*)p.in[I_X];
        const float4* c4 = (const float4*)p.in[I_CTX];
        float4* X4 = (float4*)p.X;
        for (int i = gtid; i < NROW * 256; i += gsz) {
            const int R = i >> 8, q = i & 255, b = R / TPB, pos = R % TPB;
            X4[i] = pos < CTXL ? c4[(b * CTXL + pos) * 256 + q] : x4[((size_t)b * SEQ + (pos - CTXL)) * 256 + q];
        }
    }
    if (gtid < 64) p.CNT[gtid] = 0;
    for (int i = gtid; i < 2 * 2 * 4 * 2 * 4096; i += gsz) {
        const int ii = i & 63, j = (i >> 6) & 63, gt = (i >> 12) & 1, ldh = i >> 13;
        p.LWT[i] = f2bf((gt ? p.in[I_WI] : p.in[I_WR])[(size_t)ldh * 4096 + ii * 64 + j]);
    }
    for (int i = gtid; i < 2 * 5 * 16384; i += gsz) {
        const int k = i & 63, n = (i >> 6) & 255, mtx = (i >> 14) % 5, l = i / (5 * 16384);
        const float v = mtx < 2 ? p.in[I_W2][((size_t)(l * 2 + mtx) * 64 + k) * 256 + n] : (mtx < 4 ? p.in[I_A2][((size_t)(l * 2 + mtx - 2) * 64 + k) * 256 + n] : p.in[I_G2][((size_t)l * 64 + k) * 256 + n]);
        p.RWT[i] = f2bf(v);
    }
    for (int i = gtid; i < 2 * 64 * 1024 / 8; i += gsz) {
        const int l = i / (64 * 128), r = i % (64 * 128);
        *(u32x4*)(p.WTIN + ((size_t)l * INCP + INC) * DM + (size_t)r * 8) = (u32x4){0u, 0u, 0u, 0u};
    }
    {
        float* sc = (float*)smem;
        float* part = (float*)(smem + 5 * 1024 * 4);
        for (int i = tid; i < 5 * DM; i += NTHR) { const int r = i / DM, d = i % DM; const float v = r < 4 ? p.in[I_C][r * DM + d] : p.in[I_CCTX][d]; sc[i] = v * sigmoidf_(v); }
        __syncthreads();
        for (int cb = bidx_; cb < 256; cb += gdim_) {
            const int col = tid % 48, ks = tid / 48;
            const int gc = cb * 48 + col, l = gc / 6144, n = gc % 6144;
            if (ks < 8) {
                const float* W = p.in[I_ADAW] + (size_t)l * DM * 6144 + n;
                float a0 = 0.f, a1 = 0.f, a2 = 0.f, a3 = 0.f, a4 = 0.f;
#pragma unroll 8
                for (int k = ks * 128; k < ks * 128 + 128; ++k) {
                    const float w = W[(size_t)k * 6144];
                    a0 += sc[k] * w; a1 += sc[DM + k] * w; a2 += sc[2 * DM + k] * w; a3 += sc[3 * DM + k] * w; a4 += sc[4 * DM + k] * w;
                }
                float* pp = part + (ks * 5) * 48 + col;
                pp[0] = a0; pp[48] = a1; pp[96] = a2; pp[144] = a3; pp[192] = a4;
            }
            __syncthreads();
            if (tid < 240) {
                const int r = tid / 48, c2 = tid % 48, gc2 = cb * 48 + c2, l2 = gc2 / 6144, n2 = gc2 % 6144;
                float s = p.in[I_ADAB][l2 * 6144 + n2];
#pragma unroll
                for (int k = 0; k < 8; ++k) s += part[(k * 5 + r) * 48 + c2];
                p.MOD[(l2 * 5 + r) * 6144 + n2] = s;
            }
            __syncthreads();
        }
    }
    {
        float* scr = (float*)(smem + 32768) + wave * (64 * 33);
        const int N_IN_ = 2 * 16 * 94, N_OUT_ = 2 * 16 * 32, N_GU_ = 64 * 16 * 64, N_DN_ = 64 * 16 * 32;
        for (int it = gw; it < N_IN_ + N_OUT_ + N_GU_ + N_DN_; it += NGW) {
            int r = it;
            if (r < N_IN_) { const int l = r / (16 * 94), q = r % (16 * 94), kb = q / 94, nb = q % 94;
                transpose_item(p.in[I_WIN] + (size_t)l * DM * INC, DM, INC, p.WTIN + (size_t)l * INCP * DM, kb * 64, nb * 32, nb * 32, scr, lane); continue; }
            r -= N_IN_;
            if (r < N_OUT_) { const int l = r / 512, q = r % 512, kb = q / 32, nb = q % 32;
                transpose_item(p.in[I_WOUT] + (size_t)l * DM * DM, DM, DM, p.WTOUT + (size_t)l * DM * DM, kb * 64, nb * 32, nb * 32, scr, lane); continue; }
            r -= N_OUT_;
            if (r < N_GU_) { const int le = r / 1024, q = r % 1024, kb = q / 64, nb = q % 64;
                const int c0 = nb * 32; const int dst = c0 < 1024 ? (c0 / 128) * 256 + (c0 % 128) : ((c0 - 1024) / 128) * 256 + 128 + ((c0 - 1024) % 128);
                transpose_item(p.in[I_WGU] + (size_t)le * DM * 2048, DM, 2048, p.WTGU + (size_t)le * 2048 * DM, kb * 64, c0, dst, scr, lane, true); continue; }
            r -= N_GU_;
            { const int le = r / 512, q = r % 512, kb = q / 32, nb = q % 32;
                transpose_item(p.in[I_WDN] + (size_t)le * DM * DM, DM, DM, p.WTDN + (size_t)le * DM * DM, kb * 64, nb * 32, nb * 32, scr, lane); }
        }
    }
}

__device__ __forceinline__ void norm_row_to_bf16(CParams& p, const float4 (&v)[4], float ss, int l, int which, int mr, bf16_t* hrow, int lane) {
    const float* g = (which == 0 ? p.in[I_NMG] : p.in[I_NFG]) + l * DM;
    const float* mod = p.MOD + (l * 5 + mr) * 6144 + (which == 0 ? 0 : 3 * DM);
    const float rinv = rsqrtf(ss * (1.f / DM) + 1e-6f);
#pragma unroll
    for (int i = 0; i < 4; ++i) {
        const int c = (lane + 64 * i) * 4;
        const float4 gg = *(const float4*)(g + c), sh = *(const float4*)(mod + c), sc = *(const float4*)(mod + DM + c);
        const float o0 = v[i].x * rinv * gg.x * (1.f + sc.x) + sh.x, o1 = v[i].y * rinv * gg.y * (1.f + sc.y) + sh.y;
        const float o2 = v[i].z * rinv * gg.z * (1.f + sc.z) + sh.z, o3 = v[i].w * rinv * gg.w * (1.f + sc.w) + sh.w;
        uint2 o; o.x = cvt_pk_bf16(o0, o1); o.y = cvt_pk_bf16(o2, o3);
        *(uint2*)(hrow + c) = o;
    }
}
__device__ __forceinline__ void d_norm_mix(CParams& p, int wv, int l) {
    const int tidx_ = opaque_tid(wv);
    int bidx_ = blockIdx.x, gdim_ = gridDim.x; asm volatile("" : "+s"(bidx_), "+s"(gdim_));
    const int lane = tidx_ & 63, gw = bidx_ * 8 + (tidx_ >> 6), NGW = gdim_ * 8;
    for (int R = gw; R < NROW; R += NGW) {
        const int b = R / TPB, pos = R % TPB, mr = pos < CTXL ? 4 : b;
        const float4* xr = (const float4*)(p.X + (size_t)R * DM);
        float4 v[4]; float ss = 0.f;
#pragma unroll
        for (int i = 0; i < 4; ++i) { v[i] = xr[lane + 64 * i]; ss += v[i].x * v[i].x + v[i].y * v[i].y + v[i].z * v[i].z + v[i].w * v[i].w; }
        ss = wave_sum(ss);
        norm_row_to_bf16(p, v, ss, l, 0, mr, p.H + (size_t)R * DM, lane);
    }
}

#define LAS __attribute__((address_space(3)))
#define RWS 144
#define HTB 16384
#define KB_ 2048
__device__ __forceinline__ int lds_byte(int r, int c) {
    const int st = (r >> 4) * 2 + (c >> 5), rr = r & 15, cc = c & 31, ob = rr * 64 + cc * 2;
    return st * 1024 + (ob ^ (((ob >> 9) & 1) << 5));
}
__device__ __forceinline__ void stage_rc(int b, int& R, int& C) {
    const int st = b / 1024, sb = b % 1024, swz = sb ^ (((sb >> 9) & 1) << 5);
    R = (st >> 1) * 16 + swz / 64; C = (st & 1) * 32 + (swz % 64) / 2;
}
struct Unit { int pm, pn; };
__device__ __forceinline__ bool tile_order(int i, int nM, int nN, Unit& u, int bid, int nblk) {
    const int nwg = nM * nN; const long L = (long)i * nblk + bid; if (L >= nwg) return false;
    int wgid = (int)L; { const int q = nwg / 8, r = nwg % 8, xcd = wgid % 8, off = wgid / 8; wgid = (xcd < r ? xcd * (q + 1) : r * (q + 1) + (xcd - r) * q) + off; }
    const int nig = 8 * nN, gid = wgid / nig, fm = gid * 8, gsz = (nM - fm) < 8 ? (nM - fm) : 8;
    u.pm = fm + ((wgid % nig) % gsz); u.pn = (wgid % nig) / gsz; return true;
}

#define PG_SA(b, h) (((b) * 2 + (h)) * HTB)
#define PG_SB(b, h) ((4 + (b) * 2 + (h)) * HTB)
#define PG_STAGE(bufoff, gbase, v0, v1) do { \
    __builtin_amdgcn_global_load_lds((const unsigned*)((const char*)(gbase) + (v0)), (LAS unsigned*)(lds + (bufoff) + ldsw), 16, 0, 0); \
    __builtin_amdgcn_global_load_lds((const unsigned*)((const char*)(gbase) + (v1)), (LAS unsigned*)(lds + (bufoff) + ldsw + 8192), 16, 0, 0); } while (0)
#define PG_STAGE_B(bufoff, gbase) PG_STAGE(bufoff, gbase, voffB[0], voffB[1])
#define PG_STAGE_A(bufoff, gb, h, usenext) do { if (GATHER) PG_STAGE(bufoff, gb, gc[h][0], gc[h][1]); \
    else PG_STAGE(bufoff, (gb) + (h) * hstep, voffA[0], voffA[1]); } while (0)
#define PG_LDA(dst, b, h) do { _Pragma("unroll") for (int m = 0; m < 4; ++m) _Pragma("unroll") for (int k = 0; k < 2; ++k) dst[m][k] = *(const LAS bf16x8*)(lds + PG_SA(b, h) + aoff + m * 2048 + k * 1024); } while (0)
#define PG_LDB(dst, b, h) do { _Pragma("unroll") for (int n = 0; n < 2; ++n) _Pragma("unroll") for (int k = 0; k < 2; ++k) dst[n][k] = *(const LAS bf16x8*)(lds + PG_SB(b, h) + boff + n * 2048 + k * 1024); } while (0)
#define PG_MMA(ai, bj, At_, Bt_) do { __builtin_amdgcn_s_setprio(1); _Pragma("unroll") for (int m = 0; m < 4; ++m) _Pragma("unroll") for (int n = 0; n < 2; ++n) _Pragma("unroll") for (int k = 0; k < 2; ++k) \
    acc[ai][bj][m][n] = __builtin_amdgcn_mfma_f32_16x16x32_bf16(Bt_[n][k], At_[m][k], acc[ai][bj][m][n], 0, 0, 0); __builtin_amdgcn_s_setprio(0); } while (0)
#define PG_WAIT_V(n) asm volatile("s_waitcnt vmcnt(" #n ")" ::: "memory")
#define PG_WAIT_L(n) asm volatile("s_waitcnt lgkmcnt(" #n ")" ::: "memory")
#define PG_BAR __builtin_amdgcn_s_barrier()
#define PG_SCHED __builtin_amdgcn_sched_barrier(0)

template <bool GATHER, class Prob>
__device__ __forceinline__ void gemm_phase(Prob P, int wv) {
    const int tidx_ = opaque_tid(wv);
    int bidx_ = blockIdx.x, gdim_ = gridDim.x; asm volatile("" : "+s"(bidx_), "+s"(gdim_));
    LAS unsigned char* lds = (LAS unsigned char*)smem;
    P.bid = bidx_; P.nblk = gdim_;
    const int tid = tidx_, wid = __builtin_amdgcn_readfirstlane(tid >> 6), lane = tid & 63, wr = wid >> 2, wc = wid & 3, fr = lane & 15, fq = lane >> 4;
    constexpr int nt = 16;
    unsigned voffA[2], voffB[2]; int Rr[2], Cc[2];
#pragma unroll
    for (int i = 0; i < 2; ++i) { stage_rc(tid * 16 + i * 8192, Rr[i], Cc[i]); voffA[i] = (unsigned)(Rr[i] * 1024 + Cc[i]) * 2u; voffB[i] = voffA[i]; }
    const size_t kstep = 128, hstep = (size_t)128 * KB_;
    const unsigned ldsw = (unsigned)wid * 1024u;
    const int aoff = lds_byte(wr * 64 + fr, fq * 8), boff = lds_byte(wc * 32 + fr, fq * 8);
    Unit cur, nxt; int ui = 0;
    if (!P.next(0, cur)) return;
    f32x4 acc[2][2][4][2];
#pragma unroll
    for (int a = 0; a < 2; ++a)
#pragma unroll
        for (int b = 0; b < 2; ++b)
#pragma unroll
            for (int m = 0; m < 4; ++m)
#pragma unroll
                for (int n = 0; n < 2; ++n) acc[a][b][m][n] = (f32x4){0.f, 0.f, 0.f, 0.f};
    bf16x8 At[4][2], B0[2][2], B1[2][2];
    unsigned gc[2][2] = {{0u, 0u}, {0u, 0u}};
    if (GATHER) {
#pragma unroll
        for (int h = 0; h < 2; ++h)
#pragma unroll
            for (int i = 0; i < 2; ++i) gc[h][i] = (unsigned)P.gather_row(cur, h * 128 + Rr[i]) * (unsigned)KB_ + (unsigned)Cc[i] * 2u;
    }
    const char* cA = P.a_ptr(cur); const char* cB = P.b_ptr(cur);
    PG_STAGE_B(PG_SB(0, 0), cB); PG_STAGE_A(PG_SA(0, 0), cA, 0, false); PG_STAGE_B(PG_SB(0, 1), cB + hstep); PG_STAGE_A(PG_SA(0, 1), cA, 1, false);
    if (wr == 1) PG_BAR;
    PG_WAIT_V(4); PG_BAR;
    PG_STAGE_B(PG_SB(1, 0), cB + kstep); PG_STAGE_A(PG_SA(1, 0), cA + kstep, 0, false); PG_STAGE_B(PG_SB(1, 1), cB + hstep + kstep);
    PG_WAIT_V(6); PG_BAR;
    for (;;) {
        const bool has_next = P.next(ui + 1, nxt);
        const char* nA = has_next ? P.a_ptr(nxt) : cA; const char* nB = has_next ? P.b_ptr(nxt) : cB;
        for (int t = 0; t < nt; t += 2) {
            const bool last = (t == nt - 2);
            if (GATHER && last && has_next) {
#pragma unroll
                for (int i = 0; i < 2; ++i) gc[0][i] = (unsigned)P.gather_row(nxt, Rr[i]) * (unsigned)KB_ + (unsigned)Cc[i] * 2u;
            }
            const char* a1 = cA + (size_t)(t + 1) * kstep;
            const char* a2 = last ? nA : cA + (size_t)(t + 2) * kstep; const char* b2 = last ? nB : cB + (size_t)(t + 2) * kstep;
            const char* a3 = a2 + kstep; const char* b3 = b2 + kstep;
            PG_LDB(B0, 0, 0); PG_SCHED; PG_LDA(At, 0, 0); PG_STAGE_A(PG_SA(1, 1), a1, 1, false);
            PG_WAIT_L(8); PG_BAR; PG_WAIT_L(0); PG_MMA(0, 0, At, B0); PG_BAR; PG_SCHED;
            if (GATHER && last && has_next) {
#pragma unroll
                for (int i = 0; i < 2; ++i) gc[1][i] = (unsigned)P.gather_row(nxt, 128 + Rr[i]) * (unsigned)KB_ + (unsigned)Cc[i] * 2u;
            }
            PG_LDB(B1, 0, 1); PG_STAGE_B(PG_SB(0, 0), b2);
            PG_BAR; PG_WAIT_L(0); PG_MMA(0, 1, At, B1); PG_BAR;
            PG_LDA(At, 0, 1); PG_STAGE_A(PG_SA(0, 0), a2, 0, last);
            PG_BAR; PG_WAIT_L(0); PG_MMA(1, 0, At, B0); PG_BAR; PG_SCHED;
            PG_STAGE_B(PG_SB(0, 1), b2 + hstep);
            PG_WAIT_V(6); PG_BAR; PG_MMA(1, 1, At, B1); PG_BAR;
            PG_LDB(B0, 1, 0); PG_SCHED; PG_LDA(At, 1, 0); PG_STAGE_A(PG_SA(0, 1), a2, 1, last);
            PG_WAIT_L(8); PG_BAR; PG_WAIT_L(0); PG_MMA(0, 0, At, B0); PG_BAR; PG_SCHED;
            PG_LDB(B1, 1, 1); PG_STAGE_B(PG_SB(1, 0), b3);
            PG_BAR; PG_WAIT_L(0); PG_MMA(0, 1, At, B1); PG_BAR;
            PG_LDA(At, 1, 1); PG_STAGE_A(PG_SA(1, 0), a3, 0, last);
            PG_BAR; PG_WAIT_L(0); PG_MMA(1, 0, At, B0); PG_BAR; PG_SCHED;
            PG_STAGE_B(PG_SB(1, 1), b3 + hstep);
            PG_WAIT_V(6); PG_BAR; PG_MMA(1, 1, At, B1); PG_BAR;
        }
        P.epi(acc, cur, wr, wc, fr, fq);
        if (!has_next) break;
#pragma unroll
        for (int a = 0; a < 2; ++a)
#pragma unroll
            for (int b = 0; b < 2; ++b)
#pragma unroll
                for (int m = 0; m < 4; ++m)
#pragma unroll
                    for (int n = 0; n < 2; ++n) acc[a][b][m][n] = (f32x4){0.f, 0.f, 0.f, 0.f};
        cur = nxt; cA = nA; cB = nB; ++ui;
    }
    PG_WAIT_V(0);
    if (wr == 0) PG_BAR;
    PG_BAR;
}

struct ProbIn {
    CParams& p; int l; int bid, nblk;
    __device__ __forceinline__ bool next(int i, Unit& u) const { return tile_order(i, NROW / 256, INCP / 256, u, bid, nblk); }
    __device__ __forceinline__ const char* a_ptr(const Unit& u) const { return (const char*)p.H + (size_t)u.pm * 256 * KB_; }
    __device__ __forceinline__ const char* b_ptr(const Unit& u) const { return (const char*)p.WTIN + ((size_t)l * INCP + (size_t)u.pn * 256) * KB_; }
    __device__ __forceinline__ int gather_row(const Unit&, int) const { return 0; }
    __device__ __forceinline__ void epi(const f32x4 (&acc)[2][2][4][2], const Unit& u, int wr, int wc, int fr, int fq) const {
        const int brow = u.pm * 256, bcol = u.pn * 256;
        const int bb = u.pm / 17, pos0 = (u.pm % 17) * 256;
#pragma unroll
        for (int bj = 0; bj < 2; ++bj)
#pragma unroll
            for (int n = 0; n < 2; ++n) {
                const int gcol = bcol + bj * 128 + wc * 32 + n * 16;
                const int col = gcol + fq * 4;
                if (gcol < 1472) {
#pragma unroll
                    for (int ai = 0; ai < 2; ++ai)
#pragma unroll
                        for (int m = 0; m < 4; ++m) *(f32x4*)(p.P + (size_t)(brow + ai * 128 + wr * 64 + m * 16 + fr) * PST + col) = acc[ai][bj][m][n];
                } else if (gcol < 2496) {
                    const bool isq = gcol < 1984; const int cq = col - (isq ? 1472 : 1984), hh = cq >> 6, dim = cq & 63;
                    bf16_t* base = (isq ? p.QH : p.KH) + ((size_t)(bb * 8 + hh) * TPB) * 64 + dim;
                    const float sc = isq ? 0.125f : 1.f;
#pragma unroll
                    for (int ai = 0; ai < 2; ++ai)
#pragma unroll
                        for (int m = 0; m < 4; ++m) {
                            const int pos = pos0 + ai * 128 + wr * 64 + m * 16 + fr; const f32x4 v = acc[ai][bj][m][n] * sc;
                            u32x2 o; o.x = cvt_pk_bf16(v[0], v[1]); o.y = cvt_pk_bf16(v[2], v[3]);
                            *(u32x2*)(base + (size_t)pos * 64) = o;
                        }
                } else if (gcol < INC) {
                    const int cq = col - 2496, hh = cq >> 6, dim = cq & 63;
                    bf16_t* base = p.VT + ((size_t)(bb * 8 + hh) * 64 + dim) * TPB;
#pragma unroll
                    for (int ai = 0; ai < 2; ++ai)
#pragma unroll
                        for (int m = 0; m < 4; ++m) {
                            const int pos = pos0 + ai * 128 + wr * 64 + m * 16 + fr;
#pragma unroll
                            for (int j = 0; j < 4; ++j) base[(size_t)j * TPB + pos] = f2bf(acc[ai][bj][m][n][j]);
                        }
                }
            }
    }
};
__device__ __forceinline__ void d_gemm_in(CParams& p, int wv, int l) { ProbIn P{p, l, 0, 0}; gemm_phase<false>(P, wv); }

struct ProbOut {
    CParams& p; int l; int skip_ctx; int bid, nblk;
    __device__ __forceinline__ bool next(int i, Unit& u) const {
        if (!tile_order(i, skip_ctx ? 64 : 68, 4, u, bid, nblk)) return false;
        if (skip_ctx) u.pm = (u.pm / 16) * 17 + 1 + (u.pm % 16);
        return true; }
    __device__ __forceinline__ const char* a_ptr(const Unit& u) const { return (const char*)p.MIX + (size_t)u.pm * 256 * KB_; }
    __device__ __forceinline__ const char* b_ptr(const Unit& u) const { return (const char*)p.WTOUT + ((size_t)l * DM + (size_t)u.pn * 256) * KB_; }
    __device__ __forceinline__ int gather_row(const Unit&, int) const { return 0; }
    __device__ __forceinline__ void epi(const f32x4 (&acc)[2][2][4][2], const Unit& u, int wr, int wc, int fr, int fq) const {
        const int brow = u.pm * 256, bcol = u.pn * 256;
        const int b = u.pm / 17, mr = (u.pm % 17) == 0 ? 4 : b;
        const float* gate = p.MOD + (l * 5 + mr) * 6144 + 2 * DM;
#pragma unroll
        for (int ai = 0; ai < 2; ++ai)
#pragma unroll
            for (int m = 0; m < 4; ++m) {
                const size_t roff = (size_t)(brow + ai * 128 + wr * 64 + m * 16 + fr) * DM;
#pragma unroll
                for (int bj = 0; bj < 2; ++bj)
#pragma unroll
                    for (int n = 0; n < 2; ++n) {
                        const int col = bcol + bj * 128 + wc * 32 + n * 16 + fq * 4;
                        const f32x4 gt = *(const f32x4*)(gate + col);
                        *(f32x4*)(p.X2 + roff + col) = *(const f32x4*)(p.X + roff + col) + gt * acc[ai][bj][m][n];
                    }
                asm volatile("" ::: "memory");
            }
    }
};
__device__ __forceinline__ void d_gemm_out(CParams& p, int wv, int l, int skip_ctx) { ProbOut P{p, l, skip_ctx, 0, 0}; gemm_phase<false>(P, wv); }

__device__ __forceinline__ int rwkv_pos(int d, int c, int t) { return d == 0 ? c * 64 + t : (c < 4 ? 255 - (c * 64 + t) : 4351 - ((c - 4) * 64 + t)); }
#define DPP_SHR(oldv, v, n) __int_as_float(__builtin_amdgcn_update_dpp(__float_as_int(oldv), __float_as_int(v), 0x110 + (n), 0xf, 0xf, false))
#define BCAST15(v) __int_as_float(__builtin_amdgcn_ds_swizzle(__float_as_int(v), (0x0f << 5) | 0x10))
__device__ __forceinline__ void d_lru_local(CParams& p, int wv, int l) {
    const int tidx_ = opaque_tid(wv);
    int bidx_ = blockIdx.x, gdim_ = gridDim.x; asm volatile("" : "+s"(bidx_), "+s"(gdim_));
    const int lane = tidx_ & 63, gw = bidx_ * 8 + wv, NGW = gdim_ * 8, m16 = lane & 15, g = lane >> 4;
    LAS unsigned char* xcs = (LAS unsigned char*)smem + 8192 + wv * (64 * RWS);
    const bool bal = NGW == 2048;
    for (int rnd = 0; ; ++rnd) {
        int task;
        if (bal) { if (rnd == 0) task = gw; else if (rnd == 1 && gw >= 256 && gw < 384) task = 2048 + (gw - 256); else break; }
        else { task = gw + rnd * NGW; if (task >= 2176) break; }
        const int c = task % 68, h = (task / 68) & 3, d = (task / 272) & 1, b = task / 544;
        const size_t rb = (size_t)b * TPB;
        {
            const int ch = h * 64 + lane;
            const float* cw = p.in[I_CONVW] + ((l * 2 + d) * 4) * 256 + ch;
            const float cw0 = cw[0], cw1 = cw[256], cw2 = cw[512], cw3 = cw[768], cb = p.in[I_CONVB][(l * 2 + d) * 256 + ch];
            float x1 = 0.f, x2 = 0.f, x3 = 0.f;
            if (c != 0 && c != 4) { x1 = p.P[(rb + rwkv_pos(d, c - 1, 63)) * PST + ch]; x2 = p.P[(rb + rwkv_pos(d, c - 1, 62)) * PST + ch]; x3 = p.P[(rb + rwkv_pos(d, c - 1, 61)) * PST + ch]; }
            __builtin_amdgcn_wave_barrier();
            float xin[64];
            { const int pstep = d == 0 ? PST : -PST; const float* px = p.P + (rb + rwkv_pos(d, c, 0)) * PST + ch;
#pragma unroll
              for (int t = 0; t < 64; ++t) xin[t] = px[(long)t * pstep]; }
#pragma unroll
            for (int t = 0; t < 64; ++t) {
                const float x0 = xin[t];
                const float xc = cb + cw0 * x0 + cw1 * x1 + cw2 * x2 + cw3 * x3;
                x3 = x2; x2 = x1; x1 = x0;
                *(LAS bf16_t*)(xcs + t * RWS + lane * 2) = f2bf(xc);
            }
            __builtin_amdgcn_wave_barrier();
        }
        bf16x8 xb[4][2];
#pragma unroll
        for (int tt = 0; tt < 4; ++tt)
#pragma unroll
            for (int ks = 0; ks < 2; ++ks) xb[tt][ks] = *(const LAS bf16x8*)(xcs + (tt * 16 + m16) * RWS + ks * 64 + g * 16);
        const bf16_t* wt = p.LWT + (size_t)((l * 2 + d) * 4 + h) * 2 * 4096;
#pragma unroll 1
        for (int jt = 0; jt < 4; ++jt) {
            const int j0 = jt * 16 + 4 * g, chj = h * 64 + j0;
            bf16x8 wa[2][2];
#pragma unroll
            for (int gt = 0; gt < 2; ++gt)
#pragma unroll
                for (int ks = 0; ks < 2; ++ks) wa[gt][ks] = *(const bf16x8*)(wt + (size_t)gt * 4096 + (jt * 16 + m16) * 64 + ks * 32 + 8 * g);
            const f32x4 brv = *(const f32x4*)(p.in[I_BR] + (l * 2 + d) * 256 + chj), biv = *(const f32x4*)(p.in[I_BI] + (l * 2 + d) * 256 + chj);
            const f32x4 lamv = *(const f32x4*)(p.in[I_LAM] + (l * 2 + d) * 256 + chj);
            float spl8[4];
#pragma unroll
            for (int r = 0; r < 4; ++r) spl8[r] = -8.0f * softplusf_(-lamv[r]);
            float ca[4] = {1.f, 1.f, 1.f, 1.f}, chh[4] = {0.f, 0.f, 0.f, 0.f};
#pragma unroll
            for (int tt = 0; tt < 4; ++tt) {
                f32x4 dr = {0.f, 0.f, 0.f, 0.f}, di = {0.f, 0.f, 0.f, 0.f};
#pragma unroll
                for (int ks = 0; ks < 2; ++ks) { dr = __builtin_amdgcn_mfma_f32_16x16x32_bf16(wa[0][ks], xb[tt][ks], dr, 0, 0, 0); di = __builtin_amdgcn_mfma_f32_16x16x32_bf16(wa[1][ks], xb[tt][ks], di, 0, 0, 0); }
                const int t = tt * 16 + m16;
                const u32x2 xw = *(const LAS u32x2*)(xcs + t * RWS + j0 * 2);
                const float xcv[4] = {__uint_as_float(xw.x << 16), __uint_as_float(xw.x & 0xffff0000u), __uint_as_float(xw.y << 16), __uint_as_float(xw.y & 0xffff0000u)};
                f32x4 av, bv;
#pragma unroll
                for (int r = 0; r < 4; ++r) {
                    const float gr = sigmoidf_(dr[r] + brv[r]), gi = sigmoidf_(di[r] + biv[r]);
                    const float log_a = gr * spl8[r];
                    float a = __expf(log_a), bb = __builtin_amdgcn_sqrtf(fmaxf(1.f - a * a, 0.f)) * (gi * xcv[r]);
#define SCAN_STEP(sh) { const float ap = DPP_SHR(1.f, a, sh), bp = DPP_SHR(0.f, bb, sh); bb = a * bp + bb; a = a * ap; }
                    SCAN_STEP(1) SCAN_STEP(2) SCAN_STEP(4) SCAN_STEP(8)
#undef SCAN_STEP
                    bb = a * chh[r] + bb; a = a * ca[r];
                    av[r] = a; bv[r] = bb;
                    ca[r] = BCAST15(a); chh[r] = BCAST15(bb);
                }
                const size_t R = rb + rwkv_pos(d, c, t);
                *(f32x4*)(p.LA + ((size_t)d * NROW + R) * 256 + chj) = bv;
                *(f32x4*)(p.LB + ((size_t)d * NROW + R) * 256 + chj) = av;
                if (tt == 3 && m16 == 15) { *(f32x4*)(p.LCE + (size_t)task * 128 + j0) = av; *(f32x4*)(p.LCE + (size_t)task * 128 + 64 + j0) = bv; }
            }
        }
    }
}
__device__ __forceinline__ void d_lru_carry(CParams& p, int widx, int lane) {
    const int gt = widx * 64 + lane;
    const int ch = gt & 255, d = (gt >> 8) & 1, b = gt >> 9, h = ch >> 6, j = ch & 63;
    const float* ce = p.LCE + (size_t)(((b * 2 + d) * 4 + h) * 68) * 128 + j;
    float* ci = p.LCI + (size_t)((b * 2 + d) * 68) * 256 + ch;
    float carry = 0.f;
#pragma unroll 1
    for (int c0 = 0; c0 < 68; c0 += 17) {
        float a[17], e[17];
#pragma unroll
        for (int u = 0; u < 17; ++u) { a[u] = ce[(size_t)(c0 + u) * 128]; e[u] = ce[(size_t)(c0 + u) * 128 + 64]; }
#pragma unroll
        for (int u = 0; u < 17; ++u) { ci[(size_t)(c0 + u) * 256] = carry; carry = a[u] * carry + e[u]; }
    }
}
__device__ __forceinline__ float lru_h(CParams& p, int b, int pos, size_t R, int d, int ch) {
    const int sidx = d == 0 ? pos : (pos < CTXL ? CTXL - 1 - pos : CTXL + (TPB - 1 - pos));
    const float ci = p.LCI[(size_t)((b * 2 + d) * 68 + (sidx >> 6)) * 256 + ch];
    return p.LA[((size_t)d * NROW + R) * 256 + ch] + p.LB[((size_t)d * NROW + R) * 256 + ch] * ci;
}

__device__ __forceinline__ void d_rwkv_pre(CParams& p, int wv, int l) {
    const int tidx_ = opaque_tid(wv);
    int bidx_ = blockIdx.x, gdim_ = gridDim.x; asm volatile("" : "+s"(bidx_), "+s"(gdim_));
    const int lane = tidx_ & 63, gw = bidx_ * 8 + wv, NGW = gdim_ * 8, m16 = lane & 15, g = lane >> 4;
    LAS unsigned char* stash = (LAS unsigned char*)smem + 90112 + wv * (3 * 16 * RWS);
    const float* mu = p.in[I_MU] + l * 2 * 960;
    const int gw2 = NGW == 2048 ? (gw + 1088) % 2048 : gw;
    for (int tile = gw2; tile < NROW / 16; tile += NGW) {
        const int R0 = tile * 16;
#pragma unroll 2
        for (int rr = 0; rr < 16; ++rr) {
            const int R = R0 + rr, pos = R % TPB;
            const int seg0 = pos < CTXL ? 0 : CTXL, seg1 = pos < CTXL ? CTXL : TPB;
            const float* pr = p.P + (size_t)R * PST + 512;
            float sv[15];
#pragma unroll
            for (int q = 0; q < 15; ++q) {
                const int col = lane + 64 * q;
                const float v = pr[col];
                const float pv = pos > seg0 ? pr[col - PST] : 0.f;
                const float nv = pos + 1 < seg1 ? pr[col + PST] : 0.f;
                sv[q] = v + mu[col] * (pv - v) + mu[960 + col] * (nv - v);
            }
#pragma unroll
            for (int q = 0; q < 12; ++q) p.RS[(size_t)R * 768 + lane + 64 * q] = sv[q];
            *(LAS bf16_t*)(stash + (0 * 16 + rr) * RWS + lane * 2) = f2bf(tanh_fast(sv[12]));
            *(LAS bf16_t*)(stash + (1 * 16 + rr) * RWS + lane * 2) = f2bf(sv[13]);
            *(LAS bf16_t*)(stash + (2 * 16 + rr) * RWS + lane * 2) = f2bf(sigmoidf_(sv[14]));
#pragma unroll
            for (int hq = 0; hq < 4; ++hq) {
                const int c = hq * 64 + lane;
                const float kk = sv[4 + hq] * p.in[I_KK][l * 256 + c];
                const float n2 = wave_sum(kk * kk);
                p.KKN[(size_t)R * 256 + c] = kk / fmaxf(sqrtf(n2), 1e-12f);
            }
        }
        __builtin_amdgcn_wave_barrier();
#pragma unroll 1
        for (int mtx = 0; mtx < 5; ++mtx) {
            const int src = mtx < 2 ? 0 : (mtx < 4 ? 1 : 2), d = mtx & 1;
            const bf16x8 a0 = *(const LAS bf16x8*)(stash + (src * 16 + m16) * RWS + g * 16), a1 = *(const LAS bf16x8*)(stash + (src * 16 + m16) * RWS + 64 + g * 16);
            const bf16_t* wt = p.RWT + (size_t)(l * 5 + mtx) * 16384;
#pragma unroll 4
            for (int ct = 0; ct < 16; ++ct) {
                const bf16_t* wr_ = wt + (size_t)(ct * 16 + m16) * 64 + 8 * g;
                const bf16x8 b0 = *(const bf16x8*)wr_, b1 = *(const bf16x8*)(wr_ + 32);
                f32x4 acc = {0.f, 0.f, 0.f, 0.f};
                acc = __builtin_amdgcn_mfma_f32_16x16x32_bf16(a0, b0, acc, 0, 0, 0);
                acc = __builtin_amdgcn_mfma_f32_16x16x32_bf16(a1, b1, acc, 0, 0, 0);
                const int ch = ct * 16 + m16;
                if (mtx < 2) {
                    const float w0 = p.in[I_W0][(l * 2 + d) * 256 + ch];
#pragma unroll
                    for (int r = 0; r < 4; ++r) { const float w = -softplus_fast(-(w0 + acc[r])) - 0.5f; p.DEC[((size_t)d * NROW + R0 + 4 * g + r) * 256 + ch] = -__expf(w); }
                } else if (mtx < 4) {
                    const float a0_ = p.in[I_A0][(l * 2 + d) * 256 + ch];
#pragma unroll
                    for (int r = 0; r < 4; ++r) p.AIC[((size_t)d * NROW + R0 + 4 * g + r) * 256 + ch] = sigmoidf_(a0_ + acc[r]);
                } else {
#pragma unroll
                    for (int r = 0; r < 4; ++r) p.GG[(size_t)(R0 + 4 * g + r) * 256 + ch] = acc[r];
                }
            }
        }
        __builtin_amdgcn_wave_barrier();
    }
}
#define RSLOT(k) (lds + (k) * 9216)
__device__ __forceinline__ void mm2(const LAS unsigned char* Xr, const LAS unsigned char* Yt, int mi, int ni0, int lane, f32x4 (&acc)[2]) {
    const int m = lane & 15, g = lane >> 4;
#pragma unroll
    for (int ks = 0; ks < 2; ++ks) {
        const bf16x8 a = *(const LAS bf16x8*)(Xr + (mi * 16 + m) * RWS + ks * 64 + g * 16);
#pragma unroll
        for (int n = 0; n < 2; ++n) {
            const bf16x8 b = *(const LAS bf16x8*)(Yt + ((ni0 + n) * 16 + m) * RWS + ks * 64 + g * 16);
            acc[n] = __builtin_amdgcn_mfma_f32_16x16x32_bf16(a, b, acc[n], 0, 0, 0);
        }
    }
}
__device__ __forceinline__ void st_r(LAS unsigned char* dst, int mi, int ni, int lane, const f32x4& v) {
    const int m = lane & 15, g = lane >> 4;
#pragma unroll
    for (int r = 0; r < 4; ++r) *(LAS bf16_t*)(dst + (mi * 16 + 4 * g + r) * RWS + (ni * 16 + m) * 2) = f2bf(v[r]);
}
__device__ __forceinline__ void st_t(LAS unsigned char* dst, int mi, int ni, int lane, const f32x4& v) {
    const int m = lane & 15, g = lane >> 4;
    u32x2 o; o.x = cvt_pk_bf16(v[0], v[1]); o.y = cvt_pk_bf16(v[2], v[3]);
    *(LAS u32x2*)(dst + (ni * 16 + m) * RWS + (mi * 16 + 4 * g) * 2) = o;
}
__device__ __forceinline__ float bfbits2f(unsigned short v) { return __uint_as_float(((unsigned)v) << 16); }

__device__ __forceinline__ void d_rwkv_chunkA(CParams& p, int wv, int l) {
    const int tidx_ = opaque_tid(wv);
    int bidx_ = blockIdx.x, gdim_ = gridDim.x; asm volatile("" : "+s"(bidx_), "+s"(gdim_));
    LAS unsigned char* lds = (LAS unsigned char*)smem;
    LAS float* segtot = (LAS float*)(lds + 16 * 9216);
    LAS float* gam = segtot + 512;
    const int tid = tidx_, lane = tid & 63, w = wv;
    const int mi = w >> 1, ni0 = (w & 1) * 2, m16 = lane & 15, g = lane >> 4;
    for (int task = bidx_; task < 2176; task += gdim_) {
        const int c = task % 68, d = (task / 68) & 1, h = (task / 136) & 3, b = task / 544;
        __syncthreads();
        {
            const int j = lane, tq = w, hc = h * 64 + j;
            const float ka = p.in[I_KA][l * 256 + hc];
            float lw[8], aa[8], bb[8], ke[8], rr[8], vv[8];
#pragma unroll
            for (int u = 0; u < 8; ++u) {
                const size_t R = (size_t)b * TPB + rwkv_pos(d, c, 8 * tq + u);
                lw[u] = p.DEC[((size_t)d * NROW + R) * 256 + hc];
                const float aic = p.AIC[((size_t)d * NROW + R) * 256 + hc], kkn = p.KKN[R * 256 + hc];
                const float* rs = p.RS + R * 768;
                rr[u] = rs[hc]; const float k = rs[256 + hc]; vv[u] = rs[512 + hc];
                aa[u] = -kkn; bb[u] = kkn * aic; ke[u] = k * (1.f + (aic - 1.f) * ka);
            }
            float cs[8]; cs[0] = lw[0];
#pragma unroll
            for (int u = 1; u < 8; ++u) cs[u] = cs[u - 1] + lw[u];
            segtot[tq * 64 + j] = cs[7];
            __syncthreads();
            float pre = 0.f, tot = 0.f;
#pragma unroll
            for (int q = 0; q < 8; ++q) { const float sgt = segtot[q * 64 + j]; tot += sgt; if (q < tq) pre += sgt; }
            if (tq == 0) gam[j] = __expf(tot);
            float at[8], bt[8], kt[8];
#pragma unroll
            for (int u = 0; u < 8; ++u) {
                const float Lc = pre + cs[u], Lp = Lc - lw[u];
                const float ep = __expf(Lp), ec = __expf(Lc), en = __expf(-Lc), ee = __expf(tot - Lc);
                const int t = 8 * tq + u;
                at[u] = aa[u] * ep; bt[u] = bb[u] * ee; kt[u] = ke[u] * ee;
                *(LAS bf16_t*)(RSLOT(0) + t * RWS + j * 2) = f2bf(at[u]);
                *(LAS bf16_t*)(RSLOT(1) + t * RWS + j * 2) = f2bf(rr[u] * ec);
                *(LAS bf16_t*)(RSLOT(2) + t * RWS + j * 2) = f2bf(bb[u] * en);
                *(LAS bf16_t*)(RSLOT(3) + t * RWS + j * 2) = f2bf(ke[u] * en);
            }
            u32x4 o;
            o.x = cvt_pk_bf16(at[0], at[1]); o.y = cvt_pk_bf16(at[2], at[3]); o.z = cvt_pk_bf16(at[4], at[5]); o.w = cvt_pk_bf16(at[6], at[7]);
            *(LAS u32x4*)(RSLOT(4) + j * RWS + tq * 16) = o;
            o.x = cvt_pk_bf16(bt[0], bt[1]); o.y = cvt_pk_bf16(bt[2], bt[3]); o.z = cvt_pk_bf16(bt[4], bt[5]); o.w = cvt_pk_bf16(bt[6], bt[7]);
            *(LAS u32x4*)(RSLOT(5) + j * RWS + tq * 16) = o;
            o.x = cvt_pk_bf16(kt[0], kt[1]); o.y = cvt_pk_bf16(kt[2], kt[3]); o.z = cvt_pk_bf16(kt[4], kt[5]); o.w = cvt_pk_bf16(kt[6], kt[7]);
            *(LAS u32x4*)(RSLOT(6) + j * RWS + tq * 16) = o;
            o.x = cvt_pk_bf16(vv[0], vv[1]); o.y = cvt_pk_bf16(vv[2], vv[3]); o.z = cvt_pk_bf16(vv[4], vv[5]); o.w = cvt_pk_bf16(vv[6], vv[7]);
            *(LAS u32x4*)(RSLOT(7) + j * RWS + tq * 16) = o;
        }
        __syncthreads();
        {
            f32x4 aab[2] = {}, aak[2] = {}, brb[2] = {}, brk[2] = {};
            mm2(RSLOT(0), RSLOT(2), mi, ni0, lane, aab); mm2(RSLOT(0), RSLOT(3), mi, ni0, lane, aak);
            mm2(RSLOT(1), RSLOT(2), mi, ni0, lane, brb); mm2(RSLOT(1), RSLOT(3), mi, ni0, lane, brk);
#pragma unroll
            for (int n = 0; n < 2; ++n) {
                f32x4 p0;
#pragma unroll
                for (int r = 0; r < 4; ++r) {
                    const int t = mi * 16 + 4 * g + r, sidx = (ni0 + n) * 16 + m16;
                    if (!(sidx < t)) { aab[n][r] = 0.f; aak[n][r] = 0.f; }
                    if (!(sidx <= t)) { brb[n][r] = 0.f; brk[n][r] = 0.f; }
                    p0[r] = aab[n][r] + (sidx == t ? 1.f : 0.f);
                }
                st_r(RSLOT(11), mi, ni0 + n, lane, aab[n]); st_t(RSLOT(12), mi, ni0 + n, lane, aab[n]);
                st_t(RSLOT(13), mi, ni0 + n, lane, p0);
                st_r(RSLOT(8), mi, ni0 + n, lane, aak[n]); st_r(RSLOT(9), mi, ni0 + n, lane, brb[n]); st_r(RSLOT(10), mi, ni0 + n, lane, brk[n]);
            }
        }
        __syncthreads();
#pragma unroll 1
        for (int st = 1; st <= 6; ++st) {
            LAS unsigned char* qsr = (st & 1) ? RSLOT(11) : RSLOT(0);
            LAS unsigned char* qst = (st & 1) ? RSLOT(12) : RSLOT(2);
            LAS unsigned char* qdr = (st & 1) ? RSLOT(0) : RSLOT(11);
            LAS unsigned char* qdt = (st & 1) ? RSLOT(2) : RSLOT(12);
            if (st <= 5) {
                f32x4 q[2] = {};
                mm2(qsr, qst, mi, ni0, lane, q);
#pragma unroll
                for (int n = 0; n < 2; ++n) { st_r(qdr, mi, ni0 + n, lane, q[n]); st_t(qdt, mi, ni0 + n, lane, q[n]); }
            }
            if (st >= 2) {
                LAS unsigned char* ps = (st & 1) ? RSLOT(3) : RSLOT(13);
                LAS unsigned char* pd = (st & 1) ? RSLOT(13) : RSLOT(3);
                f32x4 pp[2];
#pragma unroll
                for (int n = 0; n < 2; ++n) {
                    const u32x2 o = *(const LAS u32x2*)(ps + ((ni0 + n) * 16 + m16) * RWS + (mi * 16 + 4 * g) * 2);
                    pp[n][0] = __uint_as_float(o.x << 16); pp[n][1] = __uint_as_float(o.x & 0xffff0000u); pp[n][2] = __uint_as_float(o.y << 16); pp[n][3] = __uint_as_float(o.y & 0xffff0000u);
                }
                mm2(qsr, ps, mi, ni0, lane, pp);
#pragma unroll
                for (int n = 0; n < 2; ++n) { st_t(pd, mi, ni0 + n, lane, pp[n]); if (st == 6) st_r(RSLOT(15), mi, ni0 + n, lane, pp[n]); }
            }
            if (st == 1) {
                f32x4 akv[2] = {};
                mm2(RSLOT(8), RSLOT(7), mi, ni0, lane, akv);
#pragma unroll
                for (int n = 0; n < 2; ++n) st_t(RSLOT(14), mi, ni0 + n, lane, akv[n]);
            }
            __syncthreads();
        }
        {
            f32x4 w1[2] = {}, z[2] = {};
            mm2(RSLOT(15), RSLOT(4), mi, ni0, lane, w1); mm2(RSLOT(15), RSLOT(14), mi, ni0, lane, z);
#pragma unroll
            for (int n = 0; n < 2; ++n) { st_t(RSLOT(11), mi, ni0 + n, lane, w1[n]); st_t(RSLOT(12), mi, ni0 + n, lane, z[n]); }
        }
        __syncthreads();
        {
            f32x4 mm_[2] = {}, nn[2] = {}, qq[2] = {}, yl[2] = {};
            mm2(RSLOT(5), RSLOT(11), mi, ni0, lane, mm_);
            mm2(RSLOT(5), RSLOT(12), mi, ni0, lane, nn); mm2(RSLOT(6), RSLOT(7), mi, ni0, lane, nn);
            mm2(RSLOT(9), RSLOT(11), mi, ni0, lane, qq);
            mm2(RSLOT(9), RSLOT(12), mi, ni0, lane, yl); mm2(RSLOT(10), RSLOT(7), mi, ni0, lane, yl);
#pragma unroll
            for (int n = 0; n < 2; ++n) {
#pragma unroll
                for (int r = 0; r < 4; ++r) {
                    const int row = mi * 16 + 4 * g + r, col = (ni0 + n) * 16 + m16;
                    if (row == col) mm_[n][r] += gam[row];
                    qq[n][r] += bfbits2f(*(const LAS bf16_t*)(RSLOT(1) + row * RWS + col * 2));
                }
                st_r(RSLOT(0), mi, ni0 + n, lane, mm_[n]); st_r(RSLOT(2), mi, ni0 + n, lane, qq[n]);
                *(f32x4*)(p.RNF + (size_t)task * 4096 + (((ni0 + n) * 4 + mi) * 64 + lane) * 4) = nn[n];
#pragma unroll
                for (int r = 0; r < 4; ++r) p.RYF[(size_t)task * 4096 + (mi * 16 + 4 * g + r) * 64 + (ni0 + n) * 16 + m16] = yl[n][r];
            }
        }
        __syncthreads();
        {
            const int jb = tid >> 7, sk = (tid >> 6) & 1;
            const int row = jb * 16 + m16;
            const u32x2 m0 = *(const LAS u32x2*)(RSLOT(0) + row * RWS + (32 * sk + 4 * g) * 2), m1 = *(const LAS u32x2*)(RSLOT(0) + row * RWS + (32 * sk + 16 + 4 * g) * 2);
            const u32x2 q0 = *(const LAS u32x2*)(RSLOT(2) + row * RWS + (32 * sk + 4 * g) * 2), q1 = *(const LAS u32x2*)(RSLOT(2) + row * RWS + (32 * sk + 16 + 4 * g) * 2);
            *(u32x4*)(p.RMF + (size_t)task * 4096 + (size_t)tid * 8) = (u32x4){m0.x, m0.y, m1.x, m1.y};
            *(u32x4*)(p.RQF + (size_t)task * 4096 + (size_t)tid * 8) = (u32x4){q0.x, q0.y, q1.x, q1.y};
        }
    }
    __syncthreads();
}

#define SEQ_LOAD(M_, N_, cc) do { const int c_ = (cc) < 68 ? (cc) : 67; const size_t tk_ = task0 + c_; \
    const bf16x8* mf_ = (const bf16x8*)(p.RMF + tk_ * 4096) + lane; const f32x4* nf_ = (const f32x4*)(p.RNF + tk_ * 4096) + (ib * 4) * 64 + lane; \
    _Pragma("unroll") for (int jb = 0; jb < 4; ++jb) { M_[jb][0] = mf_[(jb * 2) * 64]; M_[jb][1] = mf_[(jb * 2 + 1) * 64]; N_[jb] = nf_[jb * 64]; } } while (0)
#define SEQ_STEP(M_, N_, cc) do { bf16x8 bfr[2]; \
    _Pragma("unroll") for (int sk = 0; sk < 2; ++sk) { union { u32x4 u; bf16x8 v; } cv; \
        cv.u.x = cvt_pk_bf16(S[2 * sk][0], S[2 * sk][1]); cv.u.y = cvt_pk_bf16(S[2 * sk][2], S[2 * sk][3]); \
        cv.u.z = cvt_pk_bf16(S[2 * sk + 1][0], S[2 * sk + 1][1]); cv.u.w = cvt_pk_bf16(S[2 * sk + 1][2], S[2 * sk + 1][3]); bfr[sk] = cv.v; \
        *((bf16x8*)(p.S0F + (task0 + (cc)) * 4096) + (ib * 2 + sk) * 64 + lane) = cv.v; } \
    _Pragma("unroll") for (int jb = 0; jb < 4; ++jb) { f32x4 a_ = N_[jb]; \
        a_ = __builtin_amdgcn_mfma_f32_16x16x32_bf16(M_[jb][0], bfr[0], a_, 0, 0, 0); a_ = __builtin_amdgcn_mfma_f32_16x16x32_bf16(M_[jb][1], bfr[1], a_, 0, 0, 0); S[jb] = a_; } } while (0)
__device__ __forceinline__ void d_rwkv_seq(CParams& p, int widx, int ib, int lane) {
    const int d = widx & 1, h = (widx >> 1) & 3, b = widx >> 3;
    f32x4 S[4];
#pragma unroll
    for (int jb = 0; jb < 4; ++jb) S[jb] = (f32x4){0.f, 0.f, 0.f, 0.f};
    const size_t task0 = (size_t)((b * 4 + h) * 2 + d) * 68;
    bf16x8 MA[4][2], MB[4][2], MC[4][2]; f32x4 NA[4], NB[4], NC[4];
    SEQ_LOAD(MA, NA, 0); SEQ_LOAD(MB, NB, 1);
#pragma unroll 1
    for (int c = 0; c < 66; c += 3) {
        SEQ_LOAD(MC, NC, c + 2); SEQ_STEP(MA, NA, c);
        SEQ_LOAD(MA, NA, c + 3); SEQ_STEP(MB, NB, c + 1);
        SEQ_LOAD(MB, NB, c + 4); SEQ_STEP(MC, NC, c + 2);
    }
    SEQ_STEP(MA, NA, 66); SEQ_STEP(MB, NB, 67);
}

__device__ __forceinline__ float xor16_max(float v) { return fmaxf(v, SWZ_XOR(v, 16)); }
__device__ __forceinline__ float max_xor32(float v) {
    int a = __float_as_int(v), b = a;
    asm volatile("s_nop 1\n\tv_permlane32_swap_b32 %0, %1\n\ts_nop 1" : "+v"(a), "+v"(b));
    return fmaxf(__int_as_float(a), __int_as_float(b));
}
#define NA_KB 15360
#define NA_KC 98304
#define NA_KST 144
#define NA_VBS 1168
#define NA_VCS 528
template <bool BAND>
__device__ __forceinline__ void attn_scores(const LAS unsigned char* kbase  , int ustride  ,
                                            const bf16x8 (&qf)[2], const float* rpbh, int c, int rr, int rs, int kc0, int lane, float& mrow, float& lrow, bf16x8 (&pf)[8]) {
    const int g = lane >> 4;
    f32x4 sc[16];
#pragma unroll
    for (int u = 0; u < 8; ++u) {
#pragma unroll
        for (int j2 = 0; j2 < 2; ++j2) {
            const LAS unsigned char* kr = kbase + u * ustride + j2 * (16 * NA_KST);
            const bf16x8 k0 = *(const LAS bf16x8*)kr, k1 = *(const LAS bf16x8*)(kr + 64);
            f32x4 a = {0.f, 0.f, 0.f, 0.f};
            a = __builtin_amdgcn_mfma_f32_16x16x32_bf16(k0, qf[0], a, 0, 0, 0);
            a = __builtin_amdgcn_mfma_f32_16x16x32_bf16(k1, qf[1], a, 0, 0, 0);
            if (BAND) {
                const int cs = min(max(c - 8, 0), 48);
#pragma unroll
                for (int r = 0; r < 4; ++r) {
                    const int kc = kc0 + 16 * j2 + 4 * g + r;
                    const int cb = min(max(kc - c + 15, 0), 30);
                    const float bias = rpbh[(rs + u - rr + 7) * 31 + cb];
                    a[r] = (kc >= cs && kc < cs + 16) ? a[r] + bias : -1e30f;
                }
            }
            sc[2 * u + j2] = a;
        }
    }
    float mx = -1e30f;
#pragma unroll
    for (int t = 0; t < 16; ++t) mx = fmaxf(mx, fmaxf(fmaxf(sc[t][0], sc[t][1]), fmaxf(sc[t][2], sc[t][3])));
    mx = xor16_max(mx); mx = max_xor32(mx);
    float sum = 0.f;
#pragma unroll
    for (int t = 0; t < 16; ++t)
#pragma unroll
        for (int r = 0; r < 4; ++r) { const float e = __expf(sc[t][r] - mx); sc[t][r] = e; sum += e; }
    sum += SWZ_XOR(sum, 16); sum = sum_xor32(sum);
    mrow = mx; lrow = sum;
#pragma unroll
    for (int u = 0; u < 8; ++u) {
        union { u32x4 w; bf16x8 v; } t;
        t.w.x = cvt_pk_bf16(sc[2 * u][0], sc[2 * u][1]); t.w.y = cvt_pk_bf16(sc[2 * u][2], sc[2 * u][3]);
        t.w.z = cvt_pk_bf16(sc[2 * u + 1][0], sc[2 * u + 1][1]); t.w.w = cvt_pk_bf16(sc[2 * u + 1][2], sc[2 * u + 1][3]);
        pf[u] = t.v;
    }
}
__device__ __forceinline__ void attn_pv(const LAS unsigned char* vbase, int vstride  , int ustride  , const bf16x8 (&pf)[8], f32x4 (&o)[4]) {
#pragma unroll
    for (int dt = 0; dt < 4; ++dt) o[dt] = (f32x4){0.f, 0.f, 0.f, 0.f};
#pragma unroll
    for (int u = 0; u < 8; ++u)
#pragma unroll
        for (int dt = 0; dt < 4; ++dt) {
            const LAS unsigned char* vr = vbase + dt * 16 * vstride + u * ustride;
            const u32x2 v0 = *(const LAS u32x2*)vr, v1 = *(const LAS u32x2*)(vr + 32);
            union { u32x4 w; bf16x8 v; } vf; vf.w = (u32x4){v0.x, v0.y, v1.x, v1.y};
            o[dt] = __builtin_amdgcn_mfma_f32_16x16x32_bf16(vf.v, pf[u], o[dt], 0, 0, 0);
        }
}
__device__ __forceinline__ void d_na(CParams& p, int wv, int l, int do_ctx, int bid, int nblk) {
    const int tidx_ = opaque_tid(wv);
    const int lane = tidx_ & 63, m16 = lane & 15, g = lane >> 4;
    LAS unsigned char* lds = (LAS unsigned char*)smem;
    const float* rpbs = (const float*)smem;
    const int nbt = 1024 + (do_ctx ? 64 : 0);
    for (int bt = bid; bt < nbt; bt += nblk) {
        const bool lat = bt < 1024;
        int b, h, rs0 = 0, nrows = 0, rr = 0, rs = 0, c0 = 0, kc0 = 0, qpos0;
        if (lat) { b = bt >> 8; h = (bt >> 5) & 7; const int r0 = (bt & 31) * 2; rs0 = min(max(r0 - 4, 0), 56); nrows = min(9, 64 - rs0);
            rr = r0 + (wv >> 2); rs = min(max(rr - 4, 0), 56); c0 = (wv & 3) * 16; kc0 = min(max(c0 - 8, 0), 32); qpos0 = CTXL + rr * 64 + c0; }
        else { const int t2 = bt - 1024; b = t2 >> 4; h = (t2 >> 1) & 7; qpos0 = ((t2 & 1) * 8 + wv) * 16; }
        const bf16_t* QHh = p.QH + (size_t)(b * 8 + h) * TPB * 64;
        const bf16_t* KHh = p.KH + (size_t)(b * 8 + h) * TPB * 64;
        const bf16_t* VTh = p.VT + (size_t)(b * 8 + h) * 64 * TPB;
        const int kpos0 = CTXL + rs0 * 64, nkb = nrows * 64;
        bf16x8 qf[2];
        { const bf16_t* qr = QHh + (size_t)(qpos0 + m16) * 64 + 8 * g; qf[0] = *(const bf16x8*)qr; qf[1] = *(const bf16x8*)(qr + 32); }
        __syncthreads();
        for (int q = tidx_; q < nkb * 8; q += NTHR) { const int key = q >> 3, part = q & 7; *(LAS u32x4*)(lds + NA_KB + key * NA_KST + part * 16) = *(const u32x4*)(KHh + (size_t)(kpos0 + key) * 64 + part * 8); }
        for (int q = tidx_; q < 256 * 8; q += NTHR) { const int key = q >> 3, part = q & 7; *(LAS u32x4*)(lds + NA_KC + key * NA_KST + part * 16) = *(const u32x4*)(KHh + (size_t)key * 64 + part * 8); }
        __syncthreads();
        float m1 = -1e30f, l1 = 0.f, m2, l2; bf16x8 pf1[8], pf2[8];
        const int c = c0 + m16, lr0 = rs - rs0;
        attn_scores<false>(lds + NA_KC + m16 * NA_KST + 16 * g, 32 * NA_KST, qf, nullptr, 0, 0, 0, 0, lane, m2, l2, pf2);
        if (lat) attn_scores<true>(lds + NA_KB + ((lr0 * 64 + kc0 + m16) * NA_KST) + 16 * g, 64 * NA_KST, qf, rpbs + h * 465, c, rr, rs, kc0, lane, m1, l1, pf1);
        __syncthreads();
        if (lat) for (int q = tidx_; q < 64 * nrows * 8; q += NTHR) { const int dim = q / (nrows * 8), part = q % (nrows * 8);
            *(LAS u32x4*)(lds + NA_KB + dim * NA_VBS + part * 16) = *(const u32x4*)(VTh + (size_t)dim * TPB + kpos0 + part * 8); }
        for (int q = tidx_; q < 64 * 32; q += NTHR) { const int dim = q >> 5, part = q & 31; *(LAS u32x4*)(lds + NA_KC + dim * NA_VCS + part * 16) = *(const u32x4*)(VTh + (size_t)dim * TPB + part * 8); }
        __syncthreads();
        f32x4 o2[4]; float inv;
        attn_pv(lds + NA_KC + m16 * NA_VCS + 8 * g, NA_VCS, 64, pf2, o2);
        if (lat) {
            f32x4 o1[4];
            attn_pv(lds + NA_KB + m16 * NA_VBS + (lr0 * 64 + kc0) * 2 + 8 * g, NA_VBS, 128, pf1, o1);
            const float mm = fmaxf(m1, m2), f1 = __expf(m1 - mm), f2 = __expf(m2 - mm);
            inv = 1.f / (l1 * f1 + l2 * f2);
#pragma unroll
            for (int dt = 0; dt < 4; ++dt) o2[dt] = o1[dt] * f1 + o2[dt] * f2;
        } else inv = 1.f / l2;
        bf16_t* orow = p.MIX + (size_t)(b * TPB + qpos0 + m16) * DM + 512 + h * 64 + 4 * g;
#pragma unroll
        for (int dt = 0; dt < 4; ++dt) {
            const f32x4 v = o2[dt] * inv;
            u32x2 ov; ov.x = cvt_pk_bf16(v[0], v[1]); ov.y = cvt_pk_bf16(v[2], v[3]);
            *(u32x2*)(orow + dt * 16) = ov;
        }
    }
}

__device__ __forceinline__ void d_scan_attn(CParams& p, int wv, int l, int do_ctx) {
    const int tidx_ = opaque_tid(wv);
    int bidx_ = blockIdx.x, gdim_ = gridDim.x; asm volatile("" : "+s"(bidx_), "+s"(gdim_));
    const int wave = tidx_ >> 6, lane = tidx_ & 63;
    if (bidx_ < 32) {
        if (wave < 4) d_rwkv_seq(p, bidx_, wave, lane);
        else if (wave == 4) d_lru_carry(p, bidx_, lane);
        return;
    }
    { float* rpbs = (float*)smem; for (int i = tidx_; i < 8 * 15 * 31; i += NTHR) rpbs[i] = p.in[I_RPB][(size_t)l * 8 * 15 * 31 + i]; }
    __syncthreads();
    d_na(p, wv, l, do_ctx, bidx_ - 32, gdim_ - 32);
}

#define SWZ16(v, o) __int_as_float(__builtin_amdgcn_ds_swizzle(__float_as_int(v), ((o) << 10) | 0x1f))
__device__ __forceinline__ float row16_sum(float v) { v += SWZ16(v, 1); v += SWZ16(v, 2); v += SWZ16(v, 4); v += SWZ16(v, 8); return v; }
__device__ __forceinline__ void d_finish(CParams& p, int wv, int l, int skip_ctx) {
    const int tidx_ = opaque_tid(wv);
    int bidx_ = blockIdx.x, gdim_ = gridDim.x; asm volatile("" : "+s"(bidx_), "+s"(gdim_));
    const int lane = tidx_ & 63, gw = bidx_ * 8 + wv, NGW = gdim_ * 8, m16 = lane & 15, g = lane >> 4;
    for (int it = gw; it < NROW * 4; it += NGW) {
        const int R = it >> 2, h = it & 3, c = h * 64 + lane;
        if (skip_ctx && (R % TPB) < CTXL) continue;
        const float gg = p.P[(size_t)R * PST + 256 + c];
        p.MIX[(size_t)R * DM + c] = f2bf(gelu_tanh(gg) * (lru_h(p, R / TPB, R % TPB, R, 0, c) + lru_h(p, R / TPB, R % TPB, R, 1, c)));
    }
    for (int it = gw; it < 4 * 4 * 272; it += NGW) {
        const int pt = it % 272, h = (it / 272) & 3, b = it / 1088;
        if (skip_ctx && pt < 16) continue;
        const int p0 = pt * 16;
        f32x4 y[4];
#pragma unroll
        for (int q = 0; q < 4; ++q) y[q] = (f32x4){0.f, 0.f, 0.f, 0.f};
#pragma unroll
        for (int d = 0; d < 2; ++d) {
            const int s0 = d == 0 ? p0 : (p0 < CTXL ? CTXL - 1 - p0 : CTXL + (TPB - 1 - p0));
            const int c = s0 >> 6, tb = (s0 & 63) >> 4;
            const size_t tk = (size_t)((b * 4 + h) * 2 + d) * 68 + c;
            const int lsrc = d == 0 ? lane : ((15 - m16) | (g << 4));
            const bf16x8* qf = (const bf16x8*)(p.RQF + tk * 4096) + (tb * 2) * 64 + lsrc;
            const bf16x8 q0 = qf[0], q1 = qf[64];
            const bf16x8* sf = (const bf16x8*)(p.S0F + tk * 4096) + lane;
            const float* yl = p.RYF + tk * 4096;
#pragma unroll
            for (int q = 0; q < 4; ++q) {
                f32x4 a;
#pragma unroll
                for (int r = 0; r < 4; ++r) { const int t = tb * 16 + (d == 0 ? 4 * g + r : 15 - (4 * g + r)); a[r] = yl[t * 64 + q * 16 + m16]; }
                a = __builtin_amdgcn_mfma_f32_16x16x32_bf16(q0, sf[(q * 2) * 64], a, 0, 0, 0);
                a = __builtin_amdgcn_mfma_f32_16x16x32_bf16(q1, sf[(q * 2 + 1) * 64], a, 0, 0, 0);
                y[q] += a;
            }
        }
        float mean[4], rstd[4], bon[4];
        float kav[4], rkv[4], lgv[4], lbv[4];
#pragma unroll
        for (int q = 0; q < 4; ++q) { const int c = h * 64 + q * 16 + m16; kav[q] = p.in[I_KA][l * 256 + c]; rkv[q] = p.in[I_RK][l * 256 + c]; lgv[q] = p.in[I_LNG][l * 256 + c]; lbv[q] = p.in[I_LNB][l * 256 + c]; }
        float rv[4][4], vv[4][4], gv[4][4];
#pragma unroll
        for (int r = 0; r < 4; ++r) {
            const size_t R = (size_t)b * TPB + p0 + 4 * g + r;
            float sm = 0.f, bs = 0.f;
#pragma unroll
            for (int q = 0; q < 4; ++q) {
                const int c = h * 64 + q * 16 + m16;
                const float* rs = p.RS + R * 768;
                const float rr_ = rs[c], kk_ = rs[256 + c]; vv[r][q] = rs[512 + c]; gv[r][q] = p.GG[R * 256 + c]; rv[r][q] = rr_;
                const float a0 = p.AIC[R * 256 + c], a1 = p.AIC[((size_t)NROW + R) * 256 + c];
                bs += rr_ * kk_ * rkv[q] * ((1.f + (a0 - 1.f) * kav[q]) + (1.f + (a1 - 1.f) * kav[q]));
                sm += y[q][r];
            }
            mean[r] = row16_sum(sm) * (1.f / 64.f); bon[r] = row16_sum(bs);
            float vs = 0.f;
#pragma unroll
            for (int q = 0; q < 4; ++q) { const float dv = y[q][r] - mean[r]; vs += dv * dv; }
            rstd[r] = rsqrtf(row16_sum(vs) * (1.f / 64.f) + 64e-5f);
        }
#pragma unroll
        for (int r = 0; r < 4; ++r) {
            const size_t R = (size_t)b * TPB + p0 + 4 * g + r;
#pragma unroll
            for (int q = 0; q < 4; ++q) {
                const float o = ((y[q][r] - mean[r]) * rstd[r] * lgv[q] + lbv[q] + bon[r] * vv[r][q]) * gv[r][q];
                p.MIX[R * DM + 256 + h * 64 + q * 16 + m16] = f2bf(o);
            }
        }
        (void)rv;
    }
}

__device__ __forceinline__ void d_norm_router(CParams& p, int wv, int l, int skip_ctx) {
    const int tidx_ = opaque_tid(wv);
    int bidx_ = blockIdx.x, gdim_ = gridDim.x; asm volatile("" : "+s"(bidx_), "+s"(gdim_));
    const int lane = tidx_ & 63, m16 = lane & 15, g = lane >> 4;
    const int gtid = bidx_ * NTHR + tidx_, gsz = gdim_ * NTHR;
    for (int i = gtid; i < CAP; i += gsz) p.SLOT_TOK[i] = 0;
    LAS float* hs = (LAS float*)smem;
    LAS float* part = hs + 16 * 1028;
    LAS int* lcnt = (LAS int*)(part + 8 * 16 * 32);
    if (tidx_ < 64) lcnt[tidx_] = 0;
    const float* rw = p.in[I_RTW] + (size_t)l * DM * 32;
    const float* gn = p.in[I_NFG] + l * DM;
    int* cnt = p.CNT + l * 32;
    for (int tile = bidx_; tile < NROW / 16; tile += gdim_) {
        const int R0 = tile * 16, b = R0 / TPB, pos0 = R0 % TPB, mr = pos0 < CTXL ? 4 : b;
        if (skip_ctx && pos0 < CTXL) continue;
        const float* mod = p.MOD + (l * 5 + mr) * 6144 + 3 * DM;
        __syncthreads();
#pragma unroll 1
        for (int q = 0; q < 2; ++q) {
            const int rr = 2 * wv + q, R = R0 + rr;
            const float4* xr = (const float4*)(p.X2 + (size_t)R * DM);
            float4 v[4]; float ss = 0.f;
#pragma unroll
            for (int i = 0; i < 4; ++i) { v[i] = xr[lane + 64 * i]; ss += v[i].x * v[i].x + v[i].y * v[i].y + v[i].z * v[i].z + v[i].w * v[i].w; }
            ss = wave_sum(ss);
            const float rinv = rsqrtf(ss * (1.f / DM) + 1e-6f);
#pragma unroll
            for (int i = 0; i < 4; ++i) {
                const int c = (lane + 64 * i) * 4;
                const float4 gg = *(const float4*)(gn + c), sh = *(const float4*)(mod + c), sc = *(const float4*)(mod + DM + c);
                f32x4 o;
                o[0] = v[i].x * rinv * gg.x * (1.f + sc.x) + sh.x; o[1] = v[i].y * rinv * gg.y * (1.f + sc.y) + sh.y;
                o[2] = v[i].z * rinv * gg.z * (1.f + sc.z) + sh.z; o[3] = v[i].w * rinv * gg.w * (1.f + sc.w) + sh.w;
                uint2 ob; ob.x = cvt_pk_bf16(o[0], o[1]); ob.y = cvt_pk_bf16(o[2], o[3]);
                *(uint2*)(p.H + (size_t)R * DM + c) = ob;
                *(LAS f32x4*)(hs + rr * 1028 + c) = o;
            }
        }
        __syncthreads();
        {
            f32x4 a0 = {0.f, 0.f, 0.f, 0.f}, a1 = {0.f, 0.f, 0.f, 0.f};
            const int kb = wv * 128 + g;
#pragma unroll 8
            for (int ks = 0; ks < 32; ++ks) {
                const int k = kb + 4 * ks;
                const float av = hs[m16 * 1028 + k];
                const float b0 = rw[k * 32 + m16], b1 = rw[k * 32 + 16 + m16];
                a0 = __builtin_amdgcn_mfma_f32_16x16x4f32(av, b0, a0, 0, 0, 0);
                a1 = __builtin_amdgcn_mfma_f32_16x16x4f32(av, b1, a1, 0, 0, 0);
            }
#pragma unroll
            for (int r = 0; r < 4; ++r) { part[(wv * 16 + 4 * g + r) * 32 + m16] = a0[r]; part[(wv * 16 + 4 * g + r) * 32 + 16 + m16] = a1[r]; }
        }
        __syncthreads();
#pragma unroll 1
        for (int q = 0; q < 2; ++q) {
            const int rr = 2 * wv + q, R = R0 + rr, e = lane & 31;
            float val = p.in[I_RTB][l * 32 + e];
#pragma unroll
            for (int w8 = 0; w8 < 8; ++w8) val += part[(w8 * 16 + rr) * 32 + e];
            if (lane >= 32) val = -3e38f;
            float tv[4]; int ti[4];
#pragma unroll
            for (int k = 0; k < 4; ++k) {
                const float m = wave_max(val);
                const unsigned long long bal = __ballot(val == m);
                const int idx = __ffsll((long long)bal) - 1;
                tv[k] = m; ti[k] = idx;
                if (lane == idx) val = -3e38f;
            }
            if (lane == 0) {
                const float e1 = __expf(tv[1] - tv[0]), e2 = __expf(tv[2] - tv[0]), e3 = __expf(tv[3] - tv[0]);
                const float inv = 1.f / (1.f + e1 + e2 + e3);
                const float gs[4] = {inv, e1 * inv, e2 * inv, e3 * inv};
#pragma unroll
                for (int k = 0; k < 4; ++k) {
                    p.TOPG[R * 4 + k] = gs[k]; p.TOPI[R * 4 + k] = ti[k];
                    p.TOKPOS[R * 4 + k] = __hip_atomic_fetch_add(&lcnt[ti[k]], 1, __ATOMIC_RELAXED, __HIP_MEMORY_SCOPE_WORKGROUP);
                }
            }
        }
    }
    __syncthreads();
    if (tidx_ < 32) lcnt[32 + tidx_] = lcnt[tidx_] ? atomicAdd(&cnt[tidx_], lcnt[tidx_]) : 0;
    __syncthreads();
    for (int tile = bidx_; tile < NROW / 16; tile += gdim_) {
        const int R0 = tile * 16;
        if (skip_ctx && (R0 % TPB) < CTXL) continue;
        if (tidx_ < 64) { const int i = R0 * 4 + tidx_; p.TOKPOS[i] += lcnt[32 + p.TOPI[i]]; }
    }
}
__device__ __forceinline__ void moe_offsets_lds(CParams& p, int wv, int l) {
    const int tidx_ = opaque_tid(wv);
    int bidx_ = blockIdx.x, gdim_ = gridDim.x; asm volatile("" : "+s"(bidx_), "+s"(gdim_));
    int* li = (int*)(smem + LDS_GEMM);
    __syncthreads();
    if (tidx_ == 0) {
        int off = 0, nt = 0;
#pragma unroll 1
        for (int e = 0; e < NEXP; ++e) {
            li[e] = off;
            const int n = (p.CNT[l * 32 + e] + MOE_TM - 1) / MOE_TM;
#pragma unroll 1
            for (int i = 0; i < n; ++i) li[64 + nt++] = e;
            off += n * MOE_TM;
        }
        li[32] = off; li[40] = nt;
    }
    __syncthreads();
}
__device__ __forceinline__ void d_moe_scatter(CParams& p, int wv, int l, int skip_ctx) {
    const int tidx_ = opaque_tid(wv);
    int bidx_ = blockIdx.x, gdim_ = gridDim.x; asm volatile("" : "+s"(bidx_), "+s"(gdim_));
    moe_offsets_lds(p, wv, l);
    const int* li = (const int*)(smem + LDS_GEMM);
    const int gtid = bidx_ * NTHR + tidx_, gsz = gdim_ * NTHR;
    for (int i = gtid; i < NROW * 4; i += gsz) {
        const int R = i >> 2;
        if (skip_ctx && (R % TPB) < CTXL) continue;
        p.SLOT_TOK[li[p.TOPI[i]] + p.TOKPOS[i]] = R;
    }
}
struct ProbG1 {
    CParams& p; int l; const int* li; int ntile; int bid, nblk;
    __device__ __forceinline__ bool next(int i, Unit& u) const { return tile_order(i, ntile, 8, u, bid, nblk); }
    __device__ __forceinline__ int expert(const Unit& u) const { return __builtin_amdgcn_readfirstlane(li[64 + u.pm]); }
    __device__ __forceinline__ const char* a_ptr(const Unit&) const { return (const char*)p.H; }
    __device__ __forceinline__ const char* b_ptr(const Unit& u) const { return (const char*)p.WTGU + ((size_t)(l * NEXP + expert(u)) * 2048 + (size_t)u.pn * 256) * KB_; }
    __device__ __forceinline__ int gather_row(const Unit& u, int r) const { return p.SLOT_TOK[u.pm * 256 + r]; }
    __device__ __forceinline__ void epi(const f32x4 (&acc)[2][2][4][2], const Unit& u, int wr, int wc, int fr, int fq) const {
        const int brow = u.pm * 256;
        const float* bias = p.in[I_BGU] + (size_t)(l * NEXP + expert(u)) * 2048;
        const int c = u.pn * 128 + wc * 32 + 8 * fq;
        const f32x4 bg0 = *(const f32x4*)(bias + c), bg1 = *(const f32x4*)(bias + c + 4);
        const f32x4 bu0 = *(const f32x4*)(bias + 1024 + c), bu1 = *(const f32x4*)(bias + 1024 + c + 4);
#pragma unroll
        for (int ai = 0; ai < 2; ++ai)
#pragma unroll
            for (int m = 0; m < 4; ++m) {
                float a[8];
#pragma unroll
                for (int n = 0; n < 2; ++n)
#pragma unroll
                    for (int j = 0; j < 4; ++j) {
                        float gv = acc[ai][0][m][n][j] + (n == 0 ? bg0[j] : bg1[j]), uv = acc[ai][1][m][n][j] + (n == 0 ? bu0[j] : bu1[j]);
                        gv = fminf(gv, 7.f); uv = fminf(fmaxf(uv, -7.f), 7.f);
                        a[n * 4 + j] = (uv + 1.f) * (gv * sigmoidf_(1.702f * gv));
                    }
                u32x4 o; o.x = cvt_pk_bf16(a[0], a[1]); o.y = cvt_pk_bf16(a[2], a[3]); o.z = cvt_pk_bf16(a[4], a[5]); o.w = cvt_pk_bf16(a[6], a[7]);
                *(u32x4*)(p.ACT + (size_t)(brow + ai * 128 + wr * 64 + m * 16 + fr) * DM + c) = o;
            }
    }
};
__device__ __forceinline__ void d_moe_gemm1(CParams& p, int wv, int l) {
    moe_offsets_lds(p, wv, l);
    const int* li = (const int*)(smem + LDS_GEMM);
    ProbG1 P{p, l, li, __builtin_amdgcn_readfirstlane(li[40]), 0, 0};
    gemm_phase<true>(P, wv);
}
struct ProbG2 {
    CParams& p; int l; const int* li; int ntile; int bid, nblk;
    __device__ __forceinline__ bool next(int i, Unit& u) const { return tile_order(i, ntile, 4, u, bid, nblk); }
    __device__ __forceinline__ int expert(const Unit& u) const { return __builtin_amdgcn_readfirstlane(li[64 + u.pm]); }
    __device__ __forceinline__ const char* a_ptr(const Unit& u) const { return (const char*)p.ACT + (size_t)u.pm * 256 * KB_; }
    __device__ __forceinline__ const char* b_ptr(const Unit& u) const { return (const char*)p.WTDN + ((size_t)(l * NEXP + expert(u)) * DM + (size_t)u.pn * 256) * KB_; }
    __device__ __forceinline__ int gather_row(const Unit&, int) const { return 0; }
    __device__ __forceinline__ void epi(const f32x4 (&acc)[2][2][4][2], const Unit& u, int wr, int wc, int fr, int fq) const {
        const int brow = u.pm * 256, bcol = u.pn * 256;
        const float* bias = p.in[I_BDN] + (size_t)(l * NEXP + expert(u)) * DM;
#pragma unroll
        for (int ai = 0; ai < 2; ++ai)
#pragma unroll
            for (int m = 0; m < 4; ++m) {
                float* yrow = p.Y + (size_t)(brow + ai * 128 + wr * 64 + m * 16 + fr) * DM;
#pragma unroll
                for (int bj = 0; bj < 2; ++bj)
#pragma unroll
                    for (int n = 0; n < 2; ++n) {
                        const int col = bcol + bj * 128 + wc * 32 + n * 16 + fq * 4;
                        *(f32x4*)(yrow + col) = acc[ai][bj][m][n] + *(const f32x4*)(bias + col);
                    }
            }
    }
};
__device__ __forceinline__ void d_moe_gemm2(CParams& p, int wv, int l) {
    moe_offsets_lds(p, wv, l);
    const int* li = (const int*)(smem + LDS_GEMM);
    ProbG2 P{p, l, li, __builtin_amdgcn_readfirstlane(li[40]), 0, 0};
    gemm_phase<false>(P, wv);
}
__device__ __forceinline__ void d_moe_combine(CParams& p, int wv, int l, int last) {
    const int tidx_ = opaque_tid(wv);
    int bidx_ = blockIdx.x, gdim_ = gridDim.x; asm volatile("" : "+s"(bidx_), "+s"(gdim_));
    moe_offsets_lds(p, wv, l);
    const int* li = (const int*)(smem + LDS_GEMM);
    const int lane = tidx_ & 63, gw = bidx_ * 8 + (tidx_ >> 6), NGW = gdim_ * 8;
    for (int R = gw; R < NROW; R += NGW) {
        const int b = R / TPB, pos = R % TPB, mr = pos < CTXL ? 4 : b;
        if (last && pos < CTXL) continue;
        float4 acc[4];
#pragma unroll
        for (int i = 0; i < 4; ++i) acc[i] = make_float4(0.f, 0.f, 0.f, 0.f);
#pragma unroll
        for (int k = 0; k < 4; ++k) {
            const float g = p.TOPG[R * 4 + k];
            const int s = li[p.TOPI[R * 4 + k]] + p.TOKPOS[R * 4 + k];
            const float4* yr = (const float4*)(p.Y + (size_t)s * DM);
#pragma unroll
            for (int i = 0; i < 4; ++i) { const float4 y = yr[lane + 64 * i]; acc[i].x += g * y.x; acc[i].y += g * y.y; acc[i].z += g * y.z; acc[i].w += g * y.w; }
        }
        const float* m5 = p.MOD + (l * 5 + mr) * 6144 + 5 * DM;
        const float4* xin = (const float4*)(p.X2 + (size_t)R * DM);
        float4* xr = (float4*)(p.X + (size_t)R * DM);
        float4 v[4]; float ss = 0.f;
#pragma unroll
        for (int i = 0; i < 4; ++i) {
            const float4 m = *(const float4*)(m5 + (lane + 64 * i) * 4);
            float4 x = xin[lane + 64 * i];
            x.x += m.x * acc[i].x; x.y += m.y * acc[i].y; x.z += m.z * acc[i].z; x.w += m.w * acc[i].w;
            v[i] = x; ss += x.x * x.x + x.y * x.y + x.z * x.z + x.w * x.w;
        }
        ss = wave_sum(ss);
        if (!last) {
#pragma unroll
            for (int i = 0; i < 4; ++i) xr[lane + 64 * i] = v[i];
            norm_row_to_bf16(p, v, ss, l + 1, 0, mr, p.H + (size_t)R * DM, lane);
        } else {
            const float rinv = rsqrtf(ss * (1.f / DM) + 1e-6f);
            float4* orow = (float4*)(p.out + ((size_t)b * SEQ + (pos - CTXL)) * DM);
#pragma unroll
            for (int i = 0; i < 4; ++i) {
                const float4 gg = *(const float4*)(p.in[I_FING] + (lane + 64 * i) * 4);
                float4 r; r.x = v[i].x * rinv * gg.x; r.y = v[i].y * rinv * gg.y; r.z = v[i].z * rinv * gg.z; r.w = v[i].w * rinv * gg.w;
                orow[lane + 64 * i] = r;
            }
        }
    }
}


#define XB_TMO      128
#define XB_XCNT(j)  (256  + 64 * (j))
#define XB_XSUB(j)  (1280 + 64 * (j))
#define XB_XGEN(j)  (2304 + 64 * (j))
#define XB_TOP      3328
#define XB_TOPGEN   3392
#define XCD_BAR_WORDS 3456
#define XB_SPIN_CAP (1u << 18)
__device__ __forceinline__ unsigned xb_ld(unsigned* q)              { return __hip_atomic_load(q, __ATOMIC_RELAXED, __HIP_MEMORY_SCOPE_AGENT); }
__device__ __forceinline__ unsigned xb_add(unsigned* q, unsigned v) { return __hip_atomic_fetch_add(q, v, __ATOMIC_RELAXED, __HIP_MEMORY_SCOPE_AGENT); }
__device__ __forceinline__ unsigned xb_xcc_id() { return (unsigned)__builtin_amdgcn_s_getreg((3 << 11) | 20) & 0xFu; }
#define XB_SPIN(cond, bar) do { unsigned _sp = 0; while (cond) { __builtin_amdgcn_s_sleep(1); \
    if ((++_sp & 255u) == 0u) { if (xb_ld(&(bar)[XB_TMO])) break; if (_sp > XB_SPIN_CAP) { atomicAdd(&(bar)[XB_TMO], 1u); break; } } } } while (0)
__device__ __forceinline__ void xcd_barrier_complete(unsigned* bar, unsigned x, unsigned G, unsigned& nloc, unsigned& nx) {
    unsigned sum, cnt, mine, sp = 0u;
    for (;;) {
        sum = 0u; cnt = 0u; mine = 0u;
#pragma unroll
        for (unsigned j = 0; j < 16; ++j) { const unsigned c = xb_ld(&bar[XB_XCNT(j)]); sum += c; cnt += (c > 0u) ? 1u : 0u; mine = (j == x) ? c : mine; }
        if (sum == G) break;
        __builtin_amdgcn_s_sleep(1);
        if ((++sp & 255u) == 0u) { if (xb_ld(&bar[XB_TMO])) break; if (sp > XB_SPIN_CAP) { atomicAdd(&bar[XB_TMO], 1u); break; } }
    }
    nloc = mine > 0u ? mine : 1u; nx = cnt > 0u ? cnt : 1u;
}
__device__ __forceinline__ void xcd_barrier(unsigned* bar, volatile LAS unsigned* st, bool t0) {
    asm volatile("s_waitcnt vmcnt(0)" ::: "memory");
    __syncthreads();
    if (t0) {
        __builtin_amdgcn_s_waitcnt(0);
        const unsigned x = xb_xcc_id();
        unsigned nloc = st[0], nx = st[1];
        if (nloc == 0u) { xcd_barrier_complete(bar, x, gridDim.x, nloc, nx); st[0] = nloc; st[1] = nx; }
        const unsigned old = xb_add(&bar[XB_XSUB(x)], 1u);
        const unsigned gen = old / nloc;
        if (old + 1u == (gen + 1u) * nloc) {
            __builtin_amdgcn_fence(__ATOMIC_RELEASE, "agent");
            asm volatile("s_waitcnt vmcnt(0)" ::: "memory");
            const unsigned og = xb_add(&bar[XB_TOP], 1u);
            const unsigned tg = og / nx;
            if (og + 1u == (tg + 1u) * nx) xb_add(&bar[XB_TOPGEN], 1u);
            else XB_SPIN(xb_ld(&bar[XB_TOPGEN]) == tg, bar);
            __builtin_amdgcn_fence(__ATOMIC_ACQUIRE, "agent");
            xb_add(&bar[XB_XGEN(x)], 1u);
            asm volatile("s_waitcnt vmcnt(0)" ::: "memory");
        } else {
            XB_SPIN(xb_ld(&bar[XB_XGEN(x)]) == gen, bar);
            __builtin_amdgcn_fence(__ATOMIC_ACQUIRE, "agent");
            asm volatile("s_waitcnt vmcnt(0)" ::: "memory");
        }
    }
    __syncthreads();
}

#ifndef MULTI
#define MULTI 0
#endif
__device__ __forceinline__ void run_phase(CParams& p, int wv, int ph) {
    if (ph == 0) { d_prologue(p, wv); return; }
    if (ph == 1) { d_norm_mix(p, wv, 0); return; }
    const int l = (ph - 2) / 11, q = (ph - 2) % 11, last = l == 1;
    if (ph >= 24) return;
    switch (q) {
        case 0: d_gemm_in(p, wv, l); break;
        case 1: d_lru_local(p, wv, l); d_rwkv_pre(p, wv, l); break;
        case 2: d_rwkv_chunkA(p, wv, l); break;
        case 3: d_scan_attn(p, wv, l, !last); break;
        case 4: d_finish(p, wv, l, last); break;
        case 5: d_gemm_out(p, wv, l, last); break;
        case 6: d_norm_router(p, wv, l, last); break;
        case 7: d_moe_scatter(p, wv, l, last); break;
        case 8: d_moe_gemm1(p, wv, l); break;
        case 9: d_moe_gemm2(p, wv, l); break;
        case 10: d_moe_combine(p, wv, l, last); break;
    }
}
#if MULTI
template <int PH> __global__ void __launch_bounds__(NTHR) mega_ph(Params p) { run_phase(p, __builtin_amdgcn_readfirstlane(threadIdx.x >> 6), PH); }
__global__ void __launch_bounds__(NTHR) mega(Params p) {}
template <int PH> static void launch_all(CParams& p, int grid, hipStream_t stream) {
    static bool attr = false; if (!attr) { (void)hipFuncSetAttribute((const void*)mega_ph<PH>, hipFuncAttributeMaxDynamicSharedMemorySize, LDS_BYTES); attr = true; }
    mega_ph<PH><<<grid, NTHR, LDS_BYTES, stream>>>(p);
    if constexpr (PH + 1 < 24) launch_all<PH + 1>(p, grid, stream);
}
#else
__global__ void __launch_bounds__(NTHR) mega(Params p) {
    cg::grid_group grid = cg::this_grid();
    const int wv = __builtin_amdgcn_readfirstlane(threadIdx.x >> 6);
    volatile LAS unsigned* xst = (volatile LAS unsigned*)((LAS unsigned char*)smem + LDS_BYTES - 16);
    if (threadIdx.x == 0) { xst[0] = 0u; xst[1] = 0u; (void)xb_add(&p.BAR[XB_XCNT(xb_xcc_id())], 1u); }
    __syncthreads();
#define RUNPH(n) { CParams* pp = (CParams*)__builtin_amdgcn_kernarg_segment_ptr(); asm volatile("" : "+s"(pp)); run_phase(*pp, wv, n); \
    if (n == 0) grid.sync(); else if (n < 23) xcd_barrier(pp->BAR, xst, opaque_tid(wv) == 0); }
    RUNPH(0) RUNPH(1) RUNPH(2) RUNPH(3) RUNPH(4) RUNPH(5) RUNPH(6) RUNPH(7) RUNPH(8) RUNPH(9) RUNPH(10)
    RUNPH(11) RUNPH(12) RUNPH(13) RUNPH(14) RUNPH(15) RUNPH(16) RUNPH(17) RUNPH(18) RUNPH(19) RUNPH(20) RUNPH(21) RUNPH(22) RUNPH(23)
}
#endif

extern "C" void kernel_launch(void* const* d_in, const int* in_sizes, int n_in, void* d_out, int out_size, void* d_ws, size_t ws_size,
                              hipStream_t stream) {
    Params p{};
    for (int i = 0; i < N_IN; ++i) p.in[i] = (const float*)d_in[i];
    p.out = (float*)d_out;
    char* w = (char*)d_ws;
    size_t off = 0;
    auto take = [&](size_t bytes) { void* r = w + off; off += (bytes + 255) & ~(size_t)255; return r; };
    p.X = (float*)take((size_t)NROW * DM * 4);
    p.X2 = (float*)take((size_t)NROW * DM * 4);
    p.H = (bf16_t*)take((size_t)NROW * DM * 2);
    p.P = (float*)take((size_t)NROW * PST * 4);
    p.QH = (bf16_t*)take((size_t)NROW * 512 * 2);
    p.KH = (bf16_t*)take((size_t)NROW * 512 * 2);
    p.VT = (bf16_t*)take((size_t)NROW * 512 * 2);
    p.MIX = (bf16_t*)take((size_t)NROW * DM * 2);
    p.MOD = (float*)take(2 * 5 * 6144 * 4);
    p.LA = (float*)take((size_t)2 * NROW * 256 * 4);
    p.LB = (float*)take((size_t)2 * NROW * 256 * 4);
    p.LCE = (float*)take((size_t)2176 * 128 * 4);
    p.LCI = (float*)take((size_t)4 * 2 * 68 * 256 * 4);
    p.RS = (float*)take((size_t)NROW * 768 * 4);
    p.DEC = (float*)take((size_t)2 * NROW * 256 * 4);
    p.AIC = (float*)take((size_t)2 * NROW * 256 * 4);
    p.KKN = (float*)take((size_t)NROW * 256 * 4);
    p.GG = (float*)take((size_t)NROW * 256 * 4);
    p.YB = (float*)take((size_t)2 * NROW * 256 * 4);
    p.TOPG = (float*)take((size_t)NROW * 4 * 4);
    p.TOPI = (int*)take((size_t)NROW * 4 * 4);
    p.TOKPOS = (int*)take((size_t)NROW * 4 * 4);
    p.CNT = (int*)take(64 * 4);
    p.SLOT_TOK = (int*)take((size_t)CAP * 4);
    p.ACT = (bf16_t*)take((size_t)CAP * DM * 2);
    p.Y = (float*)take((size_t)CAP * DM * 4);
    p.BAR = (unsigned*)take((size_t)XCD_BAR_WORDS * 4);
    p.LWT = (bf16_t*)take((size_t)2 * 2 * 4 * 2 * 4096 * 2);
    p.RWT = (bf16_t*)take((size_t)2 * 5 * 16384 * 2);
    p.RMF = (bf16_t*)take((size_t)2176 * 4096 * 2);
    p.RQF = (bf16_t*)take((size_t)2176 * 4096 * 2);
    p.RNF = (float*)take((size_t)2176 * 4096 * 4);
    p.RYF = (float*)take((size_t)2176 * 4096 * 4);
    p.S0F = (bf16_t*)take((size_t)2176 * 4096 * 2);
    p.WTIN = (bf16_t*)take((size_t)2 * INCP * DM * 2);
    p.WTOUT = (bf16_t*)take((size_t)2 * DM * DM * 2);
    p.WTGU = (bf16_t*)take((size_t)2 * NEXP * 2048 * DM * 2);
    p.WTDN = (bf16_t*)take((size_t)2 * NEXP * DM * DM * 2);

    static int grid_blocks = 0;
    if (!grid_blocks) {
        int dev = 0, cus = 0, per_cu = 0;
        (void)hipGetDevice(&dev);
        (void)hipDeviceGetAttribute(&cus, hipDeviceAttributeMultiprocessorCount, dev);
        (void)hipFuncSetAttribute((const void*)mega, hipFuncAttributeMaxDynamicSharedMemorySize, LDS_BYTES);
        (void)hipOccupancyMaxActiveBlocksPerMultiprocessor(&per_cu, (const void*)mega, NTHR, LDS_BYTES);
        if (per_cu > 1) per_cu = 1;
        if (per_cu < 1) { fprintf(stderr, "occupancy query says %d blocks/CU\n", per_cu); per_cu = 1; }
        grid_blocks = cus * per_cu;
        (void)hipGetLastError();
    }
#if MULTI
    launch_all<0>(p, grid_blocks, stream);
#else
    (void)hipMemsetAsync(p.BAR, 0, (size_t)XCD_BAR_WORDS * 4, stream);
    void* args[] = {&p};
    hipError_t e = hipLaunchCooperativeKernel((void*)mega, dim3(grid_blocks), dim3(NTHR), args, LDS_BYTES, stream);
    if (e != hipSuccess) fprintf(stderr, "cooperative launch failed: %s (grid %d)\n", hipGetErrorString(e), grid_blocks);
#endif
}
```

```cpp
#include <hip/hip_runtime.h>
#include <hip/hip_cooperative_groups.h>
#include <stdint.h>
#include <cstdio>
namespace cg = cooperative_groups;

#define DM 1024
#define NBATCH 4
#define SEQ 4096
#define CTXL 256
#define TPB 4352
#define NROW 17408
#define INC 3008
#define INCP 3072
#define PST 1472
#define NEXP 32
#define MOE_TM 256
#define CAP (NROW * 4 + NEXP * MOE_TM)
#define MAXTILES (CAP / MOE_TM)
#define NTHR 512
#define LDS_GEMM 131072
#define LDS_BYTES 155648

typedef unsigned short bf16_t;
typedef short bf16x8 __attribute__((ext_vector_type(8)));
typedef float f32x4 __attribute__((ext_vector_type(4)));
typedef unsigned u32x4 __attribute__((ext_vector_type(4)));
typedef unsigned u32x2 __attribute__((ext_vector_type(2)));

enum { I_X = 0, I_C, I_CTX, I_CCTX, I_ADAW, I_ADAB, I_NMG, I_NFG, I_WIN, I_WOUT, I_CONVW, I_CONVB, I_WR, I_BR, I_WI, I_BI,
       I_LAM, I_MU, I_W0, I_W2, I_A0, I_A2, I_G2, I_KK, I_KA, I_RK, I_LNG, I_LNB, I_RPB, I_RTW, I_RTB, I_WGU, I_BGU, I_WDN,
       I_BDN, I_FING, N_IN };

struct Params {
    const float* in[N_IN];
    float* out;
    float* X;
    float* X2;
    bf16_t* H;
    float* P;
    bf16_t* QH;
    bf16_t* KH;
    bf16_t* VT;
    bf16_t* MIX;
    float* MOD;
    float* LA;
    float* LB;
    float* LCE;
    float* LCI;
    float* RS;
    float* DEC;
    float* AIC;
    float* KKN;
    float* GG;
    float* YB;
    float* TOPG;
    int* TOPI;
    int* TOKPOS;
    int* CNT;
    int* SLOT_TOK;
    bf16_t* ACT;
    bf16_t* Y;
    unsigned* BAR;
    bf16_t* LWT;
    bf16_t* RWT;
    bf16_t* RMF;
    bf16_t* RQF;
    float* RNF;
    float* RYF;
    bf16_t* S0F;
    bf16_t* WTIN;
    bf16_t* WTOUT;
    bf16_t* WTGU;
    bf16_t* WTDN;
};

typedef const __attribute__((address_space(4))) Params CParams;
extern __shared__ __attribute__((aligned(16))) unsigned char smem[];

__device__ __forceinline__ int opaque_tid(int wv) { int t; asm volatile("v_mbcnt_lo_u32_b32 %0, -1, 0\n\tv_mbcnt_hi_u32_b32 %0, -1, %0" : "=v"(t)); return wv * 64 + t; }
__device__ __forceinline__ float sigmoidf_(float x) { return 1.f / (1.f + __expf(-x)); }
__device__ __forceinline__ float softplusf_(float x) { return x > 20.f ? x : log1pf(__expf(x)); }
__device__ __forceinline__ float softplus_fast(float x) { return x > 15.f ? x : __logf(1.f + __expf(x)); }
__device__ __forceinline__ float tanh_fast(float x) { const float e = __expf(2.f * x); return 1.f - 2.f / (1.f + e); }
#define SWZ_XOR(v, o) __int_as_float(__builtin_amdgcn_ds_swizzle(__float_as_int(v), ((o) << 10) | 0x1f))
__device__ __forceinline__ float rdlane(float v, int l) { return __int_as_float(__builtin_amdgcn_readlane(__float_as_int(v), l)); }
__device__ __forceinline__ float sum_xor32(float v) {
    int a = __float_as_int(v), b = a;
    asm volatile("s_nop 1\n\tv_permlane32_swap_b32 %0, %1\n\ts_nop 1" : "+v"(a), "+v"(b));
    return __int_as_float(a) + __int_as_float(b);
}
#define DPPF(v, ctrl) __int_as_float(__builtin_amdgcn_update_dpp(0, __float_as_int(v), ctrl, 0xf, 0xf, true))
__device__ __forceinline__ float row_sum16(float v) { v += DPPF(v, 0xB1); v += DPPF(v, 0x4E); v += DPPF(v, 0x141); v += DPPF(v, 0x140); return v; }
__device__ __forceinline__ float row_max16(float v) { v = fmaxf(v, DPPF(v, 0xB1)); v = fmaxf(v, DPPF(v, 0x4E)); v = fmaxf(v, DPPF(v, 0x141)); v = fmaxf(v, DPPF(v, 0x140)); return v; }
__device__ __forceinline__ float wave_sum(float v) {
    v = row_sum16(v);
    return (rdlane(v, 0) + rdlane(v, 16)) + (rdlane(v, 32) + rdlane(v, 48));
}
__device__ __forceinline__ float wave_max(float v) {
    v = row_max16(v);
    return fmaxf(fmaxf(rdlane(v, 0), rdlane(v, 16)), fmaxf(rdlane(v, 32), rdlane(v, 48)));
}
typedef __bf16 bf16x2_n __attribute__((ext_vector_type(2)));
__device__ __forceinline__ unsigned cvt_pk_bf16(float lo, float hi) { bf16x2_n v; v[0] = (__bf16)lo; v[1] = (__bf16)hi; return __builtin_bit_cast(unsigned, v); }
__device__ __forceinline__ bf16_t f2bf(float x) { return __builtin_bit_cast(bf16_t, (__bf16)x); }
__device__ __forceinline__ float gelu_tanh(float x) {
    const float u = 0.7978845608028654f * (x + 0.044715f * x * x * x);
    return 0.5f * x * (1.f + tanhf(u));
}

__device__ __forceinline__ int inv_perm32(int cc) { return ((cc >> 2) & 1) * 16 + (cc >> 3) * 4 + (cc & 3); }
__device__ __forceinline__ void transpose_item(const float* W, int K, int N, bf16_t* WT, int k0, int n0, int dst_row0, float* scr, int lane, bool perm = false) {
#pragma unroll 8
    for (int i = 0; i < 32; ++i) { const int kk = 2 * i + (lane >> 5); scr[kk * 33 + (lane & 31)] = W[(size_t)(k0 + kk) * N + n0 + (lane & 31)]; }
    __builtin_amdgcn_wave_barrier();
    const int c = lane & 7;
#pragma unroll
    for (int j = 0; j < 4; ++j) {
        const int n = (lane >> 3) + 8 * j; const float* s = scr + (8 * c) * 33 + n;
        u32x4 o; o.x = cvt_pk_bf16(s[0 * 33], s[1 * 33]); o.y = cvt_pk_bf16(s[2 * 33], s[3 * 33]); o.z = cvt_pk_bf16(s[4 * 33], s[5 * 33]); o.w = cvt_pk_bf16(s[6 * 33], s[7 * 33]);
        *(u32x4*)(WT + (size_t)(dst_row0 + (perm ? inv_perm32(n) : n)) * K + k0 + 8 * c) = o;
    }
    __builtin_amdgcn_wave_barrier();
}

__device__ __forceinline__ void d_prologue(CParams& p, int wv) {
    const int tidx_ = opaque_tid(wv);
    int bidx_ = blockIdx.x, gdim_ = gridDim.x; asm volatile("" : "+s"(bidx_), "+s"(gdim_));
    const int tid = tidx_, lane = tid & 63, wave = tid >> 6;
    const int gtid = bidx_ * NTHR + tid, gsz = gdim_ * NTHR;
    const int gw = bidx_ * 8 + wave, NGW = gdim_ * 8;
    {
        const float4* x4 = (const float4*)p.in[I_X];
        const float4* c4 = (const float4*)p.in[I_CTX];
        float4* X4 = (float4*)p.X;
        for (int i = gtid; i < NROW * 256; i += gsz) {
            const int R = i >> 8, q = i & 255, b = R / TPB, pos = R % TPB;
            X4[i] = pos < CTXL ? c4[(b * CTXL + pos) * 256 + q] : x4[((size_t)b * SEQ + (pos - CTXL)) * 256 + q];
        }
    }
    if (gtid < 64) p.CNT[gtid] = 0;
    for (int i = gtid; i < 2 * 2 * 4 * 2 * 4096; i += gsz) {
        const int ii = i & 63, j = (i >> 6) & 63, gt = (i >> 12) & 1, ldh = i >> 13;
        p.LWT[i] = f2bf((gt ? p.in[I_WI] : p.in[I_WR])[(size_t)ldh * 4096 + ii * 64 + j]);
    }
    for (int i = gtid; i < 2 * 5 * 16384; i += gsz) {
        const int k = i & 63, n = (i >> 6) & 255, mtx = (i >> 14) % 5, l = i / (5 * 16384);
        const float v = mtx < 2 ? p.in[I_W2][((size_t)(l * 2 + mtx) * 64 + k) * 256 + n] : (mtx < 4 ? p.in[I_A2][((size_t)(l * 2 + mtx - 2) * 64 + k) * 256 + n] : p.in[I_G2][((size_t)l * 64 + k) * 256 + n]);
        p.RWT[i] = f2bf(v);
    }
    for (int i = gtid; i < 2 * 64 * 1024 / 8; i += gsz) {
        const int l = i / (64 * 128), r = i % (64 * 128);
        *(u32x4*)(p.WTIN + ((size_t)l * INCP + INC) * DM + (size_t)r * 8) = (u32x4){0u, 0u, 0u, 0u};
    }
    {
        float* sc = (float*)smem;
        float* part = (float*)(smem + 5 * 1024 * 4);
        for (int i = tid; i < 5 * DM; i += NTHR) { const int r = i / DM, d = i % DM; const float v = r < 4 ? p.in[I_C][r * DM + d] : p.in[I_CCTX][d]; sc[i] = v * sigmoidf_(v); }
        __syncthreads();
        for (int cb = bidx_; cb < 256; cb += gdim_) {
            const int col = tid % 48, ks = tid / 48;
            const int gc = cb * 48 + col, l = gc / 6144, n = gc % 6144;
            if (ks < 8) {
                const float* W = p.in[I_ADAW] + (size_t)l * DM * 6144 + n;
                float a0 = 0.f, a1 = 0.f, a2 = 0.f, a3 = 0.f, a4 = 0.f;
#pragma unroll 8
                for (int k = ks * 128; k < ks * 128 + 128; ++k) {
                    const float w = W[(size_t)k * 6144];
                    a0 += sc[k] * w; a1 += sc[DM + k] * w; a2 += sc[2 * DM + k] * w; a3 += sc[3 * DM + k] * w; a4 += sc[4 * DM + k] * w;
                }
                float* pp = part + (ks * 5) * 48 + col;
                pp[0] = a0; pp[48] = a1; pp[96] = a2; pp[144] = a3; pp[192] = a4;
            }
            __syncthreads();
            if (tid < 240) {
                const int r = tid / 48, c2 = tid % 48, gc2 = cb * 48 + c2, l2 = gc2 / 6144, n2 = gc2 % 6144;
                float s = p.in[I_ADAB][l2 * 6144 + n2];
#pragma unroll
                for (int k = 0; k < 8; ++k) s += part[(k * 5 + r) * 48 + c2];
                p.MOD[(l2 * 5 + r) * 6144 + n2] = s;
            }
            __syncthreads();
        }
    }
    {
        float* scr = (float*)(smem + 32768) + wave * (64 * 33);
        const int N_IN_ = 2 * 16 * 94, N_OUT_ = 2 * 16 * 32, N_GU_ = 64 * 16 * 64, N_DN_ = 64 * 16 * 32;
        for (int it = gw; it < N_IN_ + N_OUT_ + N_GU_ + N_DN_; it += NGW) {
            int r = it;
            if (r < N_IN_) { const int l = r / (16 * 94), q = r % (16 * 94), kb = q / 94, nb = q % 94;
                transpose_item(p.in[I_WIN] + (size_t)l * DM * INC, DM, INC, p.WTIN + (size_t)l * INCP * DM, kb * 64, nb * 32, nb * 32, scr, lane); continue; }
            r -= N_IN_;
            if (r < N_OUT_) { const int l = r / 512, q = r % 512, kb = q / 32, nb = q % 32;
                transpose_item(p.in[I_WOUT] + (size_t)l * DM * DM, DM, DM, p.WTOUT + (size_t)l * DM * DM, kb * 64, nb * 32, nb * 32, scr, lane); continue; }
            r -= N_OUT_;
            if (r < N_GU_) { const int le = r / 1024, q = r % 1024, kb = q / 64, nb = q % 64;
                const int c0 = nb * 32; const int dst = c0 < 1024 ? (c0 / 128) * 256 + (c0 % 128) : ((c0 - 1024) / 128) * 256 + 128 + ((c0 - 1024) % 128);
                transpose_item(p.in[I_WGU] + (size_t)le * DM * 2048, DM, 2048, p.WTGU + (size_t)le * 2048 * DM, kb * 64, c0, dst, scr, lane, true); continue; }
            r -= N_GU_;
            { const int le = r / 512, q = r % 512, kb = q / 32, nb = q % 32;
                transpose_item(p.in[I_WDN] + (size_t)le * DM * DM, DM, DM, p.WTDN + (size_t)le * DM * DM, kb * 64, nb * 32, nb * 32, scr, lane, true); }
        }
    }
}

__device__ __forceinline__ void norm_row_to_bf16(CParams& p, const float4 (&v)[4], float ss, int l, int which, int mr, bf16_t* hrow, int lane) {
    const float* g = (which == 0 ? p.in[I_NMG] : p.in[I_NFG]) + l * DM;
    const float* mod = p.MOD + (l * 5 + mr) * 6144 + (which == 0 ? 0 : 3 * DM);
    const float rinv = rsqrtf(ss * (1.f / DM) + 1e-6f);
#pragma unroll
    for (int i = 0; i < 4; ++i) {
        const int c = (lane + 64 * i) * 4;
        const float4 gg = *(const float4*)(g + c), sh = *(const float4*)(mod + c), sc = *(const float4*)(mod + DM + c);
        const float o0 = v[i].x * rinv * gg.x * (1.f + sc.x) + sh.x, o1 = v[i].y * rinv * gg.y * (1.f + sc.y) + sh.y;
        const float o2 = v[i].z * rinv * gg.z * (1.f + sc.z) + sh.z, o3 = v[i].w * rinv * gg.w * (1.f + sc.w) + sh.w;
        uint2 o; o.x = cvt_pk_bf16(o0, o1); o.y = cvt_pk_bf16(o2, o3);
        *(uint2*)(hrow + c) = o;
    }
}
__device__ __forceinline__ void d_norm_mix(CParams& p, int wv, int l) {
    const int tidx_ = opaque_tid(wv);
    int bidx_ = blockIdx.x, gdim_ = gridDim.x; asm volatile("" : "+s"(bidx_), "+s"(gdim_));
    const int lane = tidx_ & 63, gw = bidx_ * 8 + (tidx_ >> 6), NGW = gdim_ * 8;
    for (int R = gw; R < NROW; R += NGW) {
        const int b = R / TPB, pos = R % TPB, mr = pos < CTXL ? 4 : b;
        const float4* xr = (const float4*)(p.X + (size_t)R * DM);
        float4 v[4]; float ss = 0.f;
#pragma unroll
        for (int i = 0; i < 4; ++i) { v[i] = xr[lane + 64 * i]; ss += v[i].x * v[i].x + v[i].y * v[i].y + v[i].z * v[i].z + v[i].w * v[i].w; }
        ss = wave_sum(ss);
        norm_row_to_bf16(p, v, ss, l, 0, mr, p.H + (size_t)R * DM, lane);
    }
}

#define LAS __attribute__((address_space(3)))
#define RWS 144
#define HTB 16384
#define KB_ 2048
__device__ __forceinline__ int lds_byte(int r, int c) {
    const int st = (r >> 4) * 2 + (c >> 5), rr = r & 15, cc = c & 31, ob = rr * 64 + cc * 2;
    return st * 1024 + (ob ^ (((ob >> 9) & 1) << 5));
}
__device__ __forceinline__ void stage_rc(int b, int& R, int& C) {
    const int st = b / 1024, sb = b % 1024, swz = sb ^ (((sb >> 9) & 1) << 5);
    R = (st >> 1) * 16 + swz / 64; C = (st & 1) * 32 + (swz % 64) / 2;
}
struct Unit { int pm, pn; };
__device__ __forceinline__ bool tile_order(int i, int nM, int nN, Unit& u, int bid, int nblk) {
    const int nwg = nM * nN; const long L = (long)i * nblk + bid; if (L >= nwg) return false;
    int wgid = (int)L; { const int q = nwg / 8, r = nwg % 8, xcd = wgid % 8, off = wgid / 8; wgid = (xcd < r ? xcd * (q + 1) : r * (q + 1) + (xcd - r) * q) + off; }
    const int nig = 8 * nN, gid = wgid / nig, fm = gid * 8, gsz = (nM - fm) < 8 ? (nM - fm) : 8;
    u.pm = fm + ((wgid % nig) % gsz); u.pn = (wgid % nig) / gsz; return true;
}

#define PG_SA(b, h) (((b) * 2 + (h)) * HTB)
#define PG_SB(b, h) ((4 + (b) * 2 + (h)) * HTB)
#define PG_STAGE(bufoff, gbase, v0, v1) do { \
    __builtin_amdgcn_global_load_lds((const unsigned*)((const char*)(gbase) + (v0)), (LAS unsigned*)(lds + (bufoff) + ldsw), 16, 0, 0); \
    __builtin_amdgcn_global_load_lds((const unsigned*)((const char*)(gbase) + (v1)), (LAS unsigned*)(lds + (bufoff) + ldsw + 8192), 16, 0, 0); } while (0)
#define PG_STAGE_B(bufoff, gbase) PG_STAGE(bufoff, gbase, voffB[0], voffB[1])
#define PG_STAGE_A(bufoff, gb, h, usenext) do { if (GATHER) PG_STAGE(bufoff, gb, gc[h][0], gc[h][1]); \
    else PG_STAGE(bufoff, (gb) + (h) * hstep, voffA[0], voffA[1]); } while (0)
#define PG_LDA(dst, b, h) do { _Pragma("unroll") for (int m = 0; m < 4; ++m) _Pragma("unroll") for (int k = 0; k < 2; ++k) dst[m][k] = *(const LAS bf16x8*)(lds + PG_SA(b, h) + aoff + m * 2048 + k * 1024); } while (0)
#define PG_LDB(dst, b, h) do { _Pragma("unroll") for (int n = 0; n < 2; ++n) _Pragma("unroll") for (int k = 0; k < 2; ++k) dst[n][k] = *(const LAS bf16x8*)(lds + PG_SB(b, h) + boff + n * 2048 + k * 1024); } while (0)
#define PG_MMA(ai, bj, At_, Bt_) do { __builtin_amdgcn_s_setprio(1); _Pragma("unroll") for (int m = 0; m < 4; ++m) _Pragma("unroll") for (int n = 0; n < 2; ++n) _Pragma("unroll") for (int k = 0; k < 2; ++k) \
    acc[ai][bj][m][n] = __builtin_amdgcn_mfma_f32_16x16x32_bf16(Bt_[n][k], At_[m][k], acc[ai][bj][m][n], 0, 0, 0); __builtin_amdgcn_s_setprio(0); } while (0)
#define PG_WAIT_V(n) asm volatile("s_waitcnt vmcnt(" #n ")" ::: "memory")
#define PG_WAIT_L(n) asm volatile("s_waitcnt lgkmcnt(" #n ")" ::: "memory")
#define PG_BAR __builtin_amdgcn_s_barrier()
#define PG_SCHED __builtin_amdgcn_sched_barrier(0)

template <bool GATHER, class Prob>
__device__ __forceinline__ void gemm_phase(Prob P, int wv) {
    const int tidx_ = opaque_tid(wv);
    int bidx_ = blockIdx.x, gdim_ = gridDim.x; asm volatile("" : "+s"(bidx_), "+s"(gdim_));
    LAS unsigned char* lds = (LAS unsigned char*)smem;
    P.bid = bidx_; P.nblk = gdim_;
    const int tid = tidx_, wid = __builtin_amdgcn_readfirstlane(tid >> 6), lane = tid & 63, wr = wid >> 2, wc = wid & 3, fr = lane & 15, fq = lane >> 4;
    constexpr int nt = 16;
    unsigned voffA[2], voffB[2]; int Rr[2], Cc[2];
#pragma unroll
    for (int i = 0; i < 2; ++i) { stage_rc(tid * 16 + i * 8192, Rr[i], Cc[i]); voffA[i] = (unsigned)(Rr[i] * 1024 + Cc[i]) * 2u; voffB[i] = voffA[i]; }
    const size_t kstep = 128, hstep = (size_t)128 * KB_;
    const unsigned ldsw = (unsigned)wid * 1024u;
    const int aoff = lds_byte(wr * 64 + fr, fq * 8), boff = lds_byte(wc * 32 + fr, fq * 8);
    Unit cur, nxt; int ui = 0;
    if (!P.next(0, cur)) return;
    f32x4 acc[2][2][4][2];
#pragma unroll
    for (int a = 0; a < 2; ++a)
#pragma unroll
        for (int b = 0; b < 2; ++b)
#pragma unroll
            for (int m = 0; m < 4; ++m)
#pragma unroll
                for (int n = 0; n < 2; ++n) acc[a][b][m][n] = (f32x4){0.f, 0.f, 0.f, 0.f};
    bf16x8 At[4][2], B0[2][2], B1[2][2];
    unsigned gc[2][2] = {{0u, 0u}, {0u, 0u}};
    if (GATHER) {
#pragma unroll
        for (int h = 0; h < 2; ++h)
#pragma unroll
            for (int i = 0; i < 2; ++i) gc[h][i] = (unsigned)P.gather_row(cur, h * 128 + Rr[i]) * (unsigned)KB_ + (unsigned)Cc[i] * 2u;
    }
    const char* cA = P.a_ptr(cur); const char* cB = P.b_ptr(cur);
    PG_STAGE_B(PG_SB(0, 0), cB); PG_STAGE_A(PG_SA(0, 0), cA, 0, false); PG_STAGE_B(PG_SB(0, 1), cB + hstep); PG_STAGE_A(PG_SA(0, 1), cA, 1, false);
    if (wr == 1) PG_BAR;
    PG_WAIT_V(4); PG_BAR;
    PG_STAGE_B(PG_SB(1, 0), cB + kstep); PG_STAGE_A(PG_SA(1, 0), cA + kstep, 0, false); PG_STAGE_B(PG_SB(1, 1), cB + hstep + kstep);
    PG_WAIT_V(6); PG_BAR;
    for (;;) {
        const bool has_next = P.next(ui + 1, nxt);
        const char* nA = has_next ? P.a_ptr(nxt) : cA; const char* nB = has_next ? P.b_ptr(nxt) : cB;
        for (int t = 0; t < nt; t += 2) {
            const bool last = (t == nt - 2);
            if (GATHER && last && has_next) {
#pragma unroll
                for (int i = 0; i < 2; ++i) gc[0][i] = (unsigned)P.gather_row(nxt, Rr[i]) * (unsigned)KB_ + (unsigned)Cc[i] * 2u;
            }
            const char* a1 = cA + (size_t)(t + 1) * kstep;
            const char* a2 = last ? nA : cA + (size_t)(t + 2) * kstep; const char* b2 = last ? nB : cB + (size_t)(t + 2) * kstep;
            const char* a3 = a2 + kstep; const char* b3 = b2 + kstep;
            PG_LDB(B0, 0, 0); PG_SCHED; PG_LDA(At, 0, 0); PG_STAGE_A(PG_SA(1, 1), a1, 1, false);
            PG_WAIT_L(8); PG_BAR; PG_WAIT_L(0); PG_MMA(0, 0, At, B0); PG_BAR; PG_SCHED;
            if (GATHER && last && has_next) {
#pragma unroll
                for (int i = 0; i < 2; ++i) gc[1][i] = (unsigned)P.gather_row(nxt, 128 + Rr[i]) * (unsigned)KB_ + (unsigned)Cc[i] * 2u;
            }
            PG_LDB(B1, 0, 1); PG_STAGE_B(PG_SB(0, 0), b2);
            PG_BAR; PG_WAIT_L(0); PG_MMA(0, 1, At, B1); PG_BAR;
            PG_LDA(At, 0, 1); PG_STAGE_A(PG_SA(0, 0), a2, 0, last);
            PG_BAR; PG_WAIT_L(0); PG_MMA(1, 0, At, B0); PG_BAR; PG_SCHED;
            PG_STAGE_B(PG_SB(0, 1), b2 + hstep);
            PG_WAIT_V(6); PG_BAR; PG_MMA(1, 1, At, B1); PG_BAR;
            PG_LDB(B0, 1, 0); PG_SCHED; PG_LDA(At, 1, 0); PG_STAGE_A(PG_SA(0, 1), a2, 1, last);
            PG_WAIT_L(8); PG_BAR; PG_WAIT_L(0); PG_MMA(0, 0, At, B0); PG_BAR; PG_SCHED;
            PG_LDB(B1, 1, 1); PG_STAGE_B(PG_SB(1, 0), b3);
            PG_BAR; PG_WAIT_L(0); PG_MMA(0, 1, At, B1); PG_BAR;
            PG_LDA(At, 1, 1); PG_STAGE_A(PG_SA(1, 0), a3, 0, last);
            PG_BAR; PG_WAIT_L(0); PG_MMA(1, 0, At, B0); PG_BAR; PG_SCHED;
            PG_STAGE_B(PG_SB(1, 1), b3 + hstep);
            PG_WAIT_V(6); PG_BAR; PG_MMA(1, 1, At, B1); PG_BAR;
        }
        P.epi(acc, cur, wr, wc, fr, fq);
        if (!has_next) break;
#pragma unroll
        for (int a = 0; a < 2; ++a)
#pragma unroll
            for (int b = 0; b < 2; ++b)
#pragma unroll
                for (int m = 0; m < 4; ++m)
#pragma unroll
                    for (int n = 0; n < 2; ++n) acc[a][b][m][n] = (f32x4){0.f, 0.f, 0.f, 0.f};
        cur = nxt; cA = nA; cB = nB; ++ui;
    }
    PG_WAIT_V(0);
    if (wr == 0) PG_BAR;
    PG_BAR;
}

struct ProbIn {
    CParams& p; int l; int bid, nblk;
    __device__ __forceinline__ bool next(int i, Unit& u) const { return tile_order(i, NROW / 256, INCP / 256, u, bid, nblk); }
    __device__ __forceinline__ const char* a_ptr(const Unit& u) const { return (const char*)p.H + (size_t)u.pm * 256 * KB_; }
    __device__ __forceinline__ const char* b_ptr(const Unit& u) const { return (const char*)p.WTIN + ((size_t)l * INCP + (size_t)u.pn * 256) * KB_; }
    __device__ __forceinline__ int gather_row(const Unit&, int) const { return 0; }
    __device__ __forceinline__ void epi(const f32x4 (&acc)[2][2][4][2], const Unit& u, int wr, int wc, int fr, int fq) const {
        const int brow = u.pm * 256, bcol = u.pn * 256;
        const int bb = u.pm / 17, pos0 = (u.pm % 17) * 256;
#pragma unroll
        for (int bj = 0; bj < 2; ++bj)
#pragma unroll
            for (int n = 0; n < 2; ++n) {
                const int gcol = bcol + bj * 128 + wc * 32 + n * 16;
                const int col = gcol + fq * 4;
                if (gcol < 1472) {
#pragma unroll
                    for (int ai = 0; ai < 2; ++ai)
#pragma unroll
                        for (int m = 0; m < 4; ++m) *(f32x4*)(p.P + (size_t)(brow + ai * 128 + wr * 64 + m * 16 + fr) * PST + col) = acc[ai][bj][m][n];
                } else if (gcol < 2496) {
                    const bool isq = gcol < 1984; const int cq = col - (isq ? 1472 : 1984), hh = cq >> 6, dim = cq & 63;
                    bf16_t* base = (isq ? p.QH : p.KH) + ((size_t)(bb * 8 + hh) * TPB) * 64 + dim;
                    const float sc = isq ? 0.125f : 1.f;
#pragma unroll
                    for (int ai = 0; ai < 2; ++ai)
#pragma unroll
                        for (int m = 0; m < 4; ++m) {
                            const int pos = pos0 + ai * 128 + wr * 64 + m * 16 + fr; const f32x4 v = acc[ai][bj][m][n] * sc;
                            u32x2 o; o.x = cvt_pk_bf16(v[0], v[1]); o.y = cvt_pk_bf16(v[2], v[3]);
                            *(u32x2*)(base + (size_t)pos * 64) = o;
                        }
                } else if (gcol < INC) {
                    const int cq = col - 2496, hh = cq >> 6, dim = cq & 63;
                    bf16_t* base = p.VT + ((size_t)(bb * 8 + hh) * 64 + dim) * TPB;
#pragma unroll
                    for (int ai = 0; ai < 2; ++ai)
#pragma unroll
                        for (int m = 0; m < 4; ++m) {
                            const int pos = pos0 + ai * 128 + wr * 64 + m * 16 + fr;
#pragma unroll
                            for (int j = 0; j < 4; ++j) base[(size_t)j * TPB + pos] = f2bf(acc[ai][bj][m][n][j]);
                        }
                }
            }
    }
};
__device__ __forceinline__ void d_gemm_in(CParams& p, int wv, int l) { ProbIn P{p, l, 0, 0}; gemm_phase<false>(P, wv); }

struct ProbOut {
    CParams& p; int l; int skip_ctx; int bid, nblk;
    __device__ __forceinline__ bool next(int i, Unit& u) const {
        if (!tile_order(i, skip_ctx ? 64 : 68, 4, u, bid, nblk)) return false;
        if (skip_ctx) u.pm = (u.pm / 16) * 17 + 1 + (u.pm % 16);
        return true; }
    __device__ __forceinline__ const char* a_ptr(const Unit& u) const { return (const char*)p.MIX + (size_t)u.pm * 256 * KB_; }
    __device__ __forceinline__ const char* b_ptr(const Unit& u) const { return (const char*)p.WTOUT + ((size_t)l * DM + (size_t)u.pn * 256) * KB_; }
    __device__ __forceinline__ int gather_row(const Unit&, int) const { return 0; }
    __device__ __forceinline__ void epi(const f32x4 (&acc)[2][2][4][2], const Unit& u, int wr, int wc, int fr, int fq) const {
        const int brow = u.pm * 256, bcol = u.pn * 256;
        const int b = u.pm / 17, mr = (u.pm % 17) == 0 ? 4 : b;
        const float* gate = p.MOD + (l * 5 + mr) * 6144 + 2 * DM;
#pragma unroll
        for (int ai = 0; ai < 2; ++ai)
#pragma unroll
            for (int m = 0; m < 4; ++m) {
                const size_t roff = (size_t)(brow + ai * 128 + wr * 64 + m * 16 + fr) * DM;
#pragma unroll
                for (int bj = 0; bj < 2; ++bj)
#pragma unroll
                    for (int n = 0; n < 2; ++n) {
                        const int col = bcol + bj * 128 + wc * 32 + n * 16 + fq * 4;
                        const f32x4 gt = *(const f32x4*)(gate + col);
                        *(f32x4*)(p.X2 + roff + col) = *(const f32x4*)(p.X + roff + col) + gt * acc[ai][bj][m][n];
                    }
                asm volatile("" ::: "memory");
            }
    }
};
__device__ __forceinline__ void d_gemm_out(CParams& p, int wv, int l, int skip_ctx) { ProbOut P{p, l, skip_ctx, 0, 0}; gemm_phase<false>(P, wv); }

__device__ __forceinline__ int rwkv_pos(int d, int c, int t) { return d == 0 ? c * 64 + t : (c < 4 ? 255 - (c * 64 + t) : 4351 - ((c - 4) * 64 + t)); }
#define DPP_SHR(oldv, v, n) __int_as_float(__builtin_amdgcn_update_dpp(__float_as_int(oldv), __float_as_int(v), 0x110 + (n), 0xf, 0xf, false))
#define BCAST15(v) __int_as_float(__builtin_amdgcn_ds_swizzle(__float_as_int(v), (0x0f << 5) | 0x10))
__device__ __forceinline__ void d_lru_local(CParams& p, int wv, int l) {
    const int tidx_ = opaque_tid(wv);
    int bidx_ = blockIdx.x, gdim_ = gridDim.x; asm volatile("" : "+s"(bidx_), "+s"(gdim_));
    const int lane = tidx_ & 63, gw = bidx_ * 8 + wv, NGW = gdim_ * 8, m16 = lane & 15, g = lane >> 4;
    LAS unsigned char* xcs = (LAS unsigned char*)smem + 8192 + wv * (64 * RWS);
    const bool bal = NGW == 2048;
    for (int rnd = 0; ; ++rnd) {
        int task;
        if (bal) { if (rnd == 0) task = gw; else if (rnd == 1 && gw >= 256 && gw < 384) task = 2048 + (gw - 256); else break; }
        else { task = gw + rnd * NGW; if (task >= 2176) break; }
        const int c = task % 68, h = (task / 68) & 3, d = (task / 272) & 1, b = task / 544;
        const size_t rb = (size_t)b * TPB;
        {
            const int ch = h * 64 + lane;
            const float* cw = p.in[I_CONVW] + ((l * 2 + d) * 4) * 256 + ch;
            const float cw0 = cw[0], cw1 = cw[256], cw2 = cw[512], cw3 = cw[768], cb = p.in[I_CONVB][(l * 2 + d) * 256 + ch];
            float x1 = 0.f, x2 = 0.f, x3 = 0.f;
            if (c != 0 && c != 4) { x1 = p.P[(rb + rwkv_pos(d, c - 1, 63)) * PST + ch]; x2 = p.P[(rb + rwkv_pos(d, c - 1, 62)) * PST + ch]; x3 = p.P[(rb + rwkv_pos(d, c - 1, 61)) * PST + ch]; }
            __builtin_amdgcn_wave_barrier();
            float xin[64];
            { const int pstep = d == 0 ? PST : -PST; const float* px = p.P + (rb + rwkv_pos(d, c, 0)) * PST + ch;
#pragma unroll
              for (int t = 0; t < 64; ++t) xin[t] = px[(long)t * pstep]; }
#pragma unroll
            for (int t = 0; t < 64; ++t) {
                const float x0 = xin[t];
                const float xc = cb + cw0 * x0 + cw1 * x1 + cw2 * x2 + cw3 * x3;
                x3 = x2; x2 = x1; x1 = x0;
                *(LAS bf16_t*)(xcs + t * RWS + lane * 2) = f2bf(xc);
            }
            __builtin_amdgcn_wave_barrier();
        }
        bf16x8 xb[4][2];
#pragma unroll
        for (int tt = 0; tt < 4; ++tt)
#pragma unroll
            for (int ks = 0; ks < 2; ++ks) xb[tt][ks] = *(const LAS bf16x8*)(xcs + (tt * 16 + m16) * RWS + ks * 64 + g * 16);
        const bf16_t* wt = p.LWT + (size_t)((l * 2 + d) * 4 + h) * 2 * 4096;
#pragma unroll 1
        for (int jt = 0; jt < 4; ++jt) {
            const int j0 = jt * 16 + 4 * g, chj = h * 64 + j0;
            bf16x8 wa[2][2];
#pragma unroll
            for (int gt = 0; gt < 2; ++gt)
#pragma unroll
                for (int ks = 0; ks < 2; ++ks) wa[gt][ks] = *(const bf16x8*)(wt + (size_t)gt * 4096 + (jt * 16 + m16) * 64 + ks * 32 + 8 * g);
            const f32x4 brv = *(const f32x4*)(p.in[I_BR] + (l * 2 + d) * 256 + chj), biv = *(const f32x4*)(p.in[I_BI] + (l * 2 + d) * 256 + chj);
            const f32x4 lamv = *(const f32x4*)(p.in[I_LAM] + (l * 2 + d) * 256 + chj);
            float spl8[4];
#pragma unroll
            for (int r = 0; r < 4; ++r) spl8[r] = -8.0f * softplusf_(-lamv[r]);
            float ca[4] = {1.f, 1.f, 1.f, 1.f}, chh[4] = {0.f, 0.f, 0.f, 0.f};
#pragma unroll
            for (int tt = 0; tt < 4; ++tt) {
                f32x4 dr = {0.f, 0.f, 0.f, 0.f}, di = {0.f, 0.f, 0.f, 0.f};
#pragma unroll
                for (int ks = 0; ks < 2; ++ks) { dr = __builtin_amdgcn_mfma_f32_16x16x32_bf16(wa[0][ks], xb[tt][ks], dr, 0, 0, 0); di = __builtin_amdgcn_mfma_f32_16x16x32_bf16(wa[1][ks], xb[tt][ks], di, 0, 0, 0); }
                const int t = tt * 16 + m16;
                const u32x2 xw = *(const LAS u32x2*)(xcs + t * RWS + j0 * 2);
                const float xcv[4] = {__uint_as_float(xw.x << 16), __uint_as_float(xw.x & 0xffff0000u), __uint_as_float(xw.y << 16), __uint_as_float(xw.y & 0xffff0000u)};
                f32x4 av, bv;
#pragma unroll
                for (int r = 0; r < 4; ++r) {
                    const float gr = sigmoidf_(dr[r] + brv[r]), gi = sigmoidf_(di[r] + biv[r]);
                    const float log_a = gr * spl8[r];
                    float a = __expf(log_a), bb = __builtin_amdgcn_sqrtf(fmaxf(1.f - a * a, 0.f)) * (gi * xcv[r]);
#define SCAN_STEP(sh) { const float ap = DPP_SHR(1.f, a, sh), bp = DPP_SHR(0.f, bb, sh); bb = a * bp + bb; a = a * ap; }
                    SCAN_STEP(1) SCAN_STEP(2) SCAN_STEP(4) SCAN_STEP(8)
#undef SCAN_STEP
                    bb = a * chh[r] + bb; a = a * ca[r];
                    av[r] = a; bv[r] = bb;
                    ca[r] = BCAST15(a); chh[r] = BCAST15(bb);
                }
                const size_t R = rb + rwkv_pos(d, c, t);
                *(f32x4*)(p.LA + ((size_t)d * NROW + R) * 256 + chj) = bv;
                *(f32x4*)(p.LB + ((size_t)d * NROW + R) * 256 + chj) = av;
                if (tt == 3 && m16 == 15) { *(f32x4*)(p.LCE + (size_t)task * 128 + j0) = av; *(f32x4*)(p.LCE + (size_t)task * 128 + 64 + j0) = bv; }
            }
        }
    }
}
__device__ __forceinline__ void d_lru_carry(CParams& p, int widx, int lane) {
    const int gt = widx * 64 + lane;
    const int ch = gt & 255, d = (gt >> 8) & 1, b = gt >> 9, h = ch >> 6, j = ch & 63;
    const float* ce = p.LCE + (size_t)(((b * 2 + d) * 4 + h) * 68) * 128 + j;
    float* ci = p.LCI + (size_t)((b * 2 + d) * 68) * 256 + ch;
    float carry = 0.f;
#pragma unroll 1
    for (int c0 = 0; c0 < 68; c0 += 17) {
        float a[17], e[17];
#pragma unroll
        for (int u = 0; u < 17; ++u) { a[u] = ce[(size_t)(c0 + u) * 128]; e[u] = ce[(size_t)(c0 + u) * 128 + 64]; }
#pragma unroll
        for (int u = 0; u < 17; ++u) { ci[(size_t)(c0 + u) * 256] = carry; carry = a[u] * carry + e[u]; }
    }
}
__device__ __forceinline__ float lru_h(CParams& p, int b, int pos, size_t R, int d, int ch) {
    const int sidx = d == 0 ? pos : (pos < CTXL ? CTXL - 1 - pos : CTXL + (TPB - 1 - pos));
    const float ci = p.LCI[(size_t)((b * 2 + d) * 68 + (sidx >> 6)) * 256 + ch];
    return p.LA[((size_t)d * NROW + R) * 256 + ch] + p.LB[((size_t)d * NROW + R) * 256 + ch] * ci;
}

__device__ __forceinline__ float sigmoid_fast(float x) { return __builtin_amdgcn_rcpf(1.f + __expf(-x)); }
template <int MTX>
__device__ __forceinline__ void rwkv_pre_mtx(CParams& p, int l, const LAS unsigned char* stash, int R0, int lane) {
    const int m16 = lane & 15, g = lane >> 4;
    constexpr int src = MTX < 2 ? 0 : (MTX < 4 ? 1 : 2), d = MTX & 1;
    const bf16x8 a0 = *(const LAS bf16x8*)(stash + (src * 16 + m16) * RWS + g * 16), a1 = *(const LAS bf16x8*)(stash + (src * 16 + m16) * RWS + 64 + g * 16);
    const bf16_t* wt = p.RWT + (size_t)(l * 5 + MTX) * 16384 + (size_t)m16 * 64 + 8 * g;
    const float* cst = MTX < 2 ? p.in[I_W0] + (l * 2 + d) * 256 + m16 : p.in[I_A0] + (l * 2 + d) * 256 + m16;
    float* dst = (MTX < 2 ? p.DEC + (size_t)d * NROW * 256 : (MTX < 4 ? p.AIC + (size_t)d * NROW * 256 : p.GG)) + ((size_t)R0 + 4 * g) * 256 + m16;
#pragma unroll 1
    for (int half = 0; half < 2; ++half) {
        bf16x8 b0[8], b1[8]; float cv[8];
        const bf16_t* wh = wt + half * 8192; const float* ch_ = cst + half * 128; float* dh = dst + half * 128;
#pragma unroll
        for (int i = 0; i < 8; ++i) { b0[i] = *(const bf16x8*)(wh + i * 1024); b1[i] = *(const bf16x8*)(wh + i * 1024 + 32); cv[i] = MTX < 4 ? ch_[i * 16] : 0.f; }
#pragma unroll
        for (int i = 0; i < 8; ++i) {
            f32x4 acc = {0.f, 0.f, 0.f, 0.f};
            acc = __builtin_amdgcn_mfma_f32_16x16x32_bf16(a0, b0[i], acc, 0, 0, 0);
            acc = __builtin_amdgcn_mfma_f32_16x16x32_bf16(a1, b1[i], acc, 0, 0, 0);
#pragma unroll
            for (int r = 0; r < 4; ++r) {
                float o;
                if (MTX < 2) { const float w = -softplus_fast(-(cv[i] + acc[r])) - 0.5f; o = -__expf(w); }
                else if (MTX < 4) o = sigmoid_fast(cv[i] + acc[r]);
                else o = acc[r];
                dh[r * 256 + i * 16] = o;
            }
        }
    }
}
__device__ __forceinline__ void d_rwkv_pre(CParams& p, int wv, int l) {
    const int tidx_ = opaque_tid(wv);
    int bidx_ = blockIdx.x, gdim_ = gridDim.x; asm volatile("" : "+s"(bidx_), "+s"(gdim_));
    const int lane = tidx_ & 63, gw = bidx_ * 8 + wv, NGW = gdim_ * 8, m16 = lane & 15, g = lane >> 4;
    LAS unsigned char* stash = (LAS unsigned char*)smem + 90112 + wv * (3 * 16 * RWS);
    const float* mu = p.in[I_MU] + l * 2 * 960;
    const int gw2 = NGW == 2048 ? (gw + 1088) % 2048 : gw;
    for (int tile = gw2; tile < NROW / 16; tile += NGW) {
        const int R0 = tile * 16;
        float pvv[15], cvv[15], nvv[15];
        {
            const int pos0 = R0 % TPB; const bool hasp = pos0 != 0 && pos0 != CTXL;
            const float* pr0 = p.P + (size_t)R0 * PST + 512;
#pragma unroll
            for (int q = 0; q < 15; ++q) { const int col = lane + 64 * q; pvv[q] = hasp ? pr0[col - PST] : 0.f; cvv[q] = pr0[col]; }
        }
#pragma unroll 2
        for (int rr = 0; rr < 16; ++rr) {
            const int R = R0 + rr, pos = R % TPB;
            const int seg1 = pos < CTXL ? CTXL : TPB;
            const float* pr = p.P + (size_t)R * PST + 512;
            const bool hasn = pos + 1 < seg1;
            float sv[15];
#pragma unroll
            for (int q = 0; q < 15; ++q) {
                const int col = lane + 64 * q;
                nvv[q] = hasn ? pr[col + PST] : 0.f;
                const float v = cvv[q];
                sv[q] = v + mu[col] * (pvv[q] - v) + mu[960 + col] * (nvv[q] - v);
                pvv[q] = v; cvv[q] = nvv[q];
            }
#pragma unroll
            for (int q = 0; q < 12; ++q) p.RS[(size_t)R * 768 + lane + 64 * q] = sv[q];
            *(LAS bf16_t*)(stash + (0 * 16 + rr) * RWS + lane * 2) = f2bf(tanh_fast(sv[12]));
            *(LAS bf16_t*)(stash + (1 * 16 + rr) * RWS + lane * 2) = f2bf(sv[13]);
            *(LAS bf16_t*)(stash + (2 * 16 + rr) * RWS + lane * 2) = f2bf(sigmoidf_(sv[14]));
#pragma unroll
            for (int hq = 0; hq < 4; ++hq) {
                const int c = hq * 64 + lane;
                const float kk = sv[4 + hq] * p.in[I_KK][l * 256 + c];
                const float n2 = wave_sum(kk * kk);
                p.KKN[(size_t)R * 256 + c] = kk / fmaxf(sqrtf(n2), 1e-12f);
            }
        }
        __builtin_amdgcn_wave_barrier();
        rwkv_pre_mtx<0>(p, l, stash, R0, lane); rwkv_pre_mtx<1>(p, l, stash, R0, lane); rwkv_pre_mtx<2>(p, l, stash, R0, lane);
        rwkv_pre_mtx<3>(p, l, stash, R0, lane); rwkv_pre_mtx<4>(p, l, stash, R0, lane);
        __builtin_amdgcn_wave_barrier();
    }
}
#define RSLOT(k) (lds + (k) * 9216)
__device__ __forceinline__ void mm2(const LAS unsigned char* Xr, const LAS unsigned char* Yt, int mi, int ni0, int lane, f32x4 (&acc)[2]) {
    const int m = lane & 15, g = lane >> 4;
#pragma unroll
    for (int ks = 0; ks < 2; ++ks) {
        const bf16x8 a = *(const LAS bf16x8*)(Xr + (mi * 16 + m) * RWS + ks * 64 + g * 16);
#pragma unroll
        for (int n = 0; n < 2; ++n) {
            const bf16x8 b = *(const LAS bf16x8*)(Yt + ((ni0 + n) * 16 + m) * RWS + ks * 64 + g * 16);
            acc[n] = __builtin_amdgcn_mfma_f32_16x16x32_bf16(a, b, acc[n], 0, 0, 0);
        }
    }
}
__device__ __forceinline__ void st_r(LAS unsigned char* dst, int mi, int ni, int lane, const f32x4& v) {
    const int m = lane & 15, g = lane >> 4;
#pragma unroll
    for (int r = 0; r < 4; ++r) *(LAS bf16_t*)(dst + (mi * 16 + 4 * g + r) * RWS + (ni * 16 + m) * 2) = f2bf(v[r]);
}
__device__ __forceinline__ void st_t(LAS unsigned char* dst, int mi, int ni, int lane, const f32x4& v) {
    const int m = lane & 15, g = lane >> 4;
    u32x2 o; o.x = cvt_pk_bf16(v[0], v[1]); o.y = cvt_pk_bf16(v[2], v[3]);
    *(LAS u32x2*)(dst + (ni * 16 + m) * RWS + (mi * 16 + 4 * g) * 2) = o;
}
__device__ __forceinline__ float bfbits2f(unsigned short v) { return __uint_as_float(((unsigned)v) << 16); }

__device__ __forceinline__ void d_rwkv_chunkA(CParams& p, int wv, int l) {
    const int tidx_ = opaque_tid(wv);
    int bidx_ = blockIdx.x, gdim_ = gridDim.x; asm volatile("" : "+s"(bidx_), "+s"(gdim_));
    LAS unsigned char* lds = (LAS unsigned char*)smem;
    LAS float* segtot = (LAS float*)(lds + 16 * 9216);
    LAS float* gam = segtot + 512;
    const int tid = tidx_, lane = tid & 63, w = wv;
    const int mi = w >> 1, ni0 = (w & 1) * 2, m16 = lane & 15, g = lane >> 4;
    for (int task = bidx_; task < 2176; task += gdim_) {
        const int c = task % 68, d = (task / 68) & 1, h = (task / 136) & 3, b = task / 544;
        __syncthreads();
        {
            const int j = lane, tq = w, hc = h * 64 + j;
            const float ka = p.in[I_KA][l * 256 + hc];
            float lw[8], aa[8], bb[8], ke[8], rr[8], vv[8];
#pragma unroll
            for (int u = 0; u < 8; ++u) {
                const size_t R = (size_t)b * TPB + rwkv_pos(d, c, 8 * tq + u);
                lw[u] = p.DEC[((size_t)d * NROW + R) * 256 + hc];
                const float aic = p.AIC[((size_t)d * NROW + R) * 256 + hc], kkn = p.KKN[R * 256 + hc];
                const float* rs = p.RS + R * 768;
                rr[u] = rs[hc]; const float k = rs[256 + hc]; vv[u] = rs[512 + hc];
                aa[u] = -kkn; bb[u] = kkn * aic; ke[u] = k * (1.f + (aic - 1.f) * ka);
            }
            float cs[8]; cs[0] = lw[0];
#pragma unroll
            for (int u = 1; u < 8; ++u) cs[u] = cs[u - 1] + lw[u];
            segtot[tq * 64 + j] = cs[7];
            __syncthreads();
            float pre = 0.f, tot = 0.f;
#pragma unroll
            for (int q = 0; q < 8; ++q) { const float sgt = segtot[q * 64 + j]; tot += sgt; if (q < tq) pre += sgt; }
            if (tq == 0) gam[j] = __expf(tot);
            float at[8], bt[8], kt[8];
#pragma unroll
            for (int u = 0; u < 8; ++u) {
                const float Lc = pre + cs[u], Lp = Lc - lw[u];
                const float ep = __expf(Lp), ec = __expf(Lc), en = __expf(-Lc), ee = __expf(tot - Lc);
                const int t = 8 * tq + u;
                at[u] = aa[u] * ep; bt[u] = bb[u] * ee; kt[u] = ke[u] * ee;
                *(LAS bf16_t*)(RSLOT(0) + t * RWS + j * 2) = f2bf(at[u]);
                *(LAS bf16_t*)(RSLOT(1) + t * RWS + j * 2) = f2bf(rr[u] * ec);
                *(LAS bf16_t*)(RSLOT(2) + t * RWS + j * 2) = f2bf(bb[u] * en);
                *(LAS bf16_t*)(RSLOT(3) + t * RWS + j * 2) = f2bf(ke[u] * en);
            }
            u32x4 o;
            o.x = cvt_pk_bf16(at[0], at[1]); o.y = cvt_pk_bf16(at[2], at[3]); o.z = cvt_pk_bf16(at[4], at[5]); o.w = cvt_pk_bf16(at[6], at[7]);
            *(LAS u32x4*)(RSLOT(4) + j * RWS + tq * 16) = o;
            o.x = cvt_pk_bf16(bt[0], bt[1]); o.y = cvt_pk_bf16(bt[2], bt[3]); o.z = cvt_pk_bf16(bt[4], bt[5]); o.w = cvt_pk_bf16(bt[6], bt[7]);
            *(LAS u32x4*)(RSLOT(5) + j * RWS + tq * 16) = o;
            o.x = cvt_pk_bf16(kt[0], kt[1]); o.y = cvt_pk_bf16(kt[2], kt[3]); o.z = cvt_pk_bf16(kt[4], kt[5]); o.w = cvt_pk_bf16(kt[6], kt[7]);
            *(LAS u32x4*)(RSLOT(6) + j * RWS + tq * 16) = o;
            o.x = cvt_pk_bf16(vv[0], vv[1]); o.y = cvt_pk_bf16(vv[2], vv[3]); o.z = cvt_pk_bf16(vv[4], vv[5]); o.w = cvt_pk_bf16(vv[6], vv[7]);
            *(LAS u32x4*)(RSLOT(7) + j * RWS + tq * 16) = o;
        }
        __syncthreads();
        {
            f32x4 aab[2] = {}, aak[2] = {}, brb[2] = {}, brk[2] = {};
            mm2(RSLOT(0), RSLOT(2), mi, ni0, lane, aab); mm2(RSLOT(0), RSLOT(3), mi, ni0, lane, aak);
            mm2(RSLOT(1), RSLOT(2), mi, ni0, lane, brb); mm2(RSLOT(1), RSLOT(3), mi, ni0, lane, brk);
#pragma unroll
            for (int n = 0; n < 2; ++n) {
                f32x4 p0;
#pragma unroll
                for (int r = 0; r < 4; ++r) {
                    const int t = mi * 16 + 4 * g + r, sidx = (ni0 + n) * 16 + m16;
                    if (!(sidx < t)) { aab[n][r] = 0.f; aak[n][r] = 0.f; }
                    if (!(sidx <= t)) { brb[n][r] = 0.f; brk[n][r] = 0.f; }
                    p0[r] = aab[n][r] + (sidx == t ? 1.f : 0.f);
                }
                st_r(RSLOT(11), mi, ni0 + n, lane, aab[n]); st_t(RSLOT(12), mi, ni0 + n, lane, aab[n]);
                st_t(RSLOT(13), mi, ni0 + n, lane, p0);
                st_r(RSLOT(8), mi, ni0 + n, lane, aak[n]); st_r(RSLOT(9), mi, ni0 + n, lane, brb[n]); st_r(RSLOT(10), mi, ni0 + n, lane, brk[n]);
            }
        }
        __syncthreads();
#pragma unroll 1
        for (int st = 1; st <= 6; ++st) {
            LAS unsigned char* qsr = (st & 1) ? RSLOT(11) : RSLOT(0);
            LAS unsigned char* qst = (st & 1) ? RSLOT(12) : RSLOT(2);
            LAS unsigned char* qdr = (st & 1) ? RSLOT(0) : RSLOT(11);
            LAS unsigned char* qdt = (st & 1) ? RSLOT(2) : RSLOT(12);
            if (st <= 5) {
                f32x4 q[2] = {};
                mm2(qsr, qst, mi, ni0, lane, q);
#pragma unroll
                for (int n = 0; n < 2; ++n) { st_r(qdr, mi, ni0 + n, lane, q[n]); st_t(qdt, mi, ni0 + n, lane, q[n]); }
            }
            if (st >= 2) {
                LAS unsigned char* ps = (st & 1) ? RSLOT(3) : RSLOT(13);
                LAS unsigned char* pd = (st & 1) ? RSLOT(13) : RSLOT(3);
                f32x4 pp[2];
#pragma unroll
                for (int n = 0; n < 2; ++n) {
                    const u32x2 o = *(const LAS u32x2*)(ps + ((ni0 + n) * 16 + m16) * RWS + (mi * 16 + 4 * g) * 2);
                    pp[n][0] = __uint_as_float(o.x << 16); pp[n][1] = __uint_as_float(o.x & 0xffff0000u); pp[n][2] = __uint_as_float(o.y << 16); pp[n][3] = __uint_as_float(o.y & 0xffff0000u);
                }
                mm2(qsr, ps, mi, ni0, lane, pp);
#pragma unroll
                for (int n = 0; n < 2; ++n) { st_t(pd, mi, ni0 + n, lane, pp[n]); if (st == 6) st_r(RSLOT(15), mi, ni0 + n, lane, pp[n]); }
            }
            if (st == 1) {
                f32x4 akv[2] = {};
                mm2(RSLOT(8), RSLOT(7), mi, ni0, lane, akv);
#pragma unroll
                for (int n = 0; n < 2; ++n) st_t(RSLOT(14), mi, ni0 + n, lane, akv[n]);
            }
            __syncthreads();
        }
        {
            f32x4 w1[2] = {}, z[2] = {};
            mm2(RSLOT(15), RSLOT(4), mi, ni0, lane, w1); mm2(RSLOT(15), RSLOT(14), mi, ni0, lane, z);
#pragma unroll
            for (int n = 0; n < 2; ++n) { st_t(RSLOT(11), mi, ni0 + n, lane, w1[n]); st_t(RSLOT(12), mi, ni0 + n, lane, z[n]); }
        }
        __syncthreads();
        {
            f32x4 mm_[2] = {}, nn[2] = {}, qq[2] = {}, yl[2] = {};
            mm2(RSLOT(5), RSLOT(11), mi, ni0, lane, mm_);
            mm2(RSLOT(5), RSLOT(12), mi, ni0, lane, nn); mm2(RSLOT(6), RSLOT(7), mi, ni0, lane, nn);
            mm2(RSLOT(9), RSLOT(11), mi, ni0, lane, qq);
            mm2(RSLOT(9), RSLOT(12), mi, ni0, lane, yl); mm2(RSLOT(10), RSLOT(7), mi, ni0, lane, yl);
#pragma unroll
            for (int n = 0; n < 2; ++n) {
#pragma unroll
                for (int r = 0; r < 4; ++r) {
                    const int row = mi * 16 + 4 * g + r, col = (ni0 + n) * 16 + m16;
                    if (row == col) mm_[n][r] += gam[row];
                    qq[n][r] += bfbits2f(*(const LAS bf16_t*)(RSLOT(1) + row * RWS + col * 2));
                }
                st_r(RSLOT(0), mi, ni0 + n, lane, mm_[n]); st_r(RSLOT(2), mi, ni0 + n, lane, qq[n]);
                *(f32x4*)(p.RNF + (size_t)task * 4096 + (((ni0 + n) * 4 + mi) * 64 + lane) * 4) = nn[n];
#pragma unroll
                for (int r = 0; r < 4; ++r) p.RYF[(size_t)task * 4096 + (mi * 16 + 4 * g + r) * 64 + (ni0 + n) * 16 + m16] = yl[n][r];
            }
        }
        __syncthreads();
        {
            const int jb = tid >> 7, sk = (tid >> 6) & 1;
            const int row = jb * 16 + m16;
            const u32x2 m0 = *(const LAS u32x2*)(RSLOT(0) + row * RWS + (32 * sk + 4 * g) * 2), m1 = *(const LAS u32x2*)(RSLOT(0) + row * RWS + (32 * sk + 16 + 4 * g) * 2);
            const u32x2 q0 = *(const LAS u32x2*)(RSLOT(2) + row * RWS + (32 * sk + 4 * g) * 2), q1 = *(const LAS u32x2*)(RSLOT(2) + row * RWS + (32 * sk + 16 + 4 * g) * 2);
            *(u32x4*)(p.RMF + (size_t)task * 4096 + (size_t)tid * 8) = (u32x4){m0.x, m0.y, m1.x, m1.y};
            *(u32x4*)(p.RQF + (size_t)task * 4096 + (size_t)tid * 8) = (u32x4){q0.x, q0.y, q1.x, q1.y};
        }
    }
    __syncthreads();
}

#define SEQ_LOAD(M_, N_, cc) do { const int c_ = (cc) < 68 ? (cc) : 67; const size_t tk_ = task0 + c_; \
    const bf16x8* mf_ = (const bf16x8*)(p.RMF + tk_ * 4096) + lane; const f32x4* nf_ = (const f32x4*)(p.RNF + tk_ * 4096) + (ib * 4) * 64 + lane; \
    _Pragma("unroll") for (int jb = 0; jb < 4; ++jb) { M_[jb][0] = mf_[(jb * 2) * 64]; M_[jb][1] = mf_[(jb * 2 + 1) * 64]; N_[jb] = nf_[jb * 64]; } } while (0)
#define SEQ_STEP(M_, N_, cc) do { bf16x8 bfr[2]; \
    _Pragma("unroll") for (int sk = 0; sk < 2; ++sk) { union { u32x4 u; bf16x8 v; } cv; \
        cv.u.x = cvt_pk_bf16(S[2 * sk][0], S[2 * sk][1]); cv.u.y = cvt_pk_bf16(S[2 * sk][2], S[2 * sk][3]); \
        cv.u.z = cvt_pk_bf16(S[2 * sk + 1][0], S[2 * sk + 1][1]); cv.u.w = cvt_pk_bf16(S[2 * sk + 1][2], S[2 * sk + 1][3]); bfr[sk] = cv.v; \
        *((bf16x8*)(p.S0F + (task0 + (cc)) * 4096) + (ib * 2 + sk) * 64 + lane) = cv.v; } \
    _Pragma("unroll") for (int jb = 0; jb < 4; ++jb) { f32x4 a_ = N_[jb]; \
        a_ = __builtin_amdgcn_mfma_f32_16x16x32_bf16(M_[jb][0], bfr[0], a_, 0, 0, 0); a_ = __builtin_amdgcn_mfma_f32_16x16x32_bf16(M_[jb][1], bfr[1], a_, 0, 0, 0); S[jb] = a_; } } while (0)
__device__ __forceinline__ void d_rwkv_seq(CParams& p, int widx, int ib, int lane) {
    const int d = widx & 1, h = (widx >> 1) & 3, b = widx >> 3;
    f32x4 S[4];
#pragma unroll
    for (int jb = 0; jb < 4; ++jb) S[jb] = (f32x4){0.f, 0.f, 0.f, 0.f};
    const size_t task0 = (size_t)((b * 4 + h) * 2 + d) * 68;
    bf16x8 MA[4][2], MB[4][2], MC[4][2]; f32x4 NA[4], NB[4], NC[4];
    SEQ_LOAD(MA, NA, 0); SEQ_LOAD(MB, NB, 1);
#pragma unroll 1
    for (int c = 0; c < 66; c += 3) {
        SEQ_LOAD(MC, NC, c + 2); SEQ_STEP(MA, NA, c);
        SEQ_LOAD(MA, NA, c + 3); SEQ_STEP(MB, NB, c + 1);
        SEQ_LOAD(MB, NB, c + 4); SEQ_STEP(MC, NC, c + 2);
    }
    SEQ_STEP(MA, NA, 66); SEQ_STEP(MB, NB, 67);
}

__device__ __forceinline__ float xor16_max(float v) { return fmaxf(v, SWZ_XOR(v, 16)); }
__device__ __forceinline__ float max_xor32(float v) {
    int a = __float_as_int(v), b = a;
    asm volatile("s_nop 1\n\tv_permlane32_swap_b32 %0, %1\n\ts_nop 1" : "+v"(a), "+v"(b));
    return fmaxf(__int_as_float(a), __int_as_float(b));
}
#define NA_KB 15360
#define NA_KC 98304
#define NA_KST 144
#define NA_VBS 1168
#define NA_VCS 528
template <bool BAND>
__device__ __forceinline__ void attn_scores(const LAS unsigned char* kbase  , int ustride  ,
                                            const bf16x8 (&qf)[2], const float* rpbh, int c, int rr, int rs, int kc0, int lane, float& mrow, float& lrow, bf16x8 (&pf)[8]) {
    const int g = lane >> 4;
    f32x4 sc[16];
#pragma unroll
    for (int u = 0; u < 8; ++u) {
#pragma unroll
        for (int j2 = 0; j2 < 2; ++j2) {
            const LAS unsigned char* kr = kbase + u * ustride + j2 * (16 * NA_KST);
            const bf16x8 k0 = *(const LAS bf16x8*)kr, k1 = *(const LAS bf16x8*)(kr + 64);
            f32x4 a = {0.f, 0.f, 0.f, 0.f};
            a = __builtin_amdgcn_mfma_f32_16x16x32_bf16(k0, qf[0], a, 0, 0, 0);
            a = __builtin_amdgcn_mfma_f32_16x16x32_bf16(k1, qf[1], a, 0, 0, 0);
            if (BAND) {
                const int cs = min(max(c - 8, 0), 48);
#pragma unroll
                for (int r = 0; r < 4; ++r) {
                    const int kc = kc0 + 16 * j2 + 4 * g + r;
                    const int cb = min(max(kc - c + 15, 0), 30);
                    const float bias = rpbh[(rs + u - rr + 7) * 31 + cb];
                    a[r] = (kc >= cs && kc < cs + 16) ? a[r] + bias : -1e30f;
                }
            }
            sc[2 * u + j2] = a;
        }
    }
    float mx = -1e30f;
#pragma unroll
    for (int t = 0; t < 16; ++t) mx = fmaxf(mx, fmaxf(fmaxf(sc[t][0], sc[t][1]), fmaxf(sc[t][2], sc[t][3])));
    mx = xor16_max(mx); mx = max_xor32(mx);
    float sum = 0.f;
#pragma unroll
    for (int t = 0; t < 16; ++t)
#pragma unroll
        for (int r = 0; r < 4; ++r) { const float e = __expf(sc[t][r] - mx); sc[t][r] = e; sum += e; }
    sum += SWZ_XOR(sum, 16); sum = sum_xor32(sum);
    mrow = mx; lrow = sum;
#pragma unroll
    for (int u = 0; u < 8; ++u) {
        union { u32x4 w; bf16x8 v; } t;
        t.w.x = cvt_pk_bf16(sc[2 * u][0], sc[2 * u][1]); t.w.y = cvt_pk_bf16(sc[2 * u][2], sc[2 * u][3]);
        t.w.z = cvt_pk_bf16(sc[2 * u + 1][0], sc[2 * u + 1][1]); t.w.w = cvt_pk_bf16(sc[2 * u + 1][2], sc[2 * u + 1][3]);
        pf[u] = t.v;
    }
}
__device__ __forceinline__ void attn_pv(const LAS unsigned char* vbase, int vstride  , int ustride  , const bf16x8 (&pf)[8], f32x4 (&o)[4]) {
#pragma unroll
    for (int dt = 0; dt < 4; ++dt) o[dt] = (f32x4){0.f, 0.f, 0.f, 0.f};
#pragma unroll
    for (int u = 0; u < 8; ++u)
#pragma unroll
        for (int dt = 0; dt < 4; ++dt) {
            const LAS unsigned char* vr = vbase + dt * 16 * vstride + u * ustride;
            const u32x2 v0 = *(const LAS u32x2*)vr, v1 = *(const LAS u32x2*)(vr + 32);
            union { u32x4 w; bf16x8 v; } vf; vf.w = (u32x4){v0.x, v0.y, v1.x, v1.y};
            o[dt] = __builtin_amdgcn_mfma_f32_16x16x32_bf16(vf.v, pf[u], o[dt], 0, 0, 0);
        }
}
__device__ __forceinline__ void d_na(CParams& p, int wv, int l, int do_ctx, int bid, int nblk) {
    const int tidx_ = opaque_tid(wv);
    const int lane = tidx_ & 63, m16 = lane & 15, g = lane >> 4;
    LAS unsigned char* lds = (LAS unsigned char*)smem;
    const float* rpbs = (const float*)smem;
    const int nbt = 1024 + (do_ctx ? 64 : 0);
    for (int bt = bid; bt < nbt; bt += nblk) {
        const bool lat = bt < 1024;
        int b, h, rs0 = 0, nrows = 0, rr = 0, rs = 0, c0 = 0, kc0 = 0, qpos0;
        if (lat) { b = bt >> 8; h = (bt >> 5) & 7; const int r0 = (bt & 31) * 2; rs0 = min(max(r0 - 4, 0), 56); nrows = min(9, 64 - rs0);
            rr = r0 + (wv >> 2); rs = min(max(rr - 4, 0), 56); c0 = (wv & 3) * 16; kc0 = min(max(c0 - 8, 0), 32); qpos0 = CTXL + rr * 64 + c0; }
        else { const int t2 = bt - 1024; b = t2 >> 4; h = (t2 >> 1) & 7; qpos0 = ((t2 & 1) * 8 + wv) * 16; }
        const bf16_t* QHh = p.QH + (size_t)(b * 8 + h) * TPB * 64;
        const bf16_t* KHh = p.KH + (size_t)(b * 8 + h) * TPB * 64;
        const bf16_t* VTh = p.VT + (size_t)(b * 8 + h) * 64 * TPB;
        const int kpos0 = CTXL + rs0 * 64, nkb = nrows * 64;
        bf16x8 qf[2];
        { const bf16_t* qr = QHh + (size_t)(qpos0 + m16) * 64 + 8 * g; qf[0] = *(const bf16x8*)qr; qf[1] = *(const bf16x8*)(qr + 32); }
        __syncthreads();
        for (int q = tidx_; q < nkb * 8; q += NTHR) { const int key = q >> 3, part = q & 7; *(LAS u32x4*)(lds + NA_KB + key * NA_KST + part * 16) = *(const u32x4*)(KHh + (size_t)(kpos0 + key) * 64 + part * 8); }
        for (int q = tidx_; q < 256 * 8; q += NTHR) { const int key = q >> 3, part = q & 7; *(LAS u32x4*)(lds + NA_KC + key * NA_KST + part * 16) = *(const u32x4*)(KHh + (size_t)key * 64 + part * 8); }
        __syncthreads();
        float m1 = -1e30f, l1 = 0.f, m2, l2; bf16x8 pf1[8], pf2[8];
        const int c = c0 + m16, lr0 = rs - rs0;
        attn_scores<false>(lds + NA_KC + m16 * NA_KST + 16 * g, 32 * NA_KST, qf, nullptr, 0, 0, 0, 0, lane, m2, l2, pf2);
        if (lat) attn_scores<true>(lds + NA_KB + ((lr0 * 64 + kc0 + m16) * NA_KST) + 16 * g, 64 * NA_KST, qf, rpbs + h * 465, c, rr, rs, kc0, lane, m1, l1, pf1);
        __syncthreads();
        if (lat) for (int q = tidx_; q < 64 * nrows * 8; q += NTHR) { const int dim = q / (nrows * 8), part = q % (nrows * 8);
            *(LAS u32x4*)(lds + NA_KB + dim * NA_VBS + part * 16) = *(const u32x4*)(VTh + (size_t)dim * TPB + kpos0 + part * 8); }
        for (int q = tidx_; q < 64 * 32; q += NTHR) { const int dim = q >> 5, part = q & 31; *(LAS u32x4*)(lds + NA_KC + dim * NA_VCS + part * 16) = *(const u32x4*)(VTh + (size_t)dim * TPB + part * 8); }
        __syncthreads();
        f32x4 o2[4]; float inv;
        attn_pv(lds + NA_KC + m16 * NA_VCS + 8 * g, NA_VCS, 64, pf2, o2);
        if (lat) {
            f32x4 o1[4];
            attn_pv(lds + NA_KB + m16 * NA_VBS + (lr0 * 64 + kc0) * 2 + 8 * g, NA_VBS, 128, pf1, o1);
            const float mm = fmaxf(m1, m2), f1 = __expf(m1 - mm), f2 = __expf(m2 - mm);
            inv = 1.f / (l1 * f1 + l2 * f2);
#pragma unroll
            for (int dt = 0; dt < 4; ++dt) o2[dt] = o1[dt] * f1 + o2[dt] * f2;
        } else inv = 1.f / l2;
        bf16_t* orow = p.MIX + (size_t)(b * TPB + qpos0 + m16) * DM + 512 + h * 64 + 4 * g;
#pragma unroll
        for (int dt = 0; dt < 4; ++dt) {
            const f32x4 v = o2[dt] * inv;
            u32x2 ov; ov.x = cvt_pk_bf16(v[0], v[1]); ov.y = cvt_pk_bf16(v[2], v[3]);
            *(u32x2*)(orow + dt * 16) = ov;
        }
    }
}

__device__ __forceinline__ void d_scan_attn(CParams& p, int wv, int l, int do_ctx) {
    const int tidx_ = opaque_tid(wv);
    int bidx_ = blockIdx.x, gdim_ = gridDim.x; asm volatile("" : "+s"(bidx_), "+s"(gdim_));
    const int wave = tidx_ >> 6, lane = tidx_ & 63;
    if (bidx_ < 32) {
        if (wave < 4) d_rwkv_seq(p, bidx_, wave, lane);
        else if (wave == 4) d_lru_carry(p, bidx_, lane);
        return;
    }
    { float* rpbs = (float*)smem; for (int i = tidx_; i < 8 * 15 * 31; i += NTHR) rpbs[i] = p.in[I_RPB][(size_t)l * 8 * 15 * 31 + i]; }
    __syncthreads();
    d_na(p, wv, l, do_ctx, bidx_ - 32, gdim_ - 32);
}

#define SWZ16(v, o) __int_as_float(__builtin_amdgcn_ds_swizzle(__float_as_int(v), ((o) << 10) | 0x1f))
__device__ __forceinline__ float row16_sum(float v) { return row_sum16(v); }
__device__ __forceinline__ void d_finish(CParams& p, int wv, int l, int skip_ctx) {
    const int tidx_ = opaque_tid(wv);
    int bidx_ = blockIdx.x, gdim_ = gridDim.x; asm volatile("" : "+s"(bidx_), "+s"(gdim_));
    const int lane = tidx_ & 63, gw = bidx_ * 8 + wv, NGW = gdim_ * 8, m16 = lane & 15, g = lane >> 4;
    for (int it = gw; it < NROW * 4; it += NGW) {
        const int R = it >> 2, h = it & 3, c = h * 64 + lane;
        if (skip_ctx && (R % TPB) < CTXL) continue;
        const float gg = p.P[(size_t)R * PST + 256 + c];
        p.MIX[(size_t)R * DM + c] = f2bf(gelu_tanh(gg) * (lru_h(p, R / TPB, R % TPB, R, 0, c) + lru_h(p, R / TPB, R % TPB, R, 1, c)));
    }
    for (int it = gw; it < 4 * 4 * 272; it += NGW) {
        const int pt = it % 272, h = (it / 272) & 3, b = it / 1088;
        if (skip_ctx && pt < 16) continue;
        const int p0 = pt * 16;
        f32x4 y[4];
#pragma unroll
        for (int q = 0; q < 4; ++q) y[q] = (f32x4){0.f, 0.f, 0.f, 0.f};
#pragma unroll
        for (int d = 0; d < 2; ++d) {
            const int s0 = d == 0 ? p0 : (p0 < CTXL ? CTXL - 1 - p0 : CTXL + (TPB - 1 - p0));
            const int c = s0 >> 6, tb = (s0 & 63) >> 4;
            const size_t tk = (size_t)((b * 4 + h) * 2 + d) * 68 + c;
            const int lsrc = d == 0 ? lane : ((15 - m16) | (g << 4));
            const bf16x8* qf = (const bf16x8*)(p.RQF + tk * 4096) + (tb * 2) * 64 + lsrc;
            const bf16x8 q0 = qf[0], q1 = qf[64];
            const bf16x8* sf = (const bf16x8*)(p.S0F + tk * 4096) + lane;
            const float* yl = p.RYF + tk * 4096;
#pragma unroll
            for (int q = 0; q < 4; ++q) {
                f32x4 a;
#pragma unroll
                for (int r = 0; r < 4; ++r) { const int t = tb * 16 + (d == 0 ? 4 * g + r : 15 - (4 * g + r)); a[r] = yl[t * 64 + q * 16 + m16]; }
                a = __builtin_amdgcn_mfma_f32_16x16x32_bf16(q0, sf[(q * 2) * 64], a, 0, 0, 0);
                a = __builtin_amdgcn_mfma_f32_16x16x32_bf16(q1, sf[(q * 2 + 1) * 64], a, 0, 0, 0);
                y[q] += a;
            }
        }
        float mean[4], rstd[4], bon[4];
        float kav[4], rkv[4], lgv[4], lbv[4];
#pragma unroll
        for (int q = 0; q < 4; ++q) { const int c = h * 64 + q * 16 + m16; kav[q] = p.in[I_KA][l * 256 + c]; rkv[q] = p.in[I_RK][l * 256 + c]; lgv[q] = p.in[I_LNG][l * 256 + c]; lbv[q] = p.in[I_LNB][l * 256 + c]; }
        float rv[4][4], vv[4][4], gv[4][4];
#pragma unroll
        for (int r = 0; r < 4; ++r) {
            const size_t R = (size_t)b * TPB + p0 + 4 * g + r;
            float sm = 0.f, bs = 0.f;
#pragma unroll
            for (int q = 0; q < 4; ++q) {
                const int c = h * 64 + q * 16 + m16;
                const float* rs = p.RS + R * 768;
                const float rr_ = rs[c], kk_ = rs[256 + c]; vv[r][q] = rs[512 + c]; gv[r][q] = p.GG[R * 256 + c]; rv[r][q] = rr_;
                const float a0 = p.AIC[R * 256 + c], a1 = p.AIC[((size_t)NROW + R) * 256 + c];
                bs += rr_ * kk_ * rkv[q] * ((1.f + (a0 - 1.f) * kav[q]) + (1.f + (a1 - 1.f) * kav[q]));
                sm += y[q][r];
            }
            mean[r] = row16_sum(sm) * (1.f / 64.f); bon[r] = row16_sum(bs);
            float vs = 0.f;
#pragma unroll
            for (int q = 0; q < 4; ++q) { const float dv = y[q][r] - mean[r]; vs += dv * dv; }
            rstd[r] = rsqrtf(row16_sum(vs) * (1.f / 64.f) + 64e-5f);
        }
#pragma unroll
        for (int r = 0; r < 4; ++r) {
            const size_t R = (size_t)b * TPB + p0 + 4 * g + r;
#pragma unroll
            for (int q = 0; q < 4; ++q) {
                const float o = ((y[q][r] - mean[r]) * rstd[r] * lgv[q] + lbv[q] + bon[r] * vv[r][q]) * gv[r][q];
                p.MIX[R * DM + 256 + h * 64 + q * 16 + m16] = f2bf(o);
            }
        }
        (void)rv;
    }
}

__device__ __forceinline__ void d_norm_router(CParams& p, int wv, int l, int skip_ctx) {
    const int tidx_ = opaque_tid(wv);
    int bidx_ = blockIdx.x, gdim_ = gridDim.x; asm volatile("" : "+s"(bidx_), "+s"(gdim_));
    const int lane = tidx_ & 63, m16 = lane & 15, g = lane >> 4;
    const int gtid = bidx_ * NTHR + tidx_, gsz = gdim_ * NTHR;
    for (int i = gtid; i < CAP; i += gsz) p.SLOT_TOK[i] = 0;
    LAS float* hs = (LAS float*)smem;
    LAS float* part = hs + 16 * 1028;
    LAS int* lcnt = (LAS int*)(part + 8 * 16 * 32);
    if (tidx_ < 64) lcnt[tidx_] = 0;
    const float* rw = p.in[I_RTW] + (size_t)l * DM * 32;
    const float* gn = p.in[I_NFG] + l * DM;
    int* cnt = p.CNT + l * 32;
    for (int tile = bidx_; tile < NROW / 16; tile += gdim_) {
        const int R0 = tile * 16, b = R0 / TPB, pos0 = R0 % TPB, mr = pos0 < CTXL ? 4 : b;
        if (skip_ctx && pos0 < CTXL) continue;
        const float* mod = p.MOD + (l * 5 + mr) * 6144 + 3 * DM;
        __syncthreads();
#pragma unroll 1
        for (int q = 0; q < 2; ++q) {
            const int rr = 2 * wv + q, R = R0 + rr;
            const float4* xr = (const float4*)(p.X2 + (size_t)R * DM);
            float4 v[4]; float ss = 0.f;
#pragma unroll
            for (int i = 0; i < 4; ++i) { v[i] = xr[lane + 64 * i]; ss += v[i].x * v[i].x + v[i].y * v[i].y + v[i].z * v[i].z + v[i].w * v[i].w; }
            ss = wave_sum(ss);
            const float rinv = rsqrtf(ss * (1.f / DM) + 1e-6f);
#pragma unroll
            for (int i = 0; i < 4; ++i) {
                const int c = (lane + 64 * i) * 4;
                const float4 gg = *(const float4*)(gn + c), sh = *(const float4*)(mod + c), sc = *(const float4*)(mod + DM + c);
                f32x4 o;
                o[0] = v[i].x * rinv * gg.x * (1.f + sc.x) + sh.x; o[1] = v[i].y * rinv * gg.y * (1.f + sc.y) + sh.y;
                o[2] = v[i].z * rinv * gg.z * (1.f + sc.z) + sh.z; o[3] = v[i].w * rinv * gg.w * (1.f + sc.w) + sh.w;
                uint2 ob; ob.x = cvt_pk_bf16(o[0], o[1]); ob.y = cvt_pk_bf16(o[2], o[3]);
                *(uint2*)(p.H + (size_t)R * DM + c) = ob;
                *(LAS f32x4*)(hs + rr * 1028 + c) = o;
            }
        }
        __syncthreads();
        {
            f32x4 a0 = {0.f, 0.f, 0.f, 0.f}, a1 = {0.f, 0.f, 0.f, 0.f};
            const int kb = wv * 128 + g;
#pragma unroll 8
            for (int ks = 0; ks < 32; ++ks) {
                const int k = kb + 4 * ks;
                const float av = hs[m16 * 1028 + k];
                const float b0 = rw[k * 32 + m16], b1 = rw[k * 32 + 16 + m16];
                a0 = __builtin_amdgcn_mfma_f32_16x16x4f32(av, b0, a0, 0, 0, 0);
                a1 = __builtin_amdgcn_mfma_f32_16x16x4f32(av, b1, a1, 0, 0, 0);
            }
#pragma unroll
            for (int r = 0; r < 4; ++r) { part[(wv * 16 + 4 * g + r) * 32 + m16] = a0[r]; part[(wv * 16 + 4 * g + r) * 32 + 16 + m16] = a1[r]; }
        }
        __syncthreads();
#pragma unroll 1
        for (int q = 0; q < 2; ++q) {
            const int rr = 2 * wv + q, R = R0 + rr, e = lane & 31;
            float val = p.in[I_RTB][l * 32 + e];
#pragma unroll
            for (int w8 = 0; w8 < 8; ++w8) val += part[(w8 * 16 + rr) * 32 + e];
            if (lane >= 32) val = -3e38f;
            float tv[4]; int ti[4];
#pragma unroll
            for (int k = 0; k < 4; ++k) {
                const float m = wave_max(val);
                const unsigned long long bal = __ballot(val == m);
                const int idx = __ffsll((long long)bal) - 1;
                tv[k] = m; ti[k] = idx;
                if (lane == idx) val = -3e38f;
            }
            if (lane == 0) {
                const float e1 = __expf(tv[1] - tv[0]), e2 = __expf(tv[2] - tv[0]), e3 = __expf(tv[3] - tv[0]);
                const float inv = 1.f / (1.f + e1 + e2 + e3);
                const float gs[4] = {inv, e1 * inv, e2 * inv, e3 * inv};
#pragma unroll
                for (int k = 0; k < 4; ++k) {
                    p.TOPG[R * 4 + k] = gs[k]; p.TOPI[R * 4 + k] = ti[k];
                    p.TOKPOS[R * 4 + k] = __hip_atomic_fetch_add(&lcnt[ti[k]], 1, __ATOMIC_RELAXED, __HIP_MEMORY_SCOPE_WORKGROUP);
                }
            }
        }
    }
    __syncthreads();
    if (tidx_ < 32) lcnt[32 + tidx_] = lcnt[tidx_] ? atomicAdd(&cnt[tidx_], lcnt[tidx_]) : 0;
    __syncthreads();
    for (int tile = bidx_; tile < NROW / 16; tile += gdim_) {
        const int R0 = tile * 16;
        if (skip_ctx && (R0 % TPB) < CTXL) continue;
        if (tidx_ < 64) { const int i = R0 * 4 + tidx_; p.TOKPOS[i] += lcnt[32 + p.TOPI[i]]; }
    }
}
__device__ __forceinline__ void moe_offsets_lds(CParams& p, int wv, int l) {
    const int tidx_ = opaque_tid(wv);
    LAS int* li = (LAS int*)((LAS unsigned char*)smem + LDS_GEMM);
    __syncthreads();
    if (tidx_ < 64) {
        const int e = tidx_;
        const int n = e < 32 ? (p.CNT[l * 32 + e] + MOE_TM - 1) / MOE_TM : 0;
        int sc = n;
#define ISHR(v, k) __builtin_amdgcn_update_dpp(0, v, 0x110 + (k), 0xf, 0xf, true)
        sc += ISHR(sc, 1); sc += ISHR(sc, 2); sc += ISHR(sc, 4); sc += ISHR(sc, 8);
#undef ISHR
        const int row0 = __builtin_amdgcn_readlane(sc, 15);
        if (e >= 16) sc += row0;
        const int excl = sc - n;
        if (e < 32) { li[e] = excl * MOE_TM; for (int i = 0; i < n; ++i) li[64 + excl + i] = e; }
        if (e == 31) { li[32] = sc * MOE_TM; li[40] = sc; }
    }
    __syncthreads();
}
__device__ __forceinline__ void d_moe_scatter(CParams& p, int wv, int l, int skip_ctx) {
    const int tidx_ = opaque_tid(wv);
    int bidx_ = blockIdx.x, gdim_ = gridDim.x; asm volatile("" : "+s"(bidx_), "+s"(gdim_));
    moe_offsets_lds(p, wv, l);
    const int* li = (const int*)(smem + LDS_GEMM);
    const int gtid = bidx_ * NTHR + tidx_, gsz = gdim_ * NTHR;
    for (int i = gtid; i < NROW * 4; i += gsz) {
        const int R = i >> 2;
        if (skip_ctx && (R % TPB) < CTXL) continue;
        p.SLOT_TOK[li[p.TOPI[i]] + p.TOKPOS[i]] = R;
    }
}
struct ProbG1 {
    CParams& p; int l; const int* li; int ntile; int bid, nblk;
    __device__ __forceinline__ bool next(int i, Unit& u) const { return tile_order(i, ntile, 8, u, bid, nblk); }
    __device__ __forceinline__ int expert(const Unit& u) const { return __builtin_amdgcn_readfirstlane(li[64 + u.pm]); }
    __device__ __forceinline__ const char* a_ptr(const Unit&) const { return (const char*)p.H; }
    __device__ __forceinline__ const char* b_ptr(const Unit& u) const { return (const char*)p.WTGU + ((size_t)(l * NEXP + expert(u)) * 2048 + (size_t)u.pn * 256) * KB_; }
    __device__ __forceinline__ int gather_row(const Unit& u, int r) const { return p.SLOT_TOK[u.pm * 256 + r]; }
    __device__ __forceinline__ void epi(const f32x4 (&acc)[2][2][4][2], const Unit& u, int wr, int wc, int fr, int fq) const {
        const int brow = u.pm * 256;
        const float* bias = p.in[I_BGU] + (size_t)(l * NEXP + expert(u)) * 2048;
        const int c = u.pn * 128 + wc * 32 + 8 * fq;
        const f32x4 bg0 = *(const f32x4*)(bias + c), bg1 = *(const f32x4*)(bias + c + 4);
        const f32x4 bu0 = *(const f32x4*)(bias + 1024 + c), bu1 = *(const f32x4*)(bias + 1024 + c + 4);
#pragma unroll
        for (int ai = 0; ai < 2; ++ai)
#pragma unroll
            for (int m = 0; m < 4; ++m) {
                float a[8];
#pragma unroll
                for (int n = 0; n < 2; ++n)
#pragma unroll
                    for (int j = 0; j < 4; ++j) {
                        float gv = acc[ai][0][m][n][j] + (n == 0 ? bg0[j] : bg1[j]), uv = acc[ai][1][m][n][j] + (n == 0 ? bu0[j] : bu1[j]);
                        gv = fminf(gv, 7.f); uv = fminf(fmaxf(uv, -7.f), 7.f);
                        a[n * 4 + j] = (uv + 1.f) * (gv * sigmoidf_(1.702f * gv));
                    }
                u32x4 o; o.x = cvt_pk_bf16(a[0], a[1]); o.y = cvt_pk_bf16(a[2], a[3]); o.z = cvt_pk_bf16(a[4], a[5]); o.w = cvt_pk_bf16(a[6], a[7]);
                *(u32x4*)(p.ACT + (size_t)(brow + ai * 128 + wr * 64 + m * 16 + fr) * DM + c) = o;
            }
    }
};
__device__ __forceinline__ void d_moe_gemm1(CParams& p, int wv, int l) {
    moe_offsets_lds(p, wv, l);
    const int* li = (const int*)(smem + LDS_GEMM);
    ProbG1 P{p, l, li, __builtin_amdgcn_readfirstlane(li[40]), 0, 0};
    gemm_phase<true>(P, wv);
}
struct ProbG2 {
    CParams& p; int l; const int* li; int ntile; int bid, nblk;
    __device__ __forceinline__ bool next(int i, Unit& u) const { return tile_order(i, ntile, 4, u, bid, nblk); }
    __device__ __forceinline__ int expert(const Unit& u) const { return __builtin_amdgcn_readfirstlane(li[64 + u.pm]); }
    __device__ __forceinline__ const char* a_ptr(const Unit& u) const { return (const char*)p.ACT + (size_t)u.pm * 256 * KB_; }
    __device__ __forceinline__ const char* b_ptr(const Unit& u) const { return (const char*)p.WTDN + ((size_t)(l * NEXP + expert(u)) * DM + (size_t)u.pn * 256) * KB_; }
    __device__ __forceinline__ int gather_row(const Unit&, int) const { return 0; }
    __device__ __forceinline__ void epi(const f32x4 (&acc)[2][2][4][2], const Unit& u, int wr, int wc, int fr, int fq) const {
        const int brow = u.pm * 256, bcol = u.pn * 256;
        const float* bias = p.in[I_BDN] + (size_t)(l * NEXP + expert(u)) * DM;
#pragma unroll
        for (int bj = 0; bj < 2; ++bj) {
            const int col = bcol + bj * 128 + wc * 32 + 8 * fq;
            const f32x4 b0 = *(const f32x4*)(bias + col), b1 = *(const f32x4*)(bias + col + 4);
#pragma unroll
            for (int ai = 0; ai < 2; ++ai)
#pragma unroll
                for (int m = 0; m < 4; ++m) {
                    const f32x4 v0 = acc[ai][bj][m][0] + b0, v1 = acc[ai][bj][m][1] + b1;
                    u32x4 o; o.x = cvt_pk_bf16(v0[0], v0[1]); o.y = cvt_pk_bf16(v0[2], v0[3]); o.z = cvt_pk_bf16(v1[0], v1[1]); o.w = cvt_pk_bf16(v1[2], v1[3]);
                    *(u32x4*)(p.Y + (size_t)(brow + ai * 128 + wr * 64 + m * 16 + fr) * DM + col) = o;
                }
        }
    }
};
__device__ __forceinline__ void d_moe_gemm2(CParams& p, int wv, int l) {
    moe_offsets_lds(p, wv, l);
    const int* li = (const int*)(smem + LDS_GEMM);
    ProbG2 P{p, l, li, __builtin_amdgcn_readfirstlane(li[40]), 0, 0};
    gemm_phase<false>(P, wv);
}
__device__ __forceinline__ void d_moe_combine(CParams& p, int wv, int l, int last) {
    moe_offsets_lds(p, wv, l);
    const int tidx_ = opaque_tid(wv);
    int bidx_ = blockIdx.x, gdim_ = gridDim.x; asm volatile("" : "+s"(bidx_), "+s"(gdim_));
    const int* li = (const int*)(smem + LDS_GEMM);
    const int lane = tidx_ & 63, gw = bidx_ * 8 + (tidx_ >> 6), NGW = gdim_ * 8;
    for (int R = gw; R < NROW; R += NGW) {
        const int b = R / TPB, pos = R % TPB, mr = pos < CTXL ? 4 : b;
        if (last && pos < CTXL) continue;
        f32x4 acc[4];
#pragma unroll
        for (int i = 0; i < 4; ++i) acc[i] = (f32x4){0.f, 0.f, 0.f, 0.f};
#pragma unroll
        for (int k = 0; k < 4; ++k) {
            const float g = p.TOPG[R * 4 + k];
            const int sl = li[p.TOPI[R * 4 + k]] + p.TOKPOS[R * 4 + k];
            const bf16_t* yr = p.Y + (size_t)sl * DM + 8 * lane;
#pragma unroll
            for (int i = 0; i < 2; ++i) {
                const u32x4 w = *(const u32x4*)(yr + 512 * i);
                acc[2 * i] += g * (f32x4){__uint_as_float(w.x << 16), __uint_as_float(w.x & 0xffff0000u), __uint_as_float(w.y << 16), __uint_as_float(w.y & 0xffff0000u)};
                acc[2 * i + 1] += g * (f32x4){__uint_as_float(w.z << 16), __uint_as_float(w.z & 0xffff0000u), __uint_as_float(w.w << 16), __uint_as_float(w.w & 0xffff0000u)};
            }
        }
        const float* m5 = p.MOD + (l * 5 + mr) * 6144 + 5 * DM;
        f32x4 v[4]; float ss = 0.f;
#pragma unroll
        for (int q = 0; q < 4; ++q) {
            const int c = 512 * (q >> 1) + 8 * lane + 4 * (q & 1);
            v[q] = *(const f32x4*)(p.X2 + (size_t)R * DM + c) + *(const f32x4*)(m5 + c) * acc[q];
            ss += v[q][0] * v[q][0] + v[q][1] * v[q][1] + v[q][2] * v[q][2] + v[q][3] * v[q][3];
        }
        ss = wave_sum(ss);
        const float rinv = rsqrtf(ss * (1.f / DM) + 1e-6f);
        if (!last) {
            const float* gn = p.in[I_NMG] + (l + 1) * DM;
            const float* mod = p.MOD + ((l + 1) * 5 + mr) * 6144;
#pragma unroll
            for (int i = 0; i < 2; ++i) {
                const int c = 512 * i + 8 * lane;
                f32x4 o[2];
#pragma unroll
                for (int j = 0; j < 2; ++j) {
                    *(f32x4*)(p.X + (size_t)R * DM + c + 4 * j) = v[2 * i + j];
                    const f32x4 gg = *(const f32x4*)(gn + c + 4 * j), sh = *(const f32x4*)(mod + c + 4 * j), sc = *(const f32x4*)(mod + DM + c + 4 * j);
                    o[j] = v[2 * i + j] * rinv * gg * (sc + 1.f) + sh;
                }
                u32x4 ob; ob.x = cvt_pk_bf16(o[0][0], o[0][1]); ob.y = cvt_pk_bf16(o[0][2], o[0][3]); ob.z = cvt_pk_bf16(o[1][0], o[1][1]); ob.w = cvt_pk_bf16(o[1][2], o[1][3]);
                *(u32x4*)(p.H + (size_t)R * DM + c) = ob;
            }
        } else {
            float* orow = p.out + ((size_t)b * SEQ + (pos - CTXL)) * DM;
#pragma unroll
            for (int q = 0; q < 4; ++q) {
                const int c = 512 * (q >> 1) + 8 * lane + 4 * (q & 1);
                *(f32x4*)(orow + c) = v[q] * rinv * *(const f32x4*)(p.in[I_FING] + c);
            }
        }
    }
}

#define XB_TMO      128
#define XB_XCNT(j)  (256  + 64 * (j))
#define XB_XSUB(j)  (1280 + 64 * (j))
#define XB_XGEN(j)  (2304 + 64 * (j))
#define XB_TOP      3328
#define XB_TOPGEN   3392
#define XCD_BAR_WORDS 3456
#define XB_SPIN_CAP (1u << 18)
__device__ __forceinline__ unsigned xb_ld(unsigned* q)              { return __hip_atomic_load(q, __ATOMIC_RELAXED, __HIP_MEMORY_SCOPE_AGENT); }
__device__ __forceinline__ unsigned xb_add(unsigned* q, unsigned v) { return __hip_atomic_fetch_add(q, v, __ATOMIC_RELAXED, __HIP_MEMORY_SCOPE_AGENT); }
__device__ __forceinline__ unsigned xb_xcc_id() { return (unsigned)__builtin_amdgcn_s_getreg((3 << 11) | 20) & 0xFu; }
#define XB_SPIN(cond, bar) do { unsigned _sp = 0; while (cond) { __builtin_amdgcn_s_sleep(1); \
    if ((++_sp & 255u) == 0u) { if (xb_ld(&(bar)[XB_TMO])) break; if (_sp > XB_SPIN_CAP) { atomicAdd(&(bar)[XB_TMO], 1u); break; } } } } while (0)
__device__ __forceinline__ void xcd_barrier_complete(unsigned* bar, unsigned x, unsigned G, unsigned& nloc, unsigned& nx) {
    unsigned sum, cnt, mine, sp = 0u;
    for (;;) {
        sum = 0u; cnt = 0u; mine = 0u;
#pragma unroll
        for (unsigned j = 0; j < 16; ++j) { const unsigned c = xb_ld(&bar[XB_XCNT(j)]); sum += c; cnt += (c > 0u) ? 1u : 0u; mine = (j == x) ? c : mine; }
        if (sum == G) break;
        __builtin_amdgcn_s_sleep(1);
        if ((++sp & 255u) == 0u) { if (xb_ld(&bar[XB_TMO])) break; if (sp > XB_SPIN_CAP) { atomicAdd(&bar[XB_TMO], 1u); break; } }
    }
    nloc = mine > 0u ? mine : 1u; nx = cnt > 0u ? cnt : 1u;
}
__device__ __forceinline__ void xcd_barrier(unsigned* bar, volatile LAS unsigned* st, bool t0) {
    asm volatile("s_waitcnt vmcnt(0)" ::: "memory");
    __syncthreads();
    if (t0) {
        __builtin_amdgcn_s_waitcnt(0);
        const unsigned x = xb_xcc_id();
        unsigned nloc = st[0], nx = st[1];
        if (nloc == 0u) { xcd_barrier_complete(bar, x, gridDim.x, nloc, nx); st[0] = nloc; st[1] = nx; }
        const unsigned old = xb_add(&bar[XB_XSUB(x)], 1u);
        const unsigned gen = old / nloc;
        if (old + 1u == (gen + 1u) * nloc) {
            __builtin_amdgcn_fence(__ATOMIC_RELEASE, "agent");
            asm volatile("s_waitcnt vmcnt(0)" ::: "memory");
            const unsigned og = xb_add(&bar[XB_TOP], 1u);
            const unsigned tg = og / nx;
            if (og + 1u == (tg + 1u) * nx) xb_add(&bar[XB_TOPGEN], 1u);
            else XB_SPIN(xb_ld(&bar[XB_TOPGEN]) == tg, bar);
            __builtin_amdgcn_fence(__ATOMIC_ACQUIRE, "agent");
            xb_add(&bar[XB_XGEN(x)], 1u);
            asm volatile("s_waitcnt vmcnt(0)" ::: "memory");
        } else {
            XB_SPIN(xb_ld(&bar[XB_XGEN(x)]) == gen, bar);
            __builtin_amdgcn_fence(__ATOMIC_ACQUIRE, "agent");
            asm volatile("s_waitcnt vmcnt(0)" ::: "memory");
        }
    }
    __syncthreads();
}

#ifndef MULTI
#define MULTI 0
#endif
__device__ __forceinline__ void run_phase(CParams& p, int wv, int ph) {
    if (ph == 0) { d_prologue(p, wv); return; }
    if (ph == 1) { d_norm_mix(p, wv, 0); return; }
    const int l = (ph - 2) / 11, q = (ph - 2) % 11, last = l == 1;
    if (ph >= 24) return;
    switch (q) {
        case 0: d_gemm_in(p, wv, l); break;
        case 1: d_lru_local(p, wv, l); d_rwkv_pre(p, wv, l); break;
        case 2: d_rwkv_chunkA(p, wv, l); break;
        case 3: d_scan_attn(p, wv, l, !last); break;
        case 4: d_finish(p, wv, l, last); break;
        case 5: d_gemm_out(p, wv, l, last); break;
        case 6: d_norm_router(p, wv, l, last); break;
        case 7: d_moe_scatter(p, wv, l, last); break;
        case 8: d_moe_gemm1(p, wv, l); break;
        case 9: d_moe_gemm2(p, wv, l); break;
        case 10: d_moe_combine(p, wv, l, last); break;
    }
}
#if MULTI
template <int PH> __global__ void __launch_bounds__(NTHR) mega_ph(Params p) { CParams* pp = (CParams*)__builtin_amdgcn_kernarg_segment_ptr(); run_phase(*pp, __builtin_amdgcn_readfirstlane(threadIdx.x >> 6), PH); }
__global__ void __launch_bounds__(NTHR) mega(Params p) {}
template <int PH> static void launch_all(const Params& p, int grid, hipStream_t stream) {
    static bool attr = false; if (!attr) { (void)hipFuncSetAttribute((const void*)mega_ph<PH>, hipFuncAttributeMaxDynamicSharedMemorySize, LDS_BYTES); attr = true; }
    mega_ph<PH><<<grid, NTHR, LDS_BYTES, stream>>>(p);
    if constexpr (PH + 1 < 24) launch_all<PH + 1>(p, grid, stream);
}
#else
__global__ void __launch_bounds__(NTHR) mega(Params p) {
    cg::grid_group grid = cg::this_grid();
    const int wv = __builtin_amdgcn_readfirstlane(threadIdx.x >> 6);
    volatile LAS unsigned* xst = (volatile LAS unsigned*)((LAS unsigned char*)smem + LDS_BYTES - 16);
    if (threadIdx.x == 0) { xst[0] = 0u; xst[1] = 0u; (void)xb_add(&p.BAR[XB_XCNT(xb_xcc_id())], 1u); }
    __syncthreads();
#define RUNPH(n) { CParams* pp = (CParams*)__builtin_amdgcn_kernarg_segment_ptr(); asm volatile("" : "+s"(pp)); run_phase(*pp, wv, n); \
    if (n == 0) grid.sync(); else if (n < 23) xcd_barrier(pp->BAR, xst, opaque_tid(wv) == 0); }
    RUNPH(0) RUNPH(1) RUNPH(2) RUNPH(3) RUNPH(4) RUNPH(5) RUNPH(6) RUNPH(7) RUNPH(8) RUNPH(9) RUNPH(10)
    RUNPH(11) RUNPH(12) RUNPH(13) RUNPH(14) RUNPH(15) RUNPH(16) RUNPH(17) RUNPH(18) RUNPH(19) RUNPH(20) RUNPH(21) RUNPH(22) RUNPH(23)
}
#endif

extern "C" void kernel_launch(void* const* d_in, const int* in_sizes, int n_in, void* d_out, int out_size, void* d_ws, size_t ws_size,
                              hipStream_t stream) {
    Params p{};
    for (int i = 0; i < N_IN; ++i) p.in[i] = (const float*)d_in[i];
    p.out = (float*)d_out;
    char* w = (char*)d_ws;
    size_t off = 0;
    auto take = [&](size_t bytes) { void* r = w + off; off += (bytes + 255) & ~(size_t)255; return r; };
    p.X = (float*)take((size_t)NROW * DM * 4);
    p.X2 = (float*)take((size_t)NROW * DM * 4);
    p.H = (bf16_t*)take((size_t)NROW * DM * 2);
    p.P = (float*)take((size_t)NROW * PST * 4);
    p.QH = (bf16_t*)take((size_t)NROW * 512 * 2);
    p.KH = (bf16_t*)take((size_t)NROW * 512 * 2);
    p.VT = (bf16_t*)take((size_t)NROW * 512 * 2);
    p.MIX = (bf16_t*)take((size_t)NROW * DM * 2);
    p.MOD = (float*)take(2 * 5 * 6144 * 4);
    p.LA = (float*)take((size_t)2 * NROW * 256 * 4);
    p.LB = (float*)take((size_t)2 * NROW * 256 * 4);
    p.LCE = (float*)take((size_t)2176 * 128 * 4);
    p.LCI = (float*)take((size_t)4 * 2 * 68 * 256 * 4);
    p.RS = (float*)take((size_t)NROW * 768 * 4);
    p.DEC = (float*)take((size_t)2 * NROW * 256 * 4);
    p.AIC = (float*)take((size_t)2 * NROW * 256 * 4);
    p.KKN = (float*)take((size_t)NROW * 256 * 4);
    p.GG = (float*)take((size_t)NROW * 256 * 4);
    p.YB = (float*)take((size_t)2 * NROW * 256 * 4);
    p.TOPG = (float*)take((size_t)NROW * 4 * 4);
    p.TOPI = (int*)take((size_t)NROW * 4 * 4);
    p.TOKPOS = (int*)take((size_t)NROW * 4 * 4);
    p.CNT = (int*)take(64 * 4);
    p.SLOT_TOK = (int*)take((size_t)CAP * 4);
    p.ACT = (bf16_t*)take((size_t)CAP * DM * 2);
    p.Y = (bf16_t*)take((size_t)CAP * DM * 2);
    p.BAR = (unsigned*)take((size_t)XCD_BAR_WORDS * 4);
    p.LWT = (bf16_t*)take((size_t)2 * 2 * 4 * 2 * 4096 * 2);
    p.RWT = (bf16_t*)take((size_t)2 * 5 * 16384 * 2);
    p.RMF = (bf16_t*)take((size_t)2176 * 4096 * 2);
    p.RQF = (bf16_t*)take((size_t)2176 * 4096 * 2);
    p.RNF = (float*)take((size_t)2176 * 4096 * 4);
    p.RYF = (float*)take((size_t)2176 * 4096 * 4);
    p.S0F = (bf16_t*)take((size_t)2176 * 4096 * 2);
    p.WTIN = (bf16_t*)take((size_t)2 * INCP * DM * 2);
    p.WTOUT = (bf16_t*)take((size_t)2 * DM * DM * 2);
    p.WTGU = (bf16_t*)take((size_t)2 * NEXP * 2048 * DM * 2);
    p.WTDN = (bf16_t*)take((size_t)2 * NEXP * DM * DM * 2);

    static int grid_blocks = 0;
    if (!grid_blocks) {
        int dev = 0, cus = 0, per_cu = 0;
        (void)hipGetDevice(&dev);
        (void)hipDeviceGetAttribute(&cus, hipDeviceAttributeMultiprocessorCount, dev);
        (void)hipFuncSetAttribute((const void*)mega, hipFuncAttributeMaxDynamicSharedMemorySize, LDS_BYTES);
        (void)hipOccupancyMaxActiveBlocksPerMultiprocessor(&per_cu, (const void*)mega, NTHR, LDS_BYTES);
        if (per_cu > 1) per_cu = 1;
        if (per_cu < 1) { fprintf(stderr, "occupancy query says %d blocks/CU\n", per_cu); per_cu = 1; }
        grid_blocks = cus * per_cu;
        (void)hipGetLastError();
    }
#if MULTI
    launch_all<0>(p, grid_blocks, stream);
#else
    (void)hipMemsetAsync(p.BAR, 0, (size_t)XCD_BAR_WORDS * 4, stream);
    void* args[] = {&p};
    hipError_t e = hipLaunchCooperativeKernel((void*)mega, dim3(grid_blocks), dim3(NTHR), args, LDS_BYTES, stream);
    if (e != hipSuccess) fprintf(stderr, "cooperative launch failed: %s (grid %d)\n", hipGetErrorString(e), grid_blocks);
#endif
}
```

```cpp
#include <hip/hip_runtime.h>
#include <hip/hip_cooperative_groups.h>
#include <stdint.h>
#include <cstdio>
namespace cg = cooperative_groups;

#define DM 1024
#define NBATCH 4
#define SEQ 4096
#define CTXL 256
#define TPB 4352
#define NROW 17408
#define INC 3008
#define INCP 3072
#define PST 1472
#define NEXP 32
#define MOE_TM 256
#define CAP (NROW * 4 + NEXP * MOE_TM)
#define MAXTILES (CAP / MOE_TM)
#define NTHR 512
#define LDS_GEMM 131072
#define LDS_BYTES 155648

typedef unsigned short bf16_t;
typedef short bf16x8 __attribute__((ext_vector_type(8)));
typedef float f32x4 __attribute__((ext_vector_type(4)));
typedef unsigned u32x4 __attribute__((ext_vector_type(4)));
typedef unsigned u32x2 __attribute__((ext_vector_type(2)));

enum { I_X = 0, I_C, I_CTX, I_CCTX, I_ADAW, I_ADAB, I_NMG, I_NFG, I_WIN, I_WOUT, I_CONVW, I_CONVB, I_WR, I_BR, I_WI, I_BI,
       I_LAM, I_MU, I_W0, I_W2, I_A0, I_A2, I_G2, I_KK, I_KA, I_RK, I_LNG, I_LNB, I_RPB, I_RTW, I_RTB, I_WGU, I_BGU, I_WDN,
       I_BDN, I_FING, N_IN };

struct Params {
    const float* in[N_IN];
    float* out;
    float* X;
    float* X2;
    bf16_t* H;
    float* P;
    bf16_t* QH;
    bf16_t* KH;
    bf16_t* VT;
    bf16_t* MIX;
    float* MOD;
    float* LA;
    float* LB;
    float* LCE;
    float* LCI;
    float* RS;
    float* DEC;
    float* AIC;
    float* KKN;
    float* GG;
    float* YB;
    float* TOPG;
    int* TOPI;
    int* TOKPOS;
    int* CNT;
    int* SLOT_TOK;
    bf16_t* ACT;
    bf16_t* Y;
    unsigned* BAR;
    bf16_t* LWT;
    bf16_t* RWT;
    bf16_t* RMF;
    bf16_t* RQF;
    float* RNF;
    float* RYF;
    bf16_t* S0F;
    bf16_t* WTIN;
    bf16_t* WTOUT;
    bf16_t* WTGU;
    bf16_t* WTDN;
};

typedef const __attribute__((address_space(4))) Params CParams;
extern __shared__ __attribute__((aligned(16))) unsigned char smem[];

__device__ __forceinline__ int opaque_tid(int wv) { int t; asm volatile("v_mbcnt_lo_u32_b32 %0, -1, 0\n\tv_mbcnt_hi_u32_b32 %0, -1, %0" : "=v"(t)); return wv * 64 + t; }
__device__ __forceinline__ float sigmoidf_(float x) { return __builtin_amdgcn_rcpf(1.f + __expf(-x)); }
__device__ __forceinline__ float softplusf_(float x) { return x > 20.f ? x : log1pf(__expf(x)); }
__device__ __forceinline__ float softplus_fast(float x) { return x > 15.f ? x : __logf(1.f + __expf(x)); }
__device__ __forceinline__ float tanh_fast(float x) { const float e = __expf(2.f * x); return 1.f - 2.f * __builtin_amdgcn_rcpf(1.f + e); }
#define SWZ_XOR(v, o) __int_as_float(__builtin_amdgcn_ds_swizzle(__float_as_int(v), ((o) << 10) | 0x1f))
__device__ __forceinline__ float rdlane(float v, int l) { return __int_as_float(__builtin_amdgcn_readlane(__float_as_int(v), l)); }
__device__ __forceinline__ float sum_xor32(float v) {
    int a = __float_as_int(v), b = a;
    asm volatile("s_nop 1\n\tv_permlane32_swap_b32 %0, %1\n\ts_nop 1" : "+v"(a), "+v"(b));
    return __int_as_float(a) + __int_as_float(b);
}
#define DPPF(v, ctrl) __int_as_float(__builtin_amdgcn_update_dpp(0, __float_as_int(v), ctrl, 0xf, 0xf, true))
__device__ __forceinline__ float row_sum16(float v) { v += DPPF(v, 0xB1); v += DPPF(v, 0x4E); v += DPPF(v, 0x141); v += DPPF(v, 0x140); return v; }
__device__ __forceinline__ float row_max16(float v) { v = fmaxf(v, DPPF(v, 0xB1)); v = fmaxf(v, DPPF(v, 0x4E)); v = fmaxf(v, DPPF(v, 0x141)); v = fmaxf(v, DPPF(v, 0x140)); return v; }
__device__ __forceinline__ float wave_sum(float v) {
    v = row_sum16(v);
    return (rdlane(v, 0) + rdlane(v, 16)) + (rdlane(v, 32) + rdlane(v, 48));
}
__device__ __forceinline__ float wave_max(float v) {
    v = row_max16(v);
    return fmaxf(fmaxf(rdlane(v, 0), rdlane(v, 16)), fmaxf(rdlane(v, 32), rdlane(v, 48)));
}
typedef __bf16 bf16x2_n __attribute__((ext_vector_type(2)));
__device__ __forceinline__ unsigned cvt_pk_bf16(float lo, float hi) { bf16x2_n v; v[0] = (__bf16)lo; v[1] = (__bf16)hi; return __builtin_bit_cast(unsigned, v); }
__device__ __forceinline__ bf16_t f2bf(float x) { return __builtin_bit_cast(bf16_t, (__bf16)x); }
__device__ __forceinline__ float gelu_tanh(float x) {
    const float u = 0.7978845608028654f * (x + 0.044715f * x * x * x);
    return 0.5f * x * (1.f + tanhf(u));
}

__device__ __forceinline__ const float* xin_row(CParams& p, int R) { const int b = R / TPB, pos = R % TPB; return pos < CTXL ? p.in[I_CTX] + (size_t)(b * CTXL + pos) * DM : p.in[I_X] + ((size_t)b * SEQ + (pos - CTXL)) * DM; }
__device__ __forceinline__ int inv_perm32(int cc) { return ((cc >> 2) & 1) * 16 + (cc >> 3) * 4 + (cc & 3); }
__device__ __forceinline__ void transpose_item(const float* W, int K, int N, bf16_t* WT, int k0, int n0, int dst_row0, float* scr, int lane, bool perm = false) {
    const int rs = lane >> 3, c4 = (lane & 7) * 4;
    float4 v[8];
#pragma unroll
    for (int i = 0; i < 8; ++i) v[i] = *(const float4*)(W + (size_t)(k0 + 8 * i + rs) * N + n0 + c4);
#pragma unroll
    for (int i = 0; i < 8; ++i) { float* d = scr + (8 * i + rs) * 33 + c4; d[0] = v[i].x; d[1] = v[i].y; d[2] = v[i].z; d[3] = v[i].w; }
    __builtin_amdgcn_wave_barrier();
    const int c = lane & 7;
#pragma unroll
    for (int j = 0; j < 4; ++j) {
        const int n = (lane >> 3) + 8 * j; const float* s = scr + (8 * c) * 33 + n;
        u32x4 o; o.x = cvt_pk_bf16(s[0 * 33], s[1 * 33]); o.y = cvt_pk_bf16(s[2 * 33], s[3 * 33]); o.z = cvt_pk_bf16(s[4 * 33], s[5 * 33]); o.w = cvt_pk_bf16(s[6 * 33], s[7 * 33]);
        *(u32x4*)(WT + (size_t)(dst_row0 + (perm ? inv_perm32(n) : n)) * K + k0 + 8 * c) = o;
    }
    __builtin_amdgcn_wave_barrier();
}

__device__ __forceinline__ void d_prologue(CParams& p, int wv) {
    const int tidx_ = opaque_tid(wv);
    int bidx_ = blockIdx.x, gdim_ = gridDim.x; asm volatile("" : "+s"(bidx_), "+s"(gdim_));
    const int tid = tidx_, lane = tid & 63, wave = tid >> 6;
    const int gtid = bidx_ * NTHR + tid, gsz = gdim_ * NTHR;
    const int gw = bidx_ * 8 + wave, NGW = gdim_ * 8;
    if (gtid < 64) p.CNT[gtid] = 0;
    for (int i = gtid; i < 2 * 2 * 4 * 2 * 4096; i += gsz) {
        const int ii = i & 63, j = (i >> 6) & 63, gt = (i >> 12) & 1, ldh = i >> 13;
        p.LWT[i] = f2bf((gt ? p.in[I_WI] : p.in[I_WR])[(size_t)ldh * 4096 + ii * 64 + j]);
    }
    for (int i = gtid; i < 2 * 5 * 16384; i += gsz) {
        const int k = i & 63, n = (i >> 6) & 255, mtx = (i >> 14) % 5, l = i / (5 * 16384);
        const float v = mtx < 2 ? p.in[I_W2][((size_t)(l * 2 + mtx) * 64 + k) * 256 + n] : (mtx < 4 ? p.in[I_A2][((size_t)(l * 2 + mtx - 2) * 64 + k) * 256 + n] : p.in[I_G2][((size_t)l * 64 + k) * 256 + n]);
        p.RWT[i] = f2bf(v);
    }
    for (int i = gtid; i < 2 * 64 * 1024 / 8; i += gsz) {
        const int l = i / (64 * 128), r = i % (64 * 128);
        *(u32x4*)(p.WTIN + ((size_t)l * INCP + INC) * DM + (size_t)r * 8) = (u32x4){0u, 0u, 0u, 0u};
    }
    {
        float* sc = (float*)smem;
        float* part = (float*)(smem + 5 * 1024 * 4);
        for (int i = tid; i < 5 * DM; i += NTHR) { const int r = i / DM, d = i % DM; const float v = r < 4 ? p.in[I_C][r * DM + d] : p.in[I_CCTX][d]; sc[i] = v * sigmoidf_(v); }
        __syncthreads();
        for (int cb = bidx_; cb < 256; cb += gdim_) {
            const int col = tid % 48, ks = tid / 48;
            const int gc = cb * 48 + col, l = gc / 6144, n = gc % 6144;
            if (ks < 8) {
                const float* W = p.in[I_ADAW] + (size_t)l * DM * 6144 + n;
                float a0 = 0.f, a1 = 0.f, a2 = 0.f, a3 = 0.f, a4 = 0.f;
#pragma unroll 8
                for (int k = ks * 128; k < ks * 128 + 128; ++k) {
                    const float w = W[(size_t)k * 6144];
                    a0 += sc[k] * w; a1 += sc[DM + k] * w; a2 += sc[2 * DM + k] * w; a3 += sc[3 * DM + k] * w; a4 += sc[4 * DM + k] * w;
                }
                float* pp = part + (ks * 5) * 48 + col;
                pp[0] = a0; pp[48] = a1; pp[96] = a2; pp[144] = a3; pp[192] = a4;
            }
            __syncthreads();
            if (tid < 240) {
                const int r = tid / 48, c2 = tid % 48, gc2 = cb * 48 + c2, l2 = gc2 / 6144, n2 = gc2 % 6144;
                float s = p.in[I_ADAB][l2 * 6144 + n2];
#pragma unroll
                for (int k = 0; k < 8; ++k) s += part[(k * 5 + r) * 48 + c2];
                p.MOD[(l2 * 5 + r) * 6144 + n2] = s;
            }
            __syncthreads();
        }
    }
    {
        float* scr = (float*)(smem + 32768) + wave * (64 * 33);
        const int N_IN_ = 2 * 16 * 94, N_OUT_ = 2 * 16 * 32, N_GU_ = 64 * 16 * 64, N_DN_ = 64 * 16 * 32;
        for (int it = gw; it < N_IN_ + N_OUT_; it += NGW) {
            int r = it;
            if (r < N_IN_) { const int l = r / (16 * 94), q = r % (16 * 94), kb = q / 94, nb = q % 94;
                transpose_item(p.in[I_WIN] + (size_t)l * DM * INC, DM, INC, p.WTIN + (size_t)l * INCP * DM, kb * 64, nb * 32, nb * 32, scr, lane); continue; }
            r -= N_IN_;
            if (r < N_OUT_) { const int l = r / 512, q = r % 512, kb = q / 32, nb = q % 32;
                transpose_item(p.in[I_WOUT] + (size_t)l * DM * DM, DM, DM, p.WTOUT + (size_t)l * DM * DM, kb * 64, nb * 32, nb * 32, scr, lane); continue; }
            (void)N_GU_; (void)N_DN_;
        }
    }
}

#define MOE_ITEMS 49152
__device__ __forceinline__ void bg_moe_convert(CParams& p, int wv, int l, int first, int count) {
    const int tidx_ = opaque_tid(wv);
    const int lane = tidx_ & 63;
    if (first >= MOE_ITEMS || count <= 0) return;
    const int last = min(first + count, MOE_ITEMS);
    float* scr = (float*)(smem + 32768) + wv * (64 * 33);
    for (int it = first + wv; it < last; it += 8) {
        if (it < 32768) { const int le = l * 32 + it / 1024, q = it % 1024, kb = q / 64, nb = q % 64;
            const int c0 = nb * 32; const int dst = c0 < 1024 ? (c0 / 128) * 256 + (c0 % 128) : ((c0 - 1024) / 128) * 256 + 128 + ((c0 - 1024) % 128);
            transpose_item(p.in[I_WGU] + (size_t)le * DM * 2048, DM, 2048, p.WTGU + (size_t)le * 2048 * DM, kb * 64, c0, dst, scr, lane, true); }
        else { const int r = it - 32768; const int le = l * 32 + r / 512, q = r % 512, kb = q / 32, nb = q % 32;
            transpose_item(p.in[I_WDN] + (size_t)le * DM * DM, DM, DM, p.WTDN + (size_t)le * DM * DM, kb * 64, nb * 32, nb * 32, scr, lane, true); }
    }
}
#define BG_KIN 96
#define BG_KOUT 96
#define BG_KMOE 80
__device__ __forceinline__ int moe_ntile(CParams& p, int l) { int nt = 0; for (int e = 0; e < NEXP; ++e) nt += (p.CNT[l * 32 + e] + MOE_TM - 1) / MOE_TM; return nt; }
__device__ __forceinline__ int bg_idle_first(int units, int nblk) { const int u = units % nblk; return u ? u : nblk; }
__device__ __forceinline__ void norm_row_to_bf16(CParams& p, const float4 (&v)[4], float ss, int l, int which, int mr, bf16_t* hrow, int lane) {
    const float* g = (which == 0 ? p.in[I_NMG] : p.in[I_NFG]) + l * DM;
    const float* mod = p.MOD + (l * 5 + mr) * 6144 + (which == 0 ? 0 : 3 * DM);
    const float rinv = rsqrtf(ss * (1.f / DM) + 1e-6f);
#pragma unroll
    for (int i = 0; i < 4; ++i) {
        const int c = (lane + 64 * i) * 4;
        const float4 gg = *(const float4*)(g + c), sh = *(const float4*)(mod + c), sc = *(const float4*)(mod + DM + c);
        const float o0 = v[i].x * rinv * gg.x * (1.f + sc.x) + sh.x, o1 = v[i].y * rinv * gg.y * (1.f + sc.y) + sh.y;
        const float o2 = v[i].z * rinv * gg.z * (1.f + sc.z) + sh.z, o3 = v[i].w * rinv * gg.w * (1.f + sc.w) + sh.w;
        uint2 o; o.x = cvt_pk_bf16(o0, o1); o.y = cvt_pk_bf16(o2, o3);
        *(uint2*)(hrow + c) = o;
    }
}
__device__ __forceinline__ void d_norm_mix(CParams& p, int wv, int l) {
    const int tidx_ = opaque_tid(wv);
    int bidx_ = blockIdx.x, gdim_ = gridDim.x; asm volatile("" : "+s"(bidx_), "+s"(gdim_));
    const int lane = tidx_ & 63, gw = bidx_ * 8 + (tidx_ >> 6), NGW = gdim_ * 8;
    for (int R = gw; R < NROW; R += NGW) {
        const int b = R / TPB, pos = R % TPB, mr = pos < CTXL ? 4 : b;
        const float4* xr = (const float4*)xin_row(p, R);
        float4 v[4]; float ss = 0.f;
#pragma unroll
        for (int i = 0; i < 4; ++i) { v[i] = xr[lane + 64 * i]; ss += v[i].x * v[i].x + v[i].y * v[i].y + v[i].z * v[i].z + v[i].w * v[i].w; }
        ss = wave_sum(ss);
        norm_row_to_bf16(p, v, ss, l, 0, mr, p.H + (size_t)R * DM, lane);
    }
}

#define LAS __attribute__((address_space(3)))
#define RWS 144
#define HTB 16384
#define KB_ 2048
__device__ __forceinline__ int lds_byte(int r, int c) {
    const int st = (r >> 4) * 2 + (c >> 5), rr = r & 15, cc = c & 31, ob = rr * 64 + cc * 2;
    return st * 1024 + (ob ^ (((ob >> 9) & 1) << 5));
}
__device__ __forceinline__ void stage_rc(int b, int& R, int& C) {
    const int st = b / 1024, sb = b % 1024, swz = sb ^ (((sb >> 9) & 1) << 5);
    R = (st >> 1) * 16 + swz / 64; C = (st & 1) * 32 + (swz % 64) / 2;
}
struct Unit { int pm, pn; };
__device__ __forceinline__ bool tile_order(int i, int nM, int nN, Unit& u, int bid, int nblk) {
    const int nwg = nM * nN; const long L = (long)i * nblk + bid; if (L >= nwg) return false;
    int wgid = (int)L; { const int q = nwg / 8, r = nwg % 8, xcd = wgid % 8, off = wgid / 8; wgid = (xcd < r ? xcd * (q + 1) : r * (q + 1) + (xcd - r) * q) + off; }
    const int nig = 8 * nN, gid = wgid / nig, fm = gid * 8, gsz = (nM - fm) < 8 ? (nM - fm) : 8;
    u.pm = fm + ((wgid % nig) % gsz); u.pn = (wgid % nig) / gsz; return true;
}

#define PG_SA(b, h) (((b) * 2 + (h)) * HTB)
#define PG_SB(b, h) ((4 + (b) * 2 + (h)) * HTB)
#define PG_STAGE(bufoff, gbase, v0, v1) do { \
    __builtin_amdgcn_global_load_lds((const unsigned*)((const char*)(gbase) + (v0)), (LAS unsigned*)(lds + (bufoff) + ldsw), 16, 0, 0); \
    __builtin_amdgcn_global_load_lds((const unsigned*)((const char*)(gbase) + (v1)), (LAS unsigned*)(lds + (bufoff) + ldsw + 8192), 16, 0, 0); } while (0)
#define PG_STAGE_B(bufoff, gbase) PG_STAGE(bufoff, gbase, voffB[0], voffB[1])
#define PG_STAGE_A(bufoff, gb, h, usenext) do { if (GATHER) PG_STAGE(bufoff, gb, gc[h][0], gc[h][1]); \
    else PG_STAGE(bufoff, (gb) + (h) * hstep, voffA[0], voffA[1]); } while (0)
#define PG_LDA(dst, b, h) do { _Pragma("unroll") for (int m = 0; m < 4; ++m) _Pragma("unroll") for (int k = 0; k < 2; ++k) dst[m][k] = *(const LAS bf16x8*)(lds + PG_SA(b, h) + aoff + m * 2048 + k * 1024); } while (0)
#define PG_LDB(dst, b, h) do { _Pragma("unroll") for (int n = 0; n < 2; ++n) _Pragma("unroll") for (int k = 0; k < 2; ++k) dst[n][k] = *(const LAS bf16x8*)(lds + PG_SB(b, h) + boff + n * 2048 + k * 1024); } while (0)
#define PG_MMA(ai, bj, At_, Bt_) do { __builtin_amdgcn_s_setprio(1); _Pragma("unroll") for (int m = 0; m < 4; ++m) _Pragma("unroll") for (int n = 0; n < 2; ++n) _Pragma("unroll") for (int k = 0; k < 2; ++k) \
    acc[ai][bj][m][n] = __builtin_amdgcn_mfma_f32_16x16x32_bf16(Bt_[n][k], At_[m][k], acc[ai][bj][m][n], 0, 0, 0); __builtin_amdgcn_s_setprio(0); } while (0)
#define PG_WAIT_V(n) asm volatile("s_waitcnt vmcnt(" #n ")" ::: "memory")
#define PG_WAIT_L(n) asm volatile("s_waitcnt lgkmcnt(" #n ")" ::: "memory")
#define PG_BAR __builtin_amdgcn_s_barrier()
#define PG_SCHED __builtin_amdgcn_sched_barrier(0)

template <bool GATHER, class Prob>
__device__ __forceinline__ void gemm_phase(Prob P, int wv) {
    const int tidx_ = opaque_tid(wv);
    int bidx_ = blockIdx.x, gdim_ = gridDim.x; asm volatile("" : "+s"(bidx_), "+s"(gdim_));
    LAS unsigned char* lds = (LAS unsigned char*)smem;
    P.bid = bidx_; P.nblk = gdim_;
    const int tid = tidx_, wid = __builtin_amdgcn_readfirstlane(tid >> 6), lane = tid & 63, wr = wid >> 2, wc = wid & 3, fr = lane & 15, fq = lane >> 4;
    constexpr int nt = 16;
    unsigned voffA[2], voffB[2]; int Rr[2], Cc[2];
#pragma unroll
    for (int i = 0; i < 2; ++i) { stage_rc(tid * 16 + i * 8192, Rr[i], Cc[i]); voffA[i] = (unsigned)(Rr[i] * 1024 + Cc[i]) * 2u; voffB[i] = voffA[i]; }
    const size_t kstep = 128, hstep = (size_t)128 * KB_;
    const unsigned ldsw = (unsigned)wid * 1024u;
    const int aoff = lds_byte(wr * 64 + fr, fq * 8), boff = lds_byte(wc * 32 + fr, fq * 8);
    Unit cur, nxt; int ui = 0;
    if (!P.next(0, cur)) return;
    f32x4 acc[2][2][4][2];
#pragma unroll
    for (int a = 0; a < 2; ++a)
#pragma unroll
        for (int b = 0; b < 2; ++b)
#pragma unroll
            for (int m = 0; m < 4; ++m)
#pragma unroll
                for (int n = 0; n < 2; ++n) acc[a][b][m][n] = (f32x4){0.f, 0.f, 0.f, 0.f};
    bf16x8 At[4][2], B0[2][2], B1[2][2];
    unsigned gc[2][2] = {{0u, 0u}, {0u, 0u}};
    if (GATHER) {
#pragma unroll
        for (int h = 0; h < 2; ++h)
#pragma unroll
            for (int i = 0; i < 2; ++i) gc[h][i] = (unsigned)P.gather_row(cur, h * 128 + Rr[i]) * (unsigned)KB_ + (unsigned)Cc[i] * 2u;
    }
    const char* cA = P.a_ptr(cur); const char* cB = P.b_ptr(cur);
    PG_STAGE_B(PG_SB(0, 0), cB); PG_STAGE_A(PG_SA(0, 0), cA, 0, false); PG_STAGE_B(PG_SB(0, 1), cB + hstep); PG_STAGE_A(PG_SA(0, 1), cA, 1, false);
    if (wr == 1) PG_BAR;
    PG_WAIT_V(4); PG_BAR;
    PG_STAGE_B(PG_SB(1, 0), cB + kstep); PG_STAGE_A(PG_SA(1, 0), cA + kstep, 0, false); PG_STAGE_B(PG_SB(1, 1), cB + hstep + kstep);
    PG_WAIT_V(6); PG_BAR;
    for (;;) {
        const bool has_next = P.next(ui + 1, nxt);
        const char* nA = has_next ? P.a_ptr(nxt) : cA; const char* nB = has_next ? P.b_ptr(nxt) : cB;
        for (int t = 0; t < nt; t += 2) {
            const bool last = (t == nt - 2);
            if (GATHER && last && has_next) {
#pragma unroll
                for (int i = 0; i < 2; ++i) gc[0][i] = (unsigned)P.gather_row(nxt, Rr[i]) * (unsigned)KB_ + (unsigned)Cc[i] * 2u;
            }
            const char* a1 = cA + (size_t)(t + 1) * kstep;
            const char* a2 = last ? nA : cA + (size_t)(t + 2) * kstep; const char* b2 = last ? nB : cB + (size_t)(t + 2) * kstep;
            const char* a3 = a2 + kstep; const char* b3 = b2 + kstep;
            PG_LDB(B0, 0, 0); PG_SCHED; PG_LDA(At, 0, 0); PG_STAGE_A(PG_SA(1, 1), a1, 1, false);
            PG_WAIT_L(8); PG_BAR; PG_WAIT_L(0); PG_MMA(0, 0, At, B0); PG_BAR; PG_SCHED;
            if (GATHER && last && has_next) {
#pragma unroll
                for (int i = 0; i < 2; ++i) gc[1][i] = (unsigned)P.gather_row(nxt, 128 + Rr[i]) * (unsigned)KB_ + (unsigned)Cc[i] * 2u;
            }
            PG_LDB(B1, 0, 1); PG_STAGE_B(PG_SB(0, 0), b2);
            PG_BAR; PG_WAIT_L(0); PG_MMA(0, 1, At, B1); PG_BAR;
            PG_LDA(At, 0, 1); PG_STAGE_A(PG_SA(0, 0), a2, 0, last);
            PG_BAR; PG_WAIT_L(0); PG_MMA(1, 0, At, B0); PG_BAR; PG_SCHED;
            PG_STAGE_B(PG_SB(0, 1), b2 + hstep);
            PG_WAIT_V(6); PG_BAR; PG_MMA(1, 1, At, B1); PG_BAR;
            PG_LDB(B0, 1, 0); PG_SCHED; PG_LDA(At, 1, 0); PG_STAGE_A(PG_SA(0, 1), a2, 1, last);
            PG_WAIT_L(8); PG_BAR; PG_WAIT_L(0); PG_MMA(0, 0, At, B0); PG_BAR; PG_SCHED;
            PG_LDB(B1, 1, 1); PG_STAGE_B(PG_SB(1, 0), b3);
            PG_BAR; PG_WAIT_L(0); PG_MMA(0, 1, At, B1); PG_BAR;
            PG_LDA(At, 1, 1); PG_STAGE_A(PG_SA(1, 0), a3, 0, last);
            PG_BAR; PG_WAIT_L(0); PG_MMA(1, 0, At, B0); PG_BAR; PG_SCHED;
            PG_STAGE_B(PG_SB(1, 1), b3 + hstep);
            PG_WAIT_V(6); PG_BAR; PG_MMA(1, 1, At, B1); PG_BAR;
        }
        P.epi(acc, cur, wr, wc, fr, fq);
        if (!has_next) break;
#pragma unroll
        for (int a = 0; a < 2; ++a)
#pragma unroll
            for (int b = 0; b < 2; ++b)
#pragma unroll
                for (int m = 0; m < 4; ++m)
#pragma unroll
                    for (int n = 0; n < 2; ++n) acc[a][b][m][n] = (f32x4){0.f, 0.f, 0.f, 0.f};
        cur = nxt; cA = nA; cB = nB; ++ui;
    }
    PG_WAIT_V(0);
    if (wr == 0) PG_BAR;
    PG_BAR;
}

struct ProbIn {
    CParams& p; int l; int bid, nblk;
    __device__ __forceinline__ bool next(int i, Unit& u) const { return tile_order(i, NROW / 256, INCP / 256, u, bid, nblk); }
    __device__ __forceinline__ const char* a_ptr(const Unit& u) const { return (const char*)p.H + (size_t)u.pm * 256 * KB_; }
    __device__ __forceinline__ const char* b_ptr(const Unit& u) const { return (const char*)p.WTIN + ((size_t)l * INCP + (size_t)u.pn * 256) * KB_; }
    __device__ __forceinline__ int gather_row(const Unit&, int) const { return 0; }
    __device__ __forceinline__ void epi(const f32x4 (&acc)[2][2][4][2], const Unit& u, int wr, int wc, int fr, int fq) const {
        const int brow = u.pm * 256, bcol = u.pn * 256;
        const int bb = u.pm / 17, pos0 = (u.pm % 17) * 256;
#pragma unroll
        for (int bj = 0; bj < 2; ++bj)
#pragma unroll
            for (int n = 0; n < 2; ++n) {
                const int gcol = bcol + bj * 128 + wc * 32 + n * 16;
                const int col = gcol + fq * 4;
                if (gcol < 1472) {
#pragma unroll
                    for (int ai = 0; ai < 2; ++ai)
#pragma unroll
                        for (int m = 0; m < 4; ++m) *(f32x4*)(p.P + (size_t)(brow + ai * 128 + wr * 64 + m * 16 + fr) * PST + col) = acc[ai][bj][m][n];
                } else if (gcol < 2496) {
                    const bool isq = gcol < 1984; const int cq = col - (isq ? 1472 : 1984), hh = cq >> 6, dim = cq & 63;
                    bf16_t* base = (isq ? p.QH : p.KH) + ((size_t)(bb * 8 + hh) * TPB) * 64 + dim;
                    const float sc = isq ? 0.125f : 1.f;
#pragma unroll
                    for (int ai = 0; ai < 2; ++ai)
#pragma unroll
                        for (int m = 0; m < 4; ++m) {
                            const int pos = pos0 + ai * 128 + wr * 64 + m * 16 + fr; const f32x4 v = acc[ai][bj][m][n] * sc;
                            u32x2 o; o.x = cvt_pk_bf16(v[0], v[1]); o.y = cvt_pk_bf16(v[2], v[3]);
                            *(u32x2*)(base + (size_t)pos * 64) = o;
                        }
                } else if (gcol < INC) {
                    const int cq = col - 2496, hh = cq >> 6, dim = cq & 63;
                    bf16_t* base = p.VT + ((size_t)(bb * 8 + hh) * 64 + dim) * TPB;
#pragma unroll
                    for (int ai = 0; ai < 2; ++ai)
#pragma unroll
                        for (int m = 0; m < 4; ++m) {
                            const int pos = pos0 + ai * 128 + wr * 64 + m * 16 + fr;
#pragma unroll
                            for (int j = 0; j < 4; ++j) base[(size_t)j * TPB + pos] = f2bf(acc[ai][bj][m][n][j]);
                        }
                }
            }
    }
};
__device__ __forceinline__ void d_gemm_in(CParams& p, int wv, int l) { ProbIn P{p, l, 0, 0}; gemm_phase<false>(P, wv); }

struct ProbOut {
    CParams& p; int l; int skip_ctx; int bid, nblk;
    __device__ __forceinline__ bool next(int i, Unit& u) const {
        if (!tile_order(i, skip_ctx ? 64 : 68, 4, u, bid, nblk)) return false;
        if (skip_ctx) u.pm = (u.pm / 16) * 17 + 1 + (u.pm % 16);
        return true; }
    __device__ __forceinline__ const char* a_ptr(const Unit& u) const { return (const char*)p.MIX + (size_t)u.pm * 256 * KB_; }
    __device__ __forceinline__ const char* b_ptr(const Unit& u) const { return (const char*)p.WTOUT + ((size_t)l * DM + (size_t)u.pn * 256) * KB_; }
    __device__ __forceinline__ int gather_row(const Unit&, int) const { return 0; }
    __device__ __forceinline__ void epi(const f32x4 (&acc)[2][2][4][2], const Unit& u, int wr, int wc, int fr, int fq) const {
        const int brow = u.pm * 256, bcol = u.pn * 256;
        const int b = u.pm / 17, mr = (u.pm % 17) == 0 ? 4 : b;
        const float* gate = p.MOD + (l * 5 + mr) * 6144 + 2 * DM;
#pragma unroll
        for (int ai = 0; ai < 2; ++ai)
#pragma unroll
            for (int m = 0; m < 4; ++m) {
                const int row = brow + ai * 128 + wr * 64 + m * 16 + fr; const size_t roff = (size_t)row * DM;
                const float* xres = l == 0 ? xin_row(p, row) : p.X + roff;
#pragma unroll
                for (int bj = 0; bj < 2; ++bj)
#pragma unroll
                    for (int n = 0; n < 2; ++n) {
                        const int col = bcol + bj * 128 + wc * 32 + n * 16 + fq * 4;
                        const f32x4 gt = *(const f32x4*)(gate + col);
                        *(f32x4*)(p.X2 + roff + col) = *(const f32x4*)(xres + col) + gt * acc[ai][bj][m][n];
                    }
                asm volatile("" ::: "memory");
            }
    }
};
__device__ __forceinline__ void d_gemm_out(CParams& p, int wv, int l, int skip_ctx) { ProbOut P{p, l, skip_ctx, 0, 0}; gemm_phase<false>(P, wv); }

__device__ __forceinline__ int rwkv_pos(int d, int c, int t) { return d == 0 ? c * 64 + t : (c < 4 ? 255 - (c * 64 + t) : 4351 - ((c - 4) * 64 + t)); }
#define DPP_SHR(oldv, v, n) __int_as_float(__builtin_amdgcn_update_dpp(__float_as_int(oldv), __float_as_int(v), 0x110 + (n), 0xf, 0xf, false))
#define BCAST15(v) __int_as_float(__builtin_amdgcn_ds_swizzle(__float_as_int(v), (0x0f << 5) | 0x10))
__device__ __forceinline__ void d_lru_local(CParams& p, int wv, int l) {
    const int tidx_ = opaque_tid(wv);
    int bidx_ = blockIdx.x, gdim_ = gridDim.x; asm volatile("" : "+s"(bidx_), "+s"(gdim_));
    const int lane = tidx_ & 63, gw = bidx_ * 8 + wv, NGW = gdim_ * 8, m16 = lane & 15, g = lane >> 4;
    LAS unsigned char* xcs = (LAS unsigned char*)smem + 8192 + wv * (64 * RWS);
    const bool bal = NGW == 2048;
    for (int rnd = 0; ; ++rnd) {
        int task;
        if (bal) { if (rnd == 0) task = gw; else if (rnd == 1 && gw >= 256 && gw < 384) task = 2048 + (gw - 256); else break; }
        else { task = gw + rnd * NGW; if (task >= 2176) break; }
        const int c = task % 68, h = (task / 68) & 3, d = (task / 272) & 1, b = task / 544;
        const size_t rb = (size_t)b * TPB;
        {
            const int ch = h * 64 + lane;
            const float* cw = p.in[I_CONVW] + ((l * 2 + d) * 4) * 256 + ch;
            const float cw0 = cw[0], cw1 = cw[256], cw2 = cw[512], cw3 = cw[768], cb = p.in[I_CONVB][(l * 2 + d) * 256 + ch];
            float x1 = 0.f, x2 = 0.f, x3 = 0.f;
            if (c != 0 && c != 4) { x1 = p.P[(rb + rwkv_pos(d, c - 1, 63)) * PST + ch]; x2 = p.P[(rb + rwkv_pos(d, c - 1, 62)) * PST + ch]; x3 = p.P[(rb + rwkv_pos(d, c - 1, 61)) * PST + ch]; }
            __builtin_amdgcn_wave_barrier();
            float xin[64];
            { const int pstep = d == 0 ? PST : -PST; const float* px = p.P + (rb + rwkv_pos(d, c, 0)) * PST + ch;
#pragma unroll
              for (int t = 0; t < 64; ++t) xin[t] = px[(long)t * pstep]; }
#pragma unroll
            for (int t = 0; t < 64; ++t) {
                const float x0 = xin[t];
                const float xc = cb + cw0 * x0 + cw1 * x1 + cw2 * x2 + cw3 * x3;
                x3 = x2; x2 = x1; x1 = x0;
                *(LAS bf16_t*)(xcs + t * RWS + lane * 2) = f2bf(xc);
            }
            __builtin_amdgcn_wave_barrier();
        }
        bf16x8 xb[4][2];
#pragma unroll
        for (int tt = 0; tt < 4; ++tt)
#pragma unroll
            for (int ks = 0; ks < 2; ++ks) xb[tt][ks] = *(const LAS bf16x8*)(xcs + (tt * 16 + m16) * RWS + ks * 64 + g * 16);
        const bf16_t* wt = p.LWT + (size_t)((l * 2 + d) * 4 + h) * 2 * 4096;
        bf16x8 wall[4][2][2];
#pragma unroll
        for (int jt = 0; jt < 4; ++jt)
#pragma unroll
            for (int gt = 0; gt < 2; ++gt)
#pragma unroll
                for (int ks = 0; ks < 2; ++ks) wall[jt][gt][ks] = *(const bf16x8*)(wt + (size_t)gt * 4096 + (jt * 16 + m16) * 64 + ks * 32 + 8 * g);
#pragma unroll
        for (int jt = 0; jt < 4; ++jt) {
            const int j0 = jt * 16 + 4 * g, chj = h * 64 + j0;
            const bf16x8 (&wa)[2][2] = wall[jt];
            const f32x4 brv = *(const f32x4*)(p.in[I_BR] + (l * 2 + d) * 256 + chj), biv = *(const f32x4*)(p.in[I_BI] + (l * 2 + d) * 256 + chj);
            const f32x4 lamv = *(const f32x4*)(p.in[I_LAM] + (l * 2 + d) * 256 + chj);
            float spl8[4];
#pragma unroll
            for (int r = 0; r < 4; ++r) spl8[r] = -8.0f * softplusf_(-lamv[r]);
            float ca[4] = {1.f, 1.f, 1.f, 1.f}, chh[4] = {0.f, 0.f, 0.f, 0.f};
#pragma unroll
            for (int tt = 0; tt < 4; ++tt) {
                f32x4 dr = {0.f, 0.f, 0.f, 0.f}, di = {0.f, 0.f, 0.f, 0.f};
#pragma unroll
                for (int ks = 0; ks < 2; ++ks) { dr = __builtin_amdgcn_mfma_f32_16x16x32_bf16(wa[0][ks], xb[tt][ks], dr, 0, 0, 0); di = __builtin_amdgcn_mfma_f32_16x16x32_bf16(wa[1][ks], xb[tt][ks], di, 0, 0, 0); }
                const int t = tt * 16 + m16;
                const u32x2 xw = *(const LAS u32x2*)(xcs + t * RWS + j0 * 2);
                const float xcv[4] = {__uint_as_float(xw.x << 16), __uint_as_float(xw.x & 0xffff0000u), __uint_as_float(xw.y << 16), __uint_as_float(xw.y & 0xffff0000u)};
                f32x4 av, bv;
#pragma unroll
                for (int r = 0; r < 4; ++r) {
                    const float gr = sigmoidf_(dr[r] + brv[r]), gi = sigmoidf_(di[r] + biv[r]);
                    const float log_a = gr * spl8[r];
                    float a = __expf(log_a), bb = __builtin_amdgcn_sqrtf(fmaxf(1.f - a * a, 0.f)) * (gi * xcv[r]);
#define SCAN_STEP(sh) { const float ap = DPP_SHR(1.f, a, sh), bp = DPP_SHR(0.f, bb, sh); bb = a * bp + bb; a = a * ap; }
                    SCAN_STEP(1) SCAN_STEP(2) SCAN_STEP(4) SCAN_STEP(8)
#undef SCAN_STEP
                    bb = a * chh[r] + bb; a = a * ca[r];
                    av[r] = a; bv[r] = bb;
                    ca[r] = BCAST15(a); chh[r] = BCAST15(bb);
                }
                const size_t R = rb + rwkv_pos(d, c, t);
                *(f32x4*)(p.LA + ((size_t)d * NROW + R) * 256 + chj) = bv;
                *(f32x4*)(p.LB + ((size_t)d * NROW + R) * 256 + chj) = av;
                if (tt == 3 && m16 == 15) { *(f32x4*)(p.LCE + (size_t)task * 128 + j0) = av; *(f32x4*)(p.LCE + (size_t)task * 128 + 64 + j0) = bv; }
            }
        }
    }
}
__device__ __forceinline__ void d_lru_carry(CParams& p, int widx, int lane) {
    const int gt = widx * 64 + lane;
    const int ch = gt & 255, d = (gt >> 8) & 1, b = gt >> 9, h = ch >> 6, j = ch & 63;
    const float* ce = p.LCE + (size_t)(((b * 2 + d) * 4 + h) * 68) * 128 + j;
    float* ci = p.LCI + (size_t)((b * 2 + d) * 68) * 256 + ch;
    float carry = 0.f;
#pragma unroll 1
    for (int c0 = 0; c0 < 68; c0 += 17) {
        float a[17], e[17];
#pragma unroll
        for (int u = 0; u < 17; ++u) { a[u] = ce[(size_t)(c0 + u) * 128]; e[u] = ce[(size_t)(c0 + u) * 128 + 64]; }
#pragma unroll
        for (int u = 0; u < 17; ++u) { ci[(size_t)(c0 + u) * 256] = carry; carry = a[u] * carry + e[u]; }
    }
}
__device__ __forceinline__ float lru_h(CParams& p, int b, int pos, size_t R, int d, int ch) {
    const int sidx = d == 0 ? pos : (pos < CTXL ? CTXL - 1 - pos : CTXL + (TPB - 1 - pos));
    const float ci = p.LCI[(size_t)((b * 2 + d) * 68 + (sidx >> 6)) * 256 + ch];
    return p.LA[((size_t)d * NROW + R) * 256 + ch] + p.LB[((size_t)d * NROW + R) * 256 + ch] * ci;
}

template <int MTX>
__device__ __forceinline__ void rwkv_pre_mtx(CParams& p, int l, const LAS unsigned char* stash, int R0, int lane) {
    const int m16 = lane & 15, g = lane >> 4;
    constexpr int src = MTX < 2 ? 0 : (MTX < 4 ? 1 : 2), d = MTX & 1;
    const bf16x8 a0 = *(const LAS bf16x8*)(stash + (src * 16 + m16) * RWS + g * 16), a1 = *(const LAS bf16x8*)(stash + (src * 16 + m16) * RWS + 64 + g * 16);
    const bf16_t* wt = p.RWT + (size_t)(l * 5 + MTX) * 16384 + (size_t)m16 * 64 + 8 * g;
    const float* cst = MTX < 2 ? p.in[I_W0] + (l * 2 + d) * 256 + m16 : p.in[I_A0] + (l * 2 + d) * 256 + m16;
    float* dst = (MTX < 2 ? p.DEC + (size_t)d * NROW * 256 : (MTX < 4 ? p.AIC + (size_t)d * NROW * 256 : p.GG)) + ((size_t)R0 + 4 * g) * 256 + m16;
#pragma unroll 1
    for (int half = 0; half < 2; ++half) {
        bf16x8 b0[8], b1[8]; float cv[8];
        const bf16_t* wh = wt + half * 8192; const float* ch_ = cst + half * 128; float* dh = dst + half * 128;
#pragma unroll
        for (int i = 0; i < 8; ++i) { b0[i] = *(const bf16x8*)(wh + i * 1024); b1[i] = *(const bf16x8*)(wh + i * 1024 + 32); cv[i] = MTX < 4 ? ch_[i * 16] : 0.f; }
#pragma unroll
        for (int i = 0; i < 8; ++i) {
            f32x4 acc = {0.f, 0.f, 0.f, 0.f};
            acc = __builtin_amdgcn_mfma_f32_16x16x32_bf16(a0, b0[i], acc, 0, 0, 0);
            acc = __builtin_amdgcn_mfma_f32_16x16x32_bf16(a1, b1[i], acc, 0, 0, 0);
#pragma unroll
            for (int r = 0; r < 4; ++r) {
                float o;
                if (MTX < 2) { const float w = -softplus_fast(-(cv[i] + acc[r])) - 0.5f; o = -__expf(w); }
                else if (MTX < 4) o = sigmoidf_(cv[i] + acc[r]);
                else o = acc[r];
                dh[r * 256 + i * 16] = o;
            }
        }
    }
}
__device__ __forceinline__ void d_rwkv_pre(CParams& p, int wv, int l) {
    const int tidx_ = opaque_tid(wv);
    int bidx_ = blockIdx.x, gdim_ = gridDim.x; asm volatile("" : "+s"(bidx_), "+s"(gdim_));
    const int lane = tidx_ & 63, gw = bidx_ * 8 + wv, NGW = gdim_ * 8, m16 = lane & 15, g = lane >> 4;
    LAS unsigned char* stash = (LAS unsigned char*)smem + 90112 + wv * (3 * 16 * RWS);
    const float* mu = p.in[I_MU] + l * 2 * 960;
    const int gw2 = NGW == 2048 ? (gw + 1088) % 2048 : gw;
    for (int tile = gw2; tile < NROW / 16; tile += NGW) {
        const int R0 = tile * 16;
        float pvv[15], cvv[15], nvv[15];
        {
            const int pos0 = R0 % TPB; const bool hasp = pos0 != 0 && pos0 != CTXL;
            const float* pr0 = p.P + (size_t)R0 * PST + 512;
#pragma unroll
            for (int q = 0; q < 15; ++q) { const int col = lane + 64 * q; pvv[q] = hasp ? pr0[col - PST] : 0.f; cvv[q] = pr0[col]; }
        }
#pragma unroll 2
        for (int rr = 0; rr < 16; ++rr) {
            const int R = R0 + rr, pos = R % TPB;
            const int seg1 = pos < CTXL ? CTXL : TPB;
            const float* pr = p.P + (size_t)R * PST + 512;
            const bool hasn = pos + 1 < seg1;
            float sv[15];
#pragma unroll
            for (int q = 0; q < 15; ++q) {
                const int col = lane + 64 * q;
                nvv[q] = hasn ? pr[col + PST] : 0.f;
                const float v = cvv[q];
                sv[q] = v + mu[col] * (pvv[q] - v) + mu[960 + col] * (nvv[q] - v);
                pvv[q] = v; cvv[q] = nvv[q];
            }
#pragma unroll
            for (int q = 0; q < 12; ++q) p.RS[(size_t)R * 768 + lane + 64 * q] = sv[q];
            *(LAS bf16_t*)(stash + (0 * 16 + rr) * RWS + lane * 2) = f2bf(tanh_fast(sv[12]));
            *(LAS bf16_t*)(stash + (1 * 16 + rr) * RWS + lane * 2) = f2bf(sv[13]);
            *(LAS bf16_t*)(stash + (2 * 16 + rr) * RWS + lane * 2) = f2bf(sigmoidf_(sv[14]));
#pragma unroll
            for (int hq = 0; hq < 4; ++hq) {
                const int c = hq * 64 + lane;
                const float kk = sv[4 + hq] * p.in[I_KK][l * 256 + c];
                const float n2 = wave_sum(kk * kk);
                p.KKN[(size_t)R * 256 + c] = kk / fmaxf(sqrtf(n2), 1e-12f);
            }
        }
        __builtin_amdgcn_wave_barrier();
        rwkv_pre_mtx<0>(p, l, stash, R0, lane); rwkv_pre_mtx<1>(p, l, stash, R0, lane); rwkv_pre_mtx<2>(p, l, stash, R0, lane);
        rwkv_pre_mtx<3>(p, l, stash, R0, lane); rwkv_pre_mtx<4>(p, l, stash, R0, lane);
        __builtin_amdgcn_wave_barrier();
    }
}
#define RSLOT(k) (lds + (k) * 9216)
__device__ __forceinline__ void mm2(const LAS unsigned char* Xr, const LAS unsigned char* Yt, int mi, int ni0, int lane, f32x4 (&acc)[2]) {
    const int m = lane & 15, g = lane >> 4;
#pragma unroll
    for (int ks = 0; ks < 2; ++ks) {
        const bf16x8 a = *(const LAS bf16x8*)(Xr + (mi * 16 + m) * RWS + ks * 64 + g * 16);
#pragma unroll
        for (int n = 0; n < 2; ++n) {
            const bf16x8 b = *(const LAS bf16x8*)(Yt + ((ni0 + n) * 16 + m) * RWS + ks * 64 + g * 16);
            acc[n] = __builtin_amdgcn_mfma_f32_16x16x32_bf16(a, b, acc[n], 0, 0, 0);
        }
    }
}
__device__ __forceinline__ void st_r(LAS unsigned char* dst, int mi, int ni, int lane, const f32x4& v) {
    const int m = lane & 15, g = lane >> 4;
#pragma unroll
    for (int r = 0; r < 4; ++r) *(LAS bf16_t*)(dst + (mi * 16 + 4 * g + r) * RWS + (ni * 16 + m) * 2) = f2bf(v[r]);
}
__device__ __forceinline__ void st_t(LAS unsigned char* dst, int mi, int ni, int lane, const f32x4& v) {
    const int m = lane & 15, g = lane >> 4;
    u32x2 o; o.x = cvt_pk_bf16(v[0], v[1]); o.y = cvt_pk_bf16(v[2], v[3]);
    *(LAS u32x2*)(dst + (ni * 16 + m) * RWS + (mi * 16 + 4 * g) * 2) = o;
}
__device__ __forceinline__ float bfbits2f(unsigned short v) { return __uint_as_float(((unsigned)v) << 16); }

__device__ __forceinline__ void d_rwkv_chunkA(CParams& p, int wv, int l) {
    const int tidx_ = opaque_tid(wv);
    int bidx_ = blockIdx.x, gdim_ = gridDim.x; asm volatile("" : "+s"(bidx_), "+s"(gdim_));
    LAS unsigned char* lds = (LAS unsigned char*)smem;
    LAS float* segtot = (LAS float*)(lds + 16 * 9216);
    LAS float* gam = segtot + 512;
    const int tid = tidx_, lane = tid & 63, w = wv;
    const int mi = w >> 1, ni0 = (w & 1) * 2, m16 = lane & 15, g = lane >> 4;
    for (int task = bidx_; task < 2176; task += gdim_) {
        const int c = task % 68, d = (task / 68) & 1, h = (task / 136) & 3, b = task / 544;
        __syncthreads();
        {
            const int j = lane, tq = w, hc = h * 64 + j;
            const float ka = p.in[I_KA][l * 256 + hc];
            float lw[8], aa[8], bb[8], ke[8], rr[8], vv[8];
#pragma unroll
            for (int u = 0; u < 8; ++u) {
                const size_t R = (size_t)b * TPB + rwkv_pos(d, c, 8 * tq + u);
                lw[u] = p.DEC[((size_t)d * NROW + R) * 256 + hc];
                const float aic = p.AIC[((size_t)d * NROW + R) * 256 + hc], kkn = p.KKN[R * 256 + hc];
                const float* rs = p.RS + R * 768;
                rr[u] = rs[hc]; const float k = rs[256 + hc]; vv[u] = rs[512 + hc];
                aa[u] = -kkn; bb[u] = kkn * aic; ke[u] = k * (1.f + (aic - 1.f) * ka);
            }
            float cs[8]; cs[0] = lw[0];
#pragma unroll
            for (int u = 1; u < 8; ++u) cs[u] = cs[u - 1] + lw[u];
            segtot[tq * 64 + j] = cs[7];
            __syncthreads();
            float pre = 0.f, tot = 0.f;
#pragma unroll
            for (int q = 0; q < 8; ++q) { const float sgt = segtot[q * 64 + j]; tot += sgt; if (q < tq) pre += sgt; }
            if (tq == 0) gam[j] = __expf(tot);
            float at[8], bt[8], kt[8];
#pragma unroll
            for (int u = 0; u < 8; ++u) {
                const float Lc = pre + cs[u], Lp = Lc - lw[u];
                const float ep = __expf(Lp), ec = __expf(Lc), en = __expf(-Lc), ee = __expf(tot - Lc);
                const int t = 8 * tq + u;
                at[u] = aa[u] * ep; bt[u] = bb[u] * ee; kt[u] = ke[u] * ee;
                *(LAS bf16_t*)(RSLOT(0) + t * RWS + j * 2) = f2bf(at[u]);
                *(LAS bf16_t*)(RSLOT(1) + t * RWS + j * 2) = f2bf(rr[u] * ec);
                *(LAS bf16_t*)(RSLOT(2) + t * RWS + j * 2) = f2bf(bb[u] * en);
                *(LAS bf16_t*)(RSLOT(3) + t * RWS + j * 2) = f2bf(ke[u] * en);
            }
            u32x4 o;
            o.x = cvt_pk_bf16(at[0], at[1]); o.y = cvt_pk_bf16(at[2], at[3]); o.z = cvt_pk_bf16(at[4], at[5]); o.w = cvt_pk_bf16(at[6], at[7]);
            *(LAS u32x4*)(RSLOT(4) + j * RWS + tq * 16) = o;
            o.x = cvt_pk_bf16(bt[0], bt[1]); o.y = cvt_pk_bf16(bt[2], bt[3]); o.z = cvt_pk_bf16(bt[4], bt[5]); o.w = cvt_pk_bf16(bt[6], bt[7]);
            *(LAS u32x4*)(RSLOT(5) + j * RWS + tq * 16) = o;
            o.x = cvt_pk_bf16(kt[0], kt[1]); o.y = cvt_pk_bf16(kt[2], kt[3]); o.z = cvt_pk_bf16(kt[4], kt[5]); o.w = cvt_pk_bf16(kt[6], kt[7]);
            *(LAS u32x4*)(RSLOT(6) + j * RWS + tq * 16) = o;
            o.x = cvt_pk_bf16(vv[0], vv[1]); o.y = cvt_pk_bf16(vv[2], vv[3]); o.z = cvt_pk_bf16(vv[4], vv[5]); o.w = cvt_pk_bf16(vv[6], vv[7]);
            *(LAS u32x4*)(RSLOT(7) + j * RWS + tq * 16) = o;
        }
        __syncthreads();
        {
            f32x4 aab[2] = {}, aak[2] = {}, brb[2] = {}, brk[2] = {};
            mm2(RSLOT(0), RSLOT(2), mi, ni0, lane, aab); mm2(RSLOT(0), RSLOT(3), mi, ni0, lane, aak);
            mm2(RSLOT(1), RSLOT(2), mi, ni0, lane, brb); mm2(RSLOT(1), RSLOT(3), mi, ni0, lane, brk);
#pragma unroll
            for (int n = 0; n < 2; ++n) {
                f32x4 p0;
#pragma unroll
                for (int r = 0; r < 4; ++r) {
                    const int t = mi * 16 + 4 * g + r, sidx = (ni0 + n) * 16 + m16;
                    if (!(sidx < t)) { aab[n][r] = 0.f; aak[n][r] = 0.f; }
                    if (!(sidx <= t)) { brb[n][r] = 0.f; brk[n][r] = 0.f; }
                    p0[r] = aab[n][r] + (sidx == t ? 1.f : 0.f);
                }
                st_r(RSLOT(11), mi, ni0 + n, lane, aab[n]); st_t(RSLOT(12), mi, ni0 + n, lane, aab[n]);
                st_t(RSLOT(13), mi, ni0 + n, lane, p0);
                st_r(RSLOT(8), mi, ni0 + n, lane, aak[n]); st_r(RSLOT(9), mi, ni0 + n, lane, brb[n]); st_r(RSLOT(10), mi, ni0 + n, lane, brk[n]);
            }
        }
        __syncthreads();
#pragma unroll 1
        for (int st = 1; st <= 6; ++st) {
            LAS unsigned char* qsr = (st & 1) ? RSLOT(11) : RSLOT(0);
            LAS unsigned char* qst = (st & 1) ? RSLOT(12) : RSLOT(2);
            LAS unsigned char* qdr = (st & 1) ? RSLOT(0) : RSLOT(11);
            LAS unsigned char* qdt = (st & 1) ? RSLOT(2) : RSLOT(12);
            if (st <= 5) {
                f32x4 q[2] = {};
                mm2(qsr, qst, mi, ni0, lane, q);
#pragma unroll
                for (int n = 0; n < 2; ++n) { st_r(qdr, mi, ni0 + n, lane, q[n]); st_t(qdt, mi, ni0 + n, lane, q[n]); }
            }
            if (st >= 2) {
                LAS unsigned char* ps = (st & 1) ? RSLOT(3) : RSLOT(13);
                LAS unsigned char* pd = (st & 1) ? RSLOT(13) : RSLOT(3);
                f32x4 pp[2];
#pragma unroll
                for (int n = 0; n < 2; ++n) {
                    const u32x2 o = *(const LAS u32x2*)(ps + ((ni0 + n) * 16 + m16) * RWS + (mi * 16 + 4 * g) * 2);
                    pp[n][0] = __uint_as_float(o.x << 16); pp[n][1] = __uint_as_float(o.x & 0xffff0000u); pp[n][2] = __uint_as_float(o.y << 16); pp[n][3] = __uint_as_float(o.y & 0xffff0000u);
                }
                mm2(qsr, ps, mi, ni0, lane, pp);
#pragma unroll
                for (int n = 0; n < 2; ++n) { st_t(pd, mi, ni0 + n, lane, pp[n]); if (st == 6) st_r(RSLOT(15), mi, ni0 + n, lane, pp[n]); }
            }
            if (st == 1) {
                f32x4 akv[2] = {};
                mm2(RSLOT(8), RSLOT(7), mi, ni0, lane, akv);
#pragma unroll
                for (int n = 0; n < 2; ++n) st_t(RSLOT(14), mi, ni0 + n, lane, akv[n]);
            }
            __syncthreads();
        }
        {
            f32x4 w1[2] = {}, z[2] = {};
            mm2(RSLOT(15), RSLOT(4), mi, ni0, lane, w1); mm2(RSLOT(15), RSLOT(14), mi, ni0, lane, z);
#pragma unroll
            for (int n = 0; n < 2; ++n) { st_t(RSLOT(11), mi, ni0 + n, lane, w1[n]); st_t(RSLOT(12), mi, ni0 + n, lane, z[n]); }
        }
        __syncthreads();
        {
            f32x4 mm_[2] = {}, nn[2] = {}, qq[2] = {}, yl[2] = {};
            mm2(RSLOT(5), RSLOT(11), mi, ni0, lane, mm_);
            mm2(RSLOT(5), RSLOT(12), mi, ni0, lane, nn); mm2(RSLOT(6), RSLOT(7), mi, ni0, lane, nn);
            mm2(RSLOT(9), RSLOT(11), mi, ni0, lane, qq);
            mm2(RSLOT(9), RSLOT(12), mi, ni0, lane, yl); mm2(RSLOT(10), RSLOT(7), mi, ni0, lane, yl);
#pragma unroll
            for (int n = 0; n < 2; ++n) {
#pragma unroll
                for (int r = 0; r < 4; ++r) {
                    const int row = mi * 16 + 4 * g + r, col = (ni0 + n) * 16 + m16;
                    if (row == col) mm_[n][r] += gam[row];
                    qq[n][r] += bfbits2f(*(const LAS bf16_t*)(RSLOT(1) + row * RWS + col * 2));
                }
                st_r(RSLOT(0), mi, ni0 + n, lane, mm_[n]); st_r(RSLOT(2), mi, ni0 + n, lane, qq[n]);
                *(f32x4*)(p.RNF + (size_t)task * 4096 + (((ni0 + n) * 4 + mi) * 64 + lane) * 4) = nn[n];
#pragma unroll
                for (int r = 0; r < 4; ++r) p.RYF[(size_t)task * 4096 + (mi * 16 + 4 * g + r) * 64 + (ni0 + n) * 16 + m16] = yl[n][r];
            }
        }
        __syncthreads();
        {
            const int jb = tid >> 7, sk = (tid >> 6) & 1;
            const int row = jb * 16 + m16;
            const u32x2 m0 = *(const LAS u32x2*)(RSLOT(0) + row * RWS + (32 * sk + 4 * g) * 2), m1 = *(const LAS u32x2*)(RSLOT(0) + row * RWS + (32 * sk + 16 + 4 * g) * 2);
            const u32x2 q0 = *(const LAS u32x2*)(RSLOT(2) + row * RWS + (32 * sk + 4 * g) * 2), q1 = *(const LAS u32x2*)(RSLOT(2) + row * RWS + (32 * sk + 16 + 4 * g) * 2);
            *(u32x4*)(p.RMF + (size_t)task * 4096 + (size_t)tid * 8) = (u32x4){m0.x, m0.y, m1.x, m1.y};
            *(u32x4*)(p.RQF + (size_t)task * 4096 + (size_t)tid * 8) = (u32x4){q0.x, q0.y, q1.x, q1.y};
        }
    }
    __syncthreads();
}

#define SEQ_LOAD(M_, N_, cc) do { const int c_ = (cc) < 68 ? (cc) : 67; const size_t tk_ = task0 + c_; \
    const bf16x8* mf_ = (const bf16x8*)(p.RMF + tk_ * 4096) + lane; const f32x4* nf_ = (const f32x4*)(p.RNF + tk_ * 4096) + (ib * 4) * 64 + lane; \
    _Pragma("unroll") for (int jb = 0; jb < 4; ++jb) { M_[jb][0] = mf_[(jb * 2) * 64]; M_[jb][1] = mf_[(jb * 2 + 1) * 64]; N_[jb] = nf_[jb * 64]; } } while (0)
#define SEQ_STEP(M_, N_, cc) do { bf16x8 bfr[2]; \
    _Pragma("unroll") for (int sk = 0; sk < 2; ++sk) { union { u32x4 u; bf16x8 v; } cv; \
        cv.u.x = cvt_pk_bf16(S[2 * sk][0], S[2 * sk][1]); cv.u.y = cvt_pk_bf16(S[2 * sk][2], S[2 * sk][3]); \
        cv.u.z = cvt_pk_bf16(S[2 * sk + 1][0], S[2 * sk + 1][1]); cv.u.w = cvt_pk_bf16(S[2 * sk + 1][2], S[2 * sk + 1][3]); bfr[sk] = cv.v; \
        *((bf16x8*)(p.S0F + (task0 + (cc)) * 4096) + (ib * 2 + sk) * 64 + lane) = cv.v; } \
    _Pragma("unroll") for (int jb = 0; jb < 4; ++jb) { f32x4 a_ = N_[jb]; \
        a_ = __builtin_amdgcn_mfma_f32_16x16x32_bf16(M_[jb][0], bfr[0], a_, 0, 0, 0); a_ = __builtin_amdgcn_mfma_f32_16x16x32_bf16(M_[jb][1], bfr[1], a_, 0, 0, 0); S[jb] = a_; } } while (0)
__device__ __forceinline__ void d_rwkv_seq(CParams& p, int widx, int ib, int lane) {
    const int d = widx & 1, h = (widx >> 1) & 3, b = widx >> 3;
    f32x4 S[4];
#pragma unroll
    for (int jb = 0; jb < 4; ++jb) S[jb] = (f32x4){0.f, 0.f, 0.f, 0.f};
    const size_t task0 = (size_t)((b * 4 + h) * 2 + d) * 68;
    bf16x8 MA[4][2], MB[4][2], MC[4][2]; f32x4 NA[4], NB[4], NC[4];
    SEQ_LOAD(MA, NA, 0); SEQ_LOAD(MB, NB, 1);
#pragma unroll 1
    for (int c = 0; c < 66; c += 3) {
        SEQ_LOAD(MC, NC, c + 2); SEQ_STEP(MA, NA, c);
        SEQ_LOAD(MA, NA, c + 3); SEQ_STEP(MB, NB, c + 1);
        SEQ_LOAD(MB, NB, c + 4); SEQ_STEP(MC, NC, c + 2);
    }
    SEQ_STEP(MA, NA, 66); SEQ_STEP(MB, NB, 67);
}

__device__ __forceinline__ float xor16_max(float v) { return fmaxf(v, SWZ_XOR(v, 16)); }
__device__ __forceinline__ float max_xor32(float v) {
    int a = __float_as_int(v), b = a;
    asm volatile("s_nop 1\n\tv_permlane32_swap_b32 %0, %1\n\ts_nop 1" : "+v"(a), "+v"(b));
    return fmaxf(__int_as_float(a), __int_as_float(b));
}
#define NA_KB 15360
#define NA_KC 98304
#define NA_KST 144
#define NA_VBS 1168
#define NA_VCS 528
template <bool BAND>
__device__ __forceinline__ void attn_scores(const LAS unsigned char* kbase  , int ustride  ,
                                            const bf16x8 (&qf)[2], const float* rpbh, int c, int rr, int rs, int kc0, int lane, float& mrow, float& lrow, bf16x8 (&pf)[8]) {
    const int g = lane >> 4;
    f32x4 sc[16];
#pragma unroll
    for (int u = 0; u < 8; ++u) {
#pragma unroll
        for (int j2 = 0; j2 < 2; ++j2) {
            const LAS unsigned char* kr = kbase + u * ustride + j2 * (16 * NA_KST);
            const bf16x8 k0 = *(const LAS bf16x8*)kr, k1 = *(const LAS bf16x8*)(kr + 64);
            f32x4 a = {0.f, 0.f, 0.f, 0.f};
            a = __builtin_amdgcn_mfma_f32_16x16x32_bf16(k0, qf[0], a, 0, 0, 0);
            a = __builtin_amdgcn_mfma_f32_16x16x32_bf16(k1, qf[1], a, 0, 0, 0);
            if (BAND) {
                const int cs = min(max(c - 8, 0), 48);
#pragma unroll
                for (int r = 0; r < 4; ++r) {
                    const int kc = kc0 + 16 * j2 + 4 * g + r;
                    const int cb = min(max(kc - c + 15, 0), 30);
                    const float bias = rpbh[(rs + u - rr + 7) * 31 + cb];
                    a[r] = (kc >= cs && kc < cs + 16) ? a[r] + bias : -1e30f;
                }
            }
            sc[2 * u + j2] = a;
        }
    }
    float mx = -1e30f;
#pragma unroll
    for (int t = 0; t < 16; ++t) mx = fmaxf(mx, fmaxf(fmaxf(sc[t][0], sc[t][1]), fmaxf(sc[t][2], sc[t][3])));
    mx = xor16_max(mx); mx = max_xor32(mx);
    float sum = 0.f;
#pragma unroll
    for (int t = 0; t < 16; ++t)
#pragma unroll
        for (int r = 0; r < 4; ++r) { const float e = __expf(sc[t][r] - mx); sc[t][r] = e; sum += e; }
    sum += SWZ_XOR(sum, 16); sum = sum_xor32(sum);
    mrow = mx; lrow = sum;
#pragma unroll
    for (int u = 0; u < 8; ++u) {
        union { u32x4 w; bf16x8 v; } t;
        t.w.x = cvt_pk_bf16(sc[2 * u][0], sc[2 * u][1]); t.w.y = cvt_pk_bf16(sc[2 * u][2], sc[2 * u][3]);
        t.w.z = cvt_pk_bf16(sc[2 * u + 1][0], sc[2 * u + 1][1]); t.w.w = cvt_pk_bf16(sc[2 * u + 1][2], sc[2 * u + 1][3]);
        pf[u] = t.v;
    }
}
__device__ __forceinline__ void attn_pv(const LAS unsigned char* vbase, int vstride  , int ustride  , const bf16x8 (&pf)[8], f32x4 (&o)[4]) {
#pragma unroll
    for (int dt = 0; dt < 4; ++dt) o[dt] = (f32x4){0.f, 0.f, 0.f, 0.f};
#pragma unroll
    for (int u = 0; u < 8; ++u)
#pragma unroll
        for (int dt = 0; dt < 4; ++dt) {
            const LAS unsigned char* vr = vbase + dt * 16 * vstride + u * ustride;
            const u32x2 v0 = *(const LAS u32x2*)vr, v1 = *(const LAS u32x2*)(vr + 32);
            union { u32x4 w; bf16x8 v; } vf; vf.w = (u32x4){v0.x, v0.y, v1.x, v1.y};
            o[dt] = __builtin_amdgcn_mfma_f32_16x16x32_bf16(vf.v, pf[u], o[dt], 0, 0, 0);
        }
}
__device__ __forceinline__ void d_na(CParams& p, int wv, int l, int do_ctx, int bid, int nblk) {
    const int tidx_ = opaque_tid(wv);
    const int lane = tidx_ & 63, m16 = lane & 15, g = lane >> 4;
    LAS unsigned char* lds = (LAS unsigned char*)smem;
    const float* rpbs = (const float*)smem;
    const int nbt = 1024 + (do_ctx ? 64 : 0);
    for (int bt = bid; bt < nbt; bt += nblk) {
        const bool lat = bt < 1024;
        int b, h, rs0 = 0, nrows = 0, rr = 0, rs = 0, c0 = 0, kc0 = 0, qpos0;
        if (lat) { b = bt >> 8; h = (bt >> 5) & 7; const int r0 = (bt & 31) * 2; rs0 = min(max(r0 - 4, 0), 56); nrows = min(9, 64 - rs0);
            rr = r0 + (wv >> 2); rs = min(max(rr - 4, 0), 56); c0 = (wv & 3) * 16; kc0 = min(max(c0 - 8, 0), 32); qpos0 = CTXL + rr * 64 + c0; }
        else { const int t2 = bt - 1024; b = t2 >> 4; h = (t2 >> 1) & 7; qpos0 = ((t2 & 1) * 8 + wv) * 16; }
        const bf16_t* QHh = p.QH + (size_t)(b * 8 + h) * TPB * 64;
        const bf16_t* KHh = p.KH + (size_t)(b * 8 + h) * TPB * 64;
        const bf16_t* VTh = p.VT + (size_t)(b * 8 + h) * 64 * TPB;
        const int kpos0 = CTXL + rs0 * 64, nkb = nrows * 64;
        bf16x8 qf[2];
        { const bf16_t* qr = QHh + (size_t)(qpos0 + m16) * 64 + 8 * g; qf[0] = *(const bf16x8*)qr; qf[1] = *(const bf16x8*)(qr + 32); }
        __syncthreads();
        for (int q = tidx_; q < nkb * 8; q += NTHR) { const int key = q >> 3, part = q & 7; *(LAS u32x4*)(lds + NA_KB + key * NA_KST + part * 16) = *(const u32x4*)(KHh + (size_t)(kpos0 + key) * 64 + part * 8); }
        for (int q = tidx_; q < 256 * 8; q += NTHR) { const int key = q >> 3, part = q & 7; *(LAS u32x4*)(lds + NA_KC + key * NA_KST + part * 16) = *(const u32x4*)(KHh + (size_t)key * 64 + part * 8); }
        __syncthreads();
        float m1 = -1e30f, l1 = 0.f, m2, l2; bf16x8 pf1[8], pf2[8];
        const int c = c0 + m16, lr0 = rs - rs0;
        attn_scores<false>(lds + NA_KC + m16 * NA_KST + 16 * g, 32 * NA_KST, qf, nullptr, 0, 0, 0, 0, lane, m2, l2, pf2);
        if (lat) attn_scores<true>(lds + NA_KB + ((lr0 * 64 + kc0 + m16) * NA_KST) + 16 * g, 64 * NA_KST, qf, rpbs + h * 465, c, rr, rs, kc0, lane, m1, l1, pf1);
        __syncthreads();
        if (lat) for (int q = tidx_; q < 64 * nrows * 8; q += NTHR) { const int dim = q / (nrows * 8), part = q % (nrows * 8);
            *(LAS u32x4*)(lds + NA_KB + dim * NA_VBS + part * 16) = *(const u32x4*)(VTh + (size_t)dim * TPB + kpos0 + part * 8); }
        for (int q = tidx_; q < 64 * 32; q += NTHR) { const int dim = q >> 5, part = q & 31; *(LAS u32x4*)(lds + NA_KC + dim * NA_VCS + part * 16) = *(const u32x4*)(VTh + (size_t)dim * TPB + part * 8); }
        __syncthreads();
        f32x4 o2[4]; float inv;
        attn_pv(lds + NA_KC + m16 * NA_VCS + 8 * g, NA_VCS, 64, pf2, o2);
        if (lat) {
            f32x4 o1[4];
            attn_pv(lds + NA_KB + m16 * NA_VBS + (lr0 * 64 + kc0) * 2 + 8 * g, NA_VBS, 128, pf1, o1);
            const float mm = fmaxf(m1, m2), f1 = __expf(m1 - mm), f2 = __expf(m2 - mm);
            inv = 1.f / (l1 * f1 + l2 * f2);
#pragma unroll
            for (int dt = 0; dt < 4; ++dt) o2[dt] = o1[dt] * f1 + o2[dt] * f2;
        } else inv = 1.f / l2;
        bf16_t* orow = p.MIX + (size_t)(b * TPB + qpos0 + m16) * DM + 512 + h * 64 + 4 * g;
#pragma unroll
        for (int dt = 0; dt < 4; ++dt) {
            const f32x4 v = o2[dt] * inv;
            u32x2 ov; ov.x = cvt_pk_bf16(v[0], v[1]); ov.y = cvt_pk_bf16(v[2], v[3]);
            *(u32x2*)(orow + dt * 16) = ov;
        }
    }
}

__device__ __forceinline__ void d_scan_attn(CParams& p, int wv, int l, int do_ctx) {
    const int tidx_ = opaque_tid(wv);
    int bidx_ = blockIdx.x, gdim_ = gridDim.x; asm volatile("" : "+s"(bidx_), "+s"(gdim_));
    const int wave = tidx_ >> 6, lane = tidx_ & 63;
    if (bidx_ < 32) {
        if (wave < 4) d_rwkv_seq(p, bidx_, wave, lane);
        else if (wave == 4) d_lru_carry(p, bidx_, lane);
        return;
    }
    { float* rpbs = (float*)smem; for (int i = tidx_; i < 8 * 15 * 31; i += NTHR) rpbs[i] = p.in[I_RPB][(size_t)l * 8 * 15 * 31 + i]; }
    __syncthreads();
    d_na(p, wv, l, do_ctx, bidx_ - 32, gdim_ - 32);
}

#define SWZ16(v, o) __int_as_float(__builtin_amdgcn_ds_swizzle(__float_as_int(v), ((o) << 10) | 0x1f))
__device__ __forceinline__ float row16_sum(float v) { return row_sum16(v); }
__device__ __forceinline__ void d_finish(CParams& p, int wv, int l, int skip_ctx) {
    const int tidx_ = opaque_tid(wv);
    int bidx_ = blockIdx.x, gdim_ = gridDim.x; asm volatile("" : "+s"(bidx_), "+s"(gdim_));
    const int lane = tidx_ & 63, gw = bidx_ * 8 + wv, NGW = gdim_ * 8, m16 = lane & 15, g = lane >> 4;
    for (int it = gw; it < NROW * 4; it += NGW) {
        const int R = it >> 2, h = it & 3, c = h * 64 + lane;
        if (skip_ctx && (R % TPB) < CTXL) continue;
        const float gg = p.P[(size_t)R * PST + 256 + c];
        p.MIX[(size_t)R * DM + c] = f2bf(gelu_tanh(gg) * (lru_h(p, R / TPB, R % TPB, R, 0, c) + lru_h(p, R / TPB, R % TPB, R, 1, c)));
    }
    for (int it = gw; it < 4 * 4 * 272; it += NGW) {
        const int pt = it % 272, h = (it / 272) & 3, b = it / 1088;
        if (skip_ctx && pt < 16) continue;
        const int p0 = pt * 16;
        f32x4 y[4];
#pragma unroll
        for (int q = 0; q < 4; ++q) y[q] = (f32x4){0.f, 0.f, 0.f, 0.f};
#pragma unroll
        for (int d = 0; d < 2; ++d) {
            const int s0 = d == 0 ? p0 : (p0 < CTXL ? CTXL - 1 - p0 : CTXL + (TPB - 1 - p0));
            const int c = s0 >> 6, tb = (s0 & 63) >> 4;
            const size_t tk = (size_t)((b * 4 + h) * 2 + d) * 68 + c;
            const int lsrc = d == 0 ? lane : ((15 - m16) | (g << 4));
            const bf16x8* qf = (const bf16x8*)(p.RQF + tk * 4096) + (tb * 2) * 64 + lsrc;
            const bf16x8 q0 = qf[0], q1 = qf[64];
            const bf16x8* sf = (const bf16x8*)(p.S0F + tk * 4096) + lane;
            const float* yl = p.RYF + tk * 4096;
#pragma unroll
            for (int q = 0; q < 4; ++q) {
                f32x4 a;
#pragma unroll
                for (int r = 0; r < 4; ++r) { const int t = tb * 16 + (d == 0 ? 4 * g + r : 15 - (4 * g + r)); a[r] = yl[t * 64 + q * 16 + m16]; }
                a = __builtin_amdgcn_mfma_f32_16x16x32_bf16(q0, sf[(q * 2) * 64], a, 0, 0, 0);
                a = __builtin_amdgcn_mfma_f32_16x16x32_bf16(q1, sf[(q * 2 + 1) * 64], a, 0, 0, 0);
                y[q] += a;
            }
        }
        float mean[4], rstd[4], bon[4];
        float kav[4], rkv[4], lgv[4], lbv[4];
#pragma unroll
        for (int q = 0; q < 4; ++q) { const int c = h * 64 + q * 16 + m16; kav[q] = p.in[I_KA][l * 256 + c]; rkv[q] = p.in[I_RK][l * 256 + c]; lgv[q] = p.in[I_LNG][l * 256 + c]; lbv[q] = p.in[I_LNB][l * 256 + c]; }
        float rv[4][4], vv[4][4], gv[4][4];
#pragma unroll
        for (int r = 0; r < 4; ++r) {
            const size_t R = (size_t)b * TPB + p0 + 4 * g + r;
            float sm = 0.f, bs = 0.f;
#pragma unroll
            for (int q = 0; q < 4; ++q) {
                const int c = h * 64 + q * 16 + m16;
                const float* rs = p.RS + R * 768;
                const float rr_ = rs[c], kk_ = rs[256 + c]; vv[r][q] = rs[512 + c]; gv[r][q] = p.GG[R * 256 + c]; rv[r][q] = rr_;
                const float a0 = p.AIC[R * 256 + c], a1 = p.AIC[((size_t)NROW + R) * 256 + c];
                bs += rr_ * kk_ * rkv[q] * ((1.f + (a0 - 1.f) * kav[q]) + (1.f + (a1 - 1.f) * kav[q]));
                sm += y[q][r];
            }
            mean[r] = row16_sum(sm) * (1.f / 64.f); bon[r] = row16_sum(bs);
            float vs = 0.f;
#pragma unroll
            for (int q = 0; q < 4; ++q) { const float dv = y[q][r] - mean[r]; vs += dv * dv; }
            rstd[r] = rsqrtf(row16_sum(vs) * (1.f / 64.f) + 64e-5f);
        }
#pragma unroll
        for (int r = 0; r < 4; ++r) {
            const size_t R = (size_t)b * TPB + p0 + 4 * g + r;
#pragma unroll
            for (int q = 0; q < 4; ++q) {
                const float o = ((y[q][r] - mean[r]) * rstd[r] * lgv[q] + lbv[q] + bon[r] * vv[r][q]) * gv[r][q];
                p.MIX[R * DM + 256 + h * 64 + q * 16 + m16] = f2bf(o);
            }
        }
        (void)rv;
    }
}

__device__ __forceinline__ void d_norm_router(CParams& p, int wv, int l, int skip_ctx) {
    const int tidx_ = opaque_tid(wv);
    int bidx_ = blockIdx.x, gdim_ = gridDim.x; asm volatile("" : "+s"(bidx_), "+s"(gdim_));
    const int lane = tidx_ & 63, m16 = lane & 15, g = lane >> 4;
    const int gtid = bidx_ * NTHR + tidx_, gsz = gdim_ * NTHR;
    for (int i = gtid; i < CAP; i += gsz) p.SLOT_TOK[i] = 0;
    LAS float* hs = (LAS float*)smem;
    LAS float* part = hs + 16 * 1028;
    LAS int* lcnt = (LAS int*)(part + 8 * 16 * 32);
    if (tidx_ < 64) lcnt[tidx_] = 0;
    const float* rw = p.in[I_RTW] + (size_t)l * DM * 32;
    const float* gn = p.in[I_NFG] + l * DM;
    int* cnt = p.CNT + l * 32;
    for (int tile = bidx_; tile < NROW / 16; tile += gdim_) {
        const int R0 = tile * 16, b = R0 / TPB, pos0 = R0 % TPB, mr = pos0 < CTXL ? 4 : b;
        if (skip_ctx && pos0 < CTXL) continue;
        const float* mod = p.MOD + (l * 5 + mr) * 6144 + 3 * DM;
        __syncthreads();
#pragma unroll 1
        for (int q = 0; q < 2; ++q) {
            const int rr = 2 * wv + q, R = R0 + rr;
            const float4* xr = (const float4*)(p.X2 + (size_t)R * DM);
            float4 v[4]; float ss = 0.f;
#pragma unroll
            for (int i = 0; i < 4; ++i) { v[i] = xr[lane + 64 * i]; ss += v[i].x * v[i].x + v[i].y * v[i].y + v[i].z * v[i].z + v[i].w * v[i].w; }
            ss = wave_sum(ss);
            const float rinv = rsqrtf(ss * (1.f / DM) + 1e-6f);
#pragma unroll
            for (int i = 0; i < 4; ++i) {
                const int c = (lane + 64 * i) * 4;
                const float4 gg = *(const float4*)(gn + c), sh = *(const float4*)(mod + c), sc = *(const float4*)(mod + DM + c);
                f32x4 o;
                o[0] = v[i].x * rinv * gg.x * (1.f + sc.x) + sh.x; o[1] = v[i].y * rinv * gg.y * (1.f + sc.y) + sh.y;
                o[2] = v[i].z * rinv * gg.z * (1.f + sc.z) + sh.z; o[3] = v[i].w * rinv * gg.w * (1.f + sc.w) + sh.w;
                uint2 ob; ob.x = cvt_pk_bf16(o[0], o[1]); ob.y = cvt_pk_bf16(o[2], o[3]);
                *(uint2*)(p.H + (size_t)R * DM + c) = ob;
                *(LAS f32x4*)(hs + rr * 1028 + c) = o;
            }
        }
        __syncthreads();
        {
            f32x4 a0 = {0.f, 0.f, 0.f, 0.f}, a1 = {0.f, 0.f, 0.f, 0.f};
            const int kb = wv * 128 + g;
#pragma unroll 8
            for (int ks = 0; ks < 32; ++ks) {
                const int k = kb + 4 * ks;
                const float av = hs[m16 * 1028 + k];
                const float b0 = rw[k * 32 + m16], b1 = rw[k * 32 + 16 + m16];
                a0 = __builtin_amdgcn_mfma_f32_16x16x4f32(av, b0, a0, 0, 0, 0);
                a1 = __builtin_amdgcn_mfma_f32_16x16x4f32(av, b1, a1, 0, 0, 0);
            }
#pragma unroll
            for (int r = 0; r < 4; ++r) { part[(wv * 16 + 4 * g + r) * 32 + m16] = a0[r]; part[(wv * 16 + 4 * g + r) * 32 + 16 + m16] = a1[r]; }
        }
        __syncthreads();
#pragma unroll 1
        for (int q = 0; q < 2; ++q) {
            const int rr = 2 * wv + q, R = R0 + rr, e = lane & 31;
            float val = p.in[I_RTB][l * 32 + e];
#pragma unroll
            for (int w8 = 0; w8 < 8; ++w8) val += part[(w8 * 16 + rr) * 32 + e];
            if (lane >= 32) val = -3e38f;
            float tv[4]; int ti[4];
#pragma unroll
            for (int k = 0; k < 4; ++k) {
                const float m = wave_max(val);
                const unsigned long long bal = __ballot(val == m);
                const int idx = __ffsll((long long)bal) - 1;
                tv[k] = m; ti[k] = idx;
                if (lane == idx) val = -3e38f;
            }
            if (lane == 0) {
                const float e1 = __expf(tv[1] - tv[0]), e2 = __expf(tv[2] - tv[0]), e3 = __expf(tv[3] - tv[0]);
                const float inv = 1.f / (1.f + e1 + e2 + e3);
                const float gs[4] = {inv, e1 * inv, e2 * inv, e3 * inv};
#pragma unroll
                for (int k = 0; k < 4; ++k) {
                    p.TOPG[R * 4 + k] = gs[k]; p.TOPI[R * 4 + k] = ti[k];
                    p.TOKPOS[R * 4 + k] = __hip_atomic_fetch_add(&lcnt[ti[k]], 1, __ATOMIC_RELAXED, __HIP_MEMORY_SCOPE_WORKGROUP);
                }
            }
        }
    }
    __syncthreads();
    if (tidx_ < 32) lcnt[32 + tidx_] = lcnt[tidx_] ? atomicAdd(&cnt[tidx_], lcnt[tidx_]) : 0;
    __syncthreads();
    for (int tile = bidx_; tile < NROW / 16; tile += gdim_) {
        const int R0 = tile * 16;
        if (skip_ctx && (R0 % TPB) < CTXL) continue;
        if (tidx_ < 64) { const int i = R0 * 4 + tidx_; p.TOKPOS[i] += lcnt[32 + p.TOPI[i]]; }
    }
}
__device__ __forceinline__ void moe_offsets_lds(CParams& p, int wv, int l) {
    const int tidx_ = opaque_tid(wv);
    LAS int* li = (LAS int*)((LAS unsigned char*)smem + LDS_GEMM);
    __syncthreads();
    if (tidx_ < 64) {
        const int e = tidx_;
        const int n = e < 32 ? (p.CNT[l * 32 + e] + MOE_TM - 1) / MOE_TM : 0;
        int sc = n;
#define ISHR(v, k) __builtin_amdgcn_update_dpp(0, v, 0x110 + (k), 0xf, 0xf, true)
        sc += ISHR(sc, 1); sc += ISHR(sc, 2); sc += ISHR(sc, 4); sc += ISHR(sc, 8);
#undef ISHR
        const int row0 = __builtin_amdgcn_readlane(sc, 15);
        if (e >= 16) sc += row0;
        const int excl = sc - n;
        if (e < 32) { li[e] = excl * MOE_TM; for (int i = 0; i < n; ++i) li[64 + excl + i] = e; }
        if (e == 31) { li[32] = sc * MOE_TM; li[40] = sc; }
    }
    __syncthreads();
}
__device__ __forceinline__ void d_moe_scatter(CParams& p, int wv, int l, int skip_ctx) {
    const int tidx_ = opaque_tid(wv);
    int bidx_ = blockIdx.x, gdim_ = gridDim.x; asm volatile("" : "+s"(bidx_), "+s"(gdim_));
    moe_offsets_lds(p, wv, l);
    const int* li = (const int*)(smem + LDS_GEMM);
    const int gtid = bidx_ * NTHR + tidx_, gsz = gdim_ * NTHR;
    for (int i = gtid; i < NROW * 4; i += gsz) {
        const int R = i >> 2;
        if (skip_ctx && (R % TPB) < CTXL) continue;
        p.SLOT_TOK[li[p.TOPI[i]] + p.TOKPOS[i]] = R;
    }
}
struct ProbG1 {
    CParams& p; int l; const int* li; int ntile; int bid, nblk;
    __device__ __forceinline__ bool next(int i, Unit& u) const { return tile_order(i, ntile, 8, u, bid, nblk); }
    __device__ __forceinline__ int expert(const Unit& u) const { return __builtin_amdgcn_readfirstlane(li[64 + u.pm]); }
    __device__ __forceinline__ const char* a_ptr(const Unit&) const { return (const char*)p.H; }
    __device__ __forceinline__ const char* b_ptr(const Unit& u) const { return (const char*)p.WTGU + ((size_t)(l * NEXP + expert(u)) * 2048 + (size_t)u.pn * 256) * KB_; }
    __device__ __forceinline__ int gather_row(const Unit& u, int r) const { return p.SLOT_TOK[u.pm * 256 + r]; }
    __device__ __forceinline__ void epi(const f32x4 (&acc)[2][2][4][2], const Unit& u, int wr, int wc, int fr, int fq) const {
        const int brow = u.pm * 256;
        const float* bias = p.in[I_BGU] + (size_t)(l * NEXP + expert(u)) * 2048;
        const int c = u.pn * 128 + wc * 32 + 8 * fq;
        const f32x4 bg0 = *(const f32x4*)(bias + c), bg1 = *(const f32x4*)(bias + c + 4);
        const f32x4 bu0 = *(const f32x4*)(bias + 1024 + c), bu1 = *(const f32x4*)(bias + 1024 + c + 4);
#pragma unroll
        for (int ai = 0; ai < 2; ++ai)
#pragma unroll
            for (int m = 0; m < 4; ++m) {
                float a[8];
#pragma unroll
                for (int n = 0; n < 2; ++n)
#pragma unroll
                    for (int j = 0; j < 4; ++j) {
                        float gv = acc[ai][0][m][n][j] + (n == 0 ? bg0[j] : bg1[j]), uv = acc[ai][1][m][n][j] + (n == 0 ? bu0[j] : bu1[j]);
                        gv = fminf(gv, 7.f); uv = fminf(fmaxf(uv, -7.f), 7.f);
                        a[n * 4 + j] = (uv + 1.f) * (gv * sigmoidf_(1.702f * gv));
                    }
                u32x4 o; o.x = cvt_pk_bf16(a[0], a[1]); o.y = cvt_pk_bf16(a[2], a[3]); o.z = cvt_pk_bf16(a[4], a[5]); o.w = cvt_pk_bf16(a[6], a[7]);
                *(u32x4*)(p.ACT + (size_t)(brow + ai * 128 + wr * 64 + m * 16 + fr) * DM + c) = o;
            }
    }
};
__device__ __forceinline__ void d_moe_gemm1(CParams& p, int wv, int l) {
    moe_offsets_lds(p, wv, l);
    const int* li = (const int*)(smem + LDS_GEMM);
    ProbG1 P{p, l, li, __builtin_amdgcn_readfirstlane(li[40]), 0, 0};
    gemm_phase<true>(P, wv);
}
struct ProbG2 {
    CParams& p; int l; const int* li; int ntile; int bid, nblk;
    __device__ __forceinline__ bool next(int i, Unit& u) const { return tile_order(i, ntile, 4, u, bid, nblk); }
    __device__ __forceinline__ int expert(const Unit& u) const { return __builtin_amdgcn_readfirstlane(li[64 + u.pm]); }
    __device__ __forceinline__ const char* a_ptr(const Unit& u) const { return (const char*)p.ACT + (size_t)u.pm * 256 * KB_; }
    __device__ __forceinline__ const char* b_ptr(const Unit& u) const { return (const char*)p.WTDN + ((size_t)(l * NEXP + expert(u)) * DM + (size_t)u.pn * 256) * KB_; }
    __device__ __forceinline__ int gather_row(const Unit&, int) const { return 0; }
    __device__ __forceinline__ void epi(const f32x4 (&acc)[2][2][4][2], const Unit& u, int wr, int wc, int fr, int fq) const {
        const int brow = u.pm * 256, bcol = u.pn * 256;
        const float* bias = p.in[I_BDN] + (size_t)(l * NEXP + expert(u)) * DM;
#pragma unroll
        for (int bj = 0; bj < 2; ++bj) {
            const int col = bcol + bj * 128 + wc * 32 + 8 * fq;
            const f32x4 b0 = *(const f32x4*)(bias + col), b1 = *(const f32x4*)(bias + col + 4);
#pragma unroll
            for (int ai = 0; ai < 2; ++ai)
#pragma unroll
                for (int m = 0; m < 4; ++m) {
                    const f32x4 v0 = acc[ai][bj][m][0] + b0, v1 = acc[ai][bj][m][1] + b1;
                    u32x4 o; o.x = cvt_pk_bf16(v0[0], v0[1]); o.y = cvt_pk_bf16(v0[2], v0[3]); o.z = cvt_pk_bf16(v1[0], v1[1]); o.w = cvt_pk_bf16(v1[2], v1[3]);
                    *(u32x4*)(p.Y + (size_t)(brow + ai * 128 + wr * 64 + m * 16 + fr) * DM + col) = o;
                }
        }
    }
};
__device__ __forceinline__ void d_moe_gemm2(CParams& p, int wv, int l) {
    moe_offsets_lds(p, wv, l);
    const int* li = (const int*)(smem + LDS_GEMM);
    ProbG2 P{p, l, li, __builtin_amdgcn_readfirstlane(li[40]), 0, 0};
    gemm_phase<false>(P, wv);
}
__device__ __forceinline__ void d_moe_combine(CParams& p, int wv, int l, int last) {
    moe_offsets_lds(p, wv, l);
    const int tidx_ = opaque_tid(wv);
    int bidx_ = blockIdx.x, gdim_ = gridDim.x; asm volatile("" : "+s"(bidx_), "+s"(gdim_));
    const int* li = (const int*)(smem + LDS_GEMM);
    const int lane = tidx_ & 63, gw = bidx_ * 8 + (tidx_ >> 6), NGW = gdim_ * 8;
    for (int R = gw; R < NROW; R += NGW) {
        const int b = R / TPB, pos = R % TPB, mr = pos < CTXL ? 4 : b;
        if (last && pos < CTXL) continue;
        f32x4 acc[4];
#pragma unroll
        for (int i = 0; i < 4; ++i) acc[i] = (f32x4){0.f, 0.f, 0.f, 0.f};
#pragma unroll
        for (int k = 0; k < 4; ++k) {
            const float g = p.TOPG[R * 4 + k];
            const int sl = li[p.TOPI[R * 4 + k]] + p.TOKPOS[R * 4 + k];
            const bf16_t* yr = p.Y + (size_t)sl * DM + 8 * lane;
#pragma unroll
            for (int i = 0; i < 2; ++i) {
                const u32x4 w = *(const u32x4*)(yr + 512 * i);
                acc[2 * i] += g * (f32x4){__uint_as_float(w.x << 16), __uint_as_float(w.x & 0xffff0000u), __uint_as_float(w.y << 16), __uint_as_float(w.y & 0xffff0000u)};
                acc[2 * i + 1] += g * (f32x4){__uint_as_float(w.z << 16), __uint_as_float(w.z & 0xffff0000u), __uint_as_float(w.w << 16), __uint_as_float(w.w & 0xffff0000u)};
            }
        }
        const float* m5 = p.MOD + (l * 5 + mr) * 6144 + 5 * DM;
        f32x4 v[4]; float ss = 0.f;
#pragma unroll
        for (int q = 0; q < 4; ++q) {
            const int c = 512 * (q >> 1) + 8 * lane + 4 * (q & 1);
            v[q] = *(const f32x4*)(p.X2 + (size_t)R * DM + c) + *(const f32x4*)(m5 + c) * acc[q];
            ss += v[q][0] * v[q][0] + v[q][1] * v[q][1] + v[q][2] * v[q][2] + v[q][3] * v[q][3];
        }
        ss = wave_sum(ss);
        const float rinv = rsqrtf(ss * (1.f / DM) + 1e-6f);
        if (!last) {
            const float* gn = p.in[I_NMG] + (l + 1) * DM;
            const float* mod = p.MOD + ((l + 1) * 5 + mr) * 6144;
#pragma unroll
            for (int i = 0; i < 2; ++i) {
                const int c = 512 * i + 8 * lane;
                f32x4 o[2];
#pragma unroll
                for (int j = 0; j < 2; ++j) {
                    *(f32x4*)(p.X + (size_t)R * DM + c + 4 * j) = v[2 * i + j];
                    const f32x4 gg = *(const f32x4*)(gn + c + 4 * j), sh = *(const f32x4*)(mod + c + 4 * j), sc = *(const f32x4*)(mod + DM + c + 4 * j);
                    o[j] = v[2 * i + j] * rinv * gg * (sc + 1.f) + sh;
                }
                u32x4 ob; ob.x = cvt_pk_bf16(o[0][0], o[0][1]); ob.y = cvt_pk_bf16(o[0][2], o[0][3]); ob.z = cvt_pk_bf16(o[1][0], o[1][1]); ob.w = cvt_pk_bf16(o[1][2], o[1][3]);
                *(u32x4*)(p.H + (size_t)R * DM + c) = ob;
            }
        } else {
            float* orow = p.out + ((size_t)b * SEQ + (pos - CTXL)) * DM;
#pragma unroll
            for (int q = 0; q < 4; ++q) {
                const int c = 512 * (q >> 1) + 8 * lane + 4 * (q & 1);
                *(f32x4*)(orow + c) = v[q] * rinv * *(const f32x4*)(p.in[I_FING] + c);
            }
        }
    }
}

#define XB_TMO      128
#define XB_XCNT(j)  (256  + 64 * (j))
#define XB_XSUB(j)  (1280 + 64 * (j))
#define XB_XGEN(j)  (2304 + 64 * (j))
#define XB_TOP      3328
#define XB_TOPGEN   3392
#define XCD_BAR_WORDS 3456
#define XB_SPIN_CAP (1u << 18)
__device__ __forceinline__ unsigned xb_ld(unsigned* q)              { return __hip_atomic_load(q, __ATOMIC_RELAXED, __HIP_MEMORY_SCOPE_AGENT); }
__device__ __forceinline__ unsigned xb_add(unsigned* q, unsigned v) { return __hip_atomic_fetch_add(q, v, __ATOMIC_RELAXED, __HIP_MEMORY_SCOPE_AGENT); }
__device__ __forceinline__ unsigned xb_xcc_id() { return (unsigned)__builtin_amdgcn_s_getreg((3 << 11) | 20) & 0xFu; }
#define XB_SPIN(cond, bar) do { unsigned _sp = 0; while (cond) { __builtin_amdgcn_s_sleep(1); \
    if ((++_sp & 255u) == 0u) { if (xb_ld(&(bar)[XB_TMO])) break; if (_sp > XB_SPIN_CAP) { atomicAdd(&(bar)[XB_TMO], 1u); break; } } } } while (0)
__device__ __forceinline__ void xcd_barrier_complete(unsigned* bar, unsigned x, unsigned G, unsigned& nloc, unsigned& nx) {
    unsigned sum, cnt, mine, sp = 0u;
    for (;;) {
        sum = 0u; cnt = 0u; mine = 0u;
#pragma unroll
        for (unsigned j = 0; j < 16; ++j) { const unsigned c = xb_ld(&bar[XB_XCNT(j)]); sum += c; cnt += (c > 0u) ? 1u : 0u; mine = (j == x) ? c : mine; }
        if (sum == G) break;
        __builtin_amdgcn_s_sleep(1);
        if ((++sp & 255u) == 0u) { if (xb_ld(&bar[XB_TMO])) break; if (sp > XB_SPIN_CAP) { atomicAdd(&bar[XB_TMO], 1u); break; } }
    }
    nloc = mine > 0u ? mine : 1u; nx = cnt > 0u ? cnt : 1u;
}
__device__ __forceinline__ void xcd_barrier(unsigned* bar, volatile LAS unsigned* st, bool t0) {
    asm volatile("s_waitcnt vmcnt(0)" ::: "memory");
    __syncthreads();
    if (t0) {
        __builtin_amdgcn_s_waitcnt(0);
        const unsigned x = xb_xcc_id();
        unsigned nloc = st[0], nx = st[1];
        if (nloc == 0u) { xcd_barrier_complete(bar, x, gridDim.x, nloc, nx); st[0] = nloc; st[1] = nx; }
        const unsigned old = xb_add(&bar[XB_XSUB(x)], 1u);
        const unsigned gen = old / nloc;
        if (old + 1u == (gen + 1u) * nloc) {
            __builtin_amdgcn_fence(__ATOMIC_RELEASE, "agent");
            asm volatile("s_waitcnt vmcnt(0)" ::: "memory");
            const unsigned og = xb_add(&bar[XB_TOP], 1u);
            const unsigned tg = og / nx;
            if (og + 1u == (tg + 1u) * nx) xb_add(&bar[XB_TOPGEN], 1u);
            else XB_SPIN(xb_ld(&bar[XB_TOPGEN]) == tg, bar);
            __builtin_amdgcn_fence(__ATOMIC_ACQUIRE, "agent");
            xb_add(&bar[XB_XGEN(x)], 1u);
            asm volatile("s_waitcnt vmcnt(0)" ::: "memory");
        } else {
            XB_SPIN(xb_ld(&bar[XB_XGEN(x)]) == gen, bar);
            __builtin_amdgcn_fence(__ATOMIC_ACQUIRE, "agent");
            asm volatile("s_waitcnt vmcnt(0)" ::: "memory");
        }
    }
    __syncthreads();
}

#ifndef MULTI
#define MULTI 0
#endif
__device__ __forceinline__ void run_phase(CParams& p, int wv, int ph) {
    if (ph == 0) { d_prologue(p, wv); return; }
    if (ph == 1) { d_norm_mix(p, wv, 0); return; }
    const int l = (ph - 2) / 11, q = (ph - 2) % 11, last = l == 1;
    if (ph >= 24) return;
    const int bid = blockIdx.x, nblk = gridDim.x;
    switch (q) {
        case 0: d_gemm_in(p, wv, l);
                if (nblk == 256 && bid >= 48) {
                    if (l == 0) bg_moe_convert(p, wv, 0, (bid - 48) * BG_KIN, BG_KIN);
                    else { const int nt0 = moe_ntile(p, 0); const int f1 = bg_idle_first(nt0 * 8, 256), f2 = bg_idle_first(nt0 * 4, 256);
                           bg_moe_convert(p, wv, 1, (256 - f1) * BG_KMOE + (256 - f2) * BG_KMOE + (bid - 48) * BG_KIN, BG_KIN); } }
                break;
        case 1: d_lru_local(p, wv, l); d_rwkv_pre(p, wv, l); break;
        case 2: d_rwkv_chunkA(p, wv, l); break;
        case 3: d_scan_attn(p, wv, l, !last); break;
        case 4: d_finish(p, wv, l, last); break;
        case 5: d_gemm_out(p, wv, l, last);
                if (nblk == 256 && l == 0 && bid >= 16) bg_moe_convert(p, wv, 0, 208 * BG_KIN + (bid - 16) * BG_KOUT, BG_KOUT);
                break;
        case 6: d_norm_router(p, wv, l, last); break;
        case 7: d_moe_scatter(p, wv, l, last);
                {
                    int start;
                    if (nblk != 256) start = 0;
                    else if (l == 0) start = 208 * BG_KIN + 240 * BG_KOUT;
                    else { const int nt0 = moe_ntile(p, 0); start = (256 - bg_idle_first(nt0 * 8, 256)) * BG_KMOE + (256 - bg_idle_first(nt0 * 4, 256)) * BG_KMOE + 208 * BG_KIN; }
                    const int rem = MOE_ITEMS - start;
                    if (rem > 0) { const int per = (rem + nblk - 1) / nblk; const int f = start + bid * per; bg_moe_convert(p, wv, l, f, min(per, MOE_ITEMS - f)); }
                }
                break;
        case 8: d_moe_gemm1(p, wv, l);
                if (nblk == 256 && l == 0) { const int f1 = bg_idle_first(moe_ntile(p, 0) * 8, 256); if (bid >= f1) bg_moe_convert(p, wv, 1, (bid - f1) * BG_KMOE, BG_KMOE); }
                break;
        case 9: d_moe_gemm2(p, wv, l);
                if (nblk == 256 && l == 0) { const int nt0 = moe_ntile(p, 0); const int f1 = bg_idle_first(nt0 * 8, 256), f2 = bg_idle_first(nt0 * 4, 256);
                    if (bid >= f2) bg_moe_convert(p, wv, 1, (256 - f1) * BG_KMOE + (bid - f2) * BG_KMOE, BG_KMOE); }
                break;
        case 10: d_moe_combine(p, wv, l, last); break;
    }
}
#if MULTI
template <int PH> __global__ void __launch_bounds__(NTHR) mega_ph(Params p) { CParams* pp = (CParams*)__builtin_amdgcn_kernarg_segment_ptr(); run_phase(*pp, __builtin_amdgcn_readfirstlane(threadIdx.x >> 6), PH); }
__global__ void __launch_bounds__(NTHR) mega(Params p) {}
template <int PH> static void launch_all(const Params& p, int grid, hipStream_t stream) {
    static bool attr = false; if (!attr) { (void)hipFuncSetAttribute((const void*)mega_ph<PH>, hipFuncAttributeMaxDynamicSharedMemorySize, LDS_BYTES); attr = true; }
    mega_ph<PH><<<grid, NTHR, LDS_BYTES, stream>>>(p);
    if constexpr (PH + 1 < 24) launch_all<PH + 1>(p, grid, stream);
}
#else
__global__ void __launch_bounds__(NTHR) mega(Params p) {
    cg::grid_group grid = cg::this_grid();
    const int wv = __builtin_amdgcn_readfirstlane(threadIdx.x >> 6);
    volatile LAS unsigned* xst = (volatile LAS unsigned*)((LAS unsigned char*)smem + LDS_BYTES - 16);
    if (threadIdx.x == 0) { xst[0] = 0u; xst[1] = 0u; (void)xb_add(&p.BAR[XB_XCNT(xb_xcc_id())], 1u); }
    __syncthreads();
#define RUNPH(n) { CParams* pp = (CParams*)__builtin_amdgcn_kernarg_segment_ptr(); asm volatile("" : "+s"(pp)); run_phase(*pp, wv, n); \
    if (n == 0) grid.sync(); else if (n < 23) xcd_barrier(pp->BAR, xst, opaque_tid(wv) == 0); }
    RUNPH(0) RUNPH(1) RUNPH(2) RUNPH(3) RUNPH(4) RUNPH(5) RUNPH(6) RUNPH(7) RUNPH(8) RUNPH(9) RUNPH(10)
    RUNPH(11) RUNPH(12) RUNPH(13) RUNPH(14) RUNPH(15) RUNPH(16) RUNPH(17) RUNPH(18) RUNPH(19) RUNPH(20) RUNPH(21) RUNPH(22) RUNPH(23)
}
#endif

extern "C" void kernel_launch(void* const* d_in, const int* in_sizes, int n_in, void* d_out, int out_size, void* d_ws, size_t ws_size,
                              hipStream_t stream) {
    Params p{};
    for (int i = 0; i < N_IN; ++i) p.in[i] = (const float*)d_in[i];
    p.out = (float*)d_out;
    char* w = (char*)d_ws;
    size_t off = 0;
    auto take = [&](size_t bytes) { void* r = w + off; off += (bytes + 255) & ~(size_t)255; return r; };
    p.X = (float*)take((size_t)NROW * DM * 4);
    p.X2 = (float*)take((size_t)NROW * DM * 4);
    p.H = (bf16_t*)take((size_t)NROW * DM * 2);
    p.P = (float*)take((size_t)NROW * PST * 4);
    p.QH = (bf16_t*)take((size_t)NROW * 512 * 2);
    p.KH = (bf16_t*)take((size_t)NROW * 512 * 2);
    p.VT = (bf16_t*)take((size_t)NROW * 512 * 2);
    p.MIX = (bf16_t*)take((size_t)NROW * DM * 2);
    p.MOD = (float*)take(2 * 5 * 6144 * 4);
    p.LA = (float*)take((size_t)2 * NROW * 256 * 4);
    p.LB = (float*)take((size_t)2 * NROW * 256 * 4);
    p.LCE = (float*)take((size_t)2176 * 128 * 4);
    p.LCI = (float*)take((size_t)4 * 2 * 68 * 256 * 4);
    p.RS = (float*)take((size_t)NROW * 768 * 4);
    p.DEC = (float*)take((size_t)2 * NROW * 256 * 4);
    p.AIC = (float*)take((size_t)2 * NROW * 256 * 4);
    p.KKN = (float*)take((size_t)NROW * 256 * 4);
    p.GG = (float*)take((size_t)NROW * 256 * 4);
    p.YB = (float*)take((size_t)2 * NROW * 256 * 4);
    p.TOPG = (float*)take((size_t)NROW * 4 * 4);
    p.TOPI = (int*)take((size_t)NROW * 4 * 4);
    p.TOKPOS = (int*)take((size_t)NROW * 4 * 4);
    p.CNT = (int*)take(64 * 4);
    p.SLOT_TOK = (int*)take((size_t)CAP * 4);
    p.ACT = (bf16_t*)take((size_t)CAP * DM * 2);
    p.Y = (bf16_t*)take((size_t)CAP * DM * 2);
    p.BAR = (unsigned*)take((size_t)XCD_BAR_WORDS * 4);
    p.LWT = (bf16_t*)take((size_t)2 * 2 * 4 * 2 * 4096 * 2);
    p.RWT = (bf16_t*)take((size_t)2 * 5 * 16384 * 2);
    p.RMF = (bf16_t*)take((size_t)2176 * 4096 * 2);
    p.RQF = (bf16_t*)take((size_t)2176 * 4096 * 2);
    p.RNF = (float*)take((size_t)2176 * 4096 * 4);
    p.RYF = (float*)take((size_t)2176 * 4096 * 4);
    p.S0F = (bf16_t*)take((size_t)2176 * 4096 * 2);
    p.WTIN = (bf16_t*)take((size_t)2 * INCP * DM * 2);
    p.WTOUT = (bf16_t*)take((size_t)2 * DM * DM * 2);
    p.WTGU = (bf16_t*)take((size_t)2 * NEXP * 2048 * DM * 2);
    p.WTDN = (bf16_t*)take((size_t)2 * NEXP * DM * DM * 2);

    static int grid_blocks = 0;
    if (!grid_blocks) {
        int dev = 0, cus = 0, per_cu = 0;
        (void)hipGetDevice(&dev);
        (void)hipDeviceGetAttribute(&cus, hipDeviceAttributeMultiprocessorCount, dev);
        (void)hipFuncSetAttribute((const void*)mega, hipFuncAttributeMaxDynamicSharedMemorySize, LDS_BYTES);
        (void)hipOccupancyMaxActiveBlocksPerMultiprocessor(&per_cu, (const void*)mega, NTHR, LDS_BYTES);
        if (per_cu > 1) per_cu = 1;
        if (per_cu < 1) { fprintf(stderr, "occupancy query says %d blocks/CU\n", per_cu); per_cu = 1; }
        grid_blocks = cus * per_cu;
        (void)hipGetLastError();
    }
#if MULTI
    launch_all<0>(p, grid_blocks, stream);
#else
    (void)hipMemsetAsync(p.BAR, 0, (size_t)XCD_BAR_WORDS * 4, stream);
    void* args[] = {&p};
    hipError_t e = hipLaunchCooperativeKernel((void*)mega, dim3(grid_blocks), dim3(NTHR), args, LDS_BYTES, stream);
    if (e != hipSuccess) fprintf(stderr, "cooperative launch failed: %s (grid %d)\n", hipGetErrorString(e), grid_blocks);
#endif
}
```

```cpp
#include <hip/hip_runtime.h>
#include <hip/hip_cooperative_groups.h>
#include <stdint.h>
#include <cstdio>
namespace cg = cooperative_groups;

#define DM 1024
#define NBATCH 4
#define SEQ 4096
#define CTXL 256
#define TPB 4352
#define NROW 17408
#define INC 3008
#define INCP 3072
#define PST 1472
#define NEXP 32
#define MOE_TM 256
#define CAP (NROW * 4 + NEXP * MOE_TM)
#define MAXTILES (CAP / MOE_TM)
#define NTHR 512
#define LDS_GEMM 131072
#define LDS_BYTES 155648

typedef unsigned short bf16_t;
typedef short bf16x8 __attribute__((ext_vector_type(8)));
typedef float f32x4 __attribute__((ext_vector_type(4)));
typedef unsigned u32x4 __attribute__((ext_vector_type(4)));
typedef unsigned u32x2 __attribute__((ext_vector_type(2)));

enum { I_X = 0, I_C, I_CTX, I_CCTX, I_ADAW, I_ADAB, I_NMG, I_NFG, I_WIN, I_WOUT, I_CONVW, I_CONVB, I_WR, I_BR, I_WI, I_BI,
       I_LAM, I_MU, I_W0, I_W2, I_A0, I_A2, I_G2, I_KK, I_KA, I_RK, I_LNG, I_LNB, I_RPB, I_RTW, I_RTB, I_WGU, I_BGU, I_WDN,
       I_BDN, I_FING, N_IN };

struct Params {
    const float* in[N_IN];
    float* out;
    float* X;
    float* X2;
    bf16_t* H;
    float* P;
    bf16_t* QH;
    bf16_t* KH;
    bf16_t* VT;
    bf16_t* MIX;
    float* MOD;
    float* LA;
    float* LB;
    float* LCE;
    float* LCI;
    float* RS;
    float* DEC;
    float* AIC;
    float* KKN;
    float* GG;
    float* YB;
    float* TOPG;
    int* TOPI;
    int* TOKPOS;
    int* CNT;
    int* SLOT_TOK;
    bf16_t* ACT;
    bf16_t* Y;
    unsigned* BAR;
    bf16_t* LWT;
    bf16_t* RWT;
    bf16_t* RMF;
    bf16_t* RQF;
    float* RNF;
    float* RYF;
    bf16_t* S0F;
    bf16_t* WTIN;
    bf16_t* WTOUT;
    bf16_t* WTGU;
    bf16_t* WTDN;
};

typedef const __attribute__((address_space(4))) Params CParams;
extern __shared__ __attribute__((aligned(16))) unsigned char smem[];

__device__ __forceinline__ int opaque_tid(int wv) { int t; asm volatile("v_mbcnt_lo_u32_b32 %0, -1, 0\n\tv_mbcnt_hi_u32_b32 %0, -1, %0" : "=v"(t)); return wv * 64 + t; }
__device__ __forceinline__ float sigmoidf_(float x) { return __builtin_amdgcn_rcpf(1.f + __expf(-x)); }
__device__ __forceinline__ float softplusf_(float x) { return x > 20.f ? x : log1pf(__expf(x)); }
__device__ __forceinline__ float softplus_fast(float x) { return x > 15.f ? x : __logf(1.f + __expf(x)); }
__device__ __forceinline__ float tanh_fast(float x) { const float e = __expf(2.f * x); return 1.f - 2.f * __builtin_amdgcn_rcpf(1.f + e); }
#define SWZ_XOR(v, o) __int_as_float(__builtin_amdgcn_ds_swizzle(__float_as_int(v), ((o) << 10) | 0x1f))
__device__ __forceinline__ float rdlane(float v, int l) { return __int_as_float(__builtin_amdgcn_readlane(__float_as_int(v), l)); }
__device__ __forceinline__ float sum_xor32(float v) {
    int a = __float_as_int(v), b = a;
    asm volatile("s_nop 1\n\tv_permlane32_swap_b32 %0, %1\n\ts_nop 1" : "+v"(a), "+v"(b));
    return __int_as_float(a) + __int_as_float(b);
}
#define DPPF(v, ctrl) __int_as_float(__builtin_amdgcn_update_dpp(0, __float_as_int(v), ctrl, 0xf, 0xf, true))
__device__ __forceinline__ float row_sum16(float v) { v += DPPF(v, 0xB1); v += DPPF(v, 0x4E); v += DPPF(v, 0x141); v += DPPF(v, 0x140); return v; }
__device__ __forceinline__ float row_max16(float v) { v = fmaxf(v, DPPF(v, 0xB1)); v = fmaxf(v, DPPF(v, 0x4E)); v = fmaxf(v, DPPF(v, 0x141)); v = fmaxf(v, DPPF(v, 0x140)); return v; }
__device__ __forceinline__ float wave_sum(float v) {
    v = row_sum16(v);
    return (rdlane(v, 0) + rdlane(v, 16)) + (rdlane(v, 32) + rdlane(v, 48));
}
__device__ __forceinline__ float wave_max(float v) {
    v = row_max16(v);
    return fmaxf(fmaxf(rdlane(v, 0), rdlane(v, 16)), fmaxf(rdlane(v, 32), rdlane(v, 48)));
}
typedef __bf16 bf16x2_n __attribute__((ext_vector_type(2)));
__device__ __forceinline__ unsigned cvt_pk_bf16(float lo, float hi) { bf16x2_n v; v[0] = (__bf16)lo; v[1] = (__bf16)hi; return __builtin_bit_cast(unsigned, v); }
__device__ __forceinline__ bf16_t f2bf(float x) { return __builtin_bit_cast(bf16_t, (__bf16)x); }
__device__ __forceinline__ float gelu_tanh(float x) {
    const float u = 0.7978845608028654f * (x + 0.044715f * x * x * x);
    return 0.5f * x * (1.f + tanhf(u));
}

__device__ __forceinline__ const float* xin_row(CParams& p, int R) { const int b = R / TPB, pos = R % TPB; return pos < CTXL ? p.in[I_CTX] + (size_t)(b * CTXL + pos) * DM : p.in[I_X] + ((size_t)b * SEQ + (pos - CTXL)) * DM; }
__device__ __forceinline__ int inv_perm32(int cc) { return ((cc >> 2) & 1) * 16 + (cc >> 3) * 4 + (cc & 3); }
__device__ __forceinline__ void transpose_item(const float* W, int K, int N, bf16_t* WT, int k0, int n0, int dst_row0, float* scr, int lane, bool perm = false) {
    const int rs = lane >> 3, c4 = (lane & 7) * 4;
    float4 v[8];
#pragma unroll
    for (int i = 0; i < 8; ++i) v[i] = *(const float4*)(W + (size_t)(k0 + 8 * i + rs) * N + n0 + c4);
#pragma unroll
    for (int i = 0; i < 8; ++i) { float* d = scr + (8 * i + rs) * 33 + c4; d[0] = v[i].x; d[1] = v[i].y; d[2] = v[i].z; d[3] = v[i].w; }
    __builtin_amdgcn_wave_barrier();
    const int c = lane & 7;
#pragma unroll
    for (int j = 0; j < 4; ++j) {
        const int n = (lane >> 3) + 8 * j; const float* s = scr + (8 * c) * 33 + n;
        u32x4 o; o.x = cvt_pk_bf16(s[0 * 33], s[1 * 33]); o.y = cvt_pk_bf16(s[2 * 33], s[3 * 33]); o.z = cvt_pk_bf16(s[4 * 33], s[5 * 33]); o.w = cvt_pk_bf16(s[6 * 33], s[7 * 33]);
        *(u32x4*)(WT + (size_t)(dst_row0 + (perm ? inv_perm32(n) : n)) * K + k0 + 8 * c) = o;
    }
    __builtin_amdgcn_wave_barrier();
}

__device__ __forceinline__ void d_prologue(CParams& p, int wv) {
    const int tidx_ = opaque_tid(wv);
    int bidx_ = blockIdx.x, gdim_ = gridDim.x; asm volatile("" : "+s"(bidx_), "+s"(gdim_));
    const int tid = tidx_, lane = tid & 63, wave = tid >> 6;
    const int gtid = bidx_ * NTHR + tid, gsz = gdim_ * NTHR;
    const int gw = bidx_ * 8 + wave, NGW = gdim_ * 8;
    if (gtid < 64) p.CNT[gtid] = 0;
    for (int i = gtid; i < 2 * 2 * 4 * 2 * 4096; i += gsz) {
        const int ii = i & 63, j = (i >> 6) & 63, gt = (i >> 12) & 1, ldh = i >> 13;
        p.LWT[i] = f2bf((gt ? p.in[I_WI] : p.in[I_WR])[(size_t)ldh * 4096 + ii * 64 + j]);
    }
    for (int i = gtid; i < 2 * 5 * 16384; i += gsz) {
        const int k = i & 63, n = (i >> 6) & 255, mtx = (i >> 14) % 5, l = i / (5 * 16384);
        const float v = mtx < 2 ? p.in[I_W2][((size_t)(l * 2 + mtx) * 64 + k) * 256 + n] : (mtx < 4 ? p.in[I_A2][((size_t)(l * 2 + mtx - 2) * 64 + k) * 256 + n] : p.in[I_G2][((size_t)l * 64 + k) * 256 + n]);
        p.RWT[i] = f2bf(v);
    }
    for (int i = gtid; i < 2 * 64 * 1024 / 8; i += gsz) {
        const int l = i / (64 * 128), r = i % (64 * 128);
        *(u32x4*)(p.WTIN + ((size_t)l * INCP + INC) * DM + (size_t)r * 8) = (u32x4){0u, 0u, 0u, 0u};
    }
    {
        float* sc = (float*)smem;
        float* part = (float*)(smem + 5 * 1024 * 4);
        for (int i = tid; i < 5 * DM; i += NTHR) { const int r = i / DM, d = i % DM; const float v = r < 4 ? p.in[I_C][r * DM + d] : p.in[I_CCTX][d]; sc[i] = v * sigmoidf_(v); }
        __syncthreads();
        for (int cb = bidx_; cb < 256; cb += gdim_) {
            const int col = tid % 48, ks = tid / 48;
            const int gc = cb * 48 + col, l = gc / 6144, n = gc % 6144;
            if (ks < 8) {
                const float* W = p.in[I_ADAW] + (size_t)l * DM * 6144 + n;
                float a0 = 0.f, a1 = 0.f, a2 = 0.f, a3 = 0.f, a4 = 0.f;
#pragma unroll 8
                for (int k = ks * 128; k < ks * 128 + 128; ++k) {
                    const float w = W[(size_t)k * 6144];
                    a0 += sc[k] * w; a1 += sc[DM + k] * w; a2 += sc[2 * DM + k] * w; a3 += sc[3 * DM + k] * w; a4 += sc[4 * DM + k] * w;
                }
                float* pp = part + (ks * 5) * 48 + col;
                pp[0] = a0; pp[48] = a1; pp[96] = a2; pp[144] = a3; pp[192] = a4;
            }
            __syncthreads();
            if (tid < 240) {
                const int r = tid / 48, c2 = tid % 48, gc2 = cb * 48 + c2, l2 = gc2 / 6144, n2 = gc2 % 6144;
                float s = p.in[I_ADAB][l2 * 6144 + n2];
#pragma unroll
                for (int k = 0; k < 8; ++k) s += part[(k * 5 + r) * 48 + c2];
                p.MOD[(l2 * 5 + r) * 6144 + n2] = s;
            }
            __syncthreads();
        }
    }
    {
        float* scr = (float*)(smem + 32768) + wave * (64 * 33);
        const int N_IN_ = 2 * 16 * 94, N_OUT_ = 2 * 16 * 32, N_GU_ = 64 * 16 * 64, N_DN_ = 64 * 16 * 32;
        for (int it = gw; it < N_IN_ + N_OUT_; it += NGW) {
            int r = it;
            if (r < N_IN_) { const int l = r / (16 * 94), q = r % (16 * 94), kb = q / 94, nb = q % 94;
                transpose_item(p.in[I_WIN] + (size_t)l * DM * INC, DM, INC, p.WTIN + (size_t)l * INCP * DM, kb * 64, nb * 32, nb * 32, scr, lane); continue; }
            r -= N_IN_;
            if (r < N_OUT_) { const int l = r / 512, q = r % 512, kb = q / 32, nb = q % 32;
                transpose_item(p.in[I_WOUT] + (size_t)l * DM * DM, DM, DM, p.WTOUT + (size_t)l * DM * DM, kb * 64, nb * 32, nb * 32, scr, lane); continue; }
            (void)N_GU_; (void)N_DN_;
        }
    }
}

#define MOE_ITEMS 49152
__device__ __forceinline__ void bg_moe_convert(CParams& p, int wv, int l, int first, int count) {
    const int tidx_ = opaque_tid(wv);
    const int lane = tidx_ & 63;
    if (first >= MOE_ITEMS || count <= 0) return;
    const int last = min(first + count, MOE_ITEMS);
    float* scr = (float*)(smem + 32768) + wv * (64 * 33);
    for (int it = first + wv; it < last; it += 8) {
        if (it < 32768) { const int le = l * 32 + it / 1024, q = it % 1024, kb = q / 64, nb = q % 64;
            const int c0 = nb * 32; const int dst = c0 < 1024 ? (c0 / 128) * 256 + (c0 % 128) : ((c0 - 1024) / 128) * 256 + 128 + ((c0 - 1024) % 128);
            transpose_item(p.in[I_WGU] + (size_t)le * DM * 2048, DM, 2048, p.WTGU + (size_t)le * 2048 * DM, kb * 64, c0, dst, scr, lane, true); }
        else { const int r = it - 32768; const int le = l * 32 + r / 512, q = r % 512, kb = q / 32, nb = q % 32;
            transpose_item(p.in[I_WDN] + (size_t)le * DM * DM, DM, DM, p.WTDN + (size_t)le * DM * DM, kb * 64, nb * 32, nb * 32, scr, lane, true); }
    }
}
#define BG_KIN 96
#define BG_KOUT 96
#define BG_KMOE 80
__device__ __forceinline__ int moe_ntile(CParams& p, int l) { int nt = 0; for (int e = 0; e < NEXP; ++e) nt += (p.CNT[l * 32 + e] + MOE_TM - 1) / MOE_TM; return nt; }
__device__ __forceinline__ int bg_idle_first(int units, int nblk) { const int u = units % nblk; return u ? u : nblk; }
__device__ __forceinline__ void norm_row_to_bf16(CParams& p, const float4 (&v)[4], float ss, int l, int which, int mr, bf16_t* hrow, int lane) {
    const float* g = (which == 0 ? p.in[I_NMG] : p.in[I_NFG]) + l * DM;
    const float* mod = p.MOD + (l * 5 + mr) * 6144 + (which == 0 ? 0 : 3 * DM);
    const float rinv = rsqrtf(ss * (1.f / DM) + 1e-6f);
#pragma unroll
    for (int i = 0; i < 4; ++i) {
        const int c = (lane + 64 * i) * 4;
        const float4 gg = *(const float4*)(g + c), sh = *(const float4*)(mod + c), sc = *(const float4*)(mod + DM + c);
        const float o0 = v[i].x * rinv * gg.x * (1.f + sc.x) + sh.x, o1 = v[i].y * rinv * gg.y * (1.f + sc.y) + sh.y;
        const float o2 = v[i].z * rinv * gg.z * (1.f + sc.z) + sh.z, o3 = v[i].w * rinv * gg.w * (1.f + sc.w) + sh.w;
        uint2 o; o.x = cvt_pk_bf16(o0, o1); o.y = cvt_pk_bf16(o2, o3);
        *(uint2*)(hrow + c) = o;
    }
}
__device__ __forceinline__ void d_norm_mix(CParams& p, int wv, int l) {
    const int tidx_ = opaque_tid(wv);
    int bidx_ = blockIdx.x, gdim_ = gridDim.x; asm volatile("" : "+s"(bidx_), "+s"(gdim_));
    const int lane = tidx_ & 63, gw = bidx_ * 8 + (tidx_ >> 6), NGW = gdim_ * 8;
    for (int R = gw; R < NROW; R += NGW) {
        const int b = R / TPB, pos = R % TPB, mr = pos < CTXL ? 4 : b;
        const float4* xr = (const float4*)xin_row(p, R);
        float4 v[4]; float ss = 0.f;
#pragma unroll
        for (int i = 0; i < 4; ++i) { v[i] = xr[lane + 64 * i]; ss += v[i].x * v[i].x + v[i].y * v[i].y + v[i].z * v[i].z + v[i].w * v[i].w; }
        ss = wave_sum(ss);
        norm_row_to_bf16(p, v, ss, l, 0, mr, p.H + (size_t)R * DM, lane);
    }
}

#define LAS __attribute__((address_space(3)))
#define RWS 144
#define HTB 16384
#define KB_ 2048
__device__ __forceinline__ int lds_byte(int r, int c) {
    const int st = (r >> 4) * 2 + (c >> 5), rr = r & 15, cc = c & 31, ob = rr * 64 + cc * 2;
    return st * 1024 + (ob ^ (((ob >> 9) & 1) << 5));
}
__device__ __forceinline__ void stage_rc(int b, int& R, int& C) {
    const int st = b / 1024, sb = b % 1024, swz = sb ^ (((sb >> 9) & 1) << 5);
    R = (st >> 1) * 16 + swz / 64; C = (st & 1) * 32 + (swz % 64) / 2;
}
struct Unit { int pm, pn; };
__device__ __forceinline__ bool tile_order(int i, int nM, int nN, Unit& u, int bid, int nblk) {
    const int nwg = nM * nN; const long L = (long)i * nblk + bid; if (L >= nwg) return false;
    int wgid = (int)L; { const int q = nwg / 8, r = nwg % 8, xcd = wgid % 8, off = wgid / 8; wgid = (xcd < r ? xcd * (q + 1) : r * (q + 1) + (xcd - r) * q) + off; }
    const int nig = 8 * nN, gid = wgid / nig, fm = gid * 8, gsz = (nM - fm) < 8 ? (nM - fm) : 8;
    u.pm = fm + ((wgid % nig) % gsz); u.pn = (wgid % nig) / gsz; return true;
}

#define PG_SA(b, h) (((b) * 2 + (h)) * HTB)
#define PG_SB(b, h) ((4 + (b) * 2 + (h)) * HTB)
#define PG_STAGE(bufoff, gbase, v0, v1) do { \
    __builtin_amdgcn_global_load_lds((const unsigned*)((const char*)(gbase) + (v0)), (LAS unsigned*)(lds + (bufoff) + ldsw), 16, 0, 0); \
    __builtin_amdgcn_global_load_lds((const unsigned*)((const char*)(gbase) + (v1)), (LAS unsigned*)(lds + (bufoff) + ldsw + 8192), 16, 0, 0); } while (0)
#define PG_STAGE_B(bufoff, gbase) PG_STAGE(bufoff, gbase, voffB[0], voffB[1])
#define PG_STAGE_A(bufoff, gb, h, usenext) do { if (GATHER) PG_STAGE(bufoff, gb, gc[h][0], gc[h][1]); \
    else PG_STAGE(bufoff, (gb) + (h) * hstep, voffA[0], voffA[1]); } while (0)
#define PG_LDA(dst, b, h) do { _Pragma("unroll") for (int m = 0; m < 4; ++m) _Pragma("unroll") for (int k = 0; k < 2; ++k) dst[m][k] = *(const LAS bf16x8*)(lds + PG_SA(b, h) + aoff + m * 2048 + k * 1024); } while (0)
#define PG_LDB(dst, b, h) do { _Pragma("unroll") for (int n = 0; n < 2; ++n) _Pragma("unroll") for (int k = 0; k < 2; ++k) dst[n][k] = *(const LAS bf16x8*)(lds + PG_SB(b, h) + boff + n * 2048 + k * 1024); } while (0)
#define PG_MMA(ai, bj, At_, Bt_) do { __builtin_amdgcn_s_setprio(1); _Pragma("unroll") for (int m = 0; m < 4; ++m) _Pragma("unroll") for (int n = 0; n < 2; ++n) _Pragma("unroll") for (int k = 0; k < 2; ++k) \
    acc[ai][bj][m][n] = __builtin_amdgcn_mfma_f32_16x16x32_bf16(Bt_[n][k], At_[m][k], acc[ai][bj][m][n], 0, 0, 0); __builtin_amdgcn_s_setprio(0); } while (0)
#define PG_WAIT_V(n) asm volatile("s_waitcnt vmcnt(" #n ")" ::: "memory")
#define PG_WAIT_L(n) asm volatile("s_waitcnt lgkmcnt(" #n ")" ::: "memory")
#define PG_BAR __builtin_amdgcn_s_barrier()
#define PG_SCHED __builtin_amdgcn_sched_barrier(0)

template <bool GATHER, class Prob>
__device__ __forceinline__ void gemm_phase(Prob P, int wv) {
    const int tidx_ = opaque_tid(wv);
    int bidx_ = blockIdx.x, gdim_ = gridDim.x; asm volatile("" : "+s"(bidx_), "+s"(gdim_));
    LAS unsigned char* lds = (LAS unsigned char*)smem;
    P.bid = bidx_; P.nblk = gdim_;
    const int tid = tidx_, wid = __builtin_amdgcn_readfirstlane(tid >> 6), lane = tid & 63, wr = wid >> 2, wc = wid & 3, fr = lane & 15, fq = lane >> 4;
    constexpr int nt = 16;
    unsigned voffA[2], voffB[2]; int Rr[2], Cc[2];
#pragma unroll
    for (int i = 0; i < 2; ++i) { stage_rc(tid * 16 + i * 8192, Rr[i], Cc[i]); voffA[i] = (unsigned)(Rr[i] * 1024 + Cc[i]) * 2u; voffB[i] = voffA[i]; }
    const size_t kstep = 128, hstep = (size_t)128 * KB_;
    const unsigned ldsw = (unsigned)wid * 1024u;
    const int aoff = lds_byte(wr * 64 + fr, fq * 8), boff = lds_byte(wc * 32 + fr, fq * 8);
    Unit cur, nxt; int ui = 0;
    if (!P.next(0, cur)) return;
    f32x4 acc[2][2][4][2];
#pragma unroll
    for (int a = 0; a < 2; ++a)
#pragma unroll
        for (int b = 0; b < 2; ++b)
#pragma unroll
            for (int m = 0; m < 4; ++m)
#pragma unroll
                for (int n = 0; n < 2; ++n) acc[a][b][m][n] = (f32x4){0.f, 0.f, 0.f, 0.f};
    bf16x8 At[4][2], B0[2][2], B1[2][2];
    unsigned gc[2][2] = {{0u, 0u}, {0u, 0u}};
    if (GATHER) {
#pragma unroll
        for (int h = 0; h < 2; ++h)
#pragma unroll
            for (int i = 0; i < 2; ++i) gc[h][i] = (unsigned)P.gather_row(cur, h * 128 + Rr[i]) * (unsigned)KB_ + (unsigned)Cc[i] * 2u;
    }
    const char* cA = P.a_ptr(cur); const char* cB = P.b_ptr(cur);
    PG_STAGE_B(PG_SB(0, 0), cB); PG_STAGE_A(PG_SA(0, 0), cA, 0, false); PG_STAGE_B(PG_SB(0, 1), cB + hstep); PG_STAGE_A(PG_SA(0, 1), cA, 1, false);
    if (wr == 1) PG_BAR;
    PG_WAIT_V(4); PG_BAR;
    PG_STAGE_B(PG_SB(1, 0), cB + kstep); PG_STAGE_A(PG_SA(1, 0), cA + kstep, 0, false); PG_STAGE_B(PG_SB(1, 1), cB + hstep + kstep);
    PG_WAIT_V(6); PG_BAR;
    for (;;) {
        const bool has_next = P.next(ui + 1, nxt);
        const char* nA = has_next ? P.a_ptr(nxt) : cA; const char* nB = has_next ? P.b_ptr(nxt) : cB;
        for (int t = 0; t < nt; t += 2) {
            const bool last = (t == nt - 2);
            if (GATHER && last && has_next) {
#pragma unroll
                for (int i = 0; i < 2; ++i) gc[0][i] = (unsigned)P.gather_row(nxt, Rr[i]) * (unsigned)KB_ + (unsigned)Cc[i] * 2u;
            }
            const char* a1 = cA + (size_t)(t + 1) * kstep;
            const char* a2 = last ? nA : cA + (size_t)(t + 2) * kstep; const char* b2 = last ? nB : cB + (size_t)(t + 2) * kstep;
            const char* a3 = a2 + kstep; const char* b3 = b2 + kstep;
            PG_LDB(B0, 0, 0); PG_SCHED; PG_LDA(At, 0, 0); PG_STAGE_A(PG_SA(1, 1), a1, 1, false);
            PG_WAIT_L(8); PG_BAR; PG_WAIT_L(0); PG_MMA(0, 0, At, B0); PG_BAR; PG_SCHED;
            if (GATHER && last && has_next) {
#pragma unroll
                for (int i = 0; i < 2; ++i) gc[1][i] = (unsigned)P.gather_row(nxt, 128 + Rr[i]) * (unsigned)KB_ + (unsigned)Cc[i] * 2u;
            }
            PG_LDB(B1, 0, 1); PG_STAGE_B(PG_SB(0, 0), b2);
            PG_BAR; PG_WAIT_L(0); PG_MMA(0, 1, At, B1); PG_BAR;
            PG_LDA(At, 0, 1); PG_STAGE_A(PG_SA(0, 0), a2, 0, last);
            PG_BAR; PG_WAIT_L(0); PG_MMA(1, 0, At, B0); PG_BAR; PG_SCHED;
            PG_STAGE_B(PG_SB(0, 1), b2 + hstep);
            PG_WAIT_V(6); PG_BAR; PG_MMA(1, 1, At, B1); PG_BAR;
            PG_LDB(B0, 1, 0); PG_SCHED; PG_LDA(At, 1, 0); PG_STAGE_A(PG_SA(0, 1), a2, 1, last);
            PG_WAIT_L(8); PG_BAR; PG_WAIT_L(0); PG_MMA(0, 0, At, B0); PG_BAR; PG_SCHED;
            PG_LDB(B1, 1, 1); PG_STAGE_B(PG_SB(1, 0), b3);
            PG_BAR; PG_WAIT_L(0); PG_MMA(0, 1, At, B1); PG_BAR;
            PG_LDA(At, 1, 1); PG_STAGE_A(PG_SA(1, 0), a3, 0, last);
            PG_BAR; PG_WAIT_L(0); PG_MMA(1, 0, At, B0); PG_BAR; PG_SCHED;
            PG_STAGE_B(PG_SB(1, 1), b3 + hstep);
            PG_WAIT_V(6); PG_BAR; PG_MMA(1, 1, At, B1); PG_BAR;
        }
        P.epi(acc, cur, wr, wc, fr, fq);
        if (!has_next) break;
#pragma unroll
        for (int a = 0; a < 2; ++a)
#pragma unroll
            for (int b = 0; b < 2; ++b)
#pragma unroll
                for (int m = 0; m < 4; ++m)
#pragma unroll
                    for (int n = 0; n < 2; ++n) acc[a][b][m][n] = (f32x4){0.f, 0.f, 0.f, 0.f};
        cur = nxt; cA = nA; cB = nB; ++ui;
    }
    PG_WAIT_V(0);
    if (wr == 0) PG_BAR;
    PG_BAR;
}

struct ProbIn {
    CParams& p; int l; int bid, nblk;
    __device__ __forceinline__ bool next(int i, Unit& u) const { return tile_order(i, NROW / 256, INCP / 256, u, bid, nblk); }
    __device__ __forceinline__ const char* a_ptr(const Unit& u) const { return (const char*)p.H + (size_t)u.pm * 256 * KB_; }
    __device__ __forceinline__ const char* b_ptr(const Unit& u) const { return (const char*)p.WTIN + ((size_t)l * INCP + (size_t)u.pn * 256) * KB_; }
    __device__ __forceinline__ int gather_row(const Unit&, int) const { return 0; }
    __device__ __forceinline__ void epi(const f32x4 (&acc)[2][2][4][2], const Unit& u, int wr, int wc, int fr, int fq) const {
        const int brow = u.pm * 256, bcol = u.pn * 256;
        const int bb = u.pm / 17, pos0 = (u.pm % 17) * 256;
#pragma unroll
        for (int bj = 0; bj < 2; ++bj)
#pragma unroll
            for (int n = 0; n < 2; ++n) {
                const int gcol = bcol + bj * 128 + wc * 32 + n * 16;
                const int col = gcol + fq * 4;
                if (gcol < 1472) {
#pragma unroll
                    for (int ai = 0; ai < 2; ++ai)
#pragma unroll
                        for (int m = 0; m < 4; ++m) *(f32x4*)(p.P + (size_t)(brow + ai * 128 + wr * 64 + m * 16 + fr) * PST + col) = acc[ai][bj][m][n];
                } else if (gcol < 2496) {
                    const bool isq = gcol < 1984; const int cq = col - (isq ? 1472 : 1984), hh = cq >> 6, dim = cq & 63;
                    bf16_t* base = (isq ? p.QH : p.KH) + ((size_t)(bb * 8 + hh) * TPB) * 64 + dim;
                    const float sc = isq ? 0.125f : 1.f;
#pragma unroll
                    for (int ai = 0; ai < 2; ++ai)
#pragma unroll
                        for (int m = 0; m < 4; ++m) {
                            const int pos = pos0 + ai * 128 + wr * 64 + m * 16 + fr; const f32x4 v = acc[ai][bj][m][n] * sc;
                            u32x2 o; o.x = cvt_pk_bf16(v[0], v[1]); o.y = cvt_pk_bf16(v[2], v[3]);
                            *(u32x2*)(base + (size_t)pos * 64) = o;
                        }
                } else if (gcol < INC) {
                    const int cq = col - 2496, hh = cq >> 6, dim = cq & 63;
                    bf16_t* base = p.VT + ((size_t)(bb * 8 + hh) * 64 + dim) * TPB;
#pragma unroll
                    for (int ai = 0; ai < 2; ++ai)
#pragma unroll
                        for (int m = 0; m < 4; ++m) {
                            const int pos = pos0 + ai * 128 + wr * 64 + m * 16 + fr;
#pragma unroll
                            for (int j = 0; j < 4; ++j) base[(size_t)j * TPB + pos] = f2bf(acc[ai][bj][m][n][j]);
                        }
                }
            }
    }
};
__device__ __forceinline__ void d_gemm_in(CParams& p, int wv, int l) { ProbIn P{p, l, 0, 0}; gemm_phase<false>(P, wv); }

struct ProbOut {
    CParams& p; int l; int skip_ctx; int bid, nblk;
    __device__ __forceinline__ bool next(int i, Unit& u) const {
        if (!tile_order(i, skip_ctx ? 64 : 68, 4, u, bid, nblk)) return false;
        if (skip_ctx) u.pm = (u.pm / 16) * 17 + 1 + (u.pm % 16);
        return true; }
    __device__ __forceinline__ const char* a_ptr(const Unit& u) const { return (const char*)p.MIX + (size_t)u.pm * 256 * KB_; }
    __device__ __forceinline__ const char* b_ptr(const Unit& u) const { return (const char*)p.WTOUT + ((size_t)l * DM + (size_t)u.pn * 256) * KB_; }
    __device__ __forceinline__ int gather_row(const Unit&, int) const { return 0; }
    __device__ __forceinline__ void epi(const f32x4 (&acc)[2][2][4][2], const Unit& u, int wr, int wc, int fr, int fq) const {
        const int brow = u.pm * 256, bcol = u.pn * 256;
        const int b = u.pm / 17, mr = (u.pm % 17) == 0 ? 4 : b;
        const float* gate = p.MOD + (l * 5 + mr) * 6144 + 2 * DM;
#pragma unroll
        for (int ai = 0; ai < 2; ++ai)
#pragma unroll
            for (int m = 0; m < 4; ++m) {
                const int row = brow + ai * 128 + wr * 64 + m * 16 + fr; const size_t roff = (size_t)row * DM;
                const float* xres = l == 0 ? xin_row(p, row) : p.X + roff;
#pragma unroll
                for (int bj = 0; bj < 2; ++bj)
#pragma unroll
                    for (int n = 0; n < 2; ++n) {
                        const int col = bcol + bj * 128 + wc * 32 + n * 16 + fq * 4;
                        const f32x4 gt = *(const f32x4*)(gate + col);
                        *(f32x4*)(p.X2 + roff + col) = *(const f32x4*)(xres + col) + gt * acc[ai][bj][m][n];
                    }
                asm volatile("" ::: "memory");
            }
    }
};
__device__ __forceinline__ void d_gemm_out(CParams& p, int wv, int l, int skip_ctx) { ProbOut P{p, l, skip_ctx, 0, 0}; gemm_phase<false>(P, wv); }

__device__ __forceinline__ int rwkv_pos(int d, int c, int t) { return d == 0 ? c * 64 + t : (c < 4 ? 255 - (c * 64 + t) : 4351 - ((c - 4) * 64 + t)); }
#define DPP_SHR(oldv, v, n) __int_as_float(__builtin_amdgcn_update_dpp(__float_as_int(oldv), __float_as_int(v), 0x110 + (n), 0xf, 0xf, false))
#define BCAST15(v) __int_as_float(__builtin_amdgcn_ds_swizzle(__float_as_int(v), (0x0f << 5) | 0x10))
__device__ __forceinline__ void d_lru_local(CParams& p, int wv, int l) {
    const int tidx_ = opaque_tid(wv);
    int bidx_ = blockIdx.x, gdim_ = gridDim.x; asm volatile("" : "+s"(bidx_), "+s"(gdim_));
    const int lane = tidx_ & 63, gw = bidx_ * 8 + wv, NGW = gdim_ * 8, m16 = lane & 15, g = lane >> 4;
    LAS unsigned char* xcs = (LAS unsigned char*)smem + 8192 + wv * (64 * RWS);
    const bool bal = NGW == 2048;
    for (int rnd = 0; ; ++rnd) {
        int task;
        if (bal) { if (rnd == 0) task = gw; else if (rnd == 1 && gw >= 256 && gw < 384) task = 2048 + (gw - 256); else break; }
        else { task = gw + rnd * NGW; if (task >= 2176) break; }
        const int c = task % 68, h = (task / 68) & 3, d = (task / 272) & 1, b = task / 544;
        const size_t rb = (size_t)b * TPB;
        {
            const int ch = h * 64 + lane;
            const float* cw = p.in[I_CONVW] + ((l * 2 + d) * 4) * 256 + ch;
            const float cw0 = cw[0], cw1 = cw[256], cw2 = cw[512], cw3 = cw[768], cb = p.in[I_CONVB][(l * 2 + d) * 256 + ch];
            float x1 = 0.f, x2 = 0.f, x3 = 0.f;
            if (c != 0 && c != 4) { x1 = p.P[(rb + rwkv_pos(d, c - 1, 63)) * PST + ch]; x2 = p.P[(rb + rwkv_pos(d, c - 1, 62)) * PST + ch]; x3 = p.P[(rb + rwkv_pos(d, c - 1, 61)) * PST + ch]; }
            __builtin_amdgcn_wave_barrier();
            float xin[64];
            { const int pstep = d == 0 ? PST : -PST; const float* px = p.P + (rb + rwkv_pos(d, c, 0)) * PST + ch;
#pragma unroll
              for (int t = 0; t < 64; ++t) xin[t] = px[(long)t * pstep]; }
#pragma unroll
            for (int t = 0; t < 64; ++t) {
                const float x0 = xin[t];
                const float xc = cb + cw0 * x0 + cw1 * x1 + cw2 * x2 + cw3 * x3;
                x3 = x2; x2 = x1; x1 = x0;
                *(LAS bf16_t*)(xcs + t * RWS + lane * 2) = f2bf(xc);
            }
            __builtin_amdgcn_wave_barrier();
        }
        bf16x8 xb[4][2];
#pragma unroll
        for (int tt = 0; tt < 4; ++tt)
#pragma unroll
            for (int ks = 0; ks < 2; ++ks) xb[tt][ks] = *(const LAS bf16x8*)(xcs + (tt * 16 + m16) * RWS + ks * 64 + g * 16);
        const bf16_t* wt = p.LWT + (size_t)((l * 2 + d) * 4 + h) * 2 * 4096;
        bf16x8 wall[4][2][2];
#pragma unroll
        for (int jt = 0; jt < 4; ++jt)
#pragma unroll
            for (int gt = 0; gt < 2; ++gt)
#pragma unroll
                for (int ks = 0; ks < 2; ++ks) wall[jt][gt][ks] = *(const bf16x8*)(wt + (size_t)gt * 4096 + (jt * 16 + m16) * 64 + ks * 32 + 8 * g);
#pragma unroll
        for (int jt = 0; jt < 4; ++jt) {
            const int j0 = jt * 16 + 4 * g, chj = h * 64 + j0;
            const bf16x8 (&wa)[2][2] = wall[jt];
            const f32x4 brv = *(const f32x4*)(p.in[I_BR] + (l * 2 + d) * 256 + chj), biv = *(const f32x4*)(p.in[I_BI] + (l * 2 + d) * 256 + chj);
            const f32x4 lamv = *(const f32x4*)(p.in[I_LAM] + (l * 2 + d) * 256 + chj);
            float spl8[4];
#pragma unroll
            for (int r = 0; r < 4; ++r) spl8[r] = -8.0f * softplusf_(-lamv[r]);
            float ca[4] = {1.f, 1.f, 1.f, 1.f}, chh[4] = {0.f, 0.f, 0.f, 0.f};
#pragma unroll
            for (int tt = 0; tt < 4; ++tt) {
                f32x4 dr = {0.f, 0.f, 0.f, 0.f}, di = {0.f, 0.f, 0.f, 0.f};
#pragma unroll
                for (int ks = 0; ks < 2; ++ks) { dr = __builtin_amdgcn_mfma_f32_16x16x32_bf16(wa[0][ks], xb[tt][ks], dr, 0, 0, 0); di = __builtin_amdgcn_mfma_f32_16x16x32_bf16(wa[1][ks], xb[tt][ks], di, 0, 0, 0); }
                const int t = tt * 16 + m16;
                const u32x2 xw = *(const LAS u32x2*)(xcs + t * RWS + j0 * 2);
                const float xcv[4] = {__uint_as_float(xw.x << 16), __uint_as_float(xw.x & 0xffff0000u), __uint_as_float(xw.y << 16), __uint_as_float(xw.y & 0xffff0000u)};
                f32x4 av, bv;
#pragma unroll
                for (int r = 0; r < 4; ++r) {
                    const float gr = sigmoidf_(dr[r] + brv[r]), gi = sigmoidf_(di[r] + biv[r]);
                    const float log_a = gr * spl8[r];
                    float a = __expf(log_a), bb = __builtin_amdgcn_sqrtf(fmaxf(1.f - a * a, 0.f)) * (gi * xcv[r]);
#define SCAN_STEP(sh) { const float ap = DPP_SHR(1.f, a, sh), bp = DPP_SHR(0.f, bb, sh); bb = a * bp + bb; a = a * ap; }
                    SCAN_STEP(1) SCAN_STEP(2) SCAN_STEP(4) SCAN_STEP(8)
#undef SCAN_STEP
                    bb = a * chh[r] + bb; a = a * ca[r];
                    av[r] = a; bv[r] = bb;
                    ca[r] = BCAST15(a); chh[r] = BCAST15(bb);
                }
                const size_t R = rb + rwkv_pos(d, c, t);
                *(f32x4*)(p.LA + ((size_t)d * NROW + R) * 256 + chj) = bv;
                *(f32x4*)(p.LB + ((size_t)d * NROW + R) * 256 + chj) = av;
                if (tt == 3 && m16 == 15) { *(f32x4*)(p.LCE + (size_t)task * 128 + j0) = av; *(f32x4*)(p.LCE + (size_t)task * 128 + 64 + j0) = bv; }
            }
        }
    }
}
__device__ __forceinline__ void d_lru_carry(CParams& p, int widx, int lane) {
    const int gt = widx * 64 + lane;
    const int ch = gt & 255, d = (gt >> 8) & 1, b = gt >> 9, h = ch >> 6, j = ch & 63;
    const float* ce = p.LCE + (size_t)(((b * 2 + d) * 4 + h) * 68) * 128 + j;
    float* ci = p.LCI + (size_t)((b * 2 + d) * 68) * 256 + ch;
    float carry = 0.f;
#pragma unroll 1
    for (int c0 = 0; c0 < 68; c0 += 17) {
        float a[17], e[17];
#pragma unroll
        for (int u = 0; u < 17; ++u) { a[u] = ce[(size_t)(c0 + u) * 128]; e[u] = ce[(size_t)(c0 + u) * 128 + 64]; }
#pragma unroll
        for (int u = 0; u < 17; ++u) { ci[(size_t)(c0 + u) * 256] = carry; carry = a[u] * carry + e[u]; }
    }
}
__device__ __forceinline__ float lru_h(CParams& p, int b, int pos, size_t R, int d, int ch) {
    const int sidx = d == 0 ? pos : (pos < CTXL ? CTXL - 1 - pos : CTXL + (TPB - 1 - pos));
    const float ci = p.LCI[(size_t)((b * 2 + d) * 68 + (sidx >> 6)) * 256 + ch];
    return p.LA[((size_t)d * NROW + R) * 256 + ch] + p.LB[((size_t)d * NROW + R) * 256 + ch] * ci;
}

template <int MTX>
__device__ __forceinline__ void rwkv_pre_mtx(CParams& p, int l, const LAS unsigned char* stash, int R0, int lane) {
    const int m16 = lane & 15, g = lane >> 4;
    constexpr int src = MTX < 2 ? 0 : (MTX < 4 ? 1 : 2), d = MTX & 1;
    const bf16x8 a0 = *(const LAS bf16x8*)(stash + (src * 16 + m16) * RWS + g * 16), a1 = *(const LAS bf16x8*)(stash + (src * 16 + m16) * RWS + 64 + g * 16);
    const bf16_t* wt = p.RWT + (size_t)(l * 5 + MTX) * 16384 + (size_t)m16 * 64 + 8 * g;
    const float* cst = MTX < 2 ? p.in[I_W0] + (l * 2 + d) * 256 + m16 : p.in[I_A0] + (l * 2 + d) * 256 + m16;
    float* dst = (MTX < 2 ? p.DEC + (size_t)d * NROW * 256 : (MTX < 4 ? p.AIC + (size_t)d * NROW * 256 : p.GG)) + ((size_t)R0 + 4 * g) * 256 + m16;
#pragma unroll 1
    for (int half = 0; half < 2; ++half) {
        bf16x8 b0[8], b1[8]; float cv[8];
        const bf16_t* wh = wt + half * 8192; const float* ch_ = cst + half * 128; float* dh = dst + half * 128;
#pragma unroll
        for (int i = 0; i < 8; ++i) { b0[i] = *(const bf16x8*)(wh + i * 1024); b1[i] = *(const bf16x8*)(wh + i * 1024 + 32); cv[i] = MTX < 4 ? ch_[i * 16] : 0.f; }
#pragma unroll
        for (int i = 0; i < 8; ++i) {
            f32x4 acc = {0.f, 0.f, 0.f, 0.f};
            acc = __builtin_amdgcn_mfma_f32_16x16x32_bf16(a0, b0[i], acc, 0, 0, 0);
            acc = __builtin_amdgcn_mfma_f32_16x16x32_bf16(a1, b1[i], acc, 0, 0, 0);
#pragma unroll
            for (int r = 0; r < 4; ++r) {
                float o;
                if (MTX < 2) { const float w = -softplus_fast(-(cv[i] + acc[r])) - 0.5f; o = -__expf(w); }
                else if (MTX < 4) o = sigmoidf_(cv[i] + acc[r]);
                else o = acc[r];
                dh[r * 256 + i * 16] = o;
            }
        }
    }
}
__device__ __forceinline__ void d_rwkv_pre(CParams& p, int wv, int l) {
    const int tidx_ = opaque_tid(wv);
    int bidx_ = blockIdx.x, gdim_ = gridDim.x; asm volatile("" : "+s"(bidx_), "+s"(gdim_));
    const int lane = tidx_ & 63, gw = bidx_ * 8 + wv, NGW = gdim_ * 8, m16 = lane & 15, g = lane >> 4;
    LAS unsigned char* stash = (LAS unsigned char*)smem + 90112 + wv * (3 * 16 * RWS);
    const float* mu = p.in[I_MU] + l * 2 * 960;
    const int gw2 = NGW == 2048 ? (gw + 1088) % 2048 : gw;
    for (int tile = gw2; tile < NROW / 16; tile += NGW) {
        const int R0 = tile * 16;
        float pvv[15], cvv[15], nvv[15];
        {
            const int pos0 = R0 % TPB; const bool hasp = pos0 != 0 && pos0 != CTXL;
            const float* pr0 = p.P + (size_t)R0 * PST + 512;
#pragma unroll
            for (int q = 0; q < 15; ++q) { const int col = lane + 64 * q; pvv[q] = hasp ? pr0[col - PST] : 0.f; cvv[q] = pr0[col]; }
        }
#pragma unroll 2
        for (int rr = 0; rr < 16; ++rr) {
            const int R = R0 + rr, pos = R % TPB;
            const int seg1 = pos < CTXL ? CTXL : TPB;
            const float* pr = p.P + (size_t)R * PST + 512;
            const bool hasn = pos + 1 < seg1;
            float sv[15];
#pragma unroll
            for (int q = 0; q < 15; ++q) {
                const int col = lane + 64 * q;
                nvv[q] = hasn ? pr[col + PST] : 0.f;
                const float v = cvv[q];
                sv[q] = v + mu[col] * (pvv[q] - v) + mu[960 + col] * (nvv[q] - v);
                pvv[q] = v; cvv[q] = nvv[q];
            }
#pragma unroll
            for (int q = 0; q < 12; ++q) p.RS[(size_t)R * 768 + lane + 64 * q] = sv[q];
            *(LAS bf16_t*)(stash + (0 * 16 + rr) * RWS + lane * 2) = f2bf(tanh_fast(sv[12]));
            *(LAS bf16_t*)(stash + (1 * 16 + rr) * RWS + lane * 2) = f2bf(sv[13]);
            *(LAS bf16_t*)(stash + (2 * 16 + rr) * RWS + lane * 2) = f2bf(sigmoidf_(sv[14]));
#pragma unroll
            for (int hq = 0; hq < 4; ++hq) {
                const int c = hq * 64 + lane;
                const float kk = sv[4 + hq] * p.in[I_KK][l * 256 + c];
                const float n2 = wave_sum(kk * kk);
                p.KKN[(size_t)R * 256 + c] = kk / fmaxf(sqrtf(n2), 1e-12f);
            }
        }
        __builtin_amdgcn_wave_barrier();
        rwkv_pre_mtx<0>(p, l, stash, R0, lane); rwkv_pre_mtx<1>(p, l, stash, R0, lane); rwkv_pre_mtx<2>(p, l, stash, R0, lane);
        rwkv_pre_mtx<3>(p, l, stash, R0, lane); rwkv_pre_mtx<4>(p, l, stash, R0, lane);
        __builtin_amdgcn_wave_barrier();
    }
}
#define RSLOT(k) (lds + (k) * 9216)
__device__ __forceinline__ void mm2(const LAS unsigned char* Xr, const LAS unsigned char* Yt, int mi, int ni0, int lane, f32x4 (&acc)[2]) {
    const int m = lane & 15, g = lane >> 4;
#pragma unroll
    for (int ks = 0; ks < 2; ++ks) {
        const bf16x8 a = *(const LAS bf16x8*)(Xr + (mi * 16 + m) * RWS + ks * 64 + g * 16);
#pragma unroll
        for (int n = 0; n < 2; ++n) {
            const bf16x8 b = *(const LAS bf16x8*)(Yt + ((ni0 + n) * 16 + m) * RWS + ks * 64 + g * 16);
            acc[n] = __builtin_amdgcn_mfma_f32_16x16x32_bf16(a, b, acc[n], 0, 0, 0);
        }
    }
}
__device__ __forceinline__ void st_r(LAS unsigned char* dst, int mi, int ni, int lane, const f32x4& v) {
    const int m = lane & 15, g = lane >> 4;
#pragma unroll
    for (int r = 0; r < 4; ++r) *(LAS bf16_t*)(dst + (mi * 16 + 4 * g + r) * RWS + (ni * 16 + m) * 2) = f2bf(v[r]);
}
__device__ __forceinline__ void st_t(LAS unsigned char* dst, int mi, int ni, int lane, const f32x4& v) {
    const int m = lane & 15, g = lane >> 4;
    u32x2 o; o.x = cvt_pk_bf16(v[0], v[1]); o.y = cvt_pk_bf16(v[2], v[3]);
    *(LAS u32x2*)(dst + (ni * 16 + m) * RWS + (mi * 16 + 4 * g) * 2) = o;
}
__device__ __forceinline__ float bfbits2f(unsigned short v) { return __uint_as_float(((unsigned)v) << 16); }

__device__ __forceinline__ void d_rwkv_chunkA(CParams& p, int wv, int l) {
    const int tidx_ = opaque_tid(wv);
    int bidx_ = blockIdx.x, gdim_ = gridDim.x; asm volatile("" : "+s"(bidx_), "+s"(gdim_));
    LAS unsigned char* lds = (LAS unsigned char*)smem;
    LAS float* segtot = (LAS float*)(lds + 16 * 9216);
    LAS float* gam = segtot + 512;
    const int tid = tidx_, lane = tid & 63, w = wv;
    const int mi = w >> 1, ni0 = (w & 1) * 2, m16 = lane & 15, g = lane >> 4;
    for (int task = bidx_; task < 2176; task += gdim_) {
        const int c = task % 68, d = (task / 68) & 1, h = (task / 136) & 3, b = task / 544;
        __syncthreads();
        {
            const int j = lane, tq = w, hc = h * 64 + j;
            const float ka = p.in[I_KA][l * 256 + hc];
            float lw[8], aa[8], bb[8], ke[8], rr[8], vv[8];
#pragma unroll
            for (int u = 0; u < 8; ++u) {
                const size_t R = (size_t)b * TPB + rwkv_pos(d, c, 8 * tq + u);
                lw[u] = p.DEC[((size_t)d * NROW + R) * 256 + hc];
                const float aic = p.AIC[((size_t)d * NROW + R) * 256 + hc], kkn = p.KKN[R * 256 + hc];
                const float* rs = p.RS + R * 768;
                rr[u] = rs[hc]; const float k = rs[256 + hc]; vv[u] = rs[512 + hc];
                aa[u] = -kkn; bb[u] = kkn * aic; ke[u] = k * (1.f + (aic - 1.f) * ka);
            }
            float cs[8]; cs[0] = lw[0];
#pragma unroll
            for (int u = 1; u < 8; ++u) cs[u] = cs[u - 1] + lw[u];
            segtot[tq * 64 + j] = cs[7];
            __syncthreads();
            float pre = 0.f, tot = 0.f;
#pragma unroll
            for (int q = 0; q < 8; ++q) { const float sgt = segtot[q * 64 + j]; tot += sgt; if (q < tq) pre += sgt; }
            if (tq == 0) gam[j] = __expf(tot);
            float at[8], bt[8], kt[8];
#pragma unroll
            for (int u = 0; u < 8; ++u) {
                const float Lc = pre + cs[u], Lp = Lc - lw[u];
                const float ep = __expf(Lp), ec = __expf(Lc), en = __expf(-Lc), ee = __expf(tot - Lc);
                const int t = 8 * tq + u;
                at[u] = aa[u] * ep; bt[u] = bb[u] * ee; kt[u] = ke[u] * ee;
                *(LAS bf16_t*)(RSLOT(0) + t * RWS + j * 2) = f2bf(at[u]);
                *(LAS bf16_t*)(RSLOT(1) + t * RWS + j * 2) = f2bf(rr[u] * ec);
                *(LAS bf16_t*)(RSLOT(2) + t * RWS + j * 2) = f2bf(bb[u] * en);
                *(LAS bf16_t*)(RSLOT(3) + t * RWS + j * 2) = f2bf(ke[u] * en);
            }
            u32x4 o;
            o.x = cvt_pk_bf16(at[0], at[1]); o.y = cvt_pk_bf16(at[2], at[3]); o.z = cvt_pk_bf16(at[4], at[5]); o.w = cvt_pk_bf16(at[6], at[7]);
            *(LAS u32x4*)(RSLOT(4) + j * RWS + tq * 16) = o;
            o.x = cvt_pk_bf16(bt[0], bt[1]); o.y = cvt_pk_bf16(bt[2], bt[3]); o.z = cvt_pk_bf16(bt[4], bt[5]); o.w = cvt_pk_bf16(bt[6], bt[7]);
            *(LAS u32x4*)(RSLOT(5) + j * RWS + tq * 16) = o;
            o.x = cvt_pk_bf16(kt[0], kt[1]); o.y = cvt_pk_bf16(kt[2], kt[3]); o.z = cvt_pk_bf16(kt[4], kt[5]); o.w = cvt_pk_bf16(kt[6], kt[7]);
            *(LAS u32x4*)(RSLOT(6) + j * RWS + tq * 16) = o;
            o.x = cvt_pk_bf16(vv[0], vv[1]); o.y = cvt_pk_bf16(vv[2], vv[3]); o.z = cvt_pk_bf16(vv[4], vv[5]); o.w = cvt_pk_bf16(vv[6], vv[7]);
            *(LAS u32x4*)(RSLOT(7) + j * RWS + tq * 16) = o;
        }
        __syncthreads();
        {
            f32x4 aab[2] = {}, aak[2] = {}, brb[2] = {}, brk[2] = {};
            mm2(RSLOT(0), RSLOT(2), mi, ni0, lane, aab); mm2(RSLOT(0), RSLOT(3), mi, ni0, lane, aak);
            mm2(RSLOT(1), RSLOT(2), mi, ni0, lane, brb); mm2(RSLOT(1), RSLOT(3), mi, ni0, lane, brk);
#pragma unroll
            for (int n = 0; n < 2; ++n) {
                f32x4 p0;
#pragma unroll
                for (int r = 0; r < 4; ++r) {
                    const int t = mi * 16 + 4 * g + r, sidx = (ni0 + n) * 16 + m16;
                    if (!(sidx < t)) { aab[n][r] = 0.f; aak[n][r] = 0.f; }
                    if (!(sidx <= t)) { brb[n][r] = 0.f; brk[n][r] = 0.f; }
                    p0[r] = aab[n][r] + (sidx == t ? 1.f : 0.f);
                }
                st_r(RSLOT(11), mi, ni0 + n, lane, aab[n]); st_t(RSLOT(12), mi, ni0 + n, lane, aab[n]);
                st_t(RSLOT(13), mi, ni0 + n, lane, p0);
                st_r(RSLOT(8), mi, ni0 + n, lane, aak[n]); st_r(RSLOT(9), mi, ni0 + n, lane, brb[n]); st_r(RSLOT(10), mi, ni0 + n, lane, brk[n]);
            }
        }
        __syncthreads();
#pragma unroll 1
        for (int st = 1; st <= 6; ++st) {
            LAS unsigned char* qsr = (st & 1) ? RSLOT(11) : RSLOT(0);
            LAS unsigned char* qst = (st & 1) ? RSLOT(12) : RSLOT(2);
            LAS unsigned char* qdr = (st & 1) ? RSLOT(0) : RSLOT(11);
            LAS unsigned char* qdt = (st & 1) ? RSLOT(2) : RSLOT(12);
            if (st <= 5) {
                f32x4 q[2] = {};
                mm2(qsr, qst, mi, ni0, lane, q);
#pragma unroll
                for (int n = 0; n < 2; ++n) { st_r(qdr, mi, ni0 + n, lane, q[n]); st_t(qdt, mi, ni0 + n, lane, q[n]); }
            }
            if (st >= 2) {
                LAS unsigned char* ps = (st & 1) ? RSLOT(3) : RSLOT(13);
                LAS unsigned char* pd = (st & 1) ? RSLOT(13) : RSLOT(3);
                f32x4 pp[2];
#pragma unroll
                for (int n = 0; n < 2; ++n) {
                    const u32x2 o = *(const LAS u32x2*)(ps + ((ni0 + n) * 16 + m16) * RWS + (mi * 16 + 4 * g) * 2);
                    pp[n][0] = __uint_as_float(o.x << 16); pp[n][1] = __uint_as_float(o.x & 0xffff0000u); pp[n][2] = __uint_as_float(o.y << 16); pp[n][3] = __uint_as_float(o.y & 0xffff0000u);
                }
                mm2(qsr, ps, mi, ni0, lane, pp);
#pragma unroll
                for (int n = 0; n < 2; ++n) { st_t(pd, mi, ni0 + n, lane, pp[n]); if (st == 6) st_r(RSLOT(15), mi, ni0 + n, lane, pp[n]); }
            }
            if (st == 1) {
                f32x4 akv[2] = {};
                mm2(RSLOT(8), RSLOT(7), mi, ni0, lane, akv);
#pragma unroll
                for (int n = 0; n < 2; ++n) st_t(RSLOT(14), mi, ni0 + n, lane, akv[n]);
            }
            __syncthreads();
        }
        {
            f32x4 w1[2] = {}, z[2] = {};
            mm2(RSLOT(15), RSLOT(4), mi, ni0, lane, w1); mm2(RSLOT(15), RSLOT(14), mi, ni0, lane, z);
#pragma unroll
            for (int n = 0; n < 2; ++n) { st_t(RSLOT(11), mi, ni0 + n, lane, w1[n]); st_t(RSLOT(12), mi, ni0 + n, lane, z[n]); }
        }
        __syncthreads();
        {
            f32x4 mm_[2] = {}, nn[2] = {}, qq[2] = {}, yl[2] = {};
            mm2(RSLOT(5), RSLOT(11), mi, ni0, lane, mm_);
            mm2(RSLOT(5), RSLOT(12), mi, ni0, lane, nn); mm2(RSLOT(6), RSLOT(7), mi, ni0, lane, nn);
            mm2(RSLOT(9), RSLOT(11), mi, ni0, lane, qq);
            mm2(RSLOT(9), RSLOT(12), mi, ni0, lane, yl); mm2(RSLOT(10), RSLOT(7), mi, ni0, lane, yl);
#pragma unroll
            for (int n = 0; n < 2; ++n) {
#pragma unroll
                for (int r = 0; r < 4; ++r) {
                    const int row = mi * 16 + 4 * g + r, col = (ni0 + n) * 16 + m16;
                    if (row == col) mm_[n][r] += gam[row];
                    qq[n][r] += bfbits2f(*(const LAS bf16_t*)(RSLOT(1) + row * RWS + col * 2));
                }
                st_r(RSLOT(0), mi, ni0 + n, lane, mm_[n]); st_r(RSLOT(2), mi, ni0 + n, lane, qq[n]);
                *(f32x4*)(p.RNF + (size_t)task * 4096 + (((ni0 + n) * 4 + mi) * 64 + lane) * 4) = nn[n];
#pragma unroll
                for (int r = 0; r < 4; ++r) p.RYF[(size_t)task * 4096 + (mi * 16 + 4 * g + r) * 64 + (ni0 + n) * 16 + m16] = yl[n][r];
            }
        }
        __syncthreads();
        {
            const int jb = tid >> 7, sk = (tid >> 6) & 1;
            const int row = jb * 16 + m16;
            const u32x2 m0 = *(const LAS u32x2*)(RSLOT(0) + row * RWS + (32 * sk + 4 * g) * 2), m1 = *(const LAS u32x2*)(RSLOT(0) + row * RWS + (32 * sk + 16 + 4 * g) * 2);
            const u32x2 q0 = *(const LAS u32x2*)(RSLOT(2) + row * RWS + (32 * sk + 4 * g) * 2), q1 = *(const LAS u32x2*)(RSLOT(2) + row * RWS + (32 * sk + 16 + 4 * g) * 2);
            *(u32x4*)(p.RMF + (size_t)task * 4096 + (size_t)tid * 8) = (u32x4){m0.x, m0.y, m1.x, m1.y};
            *(u32x4*)(p.RQF + (size_t)task * 4096 + (size_t)tid * 8) = (u32x4){q0.x, q0.y, q1.x, q1.y};
        }
    }
    __syncthreads();
}

#define SEQ_LOAD(M_, N_, cc) do { const int c_ = (cc) < 68 ? (cc) : 67; const size_t tk_ = task0 + c_; \
    const bf16x8* mf_ = (const bf16x8*)(p.RMF + tk_ * 4096) + lane; const f32x4* nf_ = (const f32x4*)(p.RNF + tk_ * 4096) + (ib * 4) * 64 + lane; \
    _Pragma("unroll") for (int jb = 0; jb < 4; ++jb) { M_[jb][0] = mf_[(jb * 2) * 64]; M_[jb][1] = mf_[(jb * 2 + 1) * 64]; N_[jb] = nf_[jb * 64]; } } while (0)
#define SEQ_STEP(M_, N_, cc) do { bf16x8 bfr[2]; \
    _Pragma("unroll") for (int sk = 0; sk < 2; ++sk) { union { u32x4 u; bf16x8 v; } cv; \
        cv.u.x = cvt_pk_bf16(S[2 * sk][0], S[2 * sk][1]); cv.u.y = cvt_pk_bf16(S[2 * sk][2], S[2 * sk][3]); \
        cv.u.z = cvt_pk_bf16(S[2 * sk + 1][0], S[2 * sk + 1][1]); cv.u.w = cvt_pk_bf16(S[2 * sk + 1][2], S[2 * sk + 1][3]); bfr[sk] = cv.v; \
        *((bf16x8*)(p.S0F + (task0 + (cc)) * 4096) + (ib * 2 + sk) * 64 + lane) = cv.v; } \
    _Pragma("unroll") for (int jb = 0; jb < 4; ++jb) { f32x4 a_ = N_[jb]; \
        a_ = __builtin_amdgcn_mfma_f32_16x16x32_bf16(M_[jb][0], bfr[0], a_, 0, 0, 0); a_ = __builtin_amdgcn_mfma_f32_16x16x32_bf16(M_[jb][1], bfr[1], a_, 0, 0, 0); S[jb] = a_; } } while (0)
__device__ __forceinline__ void d_rwkv_seq(CParams& p, int widx, int ib, int lane) {
    const int d = widx & 1, h = (widx >> 1) & 3, b = widx >> 3;
    f32x4 S[4];
#pragma unroll
    for (int jb = 0; jb < 4; ++jb) S[jb] = (f32x4){0.f, 0.f, 0.f, 0.f};
    const size_t task0 = (size_t)((b * 4 + h) * 2 + d) * 68;
    bf16x8 MA[4][2], MB[4][2], MC[4][2]; f32x4 NA[4], NB[4], NC[4];
    SEQ_LOAD(MA, NA, 0); SEQ_LOAD(MB, NB, 1);
#pragma unroll 1
    for (int c = 0; c < 66; c += 3) {
        SEQ_LOAD(MC, NC, c + 2); SEQ_STEP(MA, NA, c);
        SEQ_LOAD(MA, NA, c + 3); SEQ_STEP(MB, NB, c + 1);
        SEQ_LOAD(MB, NB, c + 4); SEQ_STEP(MC, NC, c + 2);
    }
    SEQ_STEP(MA, NA, 66); SEQ_STEP(MB, NB, 67);
}

__device__ __forceinline__ float xor16_max(float v) { return fmaxf(v, SWZ_XOR(v, 16)); }
__device__ __forceinline__ float max_xor32(float v) {
    int a = __float_as_int(v), b = a;
    asm volatile("s_nop 1\n\tv_permlane32_swap_b32 %0, %1\n\ts_nop 1" : "+v"(a), "+v"(b));
    return fmaxf(__int_as_float(a), __int_as_float(b));
}
#define NA_KB 15360
#define NA_KC 98304
#define NA_KST 144
#define NA_VBS 1168
#define NA_VCS 528
template <bool BAND>
__device__ __forceinline__ void attn_scores(const LAS unsigned char* kbase  , int ustride  ,
                                            const bf16x8 (&qf)[2], const float* rpbh, int c, int rr, int rs, int kc0, int lane, float& mrow, float& lrow, bf16x8 (&pf)[8]) {
    const int g = lane >> 4;
    f32x4 sc[16];
#pragma unroll
    for (int u = 0; u < 8; ++u) {
#pragma unroll
        for (int j2 = 0; j2 < 2; ++j2) {
            const LAS unsigned char* kr = kbase + u * ustride + j2 * (16 * NA_KST);
            const bf16x8 k0 = *(const LAS bf16x8*)kr, k1 = *(const LAS bf16x8*)(kr + 64);
            f32x4 a = {0.f, 0.f, 0.f, 0.f};
            a = __builtin_amdgcn_mfma_f32_16x16x32_bf16(k0, qf[0], a, 0, 0, 0);
            a = __builtin_amdgcn_mfma_f32_16x16x32_bf16(k1, qf[1], a, 0, 0, 0);
            if (BAND) {
                const int cs = min(max(c - 8, 0), 48);
#pragma unroll
                for (int r = 0; r < 4; ++r) {
                    const int kc = kc0 + 16 * j2 + 4 * g + r;
                    const int cb = min(max(kc - c + 15, 0), 30);
                    const float bias = rpbh[(rs + u - rr + 7) * 31 + cb];
                    a[r] = (kc >= cs && kc < cs + 16) ? a[r] + bias : -1e30f;
                }
            }
            sc[2 * u + j2] = a;
        }
    }
    float mx = -1e30f;
#pragma unroll
    for (int t = 0; t < 16; ++t) mx = fmaxf(mx, fmaxf(fmaxf(sc[t][0], sc[t][1]), fmaxf(sc[t][2], sc[t][3])));
    mx = xor16_max(mx); mx = max_xor32(mx);
    float sum = 0.f;
#pragma unroll
    for (int t = 0; t < 16; ++t)
#pragma unroll
        for (int r = 0; r < 4; ++r) { const float e = __expf(sc[t][r] - mx); sc[t][r] = e; sum += e; }
    sum += SWZ_XOR(sum, 16); sum = sum_xor32(sum);
    mrow = mx; lrow = sum;
#pragma unroll
    for (int u = 0; u < 8; ++u) {
        union { u32x4 w; bf16x8 v; } t;
        t.w.x = cvt_pk_bf16(sc[2 * u][0], sc[2 * u][1]); t.w.y = cvt_pk_bf16(sc[2 * u][2], sc[2 * u][3]);
        t.w.z = cvt_pk_bf16(sc[2 * u + 1][0], sc[2 * u + 1][1]); t.w.w = cvt_pk_bf16(sc[2 * u + 1][2], sc[2 * u + 1][3]);
        pf[u] = t.v;
    }
}
__device__ __forceinline__ void attn_pv(const LAS unsigned char* vbase, int vstride  , int ustride  , const bf16x8 (&pf)[8], f32x4 (&o)[4]) {
#pragma unroll
    for (int dt = 0; dt < 4; ++dt) o[dt] = (f32x4){0.f, 0.f, 0.f, 0.f};
#pragma unroll
    for (int u = 0; u < 8; ++u)
#pragma unroll
        for (int dt = 0; dt < 4; ++dt) {
            const LAS unsigned char* vr = vbase + dt * 16 * vstride + u * ustride;
            const u32x2 v0 = *(const LAS u32x2*)vr, v1 = *(const LAS u32x2*)(vr + 32);
            union { u32x4 w; bf16x8 v; } vf; vf.w = (u32x4){v0.x, v0.y, v1.x, v1.y};
            o[dt] = __builtin_amdgcn_mfma_f32_16x16x32_bf16(vf.v, pf[u], o[dt], 0, 0, 0);
        }
}
__device__ __forceinline__ void d_na(CParams& p, int wv, int l, int do_ctx, int bid, int nblk) {
    const int tidx_ = opaque_tid(wv);
    const int lane = tidx_ & 63, m16 = lane & 15, g = lane >> 4;
    LAS unsigned char* lds = (LAS unsigned char*)smem;
    const float* rpbs = (const float*)smem;
    const int nbt = 1024 + (do_ctx ? 64 : 0);
    for (int bt = bid; bt < nbt; bt += nblk) {
        const bool lat = bt < 1024;
        int b, h, rs0 = 0, nrows = 0, rr = 0, rs = 0, c0 = 0, kc0 = 0, qpos0;
        if (lat) { b = bt >> 8; h = (bt >> 5) & 7; const int r0 = (bt & 31) * 2; rs0 = min(max(r0 - 4, 0), 56); nrows = min(9, 64 - rs0);
            rr = r0 + (wv >> 2); rs = min(max(rr - 4, 0), 56); c0 = (wv & 3) * 16; kc0 = min(max(c0 - 8, 0), 32); qpos0 = CTXL + rr * 64 + c0; }
        else { const int t2 = bt - 1024; b = t2 >> 4; h = (t2 >> 1) & 7; qpos0 = ((t2 & 1) * 8 + wv) * 16; }
        const bf16_t* QHh = p.QH + (size_t)(b * 8 + h) * TPB * 64;
        const bf16_t* KHh = p.KH + (size_t)(b * 8 + h) * TPB * 64;
        const bf16_t* VTh = p.VT + (size_t)(b * 8 + h) * 64 * TPB;
        const int kpos0 = CTXL + rs0 * 64, nkb = nrows * 64;
        bf16x8 qf[2];
        { const bf16_t* qr = QHh + (size_t)(qpos0 + m16) * 64 + 8 * g; qf[0] = *(const bf16x8*)qr; qf[1] = *(const bf16x8*)(qr + 32); }
        __syncthreads();
        for (int q = tidx_; q < nkb * 8; q += NTHR) { const int key = q >> 3, part = q & 7; *(LAS u32x4*)(lds + NA_KB + key * NA_KST + part * 16) = *(const u32x4*)(KHh + (size_t)(kpos0 + key) * 64 + part * 8); }
        for (int q = tidx_; q < 256 * 8; q += NTHR) { const int key = q >> 3, part = q & 7; *(LAS u32x4*)(lds + NA_KC + key * NA_KST + part * 16) = *(const u32x4*)(KHh + (size_t)key * 64 + part * 8); }
        __syncthreads();
        float m1 = -1e30f, l1 = 0.f, m2, l2; bf16x8 pf1[8], pf2[8];
        const int c = c0 + m16, lr0 = rs - rs0;
        attn_scores<false>(lds + NA_KC + m16 * NA_KST + 16 * g, 32 * NA_KST, qf, nullptr, 0, 0, 0, 0, lane, m2, l2, pf2);
        if (lat) attn_scores<true>(lds + NA_KB + ((lr0 * 64 + kc0 + m16) * NA_KST) + 16 * g, 64 * NA_KST, qf, rpbs + h * 465, c, rr, rs, kc0, lane, m1, l1, pf1);
        __syncthreads();
        if (lat) for (int q = tidx_; q < 64 * nrows * 8; q += NTHR) { const int dim = q / (nrows * 8), part = q % (nrows * 8);
            *(LAS u32x4*)(lds + NA_KB + dim * NA_VBS + part * 16) = *(const u32x4*)(VTh + (size_t)dim * TPB + kpos0 + part * 8); }
        for (int q = tidx_; q < 64 * 32; q += NTHR) { const int dim = q >> 5, part = q & 31; *(LAS u32x4*)(lds + NA_KC + dim * NA_VCS + part * 16) = *(const u32x4*)(VTh + (size_t)dim * TPB + part * 8); }
        __syncthreads();
        f32x4 o2[4]; float inv;
        attn_pv(lds + NA_KC + m16 * NA_VCS + 8 * g, NA_VCS, 64, pf2, o2);
        if (lat) {
            f32x4 o1[4];
            attn_pv(lds + NA_KB + m16 * NA_VBS + (lr0 * 64 + kc0) * 2 + 8 * g, NA_VBS, 128, pf1, o1);
            const float mm = fmaxf(m1, m2), f1 = __expf(m1 - mm), f2 = __expf(m2 - mm);
            inv = 1.f / (l1 * f1 + l2 * f2);
#pragma unroll
            for (int dt = 0; dt < 4; ++dt) o2[dt] = o1[dt] * f1 + o2[dt] * f2;
        } else inv = 1.f / l2;
        bf16_t* orow = p.MIX + (size_t)(b * TPB + qpos0 + m16) * DM + 512 + h * 64 + 4 * g;
#pragma unroll
        for (int dt = 0; dt < 4; ++dt) {
            const f32x4 v = o2[dt] * inv;
            u32x2 ov; ov.x = cvt_pk_bf16(v[0], v[1]); ov.y = cvt_pk_bf16(v[2], v[3]);
            *(u32x2*)(orow + dt * 16) = ov;
        }
    }
}

__device__ __forceinline__ void d_scan_attn(CParams& p, int wv, int l, int do_ctx) {
    const int tidx_ = opaque_tid(wv);
    int bidx_ = blockIdx.x, gdim_ = gridDim.x; asm volatile("" : "+s"(bidx_), "+s"(gdim_));
    const int wave = tidx_ >> 6, lane = tidx_ & 63;
    if (bidx_ < 32) {
        if (wave < 4) d_rwkv_seq(p, bidx_, wave, lane);
        else if (wave == 4) d_lru_carry(p, bidx_, lane);
        return;
    }
    { float* rpbs = (float*)smem; for (int i = tidx_; i < 8 * 15 * 31; i += NTHR) rpbs[i] = p.in[I_RPB][(size_t)l * 8 * 15 * 31 + i]; }
    __syncthreads();
    d_na(p, wv, l, do_ctx, bidx_ - 32, gdim_ - 32);
}

#define SWZ16(v, o) __int_as_float(__builtin_amdgcn_ds_swizzle(__float_as_int(v), ((o) << 10) | 0x1f))
__device__ __forceinline__ float row16_sum(float v) { return row_sum16(v); }
__device__ __forceinline__ void d_finish(CParams& p, int wv, int l, int skip_ctx) {
    const int tidx_ = opaque_tid(wv);
    int bidx_ = blockIdx.x, gdim_ = gridDim.x; asm volatile("" : "+s"(bidx_), "+s"(gdim_));
    const int lane = tidx_ & 63, gw = bidx_ * 8 + wv, NGW = gdim_ * 8, m16 = lane & 15, g = lane >> 4;
    for (int it0 = gw; it0 < NROW * 4; it0 += 4 * NGW) {
        float gg[4], hh[4]; int Rr[4], cc[4]; bool ok[4];
#pragma unroll
        for (int u = 0; u < 4; ++u) {
            const int it = it0 + u * NGW; const int R = it >> 2, h = it & 3, c = h * 64 + lane;
            ok[u] = it < NROW * 4 && !(skip_ctx && (R % TPB) < CTXL); Rr[u] = ok[u] ? R : 0; cc[u] = c;
            gg[u] = p.P[(size_t)Rr[u] * PST + 256 + c];
            hh[u] = lru_h(p, Rr[u] / TPB, Rr[u] % TPB, Rr[u], 0, c) + lru_h(p, Rr[u] / TPB, Rr[u] % TPB, Rr[u], 1, c);
        }
#pragma unroll
        for (int u = 0; u < 4; ++u) if (ok[u]) p.MIX[(size_t)Rr[u] * DM + cc[u]] = f2bf(gelu_tanh(gg[u]) * hh[u]);
    }
    for (int it = gw; it < 4 * 4 * 272; it += NGW) {
        const int pt = it % 272, h = (it / 272) & 3, b = it / 1088;
        if (skip_ctx && pt < 16) continue;
        const int p0 = pt * 16;
        f32x4 y[4];
#pragma unroll
        for (int q = 0; q < 4; ++q) y[q] = (f32x4){0.f, 0.f, 0.f, 0.f};
#pragma unroll
        for (int d = 0; d < 2; ++d) {
            const int s0 = d == 0 ? p0 : (p0 < CTXL ? CTXL - 1 - p0 : CTXL + (TPB - 1 - p0));
            const int c = s0 >> 6, tb = (s0 & 63) >> 4;
            const size_t tk = (size_t)((b * 4 + h) * 2 + d) * 68 + c;
            const int lsrc = d == 0 ? lane : ((15 - m16) | (g << 4));
            const bf16x8* qf = (const bf16x8*)(p.RQF + tk * 4096) + (tb * 2) * 64 + lsrc;
            const bf16x8 q0 = qf[0], q1 = qf[64];
            const bf16x8* sf = (const bf16x8*)(p.S0F + tk * 4096) + lane;
            const float* yl = p.RYF + tk * 4096;
#pragma unroll
            for (int q = 0; q < 4; ++q) {
                f32x4 a;
#pragma unroll
                for (int r = 0; r < 4; ++r) { const int t = tb * 16 + (d == 0 ? 4 * g + r : 15 - (4 * g + r)); a[r] = yl[t * 64 + q * 16 + m16]; }
                a = __builtin_amdgcn_mfma_f32_16x16x32_bf16(q0, sf[(q * 2) * 64], a, 0, 0, 0);
                a = __builtin_amdgcn_mfma_f32_16x16x32_bf16(q1, sf[(q * 2 + 1) * 64], a, 0, 0, 0);
                y[q] += a;
            }
        }
        float mean[4], rstd[4], bon[4];
        float kav[4], rkv[4], lgv[4], lbv[4];
#pragma unroll
        for (int q = 0; q < 4; ++q) { const int c = h * 64 + q * 16 + m16; kav[q] = p.in[I_KA][l * 256 + c]; rkv[q] = p.in[I_RK][l * 256 + c]; lgv[q] = p.in[I_LNG][l * 256 + c]; lbv[q] = p.in[I_LNB][l * 256 + c]; }
        float rv[4][4], vv[4][4], gv[4][4];
#pragma unroll
        for (int r = 0; r < 4; ++r) {
            const size_t R = (size_t)b * TPB + p0 + 4 * g + r;
            float sm = 0.f, bs = 0.f;
#pragma unroll
            for (int q = 0; q < 4; ++q) {
                const int c = h * 64 + q * 16 + m16;
                const float* rs = p.RS + R * 768;
                const float rr_ = rs[c], kk_ = rs[256 + c]; vv[r][q] = rs[512 + c]; gv[r][q] = p.GG[R * 256 + c]; rv[r][q] = rr_;
                const float a0 = p.AIC[R * 256 + c], a1 = p.AIC[((size_t)NROW + R) * 256 + c];
                bs += rr_ * kk_ * rkv[q] * ((1.f + (a0 - 1.f) * kav[q]) + (1.f + (a1 - 1.f) * kav[q]));
                sm += y[q][r];
            }
            mean[r] = row16_sum(sm) * (1.f / 64.f); bon[r] = row16_sum(bs);
            float vs = 0.f;
#pragma unroll
            for (int q = 0; q < 4; ++q) { const float dv = y[q][r] - mean[r]; vs += dv * dv; }
            rstd[r] = rsqrtf(row16_sum(vs) * (1.f / 64.f) + 64e-5f);
        }
#pragma unroll
        for (int r = 0; r < 4; ++r) {
            const size_t R = (size_t)b * TPB + p0 + 4 * g + r;
#pragma unroll
            for (int q = 0; q < 4; ++q) {
                const float o = ((y[q][r] - mean[r]) * rstd[r] * lgv[q] + lbv[q] + bon[r] * vv[r][q]) * gv[r][q];
                p.MIX[R * DM + 256 + h * 64 + q * 16 + m16] = f2bf(o);
            }
        }
        (void)rv;
    }
}

__device__ __forceinline__ void d_norm_router(CParams& p, int wv, int l, int skip_ctx) {
    const int tidx_ = opaque_tid(wv);
    int bidx_ = blockIdx.x, gdim_ = gridDim.x; asm volatile("" : "+s"(bidx_), "+s"(gdim_));
    const int lane = tidx_ & 63, m16 = lane & 15, g = lane >> 4;
    const int gtid = bidx_ * NTHR + tidx_, gsz = gdim_ * NTHR;
    for (int i = gtid; i < CAP; i += gsz) p.SLOT_TOK[i] = 0;
    LAS float* hs = (LAS float*)smem;
    LAS float* part = hs + 16 * 1028;
    LAS int* lcnt = (LAS int*)(part + 8 * 16 * 32);
    if (tidx_ < 64) lcnt[tidx_] = 0;
    const float* rw = p.in[I_RTW] + (size_t)l * DM * 32;
    const float* gn = p.in[I_NFG] + l * DM;
    int* cnt = p.CNT + l * 32;
    for (int tile = bidx_; tile < NROW / 16; tile += gdim_) {
        const int R0 = tile * 16, b = R0 / TPB, pos0 = R0 % TPB, mr = pos0 < CTXL ? 4 : b;
        if (skip_ctx && pos0 < CTXL) continue;
        const float* mod = p.MOD + (l * 5 + mr) * 6144 + 3 * DM;
        __syncthreads();
#pragma unroll 1
        for (int q = 0; q < 2; ++q) {
            const int rr = 2 * wv + q, R = R0 + rr;
            const float4* xr = (const float4*)(p.X2 + (size_t)R * DM);
            float4 v[4]; float ss = 0.f;
#pragma unroll
            for (int i = 0; i < 4; ++i) { v[i] = xr[lane + 64 * i]; ss += v[i].x * v[i].x + v[i].y * v[i].y + v[i].z * v[i].z + v[i].w * v[i].w; }
            ss = wave_sum(ss);
            const float rinv = rsqrtf(ss * (1.f / DM) + 1e-6f);
#pragma unroll
            for (int i = 0; i < 4; ++i) {
                const int c = (lane + 64 * i) * 4;
                const float4 gg = *(const float4*)(gn + c), sh = *(const float4*)(mod + c), sc = *(const float4*)(mod + DM + c);
                f32x4 o;
                o[0] = v[i].x * rinv * gg.x * (1.f + sc.x) + sh.x; o[1] = v[i].y * rinv * gg.y * (1.f + sc.y) + sh.y;
                o[2] = v[i].z * rinv * gg.z * (1.f + sc.z) + sh.z; o[3] = v[i].w * rinv * gg.w * (1.f + sc.w) + sh.w;
                uint2 ob; ob.x = cvt_pk_bf16(o[0], o[1]); ob.y = cvt_pk_bf16(o[2], o[3]);
                *(uint2*)(p.H + (size_t)R * DM + c) = ob;
                *(LAS f32x4*)(hs + rr * 1028 + c) = o;
            }
        }
        __syncthreads();
        {
            f32x4 a0 = {0.f, 0.f, 0.f, 0.f}, a1 = {0.f, 0.f, 0.f, 0.f};
            const int kb = wv * 128 + g;
#pragma unroll 8
            for (int ks = 0; ks < 32; ++ks) {
                const int k = kb + 4 * ks;
                const float av = hs[m16 * 1028 + k];
                const float b0 = rw[k * 32 + m16], b1 = rw[k * 32 + 16 + m16];
                a0 = __builtin_amdgcn_mfma_f32_16x16x4f32(av, b0, a0, 0, 0, 0);
                a1 = __builtin_amdgcn_mfma_f32_16x16x4f32(av, b1, a1, 0, 0, 0);
            }
#pragma unroll
            for (int r = 0; r < 4; ++r) { part[(wv * 16 + 4 * g + r) * 32 + m16] = a0[r]; part[(wv * 16 + 4 * g + r) * 32 + 16 + m16] = a1[r]; }
        }
        __syncthreads();
#pragma unroll 1
        for (int q = 0; q < 2; ++q) {
            const int rr = 2 * wv + q, R = R0 + rr, e = lane & 31;
            float val = p.in[I_RTB][l * 32 + e];
#pragma unroll
            for (int w8 = 0; w8 < 8; ++w8) val += part[(w8 * 16 + rr) * 32 + e];
            if (lane >= 32) val = -3e38f;
            float tv[4]; int ti[4];
#pragma unroll
            for (int k = 0; k < 4; ++k) {
                const float m = wave_max(val);
                const unsigned long long bal = __ballot(val == m);
                const int idx = __ffsll((long long)bal) - 1;
                tv[k] = m; ti[k] = idx;
                if (lane == idx) val = -3e38f;
            }
            if (lane == 0) {
                const float e1 = __expf(tv[1] - tv[0]), e2 = __expf(tv[2] - tv[0]), e3 = __expf(tv[3] - tv[0]);
                const float inv = 1.f / (1.f + e1 + e2 + e3);
                const float gs[4] = {inv, e1 * inv, e2 * inv, e3 * inv};
#pragma unroll
                for (int k = 0; k < 4; ++k) {
                    p.TOPG[R * 4 + k] = gs[k]; p.TOPI[R * 4 + k] = ti[k];
                    p.TOKPOS[R * 4 + k] = __hip_atomic_fetch_add(&lcnt[ti[k]], 1, __ATOMIC_RELAXED, __HIP_MEMORY_SCOPE_WORKGROUP);
                }
            }
        }
    }
    __syncthreads();
    if (tidx_ < 32) lcnt[32 + tidx_] = lcnt[tidx_] ? atomicAdd(&cnt[tidx_], lcnt[tidx_]) : 0;
    __syncthreads();
    for (int tile = bidx_; tile < NROW / 16; tile += gdim_) {
        const int R0 = tile * 16;
        if (skip_ctx && (R0 % TPB) < CTXL) continue;
        if (tidx_ < 64) { const int i = R0 * 4 + tidx_; p.TOKPOS[i] += lcnt[32 + p.TOPI[i]]; }
    }
}
__device__ __forceinline__ void moe_offsets_lds(CParams& p, int wv, int l) {
    const int tidx_ = opaque_tid(wv);
    LAS int* li = (LAS int*)((LAS unsigned char*)smem + LDS_GEMM);
    __syncthreads();
    if (tidx_ < 64) {
        const int e = tidx_;
        const int n = e < 32 ? (p.CNT[l * 32 + e] + MOE_TM - 1) / MOE_TM : 0;
        int sc = n;
#define ISHR(v, k) __builtin_amdgcn_update_dpp(0, v, 0x110 + (k), 0xf, 0xf, true)
        sc += ISHR(sc, 1); sc += ISHR(sc, 2); sc += ISHR(sc, 4); sc += ISHR(sc, 8);
#undef ISHR
        const int row0 = __builtin_amdgcn_readlane(sc, 15);
        if (e >= 16) sc += row0;
        const int excl = sc - n;
        if (e < 32) { li[e] = excl * MOE_TM; for (int i = 0; i < n; ++i) li[64 + excl + i] = e; }
        if (e == 31) { li[32] = sc * MOE_TM; li[40] = sc; }
    }
    __syncthreads();
}
__device__ __forceinline__ void d_moe_scatter(CParams& p, int wv, int l, int skip_ctx) {
    const int tidx_ = opaque_tid(wv);
    int bidx_ = blockIdx.x, gdim_ = gridDim.x; asm volatile("" : "+s"(bidx_), "+s"(gdim_));
    moe_offsets_lds(p, wv, l);
    const int* li = (const int*)(smem + LDS_GEMM);
    const int gtid = bidx_ * NTHR + tidx_, gsz = gdim_ * NTHR;
    for (int i = gtid; i < NROW * 4; i += gsz) {
        const int R = i >> 2;
        if (skip_ctx && (R % TPB) < CTXL) continue;
        p.SLOT_TOK[li[p.TOPI[i]] + p.TOKPOS[i]] = R;
    }
}
struct ProbG1 {
    CParams& p; int l; const int* li; int ntile; int bid, nblk;
    __device__ __forceinline__ bool next(int i, Unit& u) const { return tile_order(i, ntile, 8, u, bid, nblk); }
    __device__ __forceinline__ int expert(const Unit& u) const { return __builtin_amdgcn_readfirstlane(li[64 + u.pm]); }
    __device__ __forceinline__ const char* a_ptr(const Unit&) const { return (const char*)p.H; }
    __device__ __forceinline__ const char* b_ptr(const Unit& u) const { return (const char*)p.WTGU + ((size_t)(l * NEXP + expert(u)) * 2048 + (size_t)u.pn * 256) * KB_; }
    __device__ __forceinline__ int gather_row(const Unit& u, int r) const { return p.SLOT_TOK[u.pm * 256 + r]; }
    __device__ __forceinline__ void epi(const f32x4 (&acc)[2][2][4][2], const Unit& u, int wr, int wc, int fr, int fq) const {
        const int brow = u.pm * 256;
        const float* bias = p.in[I_BGU] + (size_t)(l * NEXP + expert(u)) * 2048;
        const int c = u.pn * 128 + wc * 32 + 8 * fq;
        const f32x4 bg0 = *(const f32x4*)(bias + c), bg1 = *(const f32x4*)(bias + c + 4);
        const f32x4 bu0 = *(const f32x4*)(bias + 1024 + c), bu1 = *(const f32x4*)(bias + 1024 + c + 4);
#pragma unroll
        for (int ai = 0; ai < 2; ++ai)
#pragma unroll
            for (int m = 0; m < 4; ++m) {
                float a[8];
#pragma unroll
                for (int n = 0; n < 2; ++n)
#pragma unroll
                    for (int j = 0; j < 4; ++j) {
                        float gv = acc[ai][0][m][n][j] + (n == 0 ? bg0[j] : bg1[j]), uv = acc[ai][1][m][n][j] + (n == 0 ? bu0[j] : bu1[j]);
                        gv = fminf(gv, 7.f); uv = fminf(fmaxf(uv, -7.f), 7.f);
                        a[n * 4 + j] = (uv + 1.f) * (gv * sigmoidf_(1.702f * gv));
                    }
                u32x4 o; o.x = cvt_pk_bf16(a[0], a[1]); o.y = cvt_pk_bf16(a[2], a[3]); o.z = cvt_pk_bf16(a[4], a[5]); o.w = cvt_pk_bf16(a[6], a[7]);
                *(u32x4*)(p.ACT + (size_t)(brow + ai * 128 + wr * 64 + m * 16 + fr) * DM + c) = o;
            }
    }
};
__device__ __forceinline__ void d_moe_gemm1(CParams& p, int wv, int l) {
    moe_offsets_lds(p, wv, l);
    const int* li = (const int*)(smem + LDS_GEMM);
    ProbG1 P{p, l, li, __builtin_amdgcn_readfirstlane(li[40]), 0, 0};
    gemm_phase<true>(P, wv);
}
struct ProbG2 {
    CParams& p; int l; const int* li; int ntile; int bid, nblk;
    __device__ __forceinline__ bool next(int i, Unit& u) const { return tile_order(i, ntile, 4, u, bid, nblk); }
    __device__ __forceinline__ int expert(const Unit& u) const { return __builtin_amdgcn_readfirstlane(li[64 + u.pm]); }
    __device__ __forceinline__ const char* a_ptr(const Unit& u) const { return (const char*)p.ACT + (size_t)u.pm * 256 * KB_; }
    __device__ __forceinline__ const char* b_ptr(const Unit& u) const { return (const char*)p.WTDN + ((size_t)(l * NEXP + expert(u)) * DM + (size_t)u.pn * 256) * KB_; }
    __device__ __forceinline__ int gather_row(const Unit&, int) const { return 0; }
    __device__ __forceinline__ void epi(const f32x4 (&acc)[2][2][4][2], const Unit& u, int wr, int wc, int fr, int fq) const {
        const int brow = u.pm * 256, bcol = u.pn * 256;
        const float* bias = p.in[I_BDN] + (size_t)(l * NEXP + expert(u)) * DM;
#pragma unroll
        for (int bj = 0; bj < 2; ++bj) {
            const int col = bcol + bj * 128 + wc * 32 + 8 * fq;
            const f32x4 b0 = *(const f32x4*)(bias + col), b1 = *(const f32x4*)(bias + col + 4);
#pragma unroll
            for (int ai = 0; ai < 2; ++ai)
#pragma unroll
                for (int m = 0; m < 4; ++m) {
                    const f32x4 v0 = acc[ai][bj][m][0] + b0, v1 = acc[ai][bj][m][1] + b1;
                    u32x4 o; o.x = cvt_pk_bf16(v0[0], v0[1]); o.y = cvt_pk_bf16(v0[2], v0[3]); o.z = cvt_pk_bf16(v1[0], v1[1]); o.w = cvt_pk_bf16(v1[2], v1[3]);
                    *(u32x4*)(p.Y + (size_t)(brow + ai * 128 + wr * 64 + m * 16 + fr) * DM + col) = o;
                }
        }
    }
};
__device__ __forceinline__ void d_moe_gemm2(CParams& p, int wv, int l) {
    moe_offsets_lds(p, wv, l);
    const int* li = (const int*)(smem + LDS_GEMM);
    ProbG2 P{p, l, li, __builtin_amdgcn_readfirstlane(li[40]), 0, 0};
    gemm_phase<false>(P, wv);
}
__device__ __forceinline__ void d_moe_combine(CParams& p, int wv, int l, int last) {
    moe_offsets_lds(p, wv, l);
    const int tidx_ = opaque_tid(wv);
    int bidx_ = blockIdx.x, gdim_ = gridDim.x; asm volatile("" : "+s"(bidx_), "+s"(gdim_));
    const int* li = (const int*)(smem + LDS_GEMM);
    const int lane = tidx_ & 63, gw = bidx_ * 8 + (tidx_ >> 6), NGW = gdim_ * 8;
    for (int R = gw; R < NROW; R += NGW) {
        const int b = R / TPB, pos = R % TPB, mr = pos < CTXL ? 4 : b;
        if (last && pos < CTXL) continue;
        f32x4 acc[4];
#pragma unroll
        for (int i = 0; i < 4; ++i) acc[i] = (f32x4){0.f, 0.f, 0.f, 0.f};
#pragma unroll
        for (int k = 0; k < 4; ++k) {
            const float g = p.TOPG[R * 4 + k];
            const int sl = li[p.TOPI[R * 4 + k]] + p.TOKPOS[R * 4 + k];
            const bf16_t* yr = p.Y + (size_t)sl * DM + 8 * lane;
#pragma unroll
            for (int i = 0; i < 2; ++i) {
                const u32x4 w = *(const u32x4*)(yr + 512 * i);
                acc[2 * i] += g * (f32x4){__uint_as_float(w.x << 16), __uint_as_float(w.x & 0xffff0000u), __uint_as_float(w.y << 16), __uint_as_float(w.y & 0xffff0000u)};
                acc[2 * i + 1] += g * (f32x4){__uint_as_float(w.z << 16), __uint_as_float(w.z & 0xffff0000u), __uint_as_float(w.w << 16), __uint_as_float(w.w & 0xffff0000u)};
            }
        }
        const float* m5 = p.MOD + (l * 5 + mr) * 6144 + 5 * DM;
        f32x4 v[4]; float ss = 0.f;
#pragma unroll
        for (int q = 0; q < 4; ++q) {
            const int c = 512 * (q >> 1) + 8 * lane + 4 * (q & 1);
            v[q] = *(const f32x4*)(p.X2 + (size_t)R * DM + c) + *(const f32x4*)(m5 + c) * acc[q];
            ss += v[q][0] * v[q][0] + v[q][1] * v[q][1] + v[q][2] * v[q][2] + v[q][3] * v[q][3];
        }
        ss = wave_sum(ss);
        const float rinv = rsqrtf(ss * (1.f / DM) + 1e-6f);
        if (!last) {
            const float* gn = p.in[I_NMG] + (l + 1) * DM;
            const float* mod = p.MOD + ((l + 1) * 5 + mr) * 6144;
#pragma unroll
            for (int i = 0; i < 2; ++i) {
                const int c = 512 * i + 8 * lane;
                f32x4 o[2];
#pragma unroll
                for (int j = 0; j < 2; ++j) {
                    *(f32x4*)(p.X + (size_t)R * DM + c + 4 * j) = v[2 * i + j];
                    const f32x4 gg = *(const f32x4*)(gn + c + 4 * j), sh = *(const f32x4*)(mod + c + 4 * j), sc = *(const f32x4*)(mod + DM + c + 4 * j);
                    o[j] = v[2 * i + j] * rinv * gg * (sc + 1.f) + sh;
                }
                u32x4 ob; ob.x = cvt_pk_bf16(o[0][0], o[0][1]); ob.y = cvt_pk_bf16(o[0][2], o[0][3]); ob.z = cvt_pk_bf16(o[1][0], o[1][1]); ob.w = cvt_pk_bf16(o[1][2], o[1][3]);
                *(u32x4*)(p.H + (size_t)R * DM + c) = ob;
            }
        } else {
            float* orow = p.out + ((size_t)b * SEQ + (pos - CTXL)) * DM;
#pragma unroll
            for (int q = 0; q < 4; ++q) {
                const int c = 512 * (q >> 1) + 8 * lane + 4 * (q & 1);
                *(f32x4*)(orow + c) = v[q] * rinv * *(const f32x4*)(p.in[I_FING] + c);
            }
        }
    }
}

#define XB_TMO      128
#define XB_XCNT(j)  (256  + 64 * (j))
#define XB_XSUB(j)  (1280 + 64 * (j))
#define XB_XGEN(j)  (2304 + 64 * (j))
#define XB_TOP      3328
#define XB_TOPGEN   3392
#define XCD_BAR_WORDS 3456
#define XB_SPIN_CAP (1u << 18)
__device__ __forceinline__ unsigned xb_ld(unsigned* q)              { return __hip_atomic_load(q, __ATOMIC_RELAXED, __HIP_MEMORY_SCOPE_AGENT); }
__device__ __forceinline__ unsigned xb_add(unsigned* q, unsigned v) { return __hip_atomic_fetch_add(q, v, __ATOMIC_RELAXED, __HIP_MEMORY_SCOPE_AGENT); }
__device__ __forceinline__ unsigned xb_xcc_id() { return (unsigned)__builtin_amdgcn_s_getreg((3 << 11) | 20) & 0xFu; }
#define XB_SPIN(cond, bar) do { unsigned _sp = 0; while (cond) { __builtin_amdgcn_s_sleep(1); \
    if ((++_sp & 255u) == 0u) { if (xb_ld(&(bar)[XB_TMO])) break; if (_sp > XB_SPIN_CAP) { atomicAdd(&(bar)[XB_TMO], 1u); break; } } } } while (0)
__device__ __forceinline__ void xcd_barrier_complete(unsigned* bar, unsigned x, unsigned G, unsigned& nloc, unsigned& nx) {
    unsigned sum, cnt, mine, sp = 0u;
    for (;;) {
        sum = 0u; cnt = 0u; mine = 0u;
#pragma unroll
        for (unsigned j = 0; j < 16; ++j) { const unsigned c = xb_ld(&bar[XB_XCNT(j)]); sum += c; cnt += (c > 0u) ? 1u : 0u; mine = (j == x) ? c : mine; }
        if (sum == G) break;
        __builtin_amdgcn_s_sleep(1);
        if ((++sp & 255u) == 0u) { if (xb_ld(&bar[XB_TMO])) break; if (sp > XB_SPIN_CAP) { atomicAdd(&bar[XB_TMO], 1u); break; } }
    }
    nloc = mine > 0u ? mine : 1u; nx = cnt > 0u ? cnt : 1u;
}
__device__ __forceinline__ void xcd_barrier(unsigned* bar, volatile LAS unsigned* st, bool t0) {
    asm volatile("s_waitcnt vmcnt(0)" ::: "memory");
    __syncthreads();
    if (t0) {
        __builtin_amdgcn_s_waitcnt(0);
        const unsigned x = xb_xcc_id();
        unsigned nloc = st[0], nx = st[1];
        if (nloc == 0u) { xcd_barrier_complete(bar, x, gridDim.x, nloc, nx); st[0] = nloc; st[1] = nx; }
        const unsigned old = xb_add(&bar[XB_XSUB(x)], 1u);
        const unsigned gen = old / nloc;
        if (old + 1u == (gen + 1u) * nloc) {
            __builtin_amdgcn_fence(__ATOMIC_RELEASE, "agent");
            asm volatile("s_waitcnt vmcnt(0)" ::: "memory");
            const unsigned og = xb_add(&bar[XB_TOP], 1u);
            const unsigned tg = og / nx;
            if (og + 1u == (tg + 1u) * nx) xb_add(&bar[XB_TOPGEN], 1u);
            else XB_SPIN(xb_ld(&bar[XB_TOPGEN]) == tg, bar);
            __builtin_amdgcn_fence(__ATOMIC_ACQUIRE, "agent");
            xb_add(&bar[XB_XGEN(x)], 1u);
            asm volatile("s_waitcnt vmcnt(0)" ::: "memory");
        } else {
            XB_SPIN(xb_ld(&bar[XB_XGEN(x)]) == gen, bar);
            __builtin_amdgcn_fence(__ATOMIC_ACQUIRE, "agent");
            asm volatile("s_waitcnt vmcnt(0)" ::: "memory");
        }
    }
    __syncthreads();
}

#ifndef MULTI
#define MULTI 0
#endif
__device__ __forceinline__ void run_phase(CParams& p, int wv, int ph) {
    if (ph == 0) { d_prologue(p, wv); return; }
    if (ph == 1) { d_norm_mix(p, wv, 0); return; }
    const int l = (ph - 2) / 11, q = (ph - 2) % 11, last = l == 1;
    if (ph >= 24) return;
    const int bid = blockIdx.x, nblk = gridDim.x;
    switch (q) {
        case 0: d_gemm_in(p, wv, l);
                if (nblk == 256 && bid >= 48) {
                    if (l == 0) bg_moe_convert(p, wv, 0, (bid - 48) * BG_KIN, BG_KIN);
                    else { const int nt0 = moe_ntile(p, 0); const int f1 = bg_idle_first(nt0 * 8, 256), f2 = bg_idle_first(nt0 * 4, 256);
                           bg_moe_convert(p, wv, 1, (256 - f1) * BG_KMOE + (256 - f2) * BG_KMOE + (bid - 48) * BG_KIN, BG_KIN); } }
                break;
        case 1: d_lru_local(p, wv, l); d_rwkv_pre(p, wv, l); break;
        case 2: d_rwkv_chunkA(p, wv, l); break;
        case 3: d_scan_attn(p, wv, l, !last); break;
        case 4: d_finish(p, wv, l, last); break;
        case 5: d_gemm_out(p, wv, l, last);
                if (nblk == 256 && l == 0 && bid >= 16) bg_moe_convert(p, wv, 0, 208 * BG_KIN + (bid - 16) * BG_KOUT, BG_KOUT);
                break;
        case 6: d_norm_router(p, wv, l, last); break;
        case 7: d_moe_scatter(p, wv, l, last);
                {
                    int start;
                    if (nblk != 256) start = 0;
                    else if (l == 0) start = 208 * BG_KIN + 240 * BG_KOUT;
                    else { const int nt0 = moe_ntile(p, 0); start = (256 - bg_idle_first(nt0 * 8, 256)) * BG_KMOE + (256 - bg_idle_first(nt0 * 4, 256)) * BG_KMOE + 208 * BG_KIN; }
                    const int rem = MOE_ITEMS - start;
                    if (rem > 0) { const int per = (rem + nblk - 1) / nblk; const int f = start + bid * per; bg_moe_convert(p, wv, l, f, min(per, MOE_ITEMS - f)); }
                }
                break;
        case 8: d_moe_gemm1(p, wv, l);
                if (nblk == 256 && l == 0) { const int f1 = bg_idle_first(moe_ntile(p, 0) * 8, 256); if (bid >= f1) bg_moe_convert(p, wv, 1, (bid - f1) * BG_KMOE, BG_KMOE); }
                break;
        case 9: d_moe_gemm2(p, wv, l);
                if (nblk == 256 && l == 0) { const int nt0 = moe_ntile(p, 0); const int f1 = bg_idle_first(nt0 * 8, 256), f2 = bg_idle_first(nt0 * 4, 256);
                    if (bid >= f2) bg_moe_convert(p, wv, 1, (256 - f1) * BG_KMOE + (bid - f2) * BG_KMOE, BG_KMOE); }
                break;
        case 10: d_moe_combine(p, wv, l, last); break;
    }
}
#if MULTI
template <int PH> __global__ void __launch_bounds__(NTHR) mega_ph(Params p) { CParams* pp = (CParams*)__builtin_amdgcn_kernarg_segment_ptr(); run_phase(*pp, __builtin_amdgcn_readfirstlane(threadIdx.x >> 6), PH); }
__global__ void __launch_bounds__(NTHR) mega(Params p) {}
template <int PH> static void launch_all(const Params& p, int grid, hipStream_t stream) {
    static bool attr = false; if (!attr) { (void)hipFuncSetAttribute((const void*)mega_ph<PH>, hipFuncAttributeMaxDynamicSharedMemorySize, LDS_BYTES); attr = true; }
    mega_ph<PH><<<grid, NTHR, LDS_BYTES, stream>>>(p);
    if constexpr (PH + 1 < 24) launch_all<PH + 1>(p, grid, stream);
}
#else
__global__ void __launch_bounds__(NTHR) mega(Params p) {
    cg::grid_group grid = cg::this_grid();
    const int wv = __builtin_amdgcn_readfirstlane(threadIdx.x >> 6);
    volatile LAS unsigned* xst = (volatile LAS unsigned*)((LAS unsigned char*)smem + LDS_BYTES - 16);
    if (threadIdx.x == 0) { xst[0] = 0u; xst[1] = 0u; (void)xb_add(&p.BAR[XB_XCNT(xb_xcc_id())], 1u); }
    __syncthreads();
#define RUNPH(n) { CParams* pp = (CParams*)__builtin_amdgcn_kernarg_segment_ptr(); asm volatile("" : "+s"(pp)); run_phase(*pp, wv, n); \
    if (n == 0) grid.sync(); else if (n < 23) xcd_barrier(pp->BAR, xst, opaque_tid(wv) == 0); }
    RUNPH(0) RUNPH(1) RUNPH(2) RUNPH(3) RUNPH(4) RUNPH(5) RUNPH(6) RUNPH(7) RUNPH(8) RUNPH(9) RUNPH(10)
    RUNPH(11) RUNPH(12) RUNPH(13) RUNPH(14) RUNPH(15) RUNPH(16) RUNPH(17) RUNPH(18) RUNPH(19) RUNPH(20) RUNPH(21) RUNPH(22) RUNPH(23)
}
#endif

extern "C" void kernel_launch(void* const* d_in, const int* in_sizes, int n_in, void* d_out, int out_size, void* d_ws, size_t ws_size,
                              hipStream_t stream) {
    Params p{};
    for (int i = 0; i < N_IN; ++i) p.in[i] = (const float*)d_in[i];
    p.out = (float*)d_out;
    char* w = (char*)d_ws;
    size_t off = 0;
    auto take = [&](size_t bytes) { void* r = w + off; off += (bytes + 255) & ~(size_t)255; return r; };
    p.X = (float*)take((size_t)NROW * DM * 4);
    p.X2 = (float*)take((size_t)NROW * DM * 4);
    p.H = (bf16_t*)take((size_t)NROW * DM * 2);
    p.P = (float*)take((size_t)NROW * PST * 4);
    p.QH = (bf16_t*)take((size_t)NROW * 512 * 2);
    p.KH = (bf16_t*)take((size_t)NROW * 512 * 2);
    p.VT = (bf16_t*)take((size_t)NROW * 512 * 2);
    p.MIX = (bf16_t*)take((size_t)NROW * DM * 2);
    p.MOD = (float*)take(2 * 5 * 6144 * 4);
    p.LA = (float*)take((size_t)2 * NROW * 256 * 4);
    p.LB = (float*)take((size_t)2 * NROW * 256 * 4);
    p.LCE = (float*)take((size_t)2176 * 128 * 4);
    p.LCI = (float*)take((size_t)4 * 2 * 68 * 256 * 4);
    p.RS = (float*)take((size_t)NROW * 768 * 4);
    p.DEC = (float*)take((size_t)2 * NROW * 256 * 4);
    p.AIC = (float*)take((size_t)2 * NROW * 256 * 4);
    p.KKN = (float*)take((size_t)NROW * 256 * 4);
    p.GG = (float*)take((size_t)NROW * 256 * 4);
    p.YB = (float*)take((size_t)2 * NROW * 256 * 4);
    p.TOPG = (float*)take((size_t)NROW * 4 * 4);
    p.TOPI = (int*)take((size_t)NROW * 4 * 4);
    p.TOKPOS = (int*)take((size_t)NROW * 4 * 4);
    p.CNT = (int*)take(64 * 4);
    p.SLOT_TOK = (int*)take((size_t)CAP * 4);
    p.ACT = (bf16_t*)take((size_t)CAP * DM * 2);
    p.Y = (bf16_t*)take((size_t)CAP * DM * 2);
    p.BAR = (unsigned*)take((size_t)XCD_BAR_WORDS * 4);
    p.LWT = (bf16_t*)take((size_t)2 * 2 * 4 * 2 * 4096 * 2);
    p.RWT = (bf16_t*)take((size_t)2 * 5 * 16384 * 2);
    p.RMF = (bf16_t*)take((size_t)2176 * 4096 * 2);
    p.RQF = (bf16_t*)take((size_t)2176 * 4096 * 2);
    p.RNF = (float*)take((size_t)2176 * 4096 * 4);
    p.RYF = (float*)take((size_t)2176 * 4096 * 4);
    p.S0F = (bf16_t*)take((size_t)2176 * 4096 * 2);
    p.WTIN = (bf16_t*)take((size_t)2 * INCP * DM * 2);
    p.WTOUT = (bf16_t*)take((size_t)2 * DM * DM * 2);
    p.WTGU = (bf16_t*)take((size_t)2 * NEXP * 2048 * DM * 2);
    p.WTDN = (bf16_t*)take((size_t)2 * NEXP * DM * DM * 2);

    static int grid_blocks = 0;
    if (!grid_blocks) {
        int dev = 0, cus = 0, per_cu = 0;
        (void)hipGetDevice(&dev);
        (void)hipDeviceGetAttribute(&cus, hipDeviceAttributeMultiprocessorCount, dev);
        (void)hipFuncSetAttribute((const void*)mega, hipFuncAttributeMaxDynamicSharedMemorySize, LDS_BYTES);
        (void)hipOccupancyMaxActiveBlocksPerMultiprocessor(&per_cu, (const void*)mega, NTHR, LDS_BYTES);
        if (per_cu > 1) per_cu = 1;
        if (per_cu < 1) { fprintf(stderr, "occupancy query says %d blocks/CU\n", per_cu); per_cu = 1; }
        grid_blocks = cus * per_cu;
        (void)hipGetLastError();
    }
#if MULTI
    launch_all<0>(p, grid_blocks, stream);
#else
    (void)hipMemsetAsync(p.BAR, 0, (size_t)XCD_BAR_WORDS * 4, stream);
    void* args[] = {&p};
    hipError_t e = hipLaunchCooperativeKernel((void*)mega, dim3(grid_blocks), dim3(NTHR), args, LDS_BYTES, stream);
    if (e != hipSuccess) fprintf(stderr, "cooperative launch failed: %s (grid %d)\n", hipGetErrorString(e), grid_blocks);
#endif
}
```
